# Optimizing an MI355X kernel written in HIP

```python
import math
import jax
import jax.numpy as jnp
from jax import lax
import numpy as np

D_MODEL = 1024
BATCH = 8
SEQ = 2048
DEPTH = 2

CTX_LEN = 256
GRID_W = 64
NORM_EPS = 1e-6
N_MOD = 6

GROUP_W = D_MODEL // 4
HEAD_DIM = 64

RWKV_HEADS = GROUP_W // HEAD_DIM
RWKV_DECAY_LORA = 32
RWKV_AAA_LORA = 32
RWKV_GATE_LORA = 64
RWKV_GN_EPS = 64e-5
RWKV_COLS = 3 * GROUP_W + RWKV_GATE_LORA + 2 * RWKV_DECAY_LORA + 2 * RWKV_AAA_LORA

RET_HEADS = GROUP_W // HEAD_DIM
RET_CHUNK = 128
RET_GN_EPS = 1e-5
RET_FWD_OFFSET = 5.0
RET_BWD_OFFSET = 5.5
ROPE_BASE = 10000.0
RET_COLS = 4 * GROUP_W

LRU_BLOCKS = 4
LRU_BLOCK_W = GROUP_W // LRU_BLOCKS
LRU_CONV_W = 4
LRU_C = 8.0
LRU_COLS = 2 * GROUP_W

S5_CH = 16
S5_GROUPS = GROUP_W // S5_CH
S5_STATE = 64
S5_DT_MIN = 0.001
S5_DT_MAX = 0.1
S5_COLS = GROUP_W

IN_COLS = RWKV_COLS + RET_COLS + LRU_COLS + S5_COLS

PEER_HEADS = 8
PEER_NKEYS = 128
PEER_EXPERTS = PEER_NKEYS * PEER_NKEYS
PEER_DKEY = 128
PEER_TOPK = 16
PEER_BLOCK = 128

kernel_name = 'hybrid_parallel_heads_dit_peer'


def _f32(*ts):
    return [t.astype(jnp.float32) for t in ts]


def rmsnorm(x, g):
    xf = x.astype(jnp.float32)
    y = xf * lax.rsqrt(jnp.mean(xf * xf, axis=-1, keepdims=True) + NORM_EPS)
    return (y * g.astype(jnp.float32)).astype(x.dtype)


def modulate(h, shift, scale):
    return h * (1.0 + scale) + shift


def head_norm(y, eps):
    mu = jnp.mean(y, axis=-1, keepdims=True)
    var = jnp.mean(jnp.square(y - mu), axis=-1, keepdims=True)
    return (y - mu) * lax.rsqrt(var + eps)


def to_heads(t, n_heads):
    return t.reshape(t.shape[0], t.shape[1], n_heads, t.shape[-1] // n_heads)


def maybe_flip(t, rev):
    return jnp.flip(t, axis=1) if rev else t


def shift_prev(z):
    return jnp.pad(z, ((0, 0), (1, 0), (0, 0)))[:, :-1]


def shift_next(z):
    return jnp.pad(z, ((0, 0), (0, 1), (0, 0)))[:, 1:]


def linear_combine(left, right):
    a_l, b_l = left
    a_r, b_r = right
    return a_l * a_r, a_r * b_l + b_r


def linear_scan(a, b, h0, reverse):
    a_cum, h = lax.associative_scan(linear_combine, (a, b), axis=1, reverse=reverse)
    h = h + a_cum * h0[:, None]
    h_final = h[:, 0] if reverse else h[:, -1]
    return h, h_final


def rwkv7_features(za, mu, w0, w_up, a0, a_up, g_up, k_k, k_a):
    z = za + mu[0] * (shift_prev(za) - za) + mu[1] * (shift_next(za) - za)
    splits = [GROUP_W, 2 * GROUP_W, 3 * GROUP_W, 3 * GROUP_W + RWKV_GATE_LORA,
              3 * GROUP_W + RWKV_GATE_LORA + 2 * RWKV_DECAY_LORA]
    r, k, v, g_low, w_low, a_low = jnp.split(z, splits, axis=-1)
    g = jax.nn.sigmoid(g_low) @ g_up
    kk = to_heads(k * k_k, RWKV_HEADS)
    kk = kk / jnp.maximum(jnp.sqrt(jnp.sum(kk * kk, axis=-1, keepdims=True)), 1e-12)
    per_dir = []
    for d in range(2):
        w_lo = w_low[..., d * RWKV_DECAY_LORA:(d + 1) * RWKV_DECAY_LORA]
        a_lo = a_low[..., d * RWKV_AAA_LORA:(d + 1) * RWKV_AAA_LORA]
        w_log = -jax.nn.softplus(-(w0[d] + jnp.tanh(w_lo) @ w_up[d])) - 0.5
        decay = jnp.exp(-jnp.exp(w_log))
        a = jax.nn.sigmoid(a0[d] + a_lo @ a_up[d])
        k_d = k * (1.0 + (a - 1.0) * k_a)
        per_dir.append((to_heads(decay, RWKV_HEADS), to_heads(k_d, RWKV_HEADS),
                        -kk, kk * to_heads(a, RWKV_HEADS)))
    return to_heads(r, RWKV_HEADS), to_heads(k, RWKV_HEADS), to_heads(v, RWKV_HEADS), g, per_dir


def rwkv7_scan(r, v, w, k, a_vec, b_vec, s0, reverse):
    def step(s, inp):
        r_t, v_t, w_t, k_t, a_t, b_t = inp
        sa = jnp.einsum('bhvk,bhk->bhv', s, a_t)
        s = s * w_t[:, :, None, :] + sa[..., None] * b_t[:, :, None, :] + v_t[..., None] * k_t[:, :, None, :]
        return s, jnp.einsum('bhvk,bhk->bhv', s, r_t)
    xs = tuple(jnp.swapaxes(t, 0, 1) for t in (r, v, w, k, a_vec, b_vec))
    s_final, y = lax.scan(step, s0, xs, reverse=reverse)
    return jnp.swapaxes(y, 0, 1), s_final


def rwkv7_output(feat, y, r_k, ln_g, ln_b):
    r, k, v, g, _ = feat
    n_b, seq_len = g.shape[:2]
    yn = head_norm(y, RWKV_GN_EPS) * ln_g.reshape(RWKV_HEADS, HEAD_DIM) + ln_b.reshape(RWKV_HEADS, HEAD_DIM)
    bonus = jnp.sum(r * k * r_k, axis=-1, keepdims=True) * v
    return (yn + bonus).reshape(n_b, seq_len, GROUP_W) * g


def rwkv7_mixer(za_ctx, za_lat, mu, w0, w_up, a0, a_up, g_up, k_k, k_a, r_k, ln_g, ln_b):
    mu, w0, w_up, a0, a_up, g_up, k_k, k_a, r_k, ln_g, ln_b = _f32(mu, w0, w_up, a0, a_up, g_up, k_k, k_a, r_k, ln_g, ln_b)
    feats = [rwkv7_features(z, mu, w0, w_up, a0, a_up, g_up, k_k, k_a) for z in (za_ctx, za_lat)]
    s0 = jnp.zeros((za_lat.shape[0], RWKV_HEADS, HEAD_DIM, HEAD_DIM), jnp.float32)
    y_ctx, y_lat = 0.0, 0.0
    for d, rev in enumerate((False, True)):
        r, _, v, _, dirs = feats[0]
        yc, s_ctx = rwkv7_scan(r, v, *dirs[d], s0, rev)
        r, _, v, _, dirs = feats[1]
        yl, _ = rwkv7_scan(r, v, *dirs[d], s_ctx, rev)
        y_ctx, y_lat = y_ctx + yc, y_lat + yl
    return rwkv7_output(feats[0], y_ctx, r_k, ln_g, ln_b), rwkv7_output(feats[1], y_lat, r_k, ln_g, ln_b)


def rope(x, pos):
    half = x.shape[-1] // 2
    freqs = ROPE_BASE ** (-jnp.arange(half, dtype=jnp.float32) / half)
    ang = pos.astype(jnp.float32)[:, None] * freqs[None]
    cos = jnp.cos(ang)[None, :, None, :]
    sin = jnp.sin(ang)[None, :, None, :]
    x1, x2 = x[..., :half], x[..., half:]
    return jnp.concatenate([x1 * cos - x2 * sin, x1 * sin + x2 * cos], axis=-1)


def retention_log_gammas(offset):
    return jnp.log1p(-jnp.exp2(-(offset + jnp.arange(RET_HEADS, dtype=jnp.float32))))


def retention_chunkwise(q, k, v, log_gamma, strict, s0):
    n_b, seq_len, n_h, _ = q.shape
    n_c = seq_len // RET_CHUNK
    idx = jnp.arange(RET_CHUNK, dtype=jnp.float32)
    diff = idx[:, None] - idx[None, :]
    mask = diff > 0 if strict else diff >= 0
    inner_decay = jnp.where(mask[None], jnp.exp(log_gamma[:, None, None] * jnp.where(mask, diff, 0.0)[None]), 0.0)
    read_decay = jnp.exp(log_gamma[:, None] * (idx + 1.0)[None])
    write_decay = jnp.exp(log_gamma[:, None] * (RET_CHUNK - 1.0 - idx)[None])
    chunk_decay = jnp.exp(log_gamma * RET_CHUNK)

    def chunks(t):
        return t.reshape(n_b, n_c, RET_CHUNK, n_h, t.shape[-1]).transpose(1, 0, 3, 2, 4)

    def step(s, inp):
        q_i, k_i, v_i = inp
        att = jnp.einsum('bhid,bhjd->bhij', q_i, k_i) * inner_decay
        o = (jnp.einsum('bhij,bhjv->bhiv', att, v_i)
             + jnp.einsum('bhid,bhdv->bhiv', q_i, s) * read_decay[None, :, :, None])
        s = s * chunk_decay[None, :, None, None] + jnp.einsum('bhjd,bhjv->bhdv', k_i * write_decay[None, :, :, None], v_i)
        return s, o

    s_final, o = lax.scan(step, s0, (chunks(q), chunks(k), chunks(v)))
    return o.transpose(1, 0, 3, 2, 4).reshape(n_b, seq_len, n_h, -1), s_final


def retention_mixer(zb_ctx, zb_lat, gn_g):
    (gn_g,) = _f32(gn_g)
    n_b, l_ctx = zb_ctx.shape[:2]
    l_lat = zb_lat.shape[1]
    positions = (jnp.arange(l_ctx), l_ctx + jnp.arange(l_lat))
    seqs = []
    for z, pos in zip((zb_ctx, zb_lat), positions):
        q, k, v, gate = jnp.split(z, 4, axis=-1)
        q = rope(to_heads(q, RET_HEADS), pos) * HEAD_DIM ** -0.5
        k = rope(to_heads(k, RET_HEADS), pos)
        seqs.append((q, k, to_heads(v, RET_HEADS), gate))
    s0 = jnp.zeros((n_b, RET_HEADS, HEAD_DIM, HEAD_DIM), jnp.float32)
    (qc, kc, vc, gc), (ql, kl, vl, gl) = seqs
    y_ctx, y_lat = 0.0, 0.0
    for offset, rev in ((RET_FWD_OFFSET, False), (RET_BWD_OFFSET, True)):
        lg = retention_log_gammas(offset)
        oc, s_ctx = retention_chunkwise(maybe_flip(qc, rev), maybe_flip(kc, rev), maybe_flip(vc, rev), lg, rev, s0)
        ol, _ = retention_chunkwise(maybe_flip(ql, rev), maybe_flip(kl, rev), maybe_flip(vl, rev), lg, rev, s_ctx)
        y_ctx, y_lat = y_ctx + maybe_flip(oc, rev), y_lat + maybe_flip(ol, rev)
    g_h = gn_g.reshape(RET_HEADS, HEAD_DIM)
    out_ctx = jax.nn.silu(gc) * (head_norm(y_ctx, RET_GN_EPS) * g_h).reshape(n_b, l_ctx, GROUP_W)
    out_lat = jax.nn.silu(gl) * (head_norm(y_lat, RET_GN_EPS) * g_h).reshape(n_b, l_lat, GROUP_W)
    return out_ctx, out_lat


def dwconv_centred(z, w, b):
    left = LRU_CONV_W // 2
    right = LRU_CONV_W - 1 - left
    y = lax.conv_general_dilated(z, w[:, None, :], window_strides=(1,), padding=[(left, right)],
                                 dimension_numbers=('NWC', 'WIO', 'NWC'), feature_group_count=z.shape[-1])
    return y + b


def rglru_coeffs(xc, wa, ba, wx, bx, lam):
    xb = to_heads(xc, LRU_BLOCKS)
    r = jax.nn.sigmoid(jnp.einsum('blhi,hij->blhj', xb, wa).reshape(xc.shape) + ba)
    i = jax.nn.sigmoid(jnp.einsum('blhi,hij->blhj', xb, wx).reshape(xc.shape) + bx)
    log_a = -LRU_C * r * jax.nn.softplus(-lam)
    a = jnp.exp(log_a)
    b = jnp.sqrt(-jnp.expm1(2.0 * log_a)) * (i * xc)
    return a, b


def rglru_mixer(zc_ctx, zc_lat, conv_w, conv_b, wa, ba, wx, bx, lam):
    conv_w, conv_b, wa, ba, wx, bx, lam = _f32(conv_w, conv_b, wa, ba, wx, bx, lam)
    xs, gates = [], []
    for z in (zc_ctx, zc_lat):
        x_in, gate = jnp.split(z, 2, axis=-1)
        xs.append(dwconv_centred(x_in, conv_w, conv_b))
        gates.append(gate)
    h0 = jnp.zeros((zc_lat.shape[0], GROUP_W), jnp.float32)
    h_ctx, h_lat = 0.0, 0.0
    for d, rev in enumerate((False, True)):
        a, b = rglru_coeffs(xs[0], wa[d], ba[d], wx[d], bx[d], lam[d])
        hc, hc_final = linear_scan(a, b, h0, rev)
        a, b = rglru_coeffs(xs[1], wa[d], ba[d], wx[d], bx[d], lam[d])
        hl, _ = linear_scan(a, b, hc_final, rev)
        h_ctx, h_lat = h_ctx + hc, h_lat + hl
    return jax.nn.gelu(gates[0]) * h_ctx, jax.nn.gelu(gates[1]) * h_lat


def grid_to_colmajor(z):
    n_b, seq_len, ch = z.shape
    rows = seq_len // GRID_W
    return z.reshape(n_b, rows, GRID_W, ch).transpose(0, 2, 1, 3).reshape(n_b, seq_len, ch)


def colmajor_to_grid(z):
    n_b, seq_len, ch = z.shape
    rows = seq_len // GRID_W
    return z.reshape(n_b, GRID_W, rows, ch).transpose(0, 2, 1, 3).reshape(n_b, seq_len, ch)


def s5_discretise(a_re, a_im, log_dt, b_re, b_im):
    lam = lax.complex(a_re, a_im)
    lam_bar = jnp.exp(lam * jnp.exp(log_dt)[:, None])
    b_bar = ((lam_bar - 1.0) / lam)[..., None] * lax.complex(b_re, b_im)
    return lam_bar, b_bar


def s5_direction(u, lam_bar, b_bar, c_re, c_im, h0, reverse):
    n_b, seq_len, _ = u.shape
    ug = u.reshape(n_b, seq_len, S5_GROUPS, S5_CH).astype(jnp.complex64)
    bu = jnp.einsum('blgc,gpc->blgp', ug, b_bar)
    a = jnp.broadcast_to(lam_bar, bu.shape)
    h, h_final = linear_scan(a, bu, h0, reverse)
    y = jnp.einsum('blgp,gcp->blgc', h.real, c_re) - jnp.einsum('blgp,gcp->blgc', h.imag, c_im)
    return y.reshape(n_b, seq_len, GROUP_W), h_final


def s5_mixer(zd_ctx, zd_lat, a_re, a_im, log_dt, b_re, b_im, c_re, c_im, d_skip, glu_w, glu_b):
    a_re, a_im, log_dt, b_re, b_im, c_re, c_im, d_skip, glu_w, glu_b = _f32(
        a_re, a_im, log_dt, b_re, b_im, c_re, c_im, d_skip, glu_w, glu_b)
    u_ctx = zd_ctx
    u_lat = grid_to_colmajor(zd_lat)
    h0 = jnp.zeros((zd_lat.shape[0], S5_GROUPS, S5_STATE), jnp.complex64)
    y_ctx, y_lat = d_skip * u_ctx, d_skip * u_lat
    for d, rev in enumerate((False, True)):
        lam_bar, b_bar = s5_discretise(a_re[d], a_im[d], log_dt[d], b_re[d], b_im[d])
        yc, hc_final = s5_direction(u_ctx, lam_bar, b_bar, c_re[d], c_im[d], h0, rev)
        yl, _ = s5_direction(u_lat, lam_bar, b_bar, c_re[d], c_im[d], hc_final, rev)
        y_ctx, y_lat = y_ctx + yc, y_lat + yl
    y_lat = colmajor_to_grid(y_lat)

    def glu(y):
        val, gate = jnp.split(jax.nn.gelu(y) @ glu_w + glu_b, 2, axis=-1)
        return val * jax.nn.sigmoid(gate)

    return glu(y_ctx), glu(y_lat)


def peer_ffn(h, w_q, sub_keys, u, v):
    n_b, seq_len, dim = h.shape
    tok = h.reshape(-1, dim)
    n_tok = tok.shape[0]
    q = (tok @ w_q).reshape(n_tok, PEER_HEADS, 2, PEER_DKEY).astype(jnp.float32)
    s = jnp.einsum('thpd,hpnd->thpn', q, sub_keys.astype(jnp.float32))
    s1, i1 = lax.top_k(s[:, :, 0], PEER_TOPK)
    s2, i2 = lax.top_k(s[:, :, 1], PEER_TOPK)
    n_cand = PEER_TOPK * PEER_TOPK
    cand_s = (s1[..., :, None] + s2[..., None, :]).reshape(n_tok, PEER_HEADS, n_cand)
    cand_i = (i1[..., :, None] * PEER_NKEYS + i2[..., None, :]).reshape(n_tok, PEER_HEADS, n_cand)
    top_s, top_pos = lax.top_k(cand_s, PEER_TOPK)
    expert = jnp.take_along_axis(cand_i, top_pos, axis=-1)
    gate = jax.nn.softmax(top_s, axis=-1).astype(h.dtype)
    n_blk = n_tok // PEER_BLOCK

    def block(args):
        x_b, e_b, g_b = args
        u_sel = jnp.take(u, e_b, axis=0)
        v_sel = jnp.take(v, e_b, axis=0)
        act = jax.nn.gelu(jnp.einsum('td,thkd->thk', x_b, u_sel))
        return jnp.einsum('thk,thkd->td', g_b * act, v_sel)

    out = lax.map(block, (tok.reshape(n_blk, PEER_BLOCK, dim),
                          expert.reshape(n_blk, PEER_BLOCK, PEER_HEADS, PEER_TOPK),
                          gate.reshape(n_blk, PEER_BLOCK, PEER_HEADS, PEER_TOPK)))
    return out.reshape(n_b, seq_len, dim)


def setup_inputs(seed: int = 0) -> dict:
    key = jax.random.key(seed)
    keys = jax.random.split(key, 64)
    counter = [0]
    f32 = jnp.float32

    def nk():
        k = keys[counter[0]]
        counter[0] += 1
        return k

    def nrm(shape, scale):
        return scale * jax.random.normal(nk(), shape, f32)

    def uni(shape, lo, hi):
        return jax.random.uniform(nk(), shape, f32, lo, hi)

    lru_s = uni((DEPTH, 2, GROUP_W), 0.9, 0.999) ** (1.0 / LRU_C)
    s5_shape = (DEPTH, 2, S5_GROUPS, S5_STATE)
    return {
        'x': nrm((BATCH, SEQ, D_MODEL), 1.0),
        'c': nrm((BATCH, D_MODEL), 1.0),
        'ctx': nrm((BATCH, CTX_LEN, D_MODEL), 1.0),
        'c_ctx': nrm((D_MODEL,), 1.0),
        'norm1_g': 1.0 + nrm((DEPTH, D_MODEL), 0.05),
        'norm2_g': 1.0 + nrm((DEPTH, D_MODEL), 0.05),
        'ada_w': nrm((DEPTH, D_MODEL, N_MOD * D_MODEL), 0.5 * D_MODEL ** -0.5),
        'ada_b': nrm((DEPTH, N_MOD * D_MODEL), 0.1),
        'w_in': nrm((DEPTH, D_MODEL, IN_COLS), D_MODEL ** -0.5),
        'w_out': nrm((DEPTH, D_MODEL, D_MODEL), D_MODEL ** -0.5),
        'rwkv_mu': uni((DEPTH, 2, RWKV_COLS), 0.0, 0.5),
        'rwkv_w0': uni((DEPTH, 2, GROUP_W), -6.5, -1.5),
        'rwkv_w_up': nrm((DEPTH, 2, RWKV_DECAY_LORA, GROUP_W), 0.1 * RWKV_DECAY_LORA ** -0.5),
        'rwkv_a0': nrm((DEPTH, 2, GROUP_W), 0.1),
        'rwkv_a_up': nrm((DEPTH, 2, RWKV_AAA_LORA, GROUP_W), 0.5 * RWKV_AAA_LORA ** -0.5),
        'rwkv_g_up': nrm((DEPTH, RWKV_GATE_LORA, GROUP_W), RWKV_GATE_LORA ** -0.5),
        'rwkv_k_k': 0.85 + nrm((DEPTH, GROUP_W), 0.05),
        'rwkv_k_a': 1.0 + nrm((DEPTH, GROUP_W), 0.05),
        'rwkv_r_k': nrm((DEPTH, RWKV_HEADS, HEAD_DIM), 0.05),
        'rwkv_ln_g': 1.0 + nrm((DEPTH, GROUP_W), 0.05),
        'rwkv_ln_b': nrm((DEPTH, GROUP_W), 0.02),
        'ret_gn_g': 1.0 + nrm((DEPTH, GROUP_W), 0.05),
        'lru_conv_w': nrm((DEPTH, LRU_CONV_W, GROUP_W), LRU_CONV_W ** -0.5),
        'lru_conv_b': nrm((DEPTH, GROUP_W), 0.02),
        'lru_wa': nrm((DEPTH, 2, LRU_BLOCKS, LRU_BLOCK_W, LRU_BLOCK_W), LRU_BLOCK_W ** -0.5),
        'lru_ba': nrm((DEPTH, 2, GROUP_W), 0.02),
        'lru_wx': nrm((DEPTH, 2, LRU_BLOCKS, LRU_BLOCK_W, LRU_BLOCK_W), LRU_BLOCK_W ** -0.5),
        'lru_bx': nrm((DEPTH, 2, GROUP_W), 0.02),
        'lru_lambda': jnp.log(lru_s) - jnp.log1p(-lru_s),
        's5_a_re': -0.5 + nrm(s5_shape, 0.01),
        's5_a_im': jnp.pi * jnp.arange(S5_STATE, dtype=f32) + nrm(s5_shape, 0.01),
        's5_log_dt': uni((DEPTH, 2, S5_GROUPS), math.log(S5_DT_MIN), math.log(S5_DT_MAX)),
        's5_b_re': nrm((DEPTH, 2, S5_GROUPS, S5_STATE, S5_CH), (2.0 * S5_CH) ** -0.5),
        's5_b_im': nrm((DEPTH, 2, S5_GROUPS, S5_STATE, S5_CH), (2.0 * S5_CH) ** -0.5),
        's5_c_re': nrm((DEPTH, 2, S5_GROUPS, S5_CH, S5_STATE), S5_STATE ** -0.5),
        's5_c_im': nrm((DEPTH, 2, S5_GROUPS, S5_CH, S5_STATE), S5_STATE ** -0.5),
        's5_d': nrm((DEPTH, GROUP_W), 0.5),
        's5_glu_w': nrm((DEPTH, GROUP_W, 2 * GROUP_W), GROUP_W ** -0.5),
        's5_glu_b': nrm((DEPTH, 2 * GROUP_W), 0.02),
        'peer_wq': nrm((DEPTH, D_MODEL, PEER_HEADS * 2 * PEER_DKEY), D_MODEL ** -0.5),
        'peer_keys': nrm((DEPTH, PEER_HEADS, 2, PEER_NKEYS, PEER_DKEY), PEER_DKEY ** -0.5),
        'peer_u': nrm((DEPTH, PEER_EXPERTS, D_MODEL), D_MODEL ** -0.5),
        'peer_v': nrm((DEPTH, PEER_EXPERTS, D_MODEL), 0.5),
        'final_norm_g': 1.0 + nrm((D_MODEL,), 0.05),
    }


def reference(x, c, ctx, c_ctx, norm1_g, norm2_g, ada_w, ada_b, w_in, w_out,
              rwkv_mu, rwkv_w0, rwkv_w_up, rwkv_a0, rwkv_a_up, rwkv_g_up, rwkv_k_k, rwkv_k_a,
              rwkv_r_k, rwkv_ln_g, rwkv_ln_b, ret_gn_g,
              lru_conv_w, lru_conv_b, lru_wa, lru_ba, lru_wx, lru_bx, lru_lambda,
              s5_a_re, s5_a_im, s5_log_dt, s5_b_re, s5_b_im, s5_c_re, s5_c_im, s5_d, s5_glu_w, s5_glu_b,
              peer_wq, peer_keys, peer_u, peer_v, final_norm_g):
    split_cols = [RWKV_COLS, RWKV_COLS + RET_COLS, RWKV_COLS + RET_COLS + LRU_COLS]
    for l in range(DEPTH):
        mod_lat = jnp.split((jax.nn.silu(c) @ ada_w[l] + ada_b[l])[:, None, :], N_MOD, axis=-1)
        mod_ctx = jnp.split(jax.nn.silu(c_ctx) @ ada_w[l] + ada_b[l], N_MOD, axis=-1)

        z_lat = modulate(rmsnorm(x, norm1_g[l]), mod_lat[0], mod_lat[1]) @ w_in[l]
        z_ctx = modulate(rmsnorm(ctx, norm1_g[l]), mod_ctx[0], mod_ctx[1]) @ w_in[l]
        zl = jnp.split(z_lat.astype(jnp.float32), split_cols, axis=-1)
        zc = jnp.split(z_ctx.astype(jnp.float32), split_cols, axis=-1)

        ya = rwkv7_mixer(zc[0], zl[0], rwkv_mu[l], rwkv_w0[l], rwkv_w_up[l], rwkv_a0[l], rwkv_a_up[l],
                         rwkv_g_up[l], rwkv_k_k[l], rwkv_k_a[l], rwkv_r_k[l], rwkv_ln_g[l], rwkv_ln_b[l])
        yb = retention_mixer(zc[1], zl[1], ret_gn_g[l])
        yc = rglru_mixer(zc[2], zl[2], lru_conv_w[l], lru_conv_b[l], lru_wa[l], lru_ba[l],
                         lru_wx[l], lru_bx[l], lru_lambda[l])
        yd = s5_mixer(zc[3], zl[3], s5_a_re[l], s5_a_im[l], s5_log_dt[l], s5_b_re[l], s5_b_im[l],
                      s5_c_re[l], s5_c_im[l], s5_d[l], s5_glu_w[l], s5_glu_b[l])

        mix_lat = jnp.concatenate([ya[1], yb[1], yc[1], yd[1]], axis=-1).astype(x.dtype) @ w_out[l]
        x = x + mod_lat[2] * mix_lat
        h2 = modulate(rmsnorm(x, norm2_g[l]), mod_lat[3], mod_lat[4])
        x = x + mod_lat[5] * peer_ffn(h2, peer_wq[l], peer_keys[l], peer_u[l], peer_v[l])

        if l < DEPTH - 1:
            mix_ctx = jnp.concatenate([ya[0], yb[0], yc[0], yd[0]], axis=-1).astype(ctx.dtype) @ w_out[l]
            ctx = ctx + mod_ctx[2] * mix_ctx
            h2c = modulate(rmsnorm(ctx, norm2_g[l]), mod_ctx[3], mod_ctx[4])
            ctx = ctx + mod_ctx[5] * peer_ffn(h2c, peer_wq[l], peer_keys[l], peer_u[l], peer_v[l])
    return rmsnorm(x, final_norm_g)
```

```cpp
#include <hip/hip_runtime.h>
#include <hip/hip_cooperative_groups.h>
#include <hip/hip_fp16.h>
#include <cstdio>
#include <cstdint>
namespace cg = cooperative_groups;

#define LAS __attribute__((address_space(3)))
#define GAS __attribute__((address_space(1)))
typedef unsigned short bf16_t;
typedef short bf16x8 __attribute__((ext_vector_type(8)));
typedef float f32x4 __attribute__((ext_vector_type(4)));
typedef float f32x2 __attribute__((ext_vector_type(2)));
typedef unsigned u32x4 __attribute__((ext_vector_type(4)));
typedef unsigned u32x2 __attribute__((ext_vector_type(2)));
typedef _Float16 h16x2 __attribute__((ext_vector_type(2)));

constexpr int DM = 1024, NB = 8, SEQ = 2048, CTX = 256;
constexpr int TL = NB * SEQ;
constexpr int TC = NB * CTX;
constexpr int TT = TL + TC;
constexpr int ZW = 2816;
constexpr int INC = 2752;
constexpr int CB_ = 960, CC_ = 1984, CD_ = 2496;
constexpr int NEXP = 16384;

constexpr size_t MiB = 1u << 20;
constexpr size_t WS_CTL = 0;
constexpr size_t WS_MOD = 1 * MiB;
constexpr size_t WS_WIN = 2 * MiB;
constexpr size_t WS_WOUT = 14 * MiB;
constexpr size_t WS_WEFF = 18 * MiB;
constexpr size_t WS_GLU = 26 * MiB;
constexpr size_t WS_U8 = 28 * MiB;
constexpr size_t WS_V8 = 60 * MiB;
constexpr size_t WS_REC = 156 * MiB;
constexpr size_t WS_ACT = 156 * MiB;
constexpr size_t WS_S5G = 192 * MiB;
constexpr size_t WS_X1 = 202 * MiB;
constexpr size_t WS_X0C = 274 * MiB;
constexpr size_t WS_Z = 316 * MiB;
constexpr size_t WS_Y = 415 * MiB;
constexpr size_t WS_SC = 316 * MiB;
constexpr size_t WS_LIST = 462 * MiB;
constexpr size_t WS_ACU = 487 * MiB;
constexpr size_t WS_AGG = 505 * MiB;
constexpr size_t WS_CIN = 507 * MiB;
constexpr size_t WS_END = 508 * MiB;
constexpr size_t YSZ = (size_t)TT * 256;
static_assert(WS_SC + (size_t)TT * 2048 * 4 <= WS_LIST && WS_LIST + (size_t)TT * 128 * 8 <= WS_END, "ws map");
static_assert(WS_Y + 8 * YSZ * 2 <= WS_END && WS_Z + (size_t)TT * ZW * 2 <= WS_Y, "ws map");
static_assert(WS_REC + (size_t)64 * 72 * 36096 <= WS_Z, "ws map");

constexpr int LDS_BYTES = 147456;

struct Params { const float* in[44]; float* out; unsigned char* ws; };
struct PV { const LAS unsigned* tab; unsigned char* ws; float* out; LAS unsigned char* lds; };
__device__ __forceinline__ const float* inp_(const LAS unsigned* tab, int i) {
    const unsigned lo = (unsigned)__builtin_amdgcn_readfirstlane((int)tab[2 * i]), hi = (unsigned)__builtin_amdgcn_readfirstlane((int)tab[2 * i + 1]);
    return (const float*)(((unsigned long long)hi << 32) | (unsigned long long)lo);
}
#define PIN(i) inp_(P.tab, (i))
__device__ __forceinline__ PV opq(const PV& P) { PV q = P; unsigned o = 0; asm volatile("" : "+s"(q.ws), "+s"(q.out), "+s"(o)); q.lds = P.lds + o; q.tab = (const LAS unsigned*)(q.lds + LDS_BYTES - 1024); return q; }
enum { I_X = 0, I_C, I_CTX, I_CCTX, I_N1G, I_N2G, I_ADAW, I_ADAB, I_WIN, I_WOUT, I_MU, I_W0, I_WUP, I_A0, I_AUP, I_GUP, I_KK, I_KA, I_RK, I_LNG, I_LNB,
       I_GNG, I_CVW, I_CVB, I_WA, I_BA, I_WX, I_BX, I_LAM, I_SARE, I_SAIM, I_SLDT, I_SBRE, I_SBIM, I_SCRE, I_SCIM, I_SD, I_GLUW, I_GLUB, I_WQ, I_KEYS, I_PU, I_PV, I_FNG };

#define LDS_BARRIER() do { asm volatile("s_waitcnt lgkmcnt(0)" ::: "memory"); __builtin_amdgcn_s_barrier(); asm volatile("" ::: "memory"); } while (0)
__device__ __forceinline__ int otid() { int t = threadIdx.x; asm volatile("" : "+v"(t)); return t; }
__device__ __forceinline__ unsigned f2bf(float f) { unsigned u = __builtin_bit_cast(unsigned, f); return (u + 0x7fffu + ((u >> 16) & 1u)) >> 16; }
__device__ __forceinline__ unsigned pk2(float lo, float hi) { return f2bf(lo) | (f2bf(hi) << 16); }
__device__ __forceinline__ unsigned pk2a(float lo, float hi) { unsigned r; asm("v_cvt_pk_bf16_f32 %0, %1, %2" : "=v"(r) : "v"(lo), "v"(hi)); return r; }
__device__ __forceinline__ float bf2f(unsigned b) { return __builtin_bit_cast(float, b << 16); }
__device__ __forceinline__ float bflo(unsigned w) { return __builtin_bit_cast(float, w << 16); }
__device__ __forceinline__ float bfhi(unsigned w) { return __builtin_bit_cast(float, w & 0xffff0000u); }

template <int CTRL> __device__ __forceinline__ float dppf(float v) {
    return __builtin_bit_cast(float, __builtin_amdgcn_update_dpp(0, __builtin_bit_cast(int, v), CTRL, 0xF, 0xF, true));
}
template <int CTRL> __device__ __forceinline__ unsigned dppu(unsigned v) {
    return (unsigned)__builtin_amdgcn_update_dpp(0, (int)v, CTRL, 0xF, 0xF, true);
}
__device__ __forceinline__ float sum8(float v) {
    v += dppf<0xB1>(v);
    v += dppf<0x4E>(v);
    v += dppf<0x141>(v);
    return v;
}
__device__ __forceinline__ float wave_sum(float v) {
    v = sum8(v); v += dppf<0x140>(v);
    const float s0 = __builtin_bit_cast(float, __builtin_amdgcn_readlane(__builtin_bit_cast(int, v), 0)), s1 = __builtin_bit_cast(float, __builtin_amdgcn_readlane(__builtin_bit_cast(int, v), 16));
    const float s2 = __builtin_bit_cast(float, __builtin_amdgcn_readlane(__builtin_bit_cast(int, v), 32)), s3 = __builtin_bit_cast(float, __builtin_amdgcn_readlane(__builtin_bit_cast(int, v), 48));
    return (s0 + s1) + (s2 + s3);
}
__device__ __forceinline__ float sigmoidf_(float x) { return __builtin_amdgcn_rcpf(1.0f + __expf(-x)); }
__device__ __forceinline__ float tanhf_(float x) { return 1.0f - 2.0f * __builtin_amdgcn_rcpf(1.0f + __expf(2.0f * x)); }
__device__ __forceinline__ float softplusf_(float x) { return fmaxf(x, 0.0f) + __logf(1.0f + __expf(-fabsf(x))); }
__device__ __forceinline__ float geluf_(float x) { return 0.5f * x * (1.0f + tanhf_(0.7978845608f * (x + 0.044715f * x * x * x))); }
__device__ __forceinline__ float siluf_(float x) { return x * sigmoidf_(x); }

template <int MT, int NT, int KS>
__device__ __forceinline__ void lds_mma(f32x4 (&acc)[MT][NT], const LAS bf16_t* A, int lda, const LAS bf16_t* Bt, int ldb, int lane) {
    const int r = lane & 15, q = lane >> 4;
#pragma unroll
    for (int ks = 0; ks < KS; ++ks) {
        bf16x8 a[MT], b[NT];
#pragma unroll
        for (int m = 0; m < MT; ++m) a[m] = *(const LAS bf16x8*)(A + (m * 16 + r) * lda + ks * 32 + q * 8);
#pragma unroll
        for (int n = 0; n < NT; ++n) b[n] = *(const LAS bf16x8*)(Bt + (n * 16 + r) * ldb + ks * 32 + q * 8);
#pragma unroll
        for (int m = 0; m < MT; ++m)
#pragma unroll
            for (int n = 0; n < NT; ++n) acc[m][n] = __builtin_amdgcn_mfma_f32_16x16x32_bf16(b[n], a[m], acc[m][n], 0, 0, 0);
    }
}
template <int MT, int NT> __device__ __forceinline__ void zero_acc(f32x4 (&acc)[MT][NT]) {
#pragma unroll
    for (int m = 0; m < MT; ++m)
#pragma unroll
        for (int n = 0; n < NT; ++n) acc[m][n] = (f32x4){0.f, 0.f, 0.f, 0.f};
}

namespace pg8 {
#define PG8_LAS __attribute__((address_space(3)))
typedef unsigned short bf16_t;
typedef short bf16x8 __attribute__((ext_vector_type(8)));
typedef float f32x4 __attribute__((ext_vector_type(4)));
typedef unsigned u32x4 __attribute__((ext_vector_type(4)));
constexpr int BM = 256, BK = 64, HALF = 128, HTB = HALF * BK * 2  , STAGE_BYTES = 8 * HTB, NXCD = 8, WGM = 8;

__host__ __device__ __forceinline__ int lds_byte(int r, int c) { const int st = (r >> 4) * 2 + (c >> 5), rr = r & 15, cc = c & 31, ob = rr * 64 + cc * 2; return st * 1024 + (ob ^ (((ob >> 9) & 1) << 5)); }
__host__ __device__ __forceinline__ void stage_rc(int b, int& R, int& C) { const int st = b / 1024, sb = b % 1024, swz = sb ^ (((sb >> 9) & 1) << 5); R = (st >> 1) * 16 + swz / 64; C = (st & 1) * 32 + (swz % 64) / 2; }
__host__ __device__ __forceinline__ int perm32(int rho) { const int n = rho >> 4, i = rho & 15; return 8 * (i >> 2) + 4 * n + (i & 3); }

struct Unit { int pm, pn; };
struct Gemm { const bf16_t* A; const bf16_t* Bt; int M, N, K; };

struct StaticOrder {
    int nM, nN, nwg, G, c;
    __host__ __device__ void init(int M, int N, int G_, int c_) { nM = M / BM; nN = N / BM; nwg = nM * nN; G = G_; c = c_; }
    __host__ __device__ bool next(int i, Unit& u) const {
        const long L = (long)i * G + c; if (L >= nwg) return false;
        int wgid = (int)L; { const int q = nwg / NXCD, r = nwg % NXCD, xcd = wgid % NXCD, off = wgid / NXCD; wgid = (xcd < r ? xcd * (q + 1) : r * (q + 1) + (xcd - r) * q) + off; }
        const int nig = WGM * nN, gid = wgid / nig, fm = gid * WGM, gsz = (nM - fm) < WGM ? (nM - fm) : WGM;
        u.pm = fm + ((wgid % nig) % gsz); u.pn = (wgid % nig) / gsz; return true;
    }
    __device__ __forceinline__ void a_ready(const Unit&) const {}
    __device__ __forceinline__ void done(const Unit&) const {}
};


__device__ __forceinline__ unsigned cvt_pk_bf16(float lo, float hi) { unsigned r; asm volatile("v_cvt_pk_bf16_f32 %0, %1, %2" : "=v"(r) : "v"(lo), "v"(hi)); return r; }

struct EpiZ {
    static constexpr bool PERM = true, AFTER_DRAIN = false;
    bf16_t* O; int ldc;
    __device__ __forceinline__ void operator()(const f32x4 (&acc)[2][2][4][2], const Unit& u, int wr, int wc, int fr, int fq) const {
        const int row0 = u.pm * BM + wr * 64 + fr, col0 = u.pn * BM + wc * 32 + 8 * fq;
#pragma unroll
        for (int ai = 0; ai < 2; ++ai)
#pragma unroll
            for (int m = 0; m < 4; ++m) { bf16_t* rowp = O + (size_t)(row0 + ai * HALF + m * 16) * ldc + col0;
#pragma unroll
                for (int bj = 0; bj < 2; ++bj) { const f32x4 v0 = acc[ai][bj][m][0], v1 = acc[ai][bj][m][1];
                    u32x4 w; w.x = cvt_pk_bf16(v0[0], v0[1]); w.y = cvt_pk_bf16(v0[2], v0[3]); w.z = cvt_pk_bf16(v1[0], v1[1]); w.w = cvt_pk_bf16(v1[2], v1[3]);
                    *(u32x4*)(rowp + bj * HALF) = w; } }
    }
};
struct EpiGlu {
    static constexpr bool PERM = false, AFTER_DRAIN = false;
    bf16_t* O; const float* gb;
    __device__ __forceinline__ void operator()(const f32x4 (&acc)[2][2][4][2], const Unit& u, int wr, int wc, int fr, int fq) const {
#pragma unroll
        for (int ai = 0; ai < 2; ++ai)
#pragma unroll
            for (int m = 0; m < 4; ++m) { const int row = u.pm * BM + ai * HALF + wr * 64 + m * 16 + fr;
#pragma unroll
                for (int n = 0; n < 2; ++n) { const int ch = u.pn * 128 + wc * 32 + n * 16 + 4 * fq;
                    const float* gp = gb; asm volatile("" : "+s"(gp));
                    const f32x4 bv = *(const f32x4*)(gp + ch), bg = *(const f32x4*)(gp + 256 + ch);
                    const f32x4 v = acc[ai][0][m][n] + bv, g = acc[ai][1][m][n] + bg; float o[4];
#pragma unroll
                    for (int e = 0; e < 4; ++e) o[e] = v[e] * __builtin_amdgcn_rcpf(1.0f + __expf(-g[e]));
                    unsigned lo = cvt_pk_bf16(o[0], o[1]), hi = cvt_pk_bf16(o[2], o[3]);
                    *(unsigned long long*)(O + (size_t)row * 1024 + 768 + ch) = (unsigned long long)lo | ((unsigned long long)hi << 32); } }
    }
};
struct EpiRes {
    static constexpr bool PERM = false, AFTER_DRAIN = false;
    const float* baseL; const float* baseC; const float* gate; float* out;
    __device__ __forceinline__ void operator()(const f32x4 (&acc)[2][2][4][2], const Unit& u, int wr, int wc, int fr, int fq) const {
        const int rowt = u.pm * BM; const int mr = rowt < 16384 ? (rowt >> 11) : 8;
        const float* grow = gate + (size_t)mr * 6144;
#pragma unroll
        for (int bj = 0; bj < 2; ++bj)
#pragma unroll
            for (int n = 0; n < 2; ++n) { const int col = u.pn * BM + bj * HALF + wc * 32 + n * 16 + 4 * fq; const f32x4 gv = *(const f32x4*)(grow + col);
#pragma unroll
                for (int ai = 0; ai < 2; ++ai)
#pragma unroll
                    for (int m = 0; m < 4; ++m) { const int row = rowt + ai * HALF + wr * 64 + m * 16 + fr;
                        const float* bp = row < 16384 ? baseL + (size_t)row * 1024 + col : baseC + (size_t)(row - 16384) * 1024 + col;
                        const f32x4 bs = *(const f32x4*)bp; *(f32x4*)(out + (size_t)row * 1024 + col) = bs + gv * acc[ai][bj][m][n]; } }
    }
};
struct EpiF32 {
    static constexpr bool PERM = false, AFTER_DRAIN = false;
    float* O; int ldc;
    __device__ __forceinline__ void operator()(const f32x4 (&acc)[2][2][4][2], const Unit& u, int wr, int wc, int fr, int fq) const {
#pragma unroll
        for (int ai = 0; ai < 2; ++ai)
#pragma unroll
            for (int m = 0; m < 4; ++m) { const int row = u.pm * BM + ai * HALF + wr * 64 + m * 16 + fr;
#pragma unroll
                for (int bj = 0; bj < 2; ++bj)
#pragma unroll
                    for (int n = 0; n < 2; ++n) { const int col = u.pn * BM + bj * HALF + wc * 32 + n * 16 + 4 * fq;
                        *(f32x4*)(O + (size_t)row * ldc + col) = acc[ai][bj][m][n]; } }
    }
};

template <class Epi, class Sched, bool ALIGN_EPI = false, bool SP2 = false>
__device__ __forceinline__ void gemm_phase(PG8_LAS unsigned char* lds, const Gemm g, const Sched& S, const Epi& E) {
    int tid_ = threadIdx.x; asm volatile("" : "+v"(tid_));
    const int tid = tid_, wid = __builtin_amdgcn_readfirstlane(tid >> 6), lane = tid & 63, wr = wid >> 2, wc = wid & 3, fr = lane & 15, fq = lane >> 4;
    const int K = g.K, nt = K / BK;
    unsigned voffA[2], voffB[2];
#pragma unroll
    for (int i = 0; i < 2; ++i) { int R, C; stage_rc(tid * 16 + i * 8192, R, C); const int Rb = Epi::PERM ? ((R & ~31) + perm32(R & 31)) : R;
        voffA[i] = (unsigned)(R * K + C) * 2u; voffB[i] = (unsigned)(Rb * K + C) * 2u; }
    const size_t kstep = (size_t)(BK * 2);
    const size_t hstep = (size_t)HALF * K * 2;
    const size_t tstep = 2 * hstep;
    const unsigned ldsw = (unsigned)wid * 1024u;
    const int aoff = lds_byte(wr * 64 + fr, fq * 8), boff = lds_byte(wc * 32 + fr, fq * 8);
#define PG8_SA(b, h) (((b) * 2 + (h)) * HTB)
#define PG8_SB(b, h) ((4 + (b) * 2 + (h)) * HTB)
#define PG8_STAGE(bufoff, gbase, voff) do { _Pragma("unroll") for (int _i = 0; _i < 2; ++_i) \
        __builtin_amdgcn_global_load_lds((const unsigned*)((const char*)(gbase) + (voff)[_i]), (PG8_LAS unsigned*)(lds + (bufoff) + ldsw + _i * 8192), 16, 0, 0); } while (0)
#define PG8_LDA(dst, b, h) do { _Pragma("unroll") for (int m = 0; m < 4; ++m) _Pragma("unroll") for (int k = 0; k < 2; ++k) dst[m][k] = *(const PG8_LAS bf16x8*)(lds + PG8_SA(b, h) + aoff + m * 2048 + k * 1024); } while (0)
#define PG8_LDB(dst, b, h) do { _Pragma("unroll") for (int n = 0; n < 2; ++n) _Pragma("unroll") for (int k = 0; k < 2; ++k) dst[n][k] = *(const PG8_LAS bf16x8*)(lds + PG8_SB(b, h) + boff + n * 2048 + k * 1024); } while (0)
#define PG8_MMA(ai, bj, At, Bt) do { __builtin_amdgcn_s_setprio(1); _Pragma("unroll") for (int m = 0; m < 4; ++m) _Pragma("unroll") for (int n = 0; n < 2; ++n) _Pragma("unroll") for (int k = 0; k < 2; ++k) \
        acc[ai][bj][m][n] = __builtin_amdgcn_mfma_f32_16x16x32_bf16(Bt[n][k], At[m][k], acc[ai][bj][m][n], 0, 0, 0); __builtin_amdgcn_s_setprio(0); } while (0)
#define PG8_WAIT_V(n) asm volatile("s_waitcnt vmcnt(" #n ")" ::: "memory")
#define PG8_WAIT_L(n) asm volatile("s_waitcnt lgkmcnt(" #n ")" ::: "memory")
#define PG8_BAR __builtin_amdgcn_s_barrier()
#define PG8_SCHED __builtin_amdgcn_sched_barrier(0)
    Unit cur, nxt; int ui = 0;
    if (!S.next(0, cur)) return;
    f32x4 acc[2][2][4][2];
#pragma unroll
    for (int a = 0; a < 2; ++a)
#pragma unroll
        for (int b = 0; b < 2; ++b)
#pragma unroll
            for (int m = 0; m < 4; ++m)
#pragma unroll
                for (int n = 0; n < 2; ++n) acc[a][b][m][n] = (f32x4){0.f, 0.f, 0.f, 0.f};
    bf16x8 At[4][2], B0[2][2], B1[2][2];
    const char* cA = (const char*)g.A + (size_t)cur.pm * tstep; const char* cB = (const char*)g.Bt + (size_t)cur.pn * tstep;
    S.a_ready(cur);
    if constexpr (SP2) {
        PG8_STAGE(PG8_SB(0, 0), cB, voffB); PG8_STAGE(PG8_SB(0, 1), cB + hstep, voffB); PG8_STAGE(PG8_SA(0, 0), cA, voffA); PG8_STAGE(PG8_SA(0, 1), cA + hstep, voffA);
        if (wr == 1) PG8_BAR;
        PG8_WAIT_V(2); PG8_BAR;
        PG8_STAGE(PG8_SB(1, 0), cB + kstep, voffB); PG8_STAGE(PG8_SA(1, 0), cA + kstep, voffA); PG8_STAGE(PG8_SB(1, 1), cB + hstep + kstep, voffB);
        PG8_WAIT_V(6); PG8_BAR;
    } else {
        PG8_STAGE(PG8_SB(0, 0), cB, voffB); PG8_STAGE(PG8_SA(0, 0), cA, voffA); PG8_STAGE(PG8_SB(0, 1), cB + hstep, voffB); PG8_STAGE(PG8_SA(0, 1), cA + hstep, voffA);
        if (wr == 1) PG8_BAR;
        PG8_WAIT_V(4); PG8_BAR;
        PG8_STAGE(PG8_SB(1, 0), cB + kstep, voffB); PG8_STAGE(PG8_SA(1, 0), cA + kstep, voffA); PG8_STAGE(PG8_SB(1, 1), cB + hstep + kstep, voffB);
        PG8_WAIT_V(6); PG8_BAR;
    }
    for (;;) {
        const bool has_next = S.next(ui + 1, nxt);
        const char* nA = has_next ? (const char*)g.A + (size_t)nxt.pm * tstep : cA; const char* nB = has_next ? (const char*)g.Bt + (size_t)nxt.pn * tstep : cB;
        for (int t = 0; t < nt; t += 2) {
            const bool last = (t == nt - 2);
            const char* a1 = cA + (size_t)(t + 1) * kstep;
            const char* a2 = last ? nA : cA + (size_t)(t + 2) * kstep; const char* b2 = last ? nB : cB + (size_t)(t + 2) * kstep;
            const char* a3 = a2 + kstep; const char* b3 = b2 + kstep;
            if (last && has_next) S.a_ready(nxt);
            if constexpr (SP2) {
            PG8_LDB(B0, 0, 0); PG8_LDB(B1, 0, 1); PG8_SCHED; PG8_LDA(At, 0, 0); PG8_STAGE(PG8_SA(1, 1), a1 + hstep, voffA);
            PG8_WAIT_V(8); PG8_WAIT_L(0); PG8_BAR; PG8_MMA(0, 0, At, B0); PG8_MMA(0, 1, At, B1); PG8_BAR; PG8_SCHED;
            PG8_LDA(At, 0, 1); PG8_STAGE(PG8_SB(0, 0), b2, voffB); PG8_STAGE(PG8_SB(0, 1), b2 + hstep, voffB); PG8_STAGE(PG8_SA(0, 0), a2, voffA);
            PG8_WAIT_V(8); PG8_WAIT_L(0); PG8_BAR; PG8_MMA(1, 0, At, B0); PG8_MMA(1, 1, At, B1); PG8_BAR; PG8_SCHED;
            PG8_LDB(B0, 1, 0); PG8_LDB(B1, 1, 1); PG8_SCHED; PG8_LDA(At, 1, 0); PG8_STAGE(PG8_SA(0, 1), a2 + hstep, voffA);
            PG8_WAIT_V(8); PG8_WAIT_L(0); PG8_BAR; PG8_MMA(0, 0, At, B0); PG8_MMA(0, 1, At, B1); PG8_BAR; PG8_SCHED;
            PG8_LDA(At, 1, 1); PG8_STAGE(PG8_SB(1, 0), b3, voffB); PG8_STAGE(PG8_SB(1, 1), b3 + hstep, voffB); PG8_STAGE(PG8_SA(1, 0), a3, voffA);
            PG8_WAIT_V(8); PG8_WAIT_L(0); PG8_BAR; PG8_MMA(1, 0, At, B0); PG8_MMA(1, 1, At, B1); PG8_BAR; PG8_SCHED;
            } else {
            PG8_LDB(B0, 0, 0); PG8_SCHED; PG8_LDA(At, 0, 0); PG8_STAGE(PG8_SA(1, 1), a1 + hstep, voffA);
            PG8_WAIT_L(8); PG8_BAR; PG8_WAIT_L(0); PG8_MMA(0, 0, At, B0); PG8_BAR; PG8_SCHED;
            PG8_LDB(B1, 0, 1); PG8_STAGE(PG8_SB(0, 0), b2, voffB);
            PG8_BAR; PG8_WAIT_L(0); PG8_MMA(0, 1, At, B1); PG8_BAR;
            PG8_LDA(At, 0, 1); PG8_STAGE(PG8_SA(0, 0), a2, voffA);
            PG8_BAR; PG8_WAIT_L(0); PG8_MMA(1, 0, At, B0); PG8_BAR; PG8_SCHED;
            PG8_STAGE(PG8_SB(0, 1), b2 + hstep, voffB);
            PG8_WAIT_V(6); PG8_BAR; PG8_MMA(1, 1, At, B1); PG8_BAR;
            PG8_LDB(B0, 1, 0); PG8_SCHED; PG8_LDA(At, 1, 0); PG8_STAGE(PG8_SA(0, 1), a2 + hstep, voffA);
            PG8_WAIT_L(8); PG8_BAR; PG8_WAIT_L(0); PG8_MMA(0, 0, At, B0); PG8_BAR; PG8_SCHED;
            PG8_LDB(B1, 1, 1); PG8_STAGE(PG8_SB(1, 0), b3, voffB);
            PG8_BAR; PG8_WAIT_L(0); PG8_MMA(0, 1, At, B1); PG8_BAR;
            PG8_LDA(At, 1, 1); PG8_STAGE(PG8_SA(1, 0), a3, voffA);
            PG8_BAR; PG8_WAIT_L(0); PG8_MMA(1, 0, At, B0); PG8_BAR; PG8_SCHED;
            PG8_STAGE(PG8_SB(1, 1), b3 + hstep, voffB);
            PG8_WAIT_V(6); PG8_BAR; PG8_MMA(1, 1, At, B1); PG8_BAR;
            }
        }
        if constexpr (ALIGN_EPI) { if (wr == 0) PG8_BAR; }
        if constexpr (!Epi::AFTER_DRAIN) { E(acc, cur, wr, wc, fr, fq); S.done(cur); }
        if (!has_next) break;
#pragma unroll
        for (int a = 0; a < 2; ++a)
#pragma unroll
            for (int b = 0; b < 2; ++b)
#pragma unroll
                for (int m = 0; m < 4; ++m)
#pragma unroll
                    for (int n = 0; n < 2; ++n) acc[a][b][m][n] = (f32x4){0.f, 0.f, 0.f, 0.f};
        cur = nxt; cA = nA; cB = nB; ++ui;
        if constexpr (ALIGN_EPI) { if (wr == 1) PG8_BAR; }
    }
    PG8_WAIT_V(0);
    if constexpr (!ALIGN_EPI) { if (wr == 0) PG8_BAR; }
    PG8_BAR;
    if constexpr (Epi::AFTER_DRAIN) { E.fused(acc, cur, wr, wc, fr, fq, lds, wid, lane); S.done(cur); }
#undef PG8_SA
#undef PG8_SB
#undef PG8_STAGE
#undef PG8_LDA
#undef PG8_LDB
#undef PG8_MMA
#undef PG8_WAIT_V
#undef PG8_WAIT_L
#undef PG8_BAR
#undef PG8_SCHED
}
}
#ifndef PROBE_DUP
#define PROBE_DUP 64
#endif

template <class PT> __device__ __forceinline__ void load_row16(PT p, int lane, float (&x)[16]) {
    const f32x4 a = *(const GAS f32x4*)(p + 8 * lane), b = *(const GAS f32x4*)(p + 8 * lane + 4), c = *(const GAS f32x4*)(p + 512 + 8 * lane), d = *(const GAS f32x4*)(p + 512 + 8 * lane + 4);
#pragma unroll
    for (int e = 0; e < 4; ++e) { x[e] = a[e]; x[4 + e] = b[e]; x[8 + e] = c[e]; x[12 + e] = d[e]; }
}
__device__ __forceinline__ void store_row16_f32(float* p, int lane, const float (&x)[16]) {
    *(f32x4*)(p + 8 * lane) = (f32x4){x[0], x[1], x[2], x[3]}; *(f32x4*)(p + 8 * lane + 4) = (f32x4){x[4], x[5], x[6], x[7]};
    *(f32x4*)(p + 512 + 8 * lane) = (f32x4){x[8], x[9], x[10], x[11]}; *(f32x4*)(p + 512 + 8 * lane + 4) = (f32x4){x[12], x[13], x[14], x[15]};
}
template <class PT> __device__ __forceinline__ void store_row16_bf16(PT p, int lane, const float (&y)[16]) {
    u32x4 a, b; a.x = pk2(y[0], y[1]); a.y = pk2(y[2], y[3]); a.z = pk2(y[4], y[5]); a.w = pk2(y[6], y[7]);
    b.x = pk2(y[8], y[9]); b.y = pk2(y[10], y[11]); b.z = pk2(y[12], y[13]); b.w = pk2(y[14], y[15]);
    *(GAS u32x4*)(p + 8 * lane) = a; *(GAS u32x4*)(p + 512 + 8 * lane) = b;
}
template <class G1, class G2> __device__ __forceinline__ void norm_mod16(const float (&x)[16], G1 g, G2 shift, G2 scale, int lane, float (&y)[16]) {
    float ss = 0.f;
#pragma unroll
    for (int e = 0; e < 16; ++e) ss += x[e] * x[e];
    ss = wave_sum(ss);
    const float r = rsqrtf(ss * (1.0f / 1024.0f) + 1e-6f);
    float gg[16]; load_row16(g, lane, gg);
    if (shift) { float sh[16], sc[16]; load_row16(shift, lane, sh); load_row16(scale, lane, sc);
#pragma unroll
        for (int e = 0; e < 16; ++e) y[e] = x[e] * r * gg[e] * (1.0f + sc[e]) + sh[e];
    } else {
#pragma unroll
        for (int e = 0; e < 16; ++e) y[e] = x[e] * r * gg[e];
    }
}

template <int MODE>
__device__ __forceinline__ void transpose_item(const float* W, int K, int N, bf16_t* WT, LAS float* scr, int item, int lane) {
    const int nblk = N / 32, kb = item / nblk, nb = item % nblk, k0 = 64 * kb, n0 = 32 * nb;
#pragma unroll 8
    for (int i = 0; i < 32; ++i) { const int kk = 2 * i + (lane >> 5); scr[kk * 33 + (lane & 31)] = W[(size_t)(k0 + kk) * N + n0 + (lane & 31)]; }
    asm volatile("s_waitcnt lgkmcnt(0)" ::: "memory");
    const int c = lane & 7;
#pragma unroll
    for (int j = 0; j < 4; ++j) { const int n = (lane >> 3) + 8 * j; const LAS float* s = scr + (8 * c) * 33 + n;
        u32x4 o; o.x = pk2(s[0 * 33], s[1 * 33]); o.y = pk2(s[2 * 33], s[3 * 33]); o.z = pk2(s[4 * 33], s[5 * 33]); o.w = pk2(s[6 * 33], s[7 * 33]);
        int row = n0 + n;
        if (MODE == 1) { const int ch = row & 255, gatepart = row >> 8; row = (ch >> 7) * 256 + gatepart * 128 + (ch & 127); }
        *(u32x4*)(WT + (size_t)row * K + k0 + 8 * c) = o; }
    asm volatile("s_waitcnt lgkmcnt(0)" ::: "memory");
}

__device__ __forceinline__ void p0_prologue(const PV& P, LAS unsigned char* lds) {
    const int tid = otid(), lane = tid & 63, w = tid >> 6;
    const int G = gridDim.x, bx = blockIdx.x;
    unsigned char* ws = P.ws;
    {
        LAS float* scr = (LAS float*)(lds + w * 8448);
        const int gw = bx * 8 + w, NGW = G * 8;
        constexpr int I_IN = 16 * (INC / 32), I_OUT = 16 * 32, I_GL = 4 * 16, PER_L = I_IN + I_OUT + I_GL;
        for (int it = gw; it < 2 * PER_L; it += NGW) {
            const int l = it / PER_L; int r = it % PER_L;
            if (r < I_IN) { transpose_item<0>(PIN(I_WIN) + (size_t)l * 1024 * INC, 1024, INC, (bf16_t*)(ws + WS_WIN) + (size_t)l * ZW * 1024, scr, r, lane); continue; } r -= I_IN;
            if (r < I_OUT) { transpose_item<0>(PIN(I_WOUT) + (size_t)l * 1024 * 1024, 1024, 1024, (bf16_t*)(ws + WS_WOUT) + (size_t)l * 1024 * 1024, scr, r, lane); continue; } r -= I_OUT;
            transpose_item<1>(PIN(I_GLUW) + (size_t)l * 256 * 512, 256, 512, (bf16_t*)(ws + WS_GLU) + (size_t)l * 512 * 256, scr, r, lane);
        }
        for (int i = bx * 512 + tid; i < 16384; i += G * 512) { const int l = i >> 13, o = i & 8191;
            *(u32x4*)((bf16_t*)(ws + WS_WIN) + ((size_t)l * ZW + INC) * 1024 + (size_t)o * 8) = (u32x4){0u, 0u, 0u, 0u}; }
    }
    {
        const size_t n16 = (size_t)2 * NEXP * 1024 / 16, stride = (size_t)G * 512;
        const f32x4* su = (const f32x4*)PIN(I_PU); const f32x4* sv = (const f32x4*)PIN(I_PV);
        u32x4* du = (u32x4*)(ws + WS_U8); u32x4* dv = (u32x4*)(ws + WS_V8);
        for (size_t i = (size_t)bx * 512 + tid; i < n16; i += stride) {
            u32x4 o, q;
#pragma unroll
            for (int k = 0; k < 4; ++k) { const f32x4 a = su[4 * i + k] * 32.0f, c = sv[4 * i + k] * 2.0f;
                int wa = __builtin_amdgcn_cvt_pk_fp8_f32(a[0], a[1], 0, false); wa = __builtin_amdgcn_cvt_pk_fp8_f32(a[2], a[3], wa, true);
                int wc = __builtin_amdgcn_cvt_pk_fp8_f32(c[0], c[1], 0, false); wc = __builtin_amdgcn_cvt_pk_fp8_f32(c[2], c[3], wc, true);
                o[k] = (unsigned)wa; q[k] = (unsigned)wc; }
            du[i] = o; dv[i] = q;
        }
    }
    __syncthreads();
    for (int u = bx; u < 48; u += G) {
        const int l = u / 24, cb = u % 24;
        LAS float* sc = (LAS float*)lds;
        LAS float* red = sc + 9216;
        __syncthreads();
        for (int idx = tid; idx < 9216; idx += 512) { const int r = idx >> 10, k = idx & 1023; const float v = r < 8 ? PIN(I_C)[r * 1024 + k] : PIN(I_CCTX)[k]; sc[idx] = siluf_(v); }
        __syncthreads();
        f32x4 acc[9];
#pragma unroll
        for (int r = 0; r < 9; ++r) acc[r] = (f32x4){0.f, 0.f, 0.f, 0.f};
        const float* wp = PIN(I_ADAW) + ((size_t)l * 1024 + 128 * w) * 6144 + cb * 256 + 4 * lane;
#pragma unroll 16
        for (int k = 0; k < 128; ++k) { const f32x4 wv = *(const GAS f32x4*)(wp + (size_t)k * 6144);
#pragma unroll
            for (int r = 0; r < 9; ++r) acc[r] += sc[r * 1024 + 128 * w + k] * wv; }
#pragma unroll
        for (int r = 0; r < 9; ++r) *(LAS f32x4*)(red + (w * 9 + r) * 256 + 4 * lane) = acc[r];
        __syncthreads();
        for (int idx = tid; idx < 9 * 256; idx += 512) { const int r = idx >> 8, cc = idx & 255; float sacc = 0.f;
#pragma unroll
            for (int ww = 0; ww < 8; ++ww) sacc += red[(ww * 9 + r) * 256 + cc];
            ((float*)(ws + WS_MOD))[(size_t)(l * 9 + r) * 6144 + cb * 256 + cc] = sacc + PIN(I_ADAB)[l * 6144 + cb * 256 + cc]; }
    }
    __syncthreads();
    for (int u = bx; u < 256; u += G) {
        const int l = u >> 7, hp = (u >> 3) & 15, dmb = u & 7;
        LAS bf16_t* As = (LAS bf16_t*)lds; LAS bf16_t* Bs = As + 128 * 136;
        const float* kp = PIN(I_KEYS) + (size_t)(l * 16 + hp) * 128 * 128;
        const float* qp = PIN(I_WQ) + ((size_t)l * 1024 + dmb * 128) * 2048 + hp * 128;
        for (int idx = tid; idx < 16384; idx += 512) { const int n = idx >> 7, d = idx & 127;
            As[n * 136 + d] = (bf16_t)f2bf(kp[idx]); Bs[n * 136 + d] = (bf16_t)f2bf(qp[(size_t)n * 2048 + d]); }
        __syncthreads();
        f32x4 acc[1][8]; zero_acc<1, 8>(acc);
        lds_mma<1, 8, 4>(acc, As + 16 * w * 136, 136, Bs, 136, lane);
        bf16_t* op = (bf16_t*)(ws + WS_WEFF) + ((size_t)l * 2048 + hp * 128 + 16 * w + (lane & 15)) * 1024 + dmb * 128 + 4 * (lane >> 4);
#pragma unroll
        for (int n = 0; n < 8; ++n) { const f32x4 v = acc[0][n]; *(unsigned long long*)(op + 16 * n) = (unsigned long long)pk2(v[0], v[1]) | ((unsigned long long)pk2(v[2], v[3]) << 32); }
        __syncthreads();
    }
}

__device__ __forceinline__ void p0b_ain(const PV& P) {
    const int tid = otid(), lane = tid & 63, gw = blockIdx.x * 8 + (tid >> 6), NGW = gridDim.x * 8;
    const float* mod = (const float*)(P.ws + WS_MOD);
    bf16_t* act = (bf16_t*)(P.ws + WS_ACT);
    for (int row = gw; row < TT; row += NGW) {
        const float* xp = row < TL ? PIN(I_X) + (size_t)row * 1024 : PIN(I_CTX) + (size_t)(row - TL) * 1024;
        const int mr = row < TL ? (row >> 11) : 8;
        float x[16], y[16]; load_row16(xp, lane, x);
        norm_mod16(x, PIN(I_N1G), mod + (size_t)mr * 6144, mod + (size_t)mr * 6144 + 1024, lane, y);
        store_row16_bf16(act + (size_t)row * 1024, lane, y);
    }
}

__device__ __forceinline__ int rwkv_col(int gc, int h, int dir) {
    const int seg = gc >> 6;
    if (seg == 0) return h * 64 + gc;
    if (seg == 1) return 256 + h * 64 + (gc - 64);
    if (seg == 2) return 512 + h * 64 + (gc - 128);
    const int o = gc - 192; return o < 32 ? 832 + dir * 32 + o : 896 + dir * 32 + (o - 32);
}

constexpr int R_AT = 0, R_RT = 4608, R_BT = 9216, R_TL = 14336, R_MRB = 16896, R_G = 19456, R_YV = 23552, R_HV = 27648, R_GAM = 35840, REC_BYTES = 36096;

__device__ __forceinline__ void rwkv_pre(const PV& P, int l, LAS unsigned char* lds) {
    const int tid = otid(), lane = tid & 63, w = tid >> 6;
    LAS bf16_t* WUt = (LAS bf16_t*)lds;
    LAS bf16_t* AUt = WUt + 2560;
    LAS float* s_mu = (LAS float*)(AUt + 2560);
    LAS float* s_par = s_mu + 512;
    LAS bf16_t* raw = (LAS bf16_t*)(s_par + 256);
    LAS float* f_r = (LAS float*)(raw + 34 * 256);
    LAS float* f_k = f_r + 2048;
    LAS float* f_v = f_k + 2048;
    LAS bf16_t* WLb = (LAS bf16_t*)(f_v + 2048);
    LAS bf16_t* ALb = WLb + 1280;
    LAS float* lor = (LAS float*)raw;
    LAS bf16_t* Bn = ALb + 1280;
    LAS bf16_t* Kn = Bn + 2304;
    LAS bf16_t* Ktt = Kn + 2304;
    LAS bf16_t* Vt = Ktt + 2560;
    LAS float* Mabf = (LAS float*)(Vt + 2560);
    LAS bf16_t* Makb = (LAS bf16_t*)(Mabf + 1152);
    LAS bf16_t* Mrkb = Makb + 1280;
    LAS float* Ltot = (LAS float*)(Mrkb + 1280);
    LAS bf16_t* iA1 = (LAS bf16_t*)(Ltot + 512);
    LAS bf16_t* iB1 = iA1 + 640;
    LAS bf16_t* iA2 = iB1 + 640;
    LAS bf16_t* iWt = iA2 + 640;
    LAS unsigned char* rec = (LAS unsigned char*)(iWt + 640);
    LAS bf16_t* At = (LAS bf16_t*)(rec + R_AT); LAS bf16_t* Rt = (LAS bf16_t*)(rec + R_RT); LAS bf16_t* Btt = (LAS bf16_t*)(rec + R_BT);
    const GAS bf16_t* z = (const GAS bf16_t*)(P.ws + WS_Z);
    GAS unsigned char* recg = (GAS unsigned char*)(P.ws + WS_REC);
    for (int idx = tid; idx < 4 * 640 / 2; idx += 512) ((LAS unsigned*)iA1)[idx] = 0u;
    for (int idx = tid; idx < 2 * 1280 / 2; idx += 512) ((LAS unsigned*)WLb)[idx] = 0u;
    for (int idx = tid; idx < 2 * 2560 / 2; idx += 512) ((LAS unsigned*)WUt)[idx] = 0u;
    for (int idx = tid; idx < 1280 / 2; idx += 512) ((LAS unsigned*)(rec + R_TL))[idx] = 0u;
    int cur_hd = -1;
    u32x4 pre[3];
    auto geo = [&](int u, int& hd, int& b, int& c, int& tlo, int& seqlen, size_t& rb) { hd = u & 7; const int rest = u >> 3; b = rest / 72; c = rest % 72; const int dir = hd & 1;
        const bool isctx = c < 8; const int cc = isctx ? c : c - 8; seqlen = isctx ? CTX : SEQ; tlo = dir ? seqlen - 32 - 32 * cc : 32 * cc; rb = isctx ? (size_t)TL + b * CTX : (size_t)b * SEQ; };
    auto issue = [&](int u, int tid) { int hd, b, c, tlo, seqlen; size_t rb; geo(u, hd, b, c, tlo, seqlen, rb);
#pragma unroll
        for (int k = 0; k < 3; ++k) { const int v = tid + 512 * k; pre[k] = (u32x4){0u, 0u, 0u, 0u};
            if (v < 1088) { const int rr = v >> 5, vc = v & 31, t = tlo - 1 + rr; if (t >= 0 && t < seqlen) pre[k] = *(const GAS u32x4*)(z + (rb + t) * ZW + rwkv_col(vc * 8, hd >> 1, hd & 1)); } } };
    if ((int)blockIdx.x < 4608) issue(blockIdx.x, tid);
    for (int u = blockIdx.x; u < 4608; u += gridDim.x) {
        const int tid = otid(), lane = tid & 63, w = tid >> 6;
        int hd, b, c, tlo, seqlen; size_t rb; geo(u, hd, b, c, tlo, seqlen, rb); const int h = hd >> 1, dir = hd & 1;
        LDS_BARRIER();
        if (hd != cur_hd) { cur_hd = hd;
            for (int idx = tid; idx < 2048; idx += 512) { const int m = idx >> 6, j = idx & 63; const size_t o = ((size_t)(l * 2 + dir) * 32 + m) * 256 + h * 64 + j;
                WUt[j * 40 + m] = (bf16_t)f2bf(PIN(I_WUP)[o]); AUt[j * 40 + m] = (bf16_t)f2bf(PIN(I_AUP)[o]); }
            { const int which = tid >> 8, gc = tid & 255; s_mu[tid] = PIN(I_MU)[(size_t)(l * 2 + which) * 960 + rwkv_col(gc, h, dir)]; }
            if (tid < 256) { const int k = tid >> 6, j = tid & 63; float v;
                if (k == 0) v = PIN(I_W0)[(l * 2 + dir) * 256 + h * 64 + j]; else if (k == 1) v = PIN(I_A0)[(l * 2 + dir) * 256 + h * 64 + j];
                else if (k == 2) v = PIN(I_KK)[l * 256 + h * 64 + j]; else v = PIN(I_KA)[l * 256 + h * 64 + j];
                s_par[tid] = v; } }
#pragma unroll
        for (int k = 0; k < 3; ++k) { const int v = tid + 512 * k; if (v < 1088) *(LAS u32x4*)(raw + (size_t)v * 8) = pre[k]; }
        LDS_BARRIER();
        if (u + (int)gridDim.x < 4608) issue(u + gridDim.x, tid);
        { const int gc = tid & 255, th = tid >> 8; const float mu0 = s_mu[gc], mu1 = s_mu[256 + gc];
            const int r0 = th * 16 + 1;
            float zm = bf2f(raw[(r0 - 1) * 256 + gc]), z0 = bf2f(raw[r0 * 256 + gc]);
#pragma unroll 4
            for (int ii = 0; ii < 16; ++ii) { const int rr = r0 + ii, i = dir ? 32 - rr : rr - 1;
                const float zp = bf2f(raw[(rr + 1) * 256 + gc]);
                const float val = z0 + mu0 * (zm - z0) + mu1 * (zp - z0);
                zm = z0; z0 = zp;
                if (gc < 64) f_r[i * 64 + gc] = val; else if (gc < 128) f_k[i * 64 + gc - 64] = val; else if (gc < 192) f_v[i * 64 + gc - 128] = val;
                else if (gc < 224) WLb[i * 40 + gc - 192] = (bf16_t)f2bf(tanhf_(val)); else ALb[i * 40 + gc - 224] = (bf16_t)f2bf(val); } }
        LDS_BARRIER();
        { const int which = w >> 2, mt = (w >> 1) & 1, np = (w & 1) * 2; f32x4 acc[1][2]; zero_acc<1, 2>(acc);
            lds_mma<1, 2, 1>(acc, (which ? ALb : WLb) + 16 * mt * 40, 40, (which ? AUt : WUt) + 16 * np * 40, 40, lane);
#pragma unroll
            for (int n = 0; n < 2; ++n) *(LAS f32x4*)(lor + which * 2176 + (16 * mt + (lane & 15)) * 68 + 16 * (np + n) + 4 * (lane >> 4)) = acc[0][n]; }
        { const int row = tid & 63, ig = tid >> 6;
#pragma unroll
            for (int e = 0; e < 4; ++e) Vt[row * 40 + 4 * ig + e] = (bf16_t)f2bf(f_v[(4 * ig + e) * 64 + row]); }
        LDS_BARRIER();
        float Lloc[4], lwv[4], agv[4], kkv[4], kdv[4]; float Lrun = 0.f;
#pragma unroll
        for (int ii = 0; ii < 4; ++ii) { const int i = 4 * w + ii, j = lane;
            const float wv = s_par[j] + lor[i * 68 + j], av = s_par[64 + j] + lor[2176 + i * 68 + j];
            const float wlog = -softplusf_(-wv) - 0.5f, lw = -__expf(wlog);
            Lrun += lw; Lloc[ii] = Lrun; lwv[ii] = lw; agv[ii] = sigmoidf_(av);
            const float kx = f_k[i * 64 + j], kkj = kx * s_par[128 + j];
            const float ss = wave_sum(kkj * kkj); kkv[ii] = kkj * __builtin_amdgcn_rcpf(fmaxf(sqrtf(ss), 1e-12f));
            kdv[ii] = kx * (1.0f + (agv[ii] - 1.0f) * s_par[192 + j]); }
        Ltot[w * 64 + lane] = Lrun;
        LDS_BARRIER();
        { float off = 0.f;
#pragma unroll
            for (int ww = 0; ww < 7; ++ww) if (ww < w) off += Ltot[ww * 64 + lane];
#pragma unroll
            for (int ii = 0; ii < 4; ++ii) { const int i = 4 * w + ii, j = lane; const float L = off + Lloc[ii], eP = __expf(L - lwv[ii]), eL = __expf(L), eN = __expf(-L);
                const unsigned bb = f2bf(kkv[ii] * agv[ii] * eN), kb = f2bf(kdv[ii] * eN);
                At[i * 72 + j] = (bf16_t)f2bf(-kkv[ii] * eP); Rt[i * 72 + j] = (bf16_t)f2bf(f_r[i * 64 + j] * eL);
                Bn[i * 72 + j] = (bf16_t)bb; Kn[i * 72 + j] = (bf16_t)kb; Btt[j * 40 + i] = (bf16_t)bb; Ktt[j * 40 + i] = (bf16_t)kb;
                if (i == 31) ((LAS float*)(rec + R_GAM))[j] = eL; } }
        LDS_BARRIER();
        { const int mat = w >> 1, mt = w & 1; f32x4 acc[1][2]; zero_acc<1, 2>(acc);
            lds_mma<1, 2, 2>(acc, (mat < 2 ? At : Rt) + 16 * mt * 72, 72, (mat & 1) ? Kn : Bn, 72, lane);
            const int t = 16 * mt + (lane & 15);
#pragma unroll
            for (int n = 0; n < 2; ++n) { f32x4 o;
#pragma unroll
                for (int e = 0; e < 4; ++e) { const int j = 16 * n + 4 * (lane >> 4) + e; const bool keep = mat < 2 ? j < t : j <= t; o[e] = keep ? acc[0][n][e] : 0.f; }
                if (mat == 0) { *(LAS f32x4*)(Mabf + t * 36 + 16 * n + 4 * (lane >> 4)) = o;
                    if (mt == 1 && n == 0) *(LAS unsigned long long*)(iA1 + (lane & 15) * 40 + 4 * (lane >> 4)) = (unsigned long long)pk2(o[0], o[1]) | ((unsigned long long)pk2(o[2], o[3]) << 32);
                } else { LAS bf16_t* dst = mat == 1 ? Makb : (mat == 2 ? (LAS bf16_t*)(rec + R_MRB) : Mrkb);
                    *(LAS unsigned long long*)(dst + t * 40 + 16 * n + 4 * (lane >> 4)) = (unsigned long long)pk2(o[0], o[1]) | ((unsigned long long)pk2(o[2], o[3]) << 32); } } }
        LDS_BARRIER();
        if (w < 2) {
            const int cidx = lane & 15, o16 = 16 * w; float T[16];
            int vz = 0; asm volatile("" : "+v"(vz)); const LAS float* mb = Mabf + vz + o16 * 36 + o16;
#pragma unroll
            for (int t = 0; t < 16; ++t) { float row = cidx == t ? 1.0f : 0.f;
                float mrow[16];
#pragma unroll
                for (int q = 0; q < 4; ++q) if (4 * q < t) { const f32x4 mv = *(const LAS f32x4*)(mb + t * 36 + 4 * q); mrow[4 * q] = mv[0]; mrow[4 * q + 1] = mv[1]; mrow[4 * q + 2] = mv[2]; mrow[4 * q + 3] = mv[3]; }
#pragma unroll
                for (int j = 0; j < t; ++j) row += mrow[j] * T[j];
                T[t] = row; }
            if (lane < 16) {
                LAS bf16_t* tl = (LAS bf16_t*)(rec + R_TL);
#pragma unroll
                for (int t = 0; t < 16; ++t) tl[(o16 + t) * 40 + o16 + cidx] = (bf16_t)f2bf(T[t]);
                if (w == 0) {
#pragma unroll
                    for (int t = 0; t < 16; ++t) iB1[cidx * 40 + t] = (bf16_t)f2bf(T[t]);
                } else {
#pragma unroll
                    for (int t = 0; t < 16; ++t) iA2[t * 40 + cidx] = (bf16_t)f2bf(T[t]);
                } }
        } else {
            for (int tt = w - 2; tt < 32; tt += 6) { f32x4 acc[1][1]; zero_acc<1, 1>(acc);
                int m, n; const LAS bf16_t* bt; LAS bf16_t* dst; int pitch;
                if (tt < 8) { m = tt >> 1; n = tt & 1; bt = Makb + 16 * n * 40; dst = (LAS bf16_t*)(rec + R_G); pitch = 32; }
                else if (tt < 16) { m = (tt - 8) >> 1; n = (tt - 8) & 1; bt = Mrkb + 16 * n * 40; dst = (LAS bf16_t*)(rec + R_YV); pitch = 32; }
                else { m = (tt - 16) >> 2; n = (tt - 16) & 3; bt = Ktt + 16 * n * 40; dst = (LAS bf16_t*)(rec + R_HV); pitch = 64; }
                lds_mma<1, 1, 1>(acc, Vt + 16 * m * 40, 40, bt, 40, lane);
                const f32x4 v = acc[0][0];
                *(LAS unsigned long long*)(dst + (16 * m + (lane & 15)) * pitch + 16 * n + 4 * (lane >> 4)) = (unsigned long long)pk2(v[0], v[1]) | ((unsigned long long)pk2(v[2], v[3]) << 32); } }
        LDS_BARRIER();
        if (w == 0) {
            f32x4 acc[1][1]; zero_acc<1, 1>(acc);
            lds_mma<1, 1, 1>(acc, iA1, 40, iB1, 40, lane);
#pragma unroll
            for (int e = 0; e < 4; ++e) iWt[(4 * (lane >> 4) + e) * 40 + (lane & 15)] = (bf16_t)f2bf(acc[0][0][e]);
            asm volatile("s_waitcnt lgkmcnt(0)" ::: "memory");
            zero_acc<1, 1>(acc);
            lds_mma<1, 1, 1>(acc, iA2, 40, iWt, 40, lane);
            const f32x4 v = acc[0][0];
            *(LAS unsigned long long*)((LAS bf16_t*)(rec + R_TL) + (16 + (lane & 15)) * 40 + 4 * (lane >> 4)) = (unsigned long long)pk2(v[0], v[1]) | ((unsigned long long)pk2(v[2], v[3]) << 32);
        }
        LDS_BARRIER();
        { GAS u32x4* dst = (GAS u32x4*)(recg + ((size_t)(b * 8 + hd) * 72 + c) * REC_BYTES);
            for (int p = tid; p < REC_BYTES / 16; p += 512) dst[p] = *(const LAS u32x4*)(rec + (size_t)p * 16); }
    }
    __syncthreads();
}

__device__ __forceinline__ void rwkv_seq(const PV& P, int l, int unit, LAS unsigned char* lds) {
    const int tid = otid(), lane = tid & 63, w = tid >> 6, fr = lane & 15, fq = lane >> 4;
    const int dir = unit & 1, h = (unit >> 1) & 3, b = unit >> 3;
    LAS unsigned char* recb = lds;
    LAS bf16_t* S0b = (LAS bf16_t*)(lds + 2 * REC_BYTES);
    LAS bf16_t* Xb = S0b + 4608;
    LAS bf16_t* SAb = Xb + 2560;
    LAS float* Ys = (LAS float*)(SAb + 2560);
    GAS bf16_t* yout = (GAS bf16_t*)(P.ws + WS_Y) + (size_t)(0 * 2 + dir) * YSZ;
    const GAS u32x4* recg = (const GAS u32x4*)(P.ws + WS_REC + (size_t)unit * 72 * REC_BYTES);
    for (int idx = tid; idx < 4608 / 2; idx += 512) ((LAS unsigned*)S0b)[idx] = 0u;
    f32x4 Sacc[1][2]; zero_acc<1, 2>(Sacc);
    const int ms = w >> 1, nbs = (w & 1) * 2;
    const int m1 = w & 3;
    u32x4 pre[5];
    auto issue = [&](int c) {
#pragma unroll
        for (int k = 0; k < 5; ++k) { const int p = tid + 512 * k; pre[k] = (u32x4){0u, 0u, 0u, 0u}; if (p < REC_BYTES / 16) pre[k] = recg[(size_t)c * (REC_BYTES / 16) + p]; } };
    issue(0);
    for (int c = 0; c < 72; ++c) {
        LAS unsigned char* rec = recb + (c & 1) * REC_BYTES;
#pragma unroll
        for (int k = 0; k < 5; ++k) { const int p = tid + 512 * k; if (p < REC_BYTES / 16) *(LAS u32x4*)(rec + (size_t)p * 16) = pre[k]; }
        LDS_BARRIER();
        if (c + 1 < 72) issue(c + 1);
        if (c > 0) {
            const int cp = c - 1; const bool isctx = cp < 8; const int cc = isctx ? cp : cp - 8, seqlen = isctx ? CTX : SEQ;
            const int tlo = dir ? seqlen - 32 - 32 * cc : 32 * cc; const size_t rb = isctx ? (size_t)TL + b * CTX : (size_t)b * SEQ;
            const int i = tid >> 4, rg = tid & 15, t = dir ? tlo + 31 - i : tlo + i;
            const f32x4 v = *(const LAS f32x4*)(Ys + i * 64 + 4 * rg);
            *(GAS unsigned long long*)(yout + (rb + t) * 256 + h * 64 + 4 * rg) = (unsigned long long)pk2(v[0], v[1]) | ((unsigned long long)pk2(v[2], v[3]) << 32); }
        f32x4 aPQ[1][2]; zero_acc<1, 2>(aPQ);
        lds_mma<1, 2, 2>(aPQ, S0b + 16 * m1 * 72, 72, (const LAS bf16_t*)(rec + (w < 4 ? R_AT : R_RT)), 72, lane);
        if (w < 4) {
#pragma unroll
            for (int n = 0; n < 2; ++n) { const u32x2 gw = *(const LAS u32x2*)(rec + R_G + ((16 * m1 + fr) * 32 + 16 * n + 4 * fq) * 2);
                const float x0 = aPQ[0][n][0] + bflo(gw.x), x1 = aPQ[0][n][1] + bfhi(gw.x), x2 = aPQ[0][n][2] + bflo(gw.y), x3 = aPQ[0][n][3] + bfhi(gw.y);
                *(LAS unsigned long long*)(Xb + (16 * m1 + fr) * 40 + 16 * n + 4 * fq) = (unsigned long long)pk2(x0, x1) | ((unsigned long long)pk2(x2, x3) << 32); } }
        LDS_BARRIER();
        { const int n2 = w >> 2; f32x4 aSA[1][1]; zero_acc<1, 1>(aSA);
            lds_mma<1, 1, 1>(aSA, Xb + 16 * m1 * 40, 40, (const LAS bf16_t*)(rec + R_TL) + 16 * n2 * 40, 40, lane);
            const f32x4 v = aSA[0][0];
            *(LAS unsigned long long*)(SAb + (16 * m1 + fr) * 40 + 16 * n2 + 4 * fq) = (unsigned long long)pk2(v[0], v[1]) | ((unsigned long long)pk2(v[2], v[3]) << 32); }
        LDS_BARRIER();
        if (w >= 4) { lds_mma<1, 2, 1>(aPQ, SAb + 16 * m1 * 40, 40, (const LAS bf16_t*)(rec + R_MRB), 40, lane);
#pragma unroll
            for (int n = 0; n < 2; ++n) { const u32x2 yw = *(const LAS u32x2*)(rec + R_YV + ((16 * m1 + fr) * 32 + 16 * n + 4 * fq) * 2);
                const int t0 = 16 * n + 4 * fq, row = 16 * m1 + fr;
                Ys[(t0 + 0) * 64 + row] = aPQ[0][n][0] + bflo(yw.x); Ys[(t0 + 1) * 64 + row] = aPQ[0][n][1] + bfhi(yw.x);
                Ys[(t0 + 2) * 64 + row] = aPQ[0][n][2] + bflo(yw.y); Ys[(t0 + 3) * 64 + row] = aPQ[0][n][3] + bfhi(yw.y); } }
        { f32x4 aS[1][2]; zero_acc<1, 2>(aS);
            lds_mma<1, 2, 1>(aS, SAb + 16 * ms * 40, 40, (const LAS bf16_t*)(rec + R_BT) + 16 * nbs * 40, 40, lane);
#pragma unroll
            for (int n = 0; n < 2; ++n) { const int k0 = 16 * (nbs + n) + 4 * fq, row = 16 * ms + fr;
                const u32x2 hw = *(const LAS u32x2*)(rec + R_HV + (row * 64 + k0) * 2); const f32x4 gm = *(const LAS f32x4*)(rec + R_GAM + k0 * 4);
                f32x4 sn; sn[0] = gm[0] * (Sacc[0][n][0] + aS[0][n][0] + bflo(hw.x)); sn[1] = gm[1] * (Sacc[0][n][1] + aS[0][n][1] + bfhi(hw.x));
                sn[2] = gm[2] * (Sacc[0][n][2] + aS[0][n][2] + bflo(hw.y)); sn[3] = gm[3] * (Sacc[0][n][3] + aS[0][n][3] + bfhi(hw.y));
                Sacc[0][n] = sn;
                *(LAS unsigned long long*)(S0b + row * 72 + k0) = (unsigned long long)pk2(sn[0], sn[1]) | ((unsigned long long)pk2(sn[2], sn[3]) << 32); } }
    }
    LDS_BARRIER();
    { const int cp = 71; const int seqlen = SEQ, cc = cp - 8; const int tlo = dir ? seqlen - 32 - 32 * cc : 32 * cc; const size_t rb = (size_t)b * SEQ;
        const int i = tid >> 4, rg = tid & 15, t = dir ? tlo + 31 - i : tlo + i;
        const f32x4 v = *(const LAS f32x4*)(Ys + i * 64 + 4 * rg);
        *(GAS unsigned long long*)(yout + (rb + t) * 256 + h * 64 + 4 * rg) = (unsigned long long)pk2(v[0], v[1]) | ((unsigned long long)pk2(v[2], v[3]) << 32); }
    __syncthreads();
}

__device__ __forceinline__ void ret_unit(const PV& P, int l, int unit, LAS unsigned char* lds) {
    const int tid = otid(), lane = tid & 63, w = tid >> 6;
    const int dir = unit & 1, h = (unit >> 1) & 3, b = unit >> 3;
    LAS bf16_t* Qs = (LAS bf16_t*)lds; LAS bf16_t* Ks = Qs + 4608; LAS bf16_t* Kt = Ks + 4608; LAS bf16_t* Vt = Kt + 4608; LAS bf16_t* Att = Vt + 4608; LAS bf16_t* St = Att + 4608;
    const GAS bf16_t* z = (const GAS bf16_t*)(P.ws + WS_Z);
    GAS bf16_t* yout = (GAS bf16_t*)(P.ws + WS_Y) + (size_t)(1 * 2 + dir) * YSZ;
    const float lg = __logf(1.0f - exp2f(-((dir ? 5.5f : 5.0f) + (float)h)));
    for (int idx = tid; idx < 4608; idx += 512) St[idx] = 0;
    f32x4 Sacc[1][2]; zero_acc<1, 2>(Sacc);
    const int m = w >> 1, nb = (w & 1) * 2, fr = lane & 15, fq = lane >> 4;
    const float cdec = __expf(lg * 64.0f);
    u32x4 pre[3];
    auto tok = [&](int c, int i, size_t& rb, int& pos) -> int {
        const bool isctx = c < 4; const int cc = isctx ? c : c - 4, seqlen = isctx ? CTX : SEQ;
        const int tlo = dir ? seqlen - 64 - 64 * cc : 64 * cc; rb = isctx ? (size_t)TL + b * CTX : (size_t)b * SEQ;
        const int t = dir ? tlo + 63 - i : tlo + i; pos = (isctx ? 0 : CTX) + t; return t;
    };
    auto issue_loads = [&](int c) { const int i = tid >> 3, vc = tid & 7; size_t rb; int pos; const int t = tok(c, i, rb, pos);
#pragma unroll
        for (int k = 0; k < 3; ++k) pre[k] = *(const GAS u32x4*)(z + (rb + t) * ZW + CB_ + k * 256 + h * 64 + vc * 8); };
    issue_loads(0);
    for (int c = 0; c < 36; ++c) {
        LDS_BARRIER();
        { const int i = tid >> 3, vc = tid & 7;
            *(LAS u32x4*)(Qs + i * 72 + vc * 8) = pre[0]; *(LAS u32x4*)(Ks + i * 72 + vc * 8) = pre[1];
            const unsigned vw[4] = {pre[2].x, pre[2].y, pre[2].z, pre[2].w};
#pragma unroll
            for (int e = 0; e < 4; ++e) { Vt[(vc * 8 + 2 * e) * 72 + i] = (bf16_t)(vw[e] & 0xffffu); Vt[(vc * 8 + 2 * e + 1) * 72 + i] = (bf16_t)(vw[e] >> 16); } }
        LDS_BARRIER();
        if (c + 1 < 36) issue_loads(c + 1);
#pragma unroll
        for (int k = 0; k < 4; ++k) { const int idx = tid + 512 * k, i = idx >> 5, d = idx & 31; size_t rb; int pos; tok(c, i, rb, pos);
            float rev = (float)pos * (exp2f(-(float)d * (13.287712379549449f / 32.0f)) * 0.15915494309189535f); rev -= floorf(rev);
            const float sn = __builtin_amdgcn_sinf(rev), cs = __builtin_amdgcn_cosf(rev);
            const float q1 = bf2f(Qs[i * 72 + d]), q2 = bf2f(Qs[i * 72 + d + 32]), k1 = bf2f(Ks[i * 72 + d]), k2 = bf2f(Ks[i * 72 + d + 32]);
            Qs[i * 72 + d] = (bf16_t)f2bf((q1 * cs - q2 * sn) * 0.125f); Qs[i * 72 + d + 32] = (bf16_t)f2bf((q1 * sn + q2 * cs) * 0.125f);
            const float o1 = k1 * cs - k2 * sn, o2 = k1 * sn + k2 * cs, wd = __expf(lg * (float)(63 - i));
            Ks[i * 72 + d] = (bf16_t)f2bf(o1); Ks[i * 72 + d + 32] = (bf16_t)f2bf(o2);
            Kt[d * 72 + i] = (bf16_t)f2bf(o1 * wd); Kt[(d + 32) * 72 + i] = (bf16_t)f2bf(o2 * wd); }
        LDS_BARRIER();
        f32x4 aS[1][2], aO2[1][2]; zero_acc<1, 2>(aS); zero_acc<1, 2>(aO2);
        lds_mma<1, 2, 2>(aS, Qs + 16 * m * 72, 72, Ks + 16 * nb * 72, 72, lane);
        lds_mma<1, 2, 2>(aO2, Qs + 16 * m * 72, 72, St + 16 * nb * 72, 72, lane);
        const int i = 16 * m + fr;
#pragma unroll
        for (int n = 0; n < 2; ++n) { float o[4];
#pragma unroll
            for (int e = 0; e < 4; ++e) { const int j = 16 * (nb + n) + 4 * fq + e, diff = i - j; const bool keep = dir ? diff > 0 : diff >= 0;
                o[e] = keep ? aS[0][n][e] * __expf(lg * (float)diff) : 0.f; }
            *(LAS unsigned long long*)(Att + i * 72 + 16 * (nb + n) + 4 * fq) = (unsigned long long)pk2(o[0], o[1]) | ((unsigned long long)pk2(o[2], o[3]) << 32); }
        LDS_BARRIER();
        f32x4 aO1[1][2], aT[1][2]; zero_acc<1, 2>(aO1); zero_acc<1, 2>(aT);
        lds_mma<1, 2, 2>(aO1, Att + 16 * m * 72, 72, Vt + 16 * nb * 72, 72, lane);
        lds_mma<1, 2, 2>(aT, Vt + 16 * m * 72, 72, Kt + 16 * nb * 72, 72, lane);
        { size_t rb; int pos; const int t = tok(c, i, rb, pos); const float rd = __expf(lg * (float)(i + 1));
#pragma unroll
            for (int n = 0; n < 2; ++n) { const f32x4 o = aO1[0][n] + rd * aO2[0][n];
                *(GAS unsigned long long*)(yout + (rb + t) * 256 + h * 64 + 16 * (nb + n) + 4 * fq) = (unsigned long long)pk2(o[0], o[1]) | ((unsigned long long)pk2(o[2], o[3]) << 32); } }
#pragma unroll
        for (int n = 0; n < 2; ++n) { Sacc[0][n] = cdec * Sacc[0][n] + aT[0][n]; const f32x4 s = Sacc[0][n];
            *(LAS unsigned long long*)(St + i * 72 + 16 * (nb + n) + 4 * fq) = (unsigned long long)pk2(s[0], s[1]) | ((unsigned long long)pk2(s[2], s[3]) << 32); }
    }
    __syncthreads();
}

__device__ __forceinline__ void lru_items(const PV& P, int l, LAS unsigned char* lds) {
    const int tid0 = otid();
    LAS bf16_t* waT = (LAS bf16_t*)lds; LAS bf16_t* wxT = waT + 4608; LAS bf16_t* xcb = wxT + 4608;
    LAS float* xraw = (LAS float*)(lds + 27648);
    LAS float* xcf = xraw + 67 * 64;
    LAS float* a_s = xcf + 4352; LAS float* b_s = a_s + 4352;
    LAS float* segA = b_s + 4352; LAS float* segH = segA + 512; LAS float* par = segH + 512;
    const GAS bf16_t* z = (const GAS bf16_t*)(P.ws + WS_Z);
    int cur_key = -1;
    u32x4 pre[2];
    auto geo = [&](int u, int& key, int& b, int& c, int& tlo, int& seqlen, size_t& rb) { key = u & 7; const int rest = u >> 3; b = rest / 36; c = rest % 36; const int dir = key >> 2;
        const bool isctx = c < 4; const int cc = isctx ? c : c - 4; seqlen = isctx ? CTX : SEQ; tlo = dir ? seqlen - 64 - 64 * cc : 64 * cc; rb = isctx ? (size_t)TL + b * CTX : (size_t)b * SEQ; };
    auto issue = [&](int u, int tid) { int key, b, c, tlo, seqlen; size_t rb; geo(u, key, b, c, tlo, seqlen, rb);
#pragma unroll
        for (int k = 0; k < 2; ++k) { const int v = tid + 512 * k; pre[k] = (u32x4){0u, 0u, 0u, 0u};
            if (v < 536) { const int rr = v >> 3, vc = v & 7, t = tlo - 2 + rr; if (t >= 0 && t < seqlen) pre[k] = *(const GAS u32x4*)(z + (rb + t) * ZW + CC_ + (key & 3) * 64 + vc * 8); } } };
    if ((int)blockIdx.x < 2304) issue(blockIdx.x, tid0);
    for (int u = blockIdx.x; u < 2304; u += gridDim.x) {
        const int tid = otid(), lane = tid & 63, w = tid >> 6;
        int key, b, c, tlo, seqlen; size_t rb; geo(u, key, b, c, tlo, seqlen, rb); const int dir = key >> 2, blk = key & 3;
        GAS bf16_t* hout = (GAS bf16_t*)(P.ws + WS_Y) + (size_t)(2 * 2 + dir) * YSZ; GAS bf16_t* aout = (GAS bf16_t*)(P.ws + WS_ACU) + (size_t)dir * YSZ;
        LDS_BARRIER();
        if (key != cur_key) { cur_key = key;
            for (int idx = tid; idx < 4096; idx += 512) { const int i = idx >> 6, j = idx & 63; const size_t o = ((size_t)((l * 2 + dir) * 4 + blk) * 64 + i) * 64 + j;
                waT[j * 72 + i] = (bf16_t)f2bf(PIN(I_WA)[o]); wxT[j * 72 + i] = (bf16_t)f2bf(PIN(I_WX)[o]); }
            { const int k = tid >> 6, cc = tid & 63, ch = blk * 64 + cc; float v;
                if (k < 4) v = PIN(I_CVW)[(l * 4 + k) * 256 + ch]; else if (k == 4) v = PIN(I_CVB)[l * 256 + ch];
                else if (k == 5) v = PIN(I_BA)[(l * 2 + dir) * 256 + ch]; else if (k == 6) v = PIN(I_BX)[(l * 2 + dir) * 256 + ch];
                else v = softplusf_(-PIN(I_LAM)[(l * 2 + dir) * 256 + ch]);
                par[tid] = v; } }
#pragma unroll
        for (int k = 0; k < 2; ++k) { const int v = tid + 512 * k; if (v < 536) { const unsigned ww[4] = {pre[k].x, pre[k].y, pre[k].z, pre[k].w};
#pragma unroll
                for (int e = 0; e < 4; ++e) { xraw[v * 8 + 2 * e] = bflo(ww[e]); xraw[v * 8 + 2 * e + 1] = bfhi(ww[e]); } } }
        LDS_BARRIER();
        if (u + (int)gridDim.x < 2304) issue(u + gridDim.x, tid);
        { const int ch = tid & 63, tg = tid >> 6;
#pragma unroll
            for (int e = 0; e < 8; ++e) { const int tt = tg * 8 + e;
                const float xc = par[256 + ch] + par[ch] * xraw[tt * 64 + ch] + par[64 + ch] * xraw[(tt + 1) * 64 + ch] + par[128 + ch] * xraw[(tt + 2) * 64 + ch] + par[192 + ch] * xraw[(tt + 3) * 64 + ch];
                const int i = dir ? 63 - tt : tt; xcf[i * 68 + ch] = xc; xcb[i * 72 + ch] = (bf16_t)f2bf(xc); } }
        LDS_BARRIER();
        { const int m = w >> 1, nb = (w & 1) * 2, fr = lane & 15, fq = lane >> 4;
            f32x4 aR[1][2], aI[1][2]; zero_acc<1, 2>(aR); zero_acc<1, 2>(aI);
            lds_mma<1, 2, 2>(aR, xcb + 16 * m * 72, 72, waT + 16 * nb * 72, 72, lane);
            lds_mma<1, 2, 2>(aI, xcb + 16 * m * 72, 72, wxT + 16 * nb * 72, 72, lane);
            const int i = 16 * m + fr;
#pragma unroll
            for (int n = 0; n < 2; ++n) { f32x4 av, bv;
#pragma unroll
                for (int e = 0; e < 4; ++e) { const int ch = 16 * (nb + n) + 4 * fq + e;
                    const float r = sigmoidf_(aR[0][n][e] + par[320 + ch]), ig = sigmoidf_(aI[0][n][e] + par[384 + ch]);
                    const float la = -8.0f * r * par[448 + ch]; av[e] = __expf(la);
                    const float y2 = 2.0f * la;
                    const float om = y2 > -0.125f ? -y2 * (1.0f + y2 * (0.5f + y2 * (0.16666667f + y2 * (0.041666668f + y2 * 0.0083333338f)))) : 1.0f - __expf(y2);
                    bv[e] = sqrtf(fmaxf(om, 0.f)) * ig * xcf[i * 68 + ch]; }
                *(LAS f32x4*)(a_s + i * 68 + 16 * (nb + n) + 4 * fq) = av; *(LAS f32x4*)(b_s + i * 68 + 16 * (nb + n) + 4 * fq) = bv; } }
        LDS_BARRIER();
        const int ch = tid & 63, seg = tid >> 6;
        float av[8], bv[8];
        { float A = 1.f, H = 0.f;
#pragma unroll
            for (int e = 0; e < 8; ++e) { const int i = seg * 8 + e; av[e] = a_s[i * 68 + ch]; bv[e] = b_s[i * 68 + ch]; }
#pragma unroll
            for (int e = 0; e < 8; ++e) { H = av[e] * H + bv[e]; A *= av[e]; av[e] = A; bv[e] = H; }
            segA[seg * 64 + ch] = A; segH[seg * 64 + ch] = H; }
        LDS_BARRIER();
        float hin = 0.f, ap = 1.f;
#pragma unroll
        for (int s2 = 0; s2 < 7; ++s2) if (s2 < seg) { const float sa = segA[s2 * 64 + ch]; hin = sa * hin + segH[s2 * 64 + ch]; ap *= sa; }
#pragma unroll
        for (int e = 0; e < 8; ++e) { const int i = seg * 8 + e; const int t = dir ? tlo + 63 - i : tlo + i;
            const float hl = bv[e] + av[e] * hin, ac = av[e] * ap;
            hout[(rb + t) * 256 + blk * 64 + ch] = (bf16_t)f2bf(hl); aout[(rb + t) * 256 + blk * 64 + ch] = (bf16_t)f2bf(ac);
            if (i == 63) { GAS float* ag = (GAS float*)(P.ws + WS_AGG) + ((size_t)((b * 2 + dir) * 36 + c) * 2) * 256 + blk * 64 + ch; ag[0] = ac; ag[256] = hl; } }
    }
    __syncthreads();
}
__device__ __forceinline__ void lru_carry_unit(const PV& P, int unit) {
    const int tid = otid();
    if (tid < 256) { const float* ag = (const float*)(P.ws + WS_AGG) + (size_t)unit * 36 * 512 + tid; float* ci = (float*)(P.ws + WS_CIN) + (size_t)unit * 36 * 256 + tid;
        float A[36], H[36];
#pragma unroll
        for (int c = 0; c < 36; ++c) { A[c] = ag[c * 512]; H[c] = ag[c * 512 + 256]; }
        float carry = 0.f;
#pragma unroll
        for (int c = 0; c < 36; ++c) { ci[c * 256] = carry; carry = A[c] * carry + H[c]; } }
}

__device__ __forceinline__ void s5_unit(const PV& P, int l, int unit, LAS unsigned char* lds) {
    const int tid = otid(), lane = tid & 63, w = tid >> 6;
    const int gp = unit & 7, dir = (unit >> 3) & 1, b = unit >> 4;
    LAS float* bu0 = (LAS float*)lds;
    LAS bf16_t* Hs0 = (LAS bf16_t*)(lds + 66560);
    LAS bf16_t* Us0 = (LAS bf16_t*)(lds + 100352);
    LAS bf16_t* Bbu = (LAS bf16_t*)(lds + 105472);
    LAS bf16_t* By = (LAS bf16_t*)(lds + 125952);
    const GAS bf16_t* z = (const GAS bf16_t*)(P.ws + WS_Z);
    GAS bf16_t* yout = (GAS bf16_t*)(P.ws + WS_Y) + (size_t)(3 * 2 + dir) * YSZ;
    for (int idx = tid; idx < 256 * 40 / 2; idx += 512) ((LAS unsigned*)Bbu)[idx] = 0u;
    __syncthreads();
    float lr = 0.f, li = 0.f, hr = 0.f, hi = 0.f;
    if (tid < 128) { const int gl = tid >> 6, p = tid & 63, g = 2 * gp + gl; const size_t pidx = ((size_t)(l * 2 + dir) * 16 + g) * 64 + p;
        const float are = PIN(I_SARE)[pidx], aim = PIN(I_SAIM)[pidx], dt = __expf(PIN(I_SLDT)[(l * 2 + dir) * 16 + g]);
        const float mag = __expf(are * dt); float rev = aim * dt * 0.15915494309189535f; rev -= floorf(rev);
        lr = mag * __builtin_amdgcn_cosf(rev); li = mag * __builtin_amdgcn_sinf(rev);
        const float nre = lr - 1.0f, nim = li, den = 1.0f / (are * are + aim * aim);
        const float cre = (nre * are + nim * aim) * den, cim = (nim * are - nre * aim) * den;
#pragma unroll
        for (int c = 0; c < 16; ++c) { const float bre = PIN(I_SBRE)[pidx * 16 + c], bim = PIN(I_SBIM)[pidx * 16 + c];
            Bbu[(gl * 128 + p) * 40 + gl * 16 + c] = (bf16_t)f2bf(cre * bre - cim * bim); Bbu[(gl * 128 + 64 + p) * 40 + gl * 16 + c] = (bf16_t)f2bf(cre * bim + cim * bre); } }
    for (int idx = tid; idx < 4096; idx += 512) { const int gl = idx >> 11, c = (idx >> 7) & 15, kk = idx & 127, part = kk >> 6, p = kk & 63, g = 2 * gp + gl;
        const size_t src = (((size_t)(l * 2 + dir) * 16 + g) * 16 + c) * 64 + p;
        By[(gl * 16 + c) * 136 + kk] = (bf16_t)f2bf(part ? -PIN(I_SCIM)[src] : PIN(I_SCRE)[src]); }
    auto rowof = [&](int c, int i) -> size_t {
        if (c < 8) { const int s = 32 * c + i, t = dir ? 255 - s : s; return (size_t)TL + b * CTX + t; }
        const int sl = 32 * (c - 8) + i, slr = dir ? 2047 - sl : sl, col = slr >> 5, rg = slr & 31; return (size_t)b * SEQ + rg * 64 + col; };
    const int t6 = tid - 384;
    u32x4 pre = (u32x4){0u, 0u, 0u, 0u};
    if (w >= 6) { pre = *(const GAS u32x4*)(z + rowof(0, t6 >> 2) * ZW + CD_ + gp * 32 + (t6 & 3) * 8); *(LAS u32x4*)(Us0 + (t6 >> 2) * 40 + (t6 & 3) * 8) = pre;
        pre = *(const GAS u32x4*)(z + rowof(1, t6 >> 2) * ZW + CD_ + gp * 32 + (t6 & 3) * 8); }
    __syncthreads();
#pragma unroll 1
    for (int k = 0; k < 74; ++k) {
        if (w < 2) {
            const float hr_s = hr, hi_s = hi;
            for (int r3 = 0; r3 < ((PROBE_DUP & 524288) ? 2 : 1); ++r3)
            if (k >= 1 && k <= 72) { const LAS float* bu = bu0 + ((k - 1) & 1) * 8320; LAS bf16_t* Hs = Hs0 + ((k - 1) & 1) * 8448; hr = hr_s; hi = hi_s;
                const int cr = (tid >> 6) * 128 + (tid & 63), ci = cr + 64;
#pragma unroll 1
                for (int i0 = 0; i0 < 32; i0 += 8) { float br[8], bi[8];
#pragma unroll
                    for (int e = 0; e < 8; ++e) { br[e] = bu[(i0 + e) * 260 + cr]; bi[e] = bu[(i0 + e) * 260 + ci]; }
                    unsigned orr[8];
#pragma unroll
                    for (int e = 0; e < 8; ++e) { const float nr = lr * hr - li * hi + br[e], ni = lr * hi + li * hr + bi[e]; hr = nr; hi = ni; orr[e] = pk2a(nr, ni); }
#pragma unroll
                    for (int e = 0; e < 8; ++e) { Hs[(i0 + e) * 264 + cr] = (bf16_t)(orr[e] & 0xffffu); Hs[(i0 + e) * 264 + ci] = (bf16_t)(orr[e] >> 16); } } }
        } else if (w < 6) {
            for (int r3 = 0; r3 < ((PROBE_DUP & 131072) ? 2 : 1); ++r3)
            if (k <= 71) { LAS float* bu = bu0 + (k & 1) * 8320; const LAS bf16_t* Us = Us0 + (k & 1) * 1280; const int wq = w - 2;
                f32x4 acc[2][4]; zero_acc<2, 4>(acc);
                lds_mma<2, 4, 1>(acc, Us, 40, Bbu + 64 * wq * 40, 40, lane);
#pragma unroll
                for (int mm = 0; mm < 2; ++mm)
#pragma unroll
                    for (int n = 0; n < 4; ++n) *(LAS f32x4*)(bu + (16 * mm + (lane & 15)) * 260 + 64 * wq + 16 * n + 4 * (lane >> 4)) = acc[mm][n]; }
        } else {
            for (int r3 = 0; r3 < ((PROBE_DUP & 262144) ? 2 : 1); ++r3)
            if (k >= 2) { const LAS bf16_t* Hs = Hs0 + (k & 1) * 8448; const int gl = w - 6, cy = k - 2;
                f32x4 acc[2][1]; zero_acc<2, 1>(acc);
                lds_mma<2, 1, 4>(acc, Hs + gl * 128, 264, By + gl * 16 * 136, 136, lane);
#pragma unroll
                for (int mm = 0; mm < 2; ++mm) { const int i = 16 * mm + (lane & 15); const f32x4 v = acc[mm][0];
                    *(GAS unsigned long long*)(yout + rowof(cy, i) * 256 + gp * 32 + gl * 16 + 4 * (lane >> 4)) = (unsigned long long)pk2(v[0], v[1]) | ((unsigned long long)pk2(v[2], v[3]) << 32); } }
            if (k + 1 <= 71) { *(LAS u32x4*)(Us0 + ((k + 1) & 1) * 1280 + (t6 >> 2) * 40 + (t6 & 3) * 8) = pre;
                if (k + 2 <= 71) pre = *(const GAS u32x4*)(z + rowof(k + 2, t6 >> 2) * ZW + CD_ + gp * 32 + (t6 & 3) * 8); }
        }
        LDS_BARRIER();
    }
    __syncthreads();
}

__device__ __forceinline__ float sum16(float v) { v = sum8(v); return v + dppf<0x140>(v); }
struct CmbRow { u32x2 zr[3], zk[3], zv[3], zg[3], gB, gC, uD, y[8], ac[2]; f32x4 ci[2]; };
__device__ __forceinline__ void p3_combine(const PV& P, int l, int nrows, LAS unsigned char* lds) {
    const int tid = otid(), lane = tid & 63, w = tid >> 6, c4 = 4 * lane, hh = lane >> 4;
    LAS float* gup = (LAS float*)lds;
    LAS float* smu = gup + 16384;
    LAS float* spar = smu + 1664;
    LAS float* sgs = spar + 1280 + w * 64;
    for (int idx = tid; idx < 16384; idx += 512) gup[idx] = PIN(I_GUP)[(size_t)l * 16384 + idx];
    for (int idx = tid; idx < 1664; idx += 512) { const int which = idx / 832, col = idx % 832; smu[idx] = PIN(I_MU)[(size_t)(l * 2 + which) * 960 + col]; }
    for (int idx = tid; idx < 1280; idx += 512) { const int k = idx >> 8, c = idx & 255;
        spar[idx] = k == 0 ? PIN(I_LNG)[l * 256 + c] : k == 1 ? PIN(I_LNB)[l * 256 + c] : k == 2 ? PIN(I_RK)[l * 256 + c] : k == 3 ? PIN(I_GNG)[l * 256 + c] : PIN(I_SD)[l * 256 + c]; }
    __syncthreads();
    const GAS bf16_t* z = (const GAS bf16_t*)(P.ws + WS_Z); const GAS bf16_t* Y = (const GAS bf16_t*)(P.ws + WS_Y);
    GAS bf16_t* mix = (GAS bf16_t*)(P.ws + WS_ACT); GAS bf16_t* s5g = (GAS bf16_t*)(P.ws + WS_S5G);
    const int gw = blockIdx.x * 8 + w, NGW = gridDim.x * 8;
    auto ld = [&](int row, CmbRow& L) {
        const bool isctx = row >= TL; const int t = isctx ? ((row - TL) & 255) : (row & 2047), seqlen = isctx ? CTX : SEQ;
        const GAS bf16_t* zr = z + (size_t)row * ZW;
#pragma unroll
        for (int d = 0; d < 3; ++d) { const bool ok = d == 1 || (d == 0 ? t > 0 : t < seqlen - 1); const GAS bf16_t* zz = zr + (d - 1) * ZW; const u32x2 zero = (u32x2){0u, 0u};
            L.zr[d] = ok ? *(const GAS u32x2*)(zz + c4) : zero; L.zk[d] = ok ? *(const GAS u32x2*)(zz + 256 + c4) : zero; L.zv[d] = ok ? *(const GAS u32x2*)(zz + 512 + c4) : zero;
            L.zg[d] = (ok && lane < 16) ? *(const GAS u32x2*)(zz + 768 + c4) : zero; }
        L.gB = *(const GAS u32x2*)(zr + CB_ + 768 + c4); L.gC = *(const GAS u32x2*)(zr + CC_ + 256 + c4); L.uD = *(const GAS u32x2*)(zr + CD_ + c4);
#pragma unroll
        for (int k = 0; k < 8; ++k) L.y[k] = *(const GAS u32x2*)(Y + (size_t)k * YSZ + (size_t)row * 256 + c4);
        const int bb = isctx ? (row - TL) >> 8 : row >> 11;
#pragma unroll
        for (int d = 0; d < 2; ++d) { const int ts = d ? seqlen - 1 - t : t, ck = (isctx ? 0 : 4) + (ts >> 6);
            L.ac[d] = *(const GAS u32x2*)((const GAS bf16_t*)(P.ws + WS_ACU) + (size_t)d * YSZ + (size_t)row * 256 + c4);
            L.ci[d] = *(const GAS f32x4*)((const GAS float*)(P.ws + WS_CIN) + ((size_t)(bb * 2 + d) * 36 + ck) * 256 + c4); }
    };
    auto up4 = [](const u32x2 v, float (&o)[4]) { o[0] = bflo(v.x); o[1] = bfhi(v.x); o[2] = bflo(v.y); o[3] = bfhi(v.y); };
    auto st4 = [](GAS bf16_t* p, const float (&o)[4]) { *(GAS unsigned long long*)p = (unsigned long long)pk2(o[0], o[1]) | ((unsigned long long)pk2(o[2], o[3]) << 32); };
    auto shift4 = [&](const u32x2 (&zz)[3], int col, float (&o)[4]) { float a[4], m[4], n[4]; up4(zz[1], a); up4(zz[0], m); up4(zz[2], n);
        const f32x4 u0 = *(const LAS f32x4*)(smu + col), u1 = *(const LAS f32x4*)(smu + 832 + col);
#pragma unroll
        for (int e = 0; e < 4; ++e) o[e] = a[e] + u0[e] * (m[e] - a[e]) + u1[e] * (n[e] - a[e]); };
    auto cmp = [&](int row, const CmbRow& L) {
        if (lane < 16) { float gl[4]; shift4(L.zg, 768 + c4, gl);
            *(LAS f32x4*)(sgs + c4) = (f32x4){sigmoidf_(gl[0]), sigmoidf_(gl[1]), sigmoidf_(gl[2]), sigmoidf_(gl[3])}; }
        asm volatile("s_waitcnt lgkmcnt(0)" ::: "memory");
        f32x4 g = (f32x4){0.f, 0.f, 0.f, 0.f};
#pragma unroll 8
        for (int i = 0; i < 64; ++i) g += sgs[i] * *(const LAS f32x4*)(gup + i * 256 + c4);
        float r[4], k[4], v[4]; shift4(L.zr, c4, r); shift4(L.zk, 256 + c4, k); shift4(L.zv, 512 + c4, v);
        const f32x4 lng = *(const LAS f32x4*)(spar + c4), lnb = *(const LAS f32x4*)(spar + 256 + c4), rk = *(const LAS f32x4*)(spar + 512 + c4), gng = *(const LAS f32x4*)(spar + 768 + c4), sd = *(const LAS f32x4*)(spar + 1024 + c4);
        float ya[4], yb[4], t0[4], t1[4];
        up4(L.y[0], t0); up4(L.y[1], t1);
#pragma unroll
        for (int e = 0; e < 4; ++e) ya[e] = t0[e] + t1[e];
        { const float mean = sum16((ya[0] + ya[1]) + (ya[2] + ya[3])) * (1.0f / 64.0f); float q = 0.f, bsum = 0.f;
#pragma unroll
            for (int e = 0; e < 4; ++e) { ya[e] -= mean; q += ya[e] * ya[e]; bsum += r[e] * k[e] * rk[e]; }
            const float rs = rsqrtf(sum16(q) * (1.0f / 64.0f) + 64e-5f); bsum = sum16(bsum); float o[4];
#pragma unroll
            for (int e = 0; e < 4; ++e) o[e] = (ya[e] * rs * lng[e] + lnb[e] + bsum * v[e]) * g[e];
            st4(mix + (size_t)row * 1024 + c4, o); }
        up4(L.y[2], t0); up4(L.y[3], t1);
#pragma unroll
        for (int e = 0; e < 4; ++e) yb[e] = t0[e] + t1[e];
        { const float mean = sum16((yb[0] + yb[1]) + (yb[2] + yb[3])) * (1.0f / 64.0f); float q = 0.f;
#pragma unroll
            for (int e = 0; e < 4; ++e) { yb[e] -= mean; q += yb[e] * yb[e]; }
            const float rs = rsqrtf(sum16(q) * (1.0f / 64.0f) + 1e-5f); float gt[4], o[4]; up4(L.gB, gt);
#pragma unroll
            for (int e = 0; e < 4; ++e) o[e] = siluf_(gt[e]) * (yb[e] * rs * gng[e]);
            st4(mix + (size_t)row * 1024 + 256 + c4, o); }
        { float gt[4], o[4], a0[4], a1[4]; up4(L.gC, gt); up4(L.y[4], t0); up4(L.y[5], t1); up4(L.ac[0], a0); up4(L.ac[1], a1);
#pragma unroll
            for (int e = 0; e < 4; ++e) o[e] = geluf_(gt[e]) * ((t0[e] + a0[e] * L.ci[0][e]) + (t1[e] + a1[e] * L.ci[1][e]));
            st4(mix + (size_t)row * 1024 + 512 + c4, o); }
        { float uu[4], o[4]; up4(L.uD, uu); up4(L.y[6], t0); up4(L.y[7], t1);
#pragma unroll
            for (int e = 0; e < 4; ++e) o[e] = geluf_(sd[e] * uu[e] + t0[e] + t1[e]);
            st4(s5g + (size_t)row * 256 + c4, o); }
    };
    (void)hh;
    for (int row = gw; row < nrows; row += 2 * NGW) {
        CmbRow LA, LB; const int rowB = row + NGW; const bool hasB = rowB < nrows;
        ld(row, LA); if (hasB) ld(rowB, LB);
        cmp(row, LA); if (hasB) cmp(rowB, LB);
    }
}

__device__ __forceinline__ void p6_h2(const PV& P, int l, int nrows) {
    const int tid = otid(), lane = tid & 63, gw = blockIdx.x * 8 + (tid >> 6), NGW = gridDim.x * 8;
    const float* mod = (const float*)(P.ws + WS_MOD) + (size_t)l * 9 * 6144; const float* X1 = (const float*)(P.ws + WS_X1);
    bf16_t* act = (bf16_t*)(P.ws + WS_ACT);
    for (int row = gw; row < nrows; row += NGW) { const int mr = row < TL ? (row >> 11) : 8;
        float x[16], y[16]; load_row16(X1 + (size_t)row * 1024, lane, x);
        norm_mod16(x, PIN(I_N2G) + l * 1024, mod + (size_t)mr * 6144 + 3 * 1024, mod + (size_t)mr * 6144 + 4 * 1024, lane, y);
        store_row16_bf16(act + (size_t)row * 1024, lane, y); }
}

__device__ __forceinline__ unsigned skey(float f) { const unsigned u = __builtin_bit_cast(unsigned, f); return u ^ ((unsigned)((int)u >> 31) | 0x80000000u); }
__device__ __forceinline__ float unskey(unsigned s) { const unsigned u = (s & 0x80000000u) ? (s ^ 0x80000000u) : ~s; return __builtin_bit_cast(float, u); }

__device__ __forceinline__ void p8a_topk(const PV& P, int nrows, LAS unsigned char* lds) {
    const int tid = otid();
    LAS unsigned* tb = (LAS unsigned*)lds;
    const GAS float* sc = (const GAS float*)(P.ws + WS_SC); GAS u32x2* list = (GAS u32x2*)(P.ws + WS_LIST);
    const int items = nrows * 16, nth = gridDim.x * 512;
    for (int item = blockIdx.x * 512 + tid; item < items; item += nth) {
        const int row = item >> 4, hp = item & 15, hh = hp >> 1, p = hp & 1;
        const GAS f32x4* sp = (const GAS f32x4*)(sc + (size_t)row * 2048 + hp * 128);
        unsigned top[16];
#pragma unroll
        for (int s = 0; s < 16; ++s) top[s] = 0u;
#pragma unroll 2
        for (int e4 = 0; e4 < 32; ++e4) { const f32x4 v = sp[e4];
#pragma unroll
            for (int k = 0; k < 4; ++k) { unsigned key = (skey(v[k]) & 0xFFFFFF80u) | (unsigned)(e4 * 4 + k);
#pragma unroll
                for (int s = 0; s < 16; ++s) { const unsigned hi = max(top[s], key); key = min(top[s], key); top[s] = hi; } } }
        float v1[16], v2[16]; unsigned i1[16], i2[16];
#pragma unroll
        for (int s = 0; s < 16; ++s) { const float mv = unskey(top[s] & 0xFFFFFF80u); const unsigned mi = top[s] & 127u;
            const float ov = dppf<0xB1>(mv); const unsigned oi = dppu<0xB1>(mi);
            v1[s] = p ? ov : mv; i1[s] = p ? oi : mi; v2[s] = p ? mv : ov; i2[s] = p ? mi : oi; }
        unsigned k2[16];
#pragma unroll
        for (int s = 0; s < 16; ++s) k2[s] = 0u;
#pragma unroll
        for (int a = 0; a < 16; ++a)
#pragma unroll
            for (int bb = 0; bb < 16; ++bb) if ((a + 1) * (bb + 1) <= 16) {
                unsigned key = (skey(v1[a] + v2[bb]) & 0xFFFFFF00u) | (unsigned)(a * 16 + bb);
#pragma unroll
                for (int s = 0; s < 16; ++s) { const unsigned hi = max(k2[s], key); key = min(k2[s], key); k2[s] = hi; } }
#pragma unroll
        for (int s = 0; s < 16; ++s) { tb[s * 512 + tid] = i1[s]; tb[(16 + s) * 512 + tid] = i2[s]; }
        const float mx = unskey(k2[0] & 0xFFFFFF00u); float ev[16], sum = 0.f; unsigned pl[16];
#pragma unroll
        for (int s = 0; s < 16; ++s) { ev[s] = __expf(unskey(k2[s] & 0xFFFFFF00u) - mx); sum += ev[s];
            const unsigned a = (k2[s] >> 4) & 15u, bb = k2[s] & 15u; pl[s] = (tb[a * 512 + tid] << 7) | tb[(16 + bb) * 512 + tid]; }
        const float inv = __builtin_amdgcn_rcpf(sum);
        if (p == 0) { GAS u32x2* lp = list + (size_t)row * 128 + hh * 16;
#pragma unroll
            for (int s = 0; s < 16; ++s) lp[s] = (u32x2){pl[s], __builtin_bit_cast(unsigned, ev[s] * inv)}; }
    }
}

template <class PT> __device__ __forceinline__ void load_row16c(PT p, int lane, float (&x)[16]) {
#pragma unroll
    for (int k = 0; k < 4; ++k) { const f32x4 a = *(const GAS f32x4*)(p + 16 * lane + 4 * k);
#pragma unroll
        for (int e = 0; e < 4; ++e) x[4 * k + e] = a[e]; }
}
template <class PT> __device__ __forceinline__ void store_row16c_f32(PT p, int lane, const float (&x)[16]) {
#pragma unroll
    for (int k = 0; k < 4; ++k) *(GAS f32x4*)(p + 16 * lane + 4 * k) = (f32x4){x[4 * k], x[4 * k + 1], x[4 * k + 2], x[4 * k + 3]};
}
template <class PT> __device__ __forceinline__ void store_row16c_bf16(PT p, int lane, const float (&y)[16]) {
    u32x4 a, b; a.x = pk2(y[0], y[1]); a.y = pk2(y[2], y[3]); a.z = pk2(y[4], y[5]); a.w = pk2(y[6], y[7]);
    b.x = pk2(y[8], y[9]); b.y = pk2(y[10], y[11]); b.z = pk2(y[12], y[13]); b.w = pk2(y[14], y[15]);
    *(GAS u32x4*)(p + 16 * lane) = a; *(GAS u32x4*)(p + 16 * lane + 8) = b;
}
template <class G1, class G2> __device__ __forceinline__ void norm_mod16c(const float (&x)[16], G1 g, G2 shift, G2 scale, int lane, float (&y)[16]) {
    float ss = 0.f;
#pragma unroll
    for (int e = 0; e < 16; ++e) ss += x[e] * x[e];
    ss = wave_sum(ss);
    const float r = rsqrtf(ss * (1.0f / 1024.0f) + 1e-6f);
    float gg[16]; load_row16c(g, lane, gg);
    if (shift) { float sh[16], sc[16]; load_row16c(shift, lane, sh); load_row16c(scale, lane, sc);
#pragma unroll
        for (int e = 0; e < 16; ++e) y[e] = x[e] * r * gg[e] * (1.0f + sc[e]) + sh[e];
    } else {
#pragma unroll
        for (int e = 0; e < 16; ++e) y[e] = x[e] * r * gg[e];
    }
}
__device__ __forceinline__ void p8u_dots(const PV& P, int l, int nrows) {
    const int tid = otid(), lane = tid & 63, w = tid >> 6, eg = lane >> 3, cs = lane & 7;
    const bool sliced = (gridDim.x & 7) == 0;
    const int x0 = sliced ? (blockIdx.x & 7) : 0, xstep = sliced ? 8 : 1;
    const int gwx = sliced ? (blockIdx.x >> 3) * 8 + w : blockIdx.x * 8 + w, nW = sliced ? (gridDim.x >> 3) * 8 : gridDim.x * 8;
    const GAS unsigned* listw = (const GAS unsigned*)(P.ws + WS_LIST); const GAS bf16_t* h2 = (const GAS bf16_t*)(P.ws + WS_ACT);
    GAS float* pd = (GAS float*)(P.ws + WS_SC);
    for (int x = x0; x < 8; x += xstep) {
        const GAS unsigned char* U8 = (const GAS unsigned char*)P.ws + WS_U8 + (size_t)l * NEXP * 1024 + 128 * x + 16 * cs;
        unsigned idn[16]; u32x4 uu[16]; u32x4 hc0, hc1, hn0, hn1;
        int row = gwx;
        if (row < nrows) {
#pragma unroll
            for (int g = 0; g < 16; ++g) idn[g] = listw[((size_t)row * 128 + 8 * g + eg) * 2];
            hc0 = *(const GAS u32x4*)(h2 + (size_t)row * 1024 + 128 * x + 16 * cs); hc1 = *(const GAS u32x4*)(h2 + (size_t)row * 1024 + 128 * x + 16 * cs + 8);
#pragma unroll
            for (int g = 0; g < 16; ++g) uu[g] = *(const GAS u32x4*)(U8 + (size_t)idn[g] * 1024);
            const int rn = row + nW < nrows ? row + nW : row;
#pragma unroll
            for (int g = 0; g < 16; ++g) idn[g] = listw[((size_t)rn * 128 + 8 * g + eg) * 2];
            hn0 = *(const GAS u32x4*)(h2 + (size_t)rn * 1024 + 128 * x + 16 * cs); hn1 = *(const GAS u32x4*)(h2 + (size_t)rn * 1024 + 128 * x + 16 * cs + 8);
        }
        for (; row < nrows; row += nW) {
            f32x2 hx[8];
            hx[0] = (f32x2){bflo(hc0.x), bfhi(hc0.x)}; hx[1] = (f32x2){bflo(hc0.y), bfhi(hc0.y)}; hx[2] = (f32x2){bflo(hc0.z), bfhi(hc0.z)}; hx[3] = (f32x2){bflo(hc0.w), bfhi(hc0.w)};
            hx[4] = (f32x2){bflo(hc1.x), bfhi(hc1.x)}; hx[5] = (f32x2){bflo(hc1.y), bfhi(hc1.y)}; hx[6] = (f32x2){bflo(hc1.z), bfhi(hc1.z)}; hx[7] = (f32x2){bflo(hc1.w), bfhi(hc1.w)};
            GAS float* pdr = pd + ((size_t)x * nrows + row) * 128 + eg;
#pragma unroll
            for (int g = 0; g < 16; ++g) { f32x2 a2 = (f32x2){0.f, 0.f};
#pragma unroll
                for (int q = 0; q < 4; ++q) { const f32x2 lo = __builtin_amdgcn_cvt_pk_f32_fp8((int)uu[g][q], false), hi = __builtin_amdgcn_cvt_pk_f32_fp8((int)uu[g][q], true);
                    a2 += lo * hx[2 * q]; a2 += hi * hx[2 * q + 1]; }
                uu[g] = *(const GAS u32x4*)(U8 + (size_t)idn[g] * 1024);
                const float d = sum8(a2[0] + a2[1]);
                if (cs == 0) pdr[8 * g] = d; }
            hc0 = hn0; hc1 = hn1;
            const int r2 = row + 2 * nW < nrows ? row + 2 * nW : row;
#pragma unroll
            for (int g = 0; g < 16; ++g) idn[g] = listw[((size_t)r2 * 128 + 8 * g + eg) * 2];
            hn0 = *(const GAS u32x4*)(h2 + (size_t)r2 * 1024 + 128 * x + 16 * cs); hn1 = *(const GAS u32x4*)(h2 + (size_t)r2 * 1024 + 128 * x + 16 * cs + 8);
        }
    }
}
__device__ __forceinline__ void p8c_coef(const PV& P, int nrows) {
    const int tid = otid();
    GAS unsigned* listw = (GAS unsigned*)(P.ws + WS_LIST); const GAS float* pd = (const GAS float*)(P.ws + WS_SC);
    const int n = nrows * 128, nth = gridDim.x * 512;
    for (int i = blockIdx.x * 512 + tid; i < n; i += nth) { float s = 0.f;
#pragma unroll
        for (int xx = 0; xx < 8; ++xx) s += pd[(size_t)xx * n + i];
        const float g = __builtin_bit_cast(float, listw[(size_t)i * 2 + 1]);
        listw[(size_t)i * 2 + 1] = __builtin_bit_cast(unsigned, g * geluf_(s * (1.0f / 32.0f)) * 0.5f); }
}
__device__ __forceinline__ void p8v_accum(const PV& P, int l, int nrows, LAS unsigned char* lds) {
    const int tid = otid(), lane = tid & 63, w = tid >> 6, eg = lane >> 3, cs = lane & 7;
    const bool sliced = (gridDim.x & 7) == 0;
    const int x0 = sliced ? (blockIdx.x & 7) : 0, xstep = sliced ? 8 : 1;
    const int gwx = sliced ? (blockIdx.x >> 3) * 8 + w : blockIdx.x * 8 + w, nW = sliced ? (gridDim.x >> 3) * 8 : gridDim.x * 8;
    const GAS unsigned* listw = (const GAS unsigned*)(P.ws + WS_LIST);
    const GAS float* modl = (const GAS float*)(P.ws + WS_MOD) + (size_t)l * 9 * 6144; const GAS float* X1 = (const GAS float*)(P.ws + WS_X1);
    LAS float* cl = (LAS float*)(lds + w * 1024);
    LAS unsigned* il = (LAS unsigned*)(cl + 128);
    const bool b5 = (lane & 32) != 0, b4 = (lane & 16) != 0, b3 = (lane & 8) != 0;
    for (int x = x0; x < 8; x += xstep) {
        const GAS unsigned char* V8 = (const GAS unsigned char*)P.ws + WS_V8 + (size_t)l * NEXP * 1024 + 128 * x + 16 * cs;
        unsigned n_i0, n_i1, n_c0, n_c1;
        u32x4 vv[16]; float cfc[16];
#define V_LOAD1(r) do { const GAS unsigned* lw = listw + ((size_t)(r) * 128 + lane) * 2; n_i0 = lw[0]; n_c0 = lw[1]; n_i1 = lw[128]; n_c1 = lw[129]; } while (0)
#define V_TOLDS() do { cl[lane] = __builtin_bit_cast(float, n_c0); cl[64 + lane] = __builtin_bit_cast(float, n_c1); il[lane] = n_i0; il[64 + lane] = n_i1; asm volatile("s_waitcnt lgkmcnt(0)" ::: "memory"); } while (0)
        int row = gwx;
        if (row < nrows) {
            V_LOAD1(row); V_TOLDS();
#pragma unroll
            for (int g = 0; g < 16; ++g) { const unsigned id = il[8 * g + eg]; cfc[g] = cl[8 * g + eg]; vv[g] = *(const GAS u32x4*)(V8 + (size_t)id * 1024); }
            const int rn = row + nW < nrows ? row + nW : row;
            V_LOAD1(rn); asm volatile("s_waitcnt lgkmcnt(0)" ::: "memory"); V_TOLDS();
            const int r2 = row + 2 * nW < nrows ? row + 2 * nW : row;
            V_LOAD1(r2);
        }
        for (; row < nrows; row += nW) { const int mr = row < TL ? (row >> 11) : 8;
            f32x2 acc[8];
#pragma unroll
            for (int j = 0; j < 8; ++j) acc[j] = (f32x2){0.f, 0.f};
#pragma unroll
            for (int g = 0; g < 16; ++g) { const f32x2 c2 = (f32x2){cfc[g], cfc[g]};
#pragma unroll
                for (int q = 0; q < 4; ++q) { const f32x2 lo = __builtin_amdgcn_cvt_pk_f32_fp8((int)vv[g][q], false), hi = __builtin_amdgcn_cvt_pk_f32_fp8((int)vv[g][q], true);
                    acc[2 * q] += c2 * lo; acc[2 * q + 1] += c2 * hi; }
                const unsigned id = il[8 * g + eg]; cfc[g] = cl[8 * g + eg]; vv[g] = *(const GAS u32x4*)(V8 + (size_t)id * 1024); }
            f32x2 a4[4], a2v[2], a1;
#pragma unroll
            for (int j = 0; j < 4; ++j) { const f32x2 snd = b5 ? acc[j] : acc[j + 4], kp = b5 ? acc[j + 4] : acc[j]; a4[j] = kp + (f32x2){__shfl_xor(snd[0], 32), __shfl_xor(snd[1], 32)}; }
#pragma unroll
            for (int j = 0; j < 2; ++j) { const f32x2 snd = b4 ? a4[j] : a4[j + 2], kp = b4 ? a4[j + 2] : a4[j]; a2v[j] = kp + (f32x2){__shfl_xor(snd[0], 16), __shfl_xor(snd[1], 16)}; }
            { const f32x2 snd = b3 ? a2v[0] : a2v[1], kp = b3 ? a2v[1] : a2v[0]; a1 = kp + (f32x2){__shfl_xor(snd[0], 8), __shfl_xor(snd[1], 8)}; }
            const int col = 128 * x + 16 * cs + 2 * eg;
            const f32x2 xm = *(const GAS f32x2*)(X1 + (size_t)row * 1024 + col), g5 = *(const GAS f32x2*)(modl + (size_t)mr * 6144 + 5 * 1024 + col);
            GAS float* xo = row < TL ? (GAS float*)P.out + (size_t)row * 1024 : (GAS float*)(P.ws + WS_X0C) + (size_t)(row - TL) * 1024;
            *(GAS f32x2*)(xo + col) = xm + g5 * a1;
            V_TOLDS();
            const int r3 = row + 3 * nW < nrows ? row + 3 * nW : row;
            V_LOAD1(r3);
        }
#undef V_LOAD1
#undef V_TOLDS
    }
}
__device__ __forceinline__ void p8w_norm(const PV& P, int l, int nrows) {
    const int tid = otid(), lane = tid & 63, gw = blockIdx.x * 8 + (tid >> 6), NGW = gridDim.x * 8;
    for (int row = gw; row < nrows; row += NGW) { const int mr = row < TL ? (row >> 11) : 8;
        float* xo = row < TL ? P.out + (size_t)row * 1024 : (float*)(P.ws + WS_X0C) + (size_t)(row - TL) * 1024;
        float xn[16], y[16]; load_row16c(xo, lane, xn);
        if (l == 0) { const float* mod1 = (const float*)(P.ws + WS_MOD) + (size_t)9 * 6144 + (size_t)mr * 6144;
            norm_mod16c(xn, PIN(I_N1G) + 1024, mod1, mod1 + 1024, lane, y);
            store_row16c_bf16((bf16_t*)(P.ws + WS_ACT) + (size_t)row * 1024, lane, y);
        } else { norm_mod16c(xn, PIN(I_FNG), (const float*)nullptr, (const float*)nullptr, lane, y); store_row16c_f32(xo, lane, y); }
    }
}

typedef __attribute__((address_space(1))) unsigned gu32;
#define XB_TMO      128
#define XB_XCNT(j)  (256  + 64 * (j))
#define XB_XSUB(j)  (1280 + 64 * (j))
#define XB_XGEN(j)  (2304 + 64 * (j))
#define XB_TOP      3328
#define XB_TOPGEN   3392
#define XCD_BAR_WORDS 3456
#define XB_SPIN_CAP (1u << 18)

__device__ __forceinline__ unsigned xb_ld(unsigned* p)              { return __hip_atomic_load(p, __ATOMIC_RELAXED, __HIP_MEMORY_SCOPE_AGENT); }
__device__ __forceinline__ unsigned xb_add(unsigned* p, unsigned v) { return __hip_atomic_fetch_add(p, v, __ATOMIC_RELAXED, __HIP_MEMORY_SCOPE_AGENT); }
__device__ __forceinline__ unsigned xb_xcc_id() { return (unsigned)__builtin_amdgcn_s_getreg((3 << 11) | 20) & 0xFu; }
#define XB_SPIN(cond, bar) do { unsigned _sp = 0; while (cond) { __builtin_amdgcn_s_sleep(1); \
    if ((++_sp & 255u) == 0u) { if (xb_ld(&(bar)[XB_TMO])) break; if (_sp > XB_SPIN_CAP) { atomicAdd(&(bar)[XB_TMO], 1u); break; } } } } while (0)

struct XcdBarrier {
    unsigned* bar; unsigned x;
    volatile LAS unsigned* st;
};

__device__ __forceinline__ XcdBarrier xcd_barrier_post(unsigned* bar, volatile LAS unsigned* st) {
    XcdBarrier b; b.bar = bar; b.x = xb_xcc_id(); b.st = st;
    if (threadIdx.x == 0) (void)xb_add(&bar[XB_XCNT(b.x)], 1u);
    return b;
}
__device__ __forceinline__ void xcd_barrier_complete(unsigned* bar, unsigned x, unsigned& nloc, unsigned& nx) {
    const unsigned G = gridDim.x * gridDim.y * gridDim.z;
    unsigned sum, cnt, mine, sp = 0u;
    for (;;) {
        sum = 0u; cnt = 0u; mine = 0u;
#pragma unroll
        for (unsigned j = 0; j < 16; ++j) { const unsigned c = xb_ld(&bar[XB_XCNT(j)]); sum += c; cnt += (c > 0u) ? 1u : 0u; mine = (j == x) ? c : mine; }
        if (sum == G) break;
        __builtin_amdgcn_s_sleep(1);
        if ((++sp & 255u) == 0u) { if (xb_ld(&bar[XB_TMO])) break; if (sp > XB_SPIN_CAP) { atomicAdd(&bar[XB_TMO], 1u); break; } }
    }
    nloc = mine > 0u ? mine : 1u; nx = cnt > 0u ? cnt : 1u;
}

__device__ __forceinline__ void xcd_barrier(const XcdBarrier& b) {
    asm volatile("s_waitcnt vmcnt(0)" ::: "memory");
    __syncthreads();
    if (threadIdx.x == 0) {
        unsigned* bar = b.bar;
        __builtin_amdgcn_s_waitcnt(0);
        unsigned nloc = b.st[0], nx = b.st[1];
        if (nloc == 0u) { xcd_barrier_complete(bar, b.x, nloc, nx); b.st[0] = nloc; b.st[1] = nx; }
        const unsigned old = xb_add(&bar[XB_XSUB(b.x)], 1u);
        const unsigned gen = old / nloc;
        if (old + 1u == (gen + 1u) * nloc) {
            __builtin_amdgcn_fence(__ATOMIC_RELEASE, "agent");
            asm volatile("s_waitcnt vmcnt(0)" ::: "memory");
            const unsigned og = xb_add(&bar[XB_TOP], 1u);
            const unsigned tg = og / nx;
            if (og + 1u == (tg + 1u) * nx) xb_add(&bar[XB_TOPGEN], 1u);
            else XB_SPIN(xb_ld(&bar[XB_TOPGEN]) == tg, bar);
            __builtin_amdgcn_fence(__ATOMIC_ACQUIRE, "agent");
            xb_add(&bar[XB_XGEN(b.x)], 1u);
            asm volatile("s_waitcnt vmcnt(0)" ::: "memory");
        } else {
            XB_SPIN(xb_ld(&bar[XB_XGEN(b.x)]) == gen, bar);
            __builtin_amdgcn_fence(__ATOMIC_ACQUIRE, "agent");
            asm volatile("s_waitcnt vmcnt(0)" ::: "memory");
        }
    }
    __syncthreads();
}

#define GSYNC() do { xcd_barrier(xbar); if (PROBE_DUP & 32) xcd_barrier(xbar); } while (0)
template <int l>
__device__ __forceinline__ void run_layer(const PV& P, const XcdBarrier& xbar) {
    const int nrows = l == 0 ? TT : TL;
    for (int rep = 0; rep < ((PROBE_DUP & 8) ? 2 : 1); ++rep) { const PV Q = opq(P);
        pg8::Gemm g{(const bf16_t*)(Q.ws + WS_ACT), (const bf16_t*)(Q.ws + WS_WIN) + (size_t)l * ZW * 1024, TT, ZW, 1024};
        pg8::StaticOrder S; S.init(TT, ZW, gridDim.x, blockIdx.x);
        pg8::EpiZ E{(bf16_t*)(Q.ws + WS_Z), ZW};
        pg8::gemm_phase<pg8::EpiZ, pg8::StaticOrder, true, true>(Q.lds, g, S, E); }
    GSYNC();
    for (int rep = 0; rep < ((PROBE_DUP & 128) ? 2 : 1); ++rep) { const PV Q = opq(P); rwkv_pre(Q, l, Q.lds); }
    for (int rep = 0; rep < ((PROBE_DUP & 65536) ? 2 : 1); ++rep) { const PV Q = opq(P); lru_items(Q, l, Q.lds); }
    GSYNC();
    for (int rep = 0; rep < ((PROBE_DUP & 2) ? 2 : 1); ++rep) {
        for (;;) {
            const PV Q = opq(P);
            __syncthreads();
            if (otid() == 0) *(LAS int*)(Q.lds + LDS_BYTES - 16) = (int)atomicAdd((unsigned*)(Q.ws + WS_CTL) + 64 * (1 + l + 2 * rep), 1u);
            __syncthreads();
            const int u = *(LAS int*)(Q.lds + LDS_BYTES - 16);
            if (u >= 272) break;
            if (u < 128) { for (int r2 = 0; r2 < ((PROBE_DUP & 16384) ? 2 : 1); ++r2) s5_unit(Q, l, u, Q.lds); }
            else if (u < 192) { for (int r2 = 0; r2 < ((PROBE_DUP & 4096) ? 2 : 1); ++r2) rwkv_seq(Q, l, u - 128, Q.lds); }
            else if (u < 256) { for (int r2 = 0; r2 < ((PROBE_DUP & 8192) ? 2 : 1); ++r2) ret_unit(Q, l, u - 192, Q.lds); }
            else lru_carry_unit(Q, u - 256);
        }
        if (PROBE_DUP & 2) GSYNC();
    }
    if (!(PROBE_DUP & 2)) GSYNC();
    for (int rep = 0; rep < ((PROBE_DUP & 16) ? 2 : 1); ++rep) { const PV Q = opq(P); p3_combine(Q, l, nrows, Q.lds); __syncthreads(); }
    GSYNC();
    for (int rep = 0; rep < ((PROBE_DUP & 8) ? 2 : 1); ++rep) { const PV Q = opq(P);
        pg8::Gemm g{(const bf16_t*)(Q.ws + WS_S5G), (const bf16_t*)(Q.ws + WS_GLU) + (size_t)l * 512 * 256, nrows, 512, 256};
        pg8::StaticOrder S; S.init(nrows, 512, gridDim.x, blockIdx.x);
        pg8::EpiGlu E{(bf16_t*)(Q.ws + WS_ACT), inp_(Q.tab, I_GLUB) + l * 512};
        pg8::gemm_phase<pg8::EpiGlu, pg8::StaticOrder, true, true>(Q.lds, g, S, E); }
    GSYNC();
    for (int rep = 0; rep < ((PROBE_DUP & 8) ? 2 : 1); ++rep) { const PV Q = opq(P);
        pg8::Gemm g{(const bf16_t*)(Q.ws + WS_ACT), (const bf16_t*)(Q.ws + WS_WOUT) + (size_t)l * 1024 * 1024, nrows, 1024, 1024};
        pg8::StaticOrder S; S.init(nrows, 1024, gridDim.x, blockIdx.x);
        pg8::EpiRes E{l == 0 ? inp_(Q.tab, I_X) : (const float*)Q.out, l == 0 ? inp_(Q.tab, I_CTX) : (const float*)(Q.ws + WS_X0C),
                      (const float*)(Q.ws + WS_MOD) + (size_t)l * 9 * 6144 + 2048, (float*)(Q.ws + WS_X1)};
        pg8::gemm_phase<pg8::EpiRes, pg8::StaticOrder, true, true>(Q.lds, g, S, E); }
    GSYNC();
    for (int rep = 0; rep < ((PROBE_DUP & 16) ? 2 : 1); ++rep) { const PV Q = opq(P); p6_h2(Q, l, nrows); }
    GSYNC();
    for (int rep = 0; rep < ((PROBE_DUP & 8) ? 2 : 1); ++rep) { const PV Q = opq(P);
        pg8::Gemm g{(const bf16_t*)(Q.ws + WS_ACT), (const bf16_t*)(Q.ws + WS_WEFF) + (size_t)l * 2048 * 1024, nrows, 2048, 1024};
        pg8::StaticOrder S; S.init(nrows, 2048, gridDim.x, blockIdx.x);
        pg8::EpiF32 E{(float*)(Q.ws + WS_SC), 2048};
        pg8::gemm_phase<pg8::EpiF32, pg8::StaticOrder, true, true>(Q.lds, g, S, E); }
    GSYNC();
    for (int rep = 0; rep < ((PROBE_DUP & 4) ? 2 : 1); ++rep) { const PV Q = opq(P); p8a_topk(Q, nrows, Q.lds); }
    GSYNC();
    for (int rep = 0; rep < ((PROBE_DUP & 1) ? 2 : 1); ++rep) { const PV Q = opq(P); p8u_dots(Q, l, nrows); }
    GSYNC();
    { const PV Q = opq(P); p8c_coef(Q, nrows); }
    GSYNC();
    for (int rep = 0; rep < ((PROBE_DUP & 2048) ? 2 : 1); ++rep) { const PV Q = opq(P); p8v_accum(Q, l, nrows, Q.lds); }
    GSYNC();
    { const PV Q = opq(P); p8w_norm(Q, l, nrows); }
    if (l == 0) GSYNC();
}

__global__ void __launch_bounds__(512, 2) fwd_mega(Params KP) {
    extern __shared__ __attribute__((aligned(16))) unsigned char lds_raw[];
    LAS unsigned char* lds = (LAS unsigned char*)lds_raw;
    cg::grid_group grid = cg::this_grid();
    const int tid = otid();
    PV P; P.tab = (const LAS unsigned*)(lds + LDS_BYTES - 1024); P.ws = KP.ws; P.out = KP.out; P.lds = lds;
    if (tid < 88) { const unsigned* ka = (const unsigned*)__builtin_amdgcn_kernarg_segment_ptr(); ((LAS unsigned*)(lds + LDS_BYTES - 1024))[tid] = ka[tid]; }
    if (tid < 4) ((LAS unsigned*)(lds + LDS_BYTES - 64))[tid] = 0u;
    __syncthreads();
    const XcdBarrier xbar = xcd_barrier_post((unsigned*)(KP.ws + WS_CTL) + 4096, (volatile LAS unsigned*)(lds + LDS_BYTES - 64));

    for (int rep = 0; rep < ((PROBE_DUP & 64) ? 2 : 1); ++rep) { const PV Q = opq(P); p0_prologue(Q, Q.lds); __syncthreads(); }
    if (KP.ws == nullptr) grid.sync();
    GSYNC();
    { const PV Q = opq(P); p0b_ain(Q); }
    GSYNC();

    run_layer<0>(P, xbar);
    run_layer<1>(P, xbar);
}

extern "C" void kernel_launch(void* const* d_in, const int* in_sizes, int n_in, void* d_out, int out_size, void* d_ws, size_t ws_size, hipStream_t stream) {
    static int grid = 0;
    if (grid == 0) {
        if (n_in != 44 || out_size != TL * DM || ws_size < WS_END) { fprintf(stderr, "kernel_launch: unexpected shapes (n_in %d, out %d, ws %zu; need ws >= %zu)\n", n_in, out_size, ws_size, (size_t)WS_END); grid = -1; return; }
        int dev = 0, cus = 0, per_cu = 0;
        hipGetDevice(&dev); hipDeviceGetAttribute(&cus, hipDeviceAttributeMultiprocessorCount, dev);
        hipFuncSetAttribute((const void*)fwd_mega, hipFuncAttributeMaxDynamicSharedMemorySize, LDS_BYTES);
        hipOccupancyMaxActiveBlocksPerMultiprocessor(&per_cu, (const void*)fwd_mega, 512, LDS_BYTES);
        if (per_cu < 1) { fprintf(stderr, "kernel_launch: occupancy query says %d blocks/CU\n", per_cu); per_cu = 1; }
        grid = cus;
        (void)hipGetLastError();
    }
    if (grid < 0) return;
    hipMemsetAsync((char*)d_ws + WS_CTL, 0, 65536, stream);
    Params p{};
    for (int i = 0; i < 44; ++i) p.in[i] = (const float*)d_in[i];
    p.out = (float*)d_out; p.ws = (unsigned char*)d_ws;
    void* args[] = {&p};
    hipError_t e = hipLaunchCooperativeKernel((const void*)fwd_mega, dim3(grid), dim3(512), args, LDS_BYTES, stream);
    if (e != hipSuccess) fprintf(stderr, "cooperative launch failed: %s (grid %d)\n", hipGetErrorString(e), grid);
}
```

```cpp
#include <hip/hip_runtime.h>
#include <hip/hip_cooperative_groups.h>
#include <hip/hip_fp16.h>
#include <cstdio>
#include <cstdint>
namespace cg = cooperative_groups;

#define LAS __attribute__((address_space(3)))
#define GAS __attribute__((address_space(1)))
typedef unsigned short bf16_t;
typedef short bf16x8 __attribute__((ext_vector_type(8)));
typedef float f32x4 __attribute__((ext_vector_type(4)));
typedef float f32x2 __attribute__((ext_vector_type(2)));
typedef unsigned u32x4 __attribute__((ext_vector_type(4)));
typedef unsigned u32x2 __attribute__((ext_vector_type(2)));
typedef _Float16 h16x2 __attribute__((ext_vector_type(2)));

constexpr int DM = 1024, NB = 8, SEQ = 2048, CTX = 256;
constexpr int TL = NB * SEQ;
constexpr int TC = NB * CTX;
constexpr int TT = TL + TC;
constexpr int ZW = 2816;
constexpr int INC = 2752;
constexpr int CB_ = 960, CC_ = 1984, CD_ = 2496;
constexpr int NEXP = 16384;

constexpr size_t MiB = 1u << 20;
constexpr size_t WS_CTL = 0;
constexpr size_t WS_MOD = 1 * MiB;
constexpr size_t WS_WIN = 2 * MiB;
constexpr size_t WS_WOUT = 14 * MiB;
constexpr size_t WS_WEFF = 18 * MiB;
constexpr size_t WS_GLU = 26 * MiB;
constexpr size_t WS_U8 = 28 * MiB;
constexpr size_t WS_V8 = 60 * MiB;
constexpr size_t WS_REC = 156 * MiB;
constexpr size_t WS_ACT = 156 * MiB;
constexpr size_t WS_S5G = 192 * MiB;
constexpr size_t WS_X1 = 202 * MiB;
constexpr size_t WS_X0C = 274 * MiB;
constexpr size_t WS_Z = 316 * MiB;
constexpr size_t WS_Y = 415 * MiB;
constexpr size_t WS_SC = 316 * MiB;
constexpr size_t WS_LIST = 462 * MiB;
constexpr size_t WS_ACU = 487 * MiB;
constexpr size_t WS_AGG = 505 * MiB;
constexpr size_t WS_CIN = 507 * MiB;
constexpr size_t WS_END = 508 * MiB;
constexpr size_t YSZ = (size_t)TT * 256;
static_assert(WS_SC + (size_t)TT * 2048 * 4 <= WS_LIST && WS_LIST + (size_t)TT * 128 * 8 <= WS_END, "ws map");
static_assert(WS_Y + 8 * YSZ * 2 <= WS_END && WS_Z + (size_t)TT * ZW * 2 <= WS_Y, "ws map");
static_assert(WS_REC + (size_t)64 * 72 * 36096 <= WS_Z, "ws map");

constexpr int LDS_BYTES = 147456;

struct Params { const float* in[44]; float* out; unsigned char* ws; };
struct PV { const LAS unsigned* tab; unsigned char* ws; float* out; LAS unsigned char* lds; };
__device__ __forceinline__ const float* inp_(const LAS unsigned* tab, int i) {
    const unsigned lo = (unsigned)__builtin_amdgcn_readfirstlane((int)tab[2 * i]), hi = (unsigned)__builtin_amdgcn_readfirstlane((int)tab[2 * i + 1]);
    return (const float*)(((unsigned long long)hi << 32) | (unsigned long long)lo);
}
#define PIN(i) inp_(P.tab, (i))
__device__ __forceinline__ PV opq(const PV& P) { PV q = P; unsigned o = 0; asm volatile("" : "+s"(q.ws), "+s"(q.out), "+s"(o)); q.lds = P.lds + o; q.tab = (const LAS unsigned*)(q.lds + LDS_BYTES - 1024); return q; }
enum { I_X = 0, I_C, I_CTX, I_CCTX, I_N1G, I_N2G, I_ADAW, I_ADAB, I_WIN, I_WOUT, I_MU, I_W0, I_WUP, I_A0, I_AUP, I_GUP, I_KK, I_KA, I_RK, I_LNG, I_LNB,
       I_GNG, I_CVW, I_CVB, I_WA, I_BA, I_WX, I_BX, I_LAM, I_SARE, I_SAIM, I_SLDT, I_SBRE, I_SBIM, I_SCRE, I_SCIM, I_SD, I_GLUW, I_GLUB, I_WQ, I_KEYS, I_PU, I_PV, I_FNG };

#define LDS_BARRIER() do { asm volatile("s_waitcnt lgkmcnt(0)" ::: "memory"); __builtin_amdgcn_s_barrier(); asm volatile("" ::: "memory"); } while (0)
__device__ __forceinline__ int otid() { int t = threadIdx.x; asm volatile("" : "+v"(t)); return t; }
__device__ __forceinline__ unsigned f2bf(float f) { unsigned u = __builtin_bit_cast(unsigned, f); return (u + 0x7fffu + ((u >> 16) & 1u)) >> 16; }
__device__ __forceinline__ unsigned pk2(float lo, float hi) { return f2bf(lo) | (f2bf(hi) << 16); }
__device__ __forceinline__ unsigned pk2a(float lo, float hi) { unsigned r; asm("v_cvt_pk_bf16_f32 %0, %1, %2" : "=v"(r) : "v"(lo), "v"(hi)); return r; }
__device__ __forceinline__ float bf2f(unsigned b) { return __builtin_bit_cast(float, b << 16); }
__device__ __forceinline__ float bflo(unsigned w) { return __builtin_bit_cast(float, w << 16); }
__device__ __forceinline__ float bfhi(unsigned w) { return __builtin_bit_cast(float, w & 0xffff0000u); }

template <int CTRL> __device__ __forceinline__ float dppf(float v) {
    return __builtin_bit_cast(float, __builtin_amdgcn_update_dpp(0, __builtin_bit_cast(int, v), CTRL, 0xF, 0xF, true));
}
template <int CTRL> __device__ __forceinline__ unsigned dppu(unsigned v) {
    return (unsigned)__builtin_amdgcn_update_dpp(0, (int)v, CTRL, 0xF, 0xF, true);
}
__device__ __forceinline__ float sum8(float v) {
    v += dppf<0xB1>(v);
    v += dppf<0x4E>(v);
    v += dppf<0x141>(v);
    return v;
}
__device__ __forceinline__ float wave_sum(float v) {
    v = sum8(v); v += dppf<0x140>(v);
    const float s0 = __builtin_bit_cast(float, __builtin_amdgcn_readlane(__builtin_bit_cast(int, v), 0)), s1 = __builtin_bit_cast(float, __builtin_amdgcn_readlane(__builtin_bit_cast(int, v), 16));
    const float s2 = __builtin_bit_cast(float, __builtin_amdgcn_readlane(__builtin_bit_cast(int, v), 32)), s3 = __builtin_bit_cast(float, __builtin_amdgcn_readlane(__builtin_bit_cast(int, v), 48));
    return (s0 + s1) + (s2 + s3);
}
__device__ __forceinline__ float sigmoidf_(float x) { return __builtin_amdgcn_rcpf(1.0f + __expf(-x)); }
__device__ __forceinline__ float tanhf_(float x) { return 1.0f - 2.0f * __builtin_amdgcn_rcpf(1.0f + __expf(2.0f * x)); }
__device__ __forceinline__ float softplusf_(float x) { return fmaxf(x, 0.0f) + __logf(1.0f + __expf(-fabsf(x))); }
__device__ __forceinline__ float geluf_(float x) { return 0.5f * x * (1.0f + tanhf_(0.7978845608f * (x + 0.044715f * x * x * x))); }
__device__ __forceinline__ float siluf_(float x) { return x * sigmoidf_(x); }

template <int MT, int NT, int KS>
__device__ __forceinline__ void lds_mma(f32x4 (&acc)[MT][NT], const LAS bf16_t* A, int lda, const LAS bf16_t* Bt, int ldb, int lane) {
    const int r = lane & 15, q = lane >> 4;
#pragma unroll
    for (int ks = 0; ks < KS; ++ks) {
        bf16x8 a[MT], b[NT];
#pragma unroll
        for (int m = 0; m < MT; ++m) a[m] = *(const LAS bf16x8*)(A + (m * 16 + r) * lda + ks * 32 + q * 8);
#pragma unroll
        for (int n = 0; n < NT; ++n) b[n] = *(const LAS bf16x8*)(Bt + (n * 16 + r) * ldb + ks * 32 + q * 8);
#pragma unroll
        for (int m = 0; m < MT; ++m)
#pragma unroll
            for (int n = 0; n < NT; ++n) acc[m][n] = __builtin_amdgcn_mfma_f32_16x16x32_bf16(b[n], a[m], acc[m][n], 0, 0, 0);
    }
}
template <int MT, int NT> __device__ __forceinline__ void zero_acc(f32x4 (&acc)[MT][NT]) {
#pragma unroll
    for (int m = 0; m < MT; ++m)
#pragma unroll
        for (int n = 0; n < NT; ++n) acc[m][n] = (f32x4){0.f, 0.f, 0.f, 0.f};
}

namespace pg8 {
#define PG8_LAS __attribute__((address_space(3)))
typedef unsigned short bf16_t;
typedef short bf16x8 __attribute__((ext_vector_type(8)));
typedef float f32x4 __attribute__((ext_vector_type(4)));
typedef unsigned u32x4 __attribute__((ext_vector_type(4)));
constexpr int BM = 256, BK = 64, HALF = 128, HTB = HALF * BK * 2  , STAGE_BYTES = 8 * HTB, NXCD = 8, WGM = 8;

__host__ __device__ __forceinline__ int lds_byte(int r, int c) { const int st = (r >> 4) * 2 + (c >> 5), rr = r & 15, cc = c & 31, ob = rr * 64 + cc * 2; return st * 1024 + (ob ^ (((ob >> 9) & 1) << 5)); }
__host__ __device__ __forceinline__ void stage_rc(int b, int& R, int& C) { const int st = b / 1024, sb = b % 1024, swz = sb ^ (((sb >> 9) & 1) << 5); R = (st >> 1) * 16 + swz / 64; C = (st & 1) * 32 + (swz % 64) / 2; }
__host__ __device__ __forceinline__ int perm32(int rho) { const int n = rho >> 4, i = rho & 15; return 8 * (i >> 2) + 4 * n + (i & 3); }

struct Unit { int pm, pn; };
struct Gemm { const bf16_t* A; const bf16_t* Bt; int M, N, K; };

struct StaticOrder {
    int nM, nN, nwg, G, c;
    __host__ __device__ void init(int M, int N, int G_, int c_) { nM = M / BM; nN = N / BM; nwg = nM * nN; G = G_; c = c_; }
    __host__ __device__ bool next(int i, Unit& u) const {
        const long L = (long)i * G + c; if (L >= nwg) return false;
        int wgid = (int)L; { const int q = nwg / NXCD, r = nwg % NXCD, xcd = wgid % NXCD, off = wgid / NXCD; wgid = (xcd < r ? xcd * (q + 1) : r * (q + 1) + (xcd - r) * q) + off; }
        const int nig = WGM * nN, gid = wgid / nig, fm = gid * WGM, gsz = (nM - fm) < WGM ? (nM - fm) : WGM;
        u.pm = fm + ((wgid % nig) % gsz); u.pn = (wgid % nig) / gsz; return true;
    }
    __device__ __forceinline__ void a_ready(const Unit&) const {}
    __device__ __forceinline__ void done(const Unit&) const {}
};


__device__ __forceinline__ unsigned cvt_pk_bf16(float lo, float hi) { unsigned r; asm volatile("v_cvt_pk_bf16_f32 %0, %1, %2" : "=v"(r) : "v"(lo), "v"(hi)); return r; }

struct EpiZ {
    static constexpr bool PERM = true, AFTER_DRAIN = false;
    bf16_t* O; int ldc;
    __device__ __forceinline__ void operator()(const f32x4 (&acc)[2][2][4][2], const Unit& u, int wr, int wc, int fr, int fq) const {
        const int row0 = u.pm * BM + wr * 64 + fr, col0 = u.pn * BM + wc * 32 + 8 * fq;
#pragma unroll
        for (int ai = 0; ai < 2; ++ai)
#pragma unroll
            for (int m = 0; m < 4; ++m) { bf16_t* rowp = O + (size_t)(row0 + ai * HALF + m * 16) * ldc + col0;
#pragma unroll
                for (int bj = 0; bj < 2; ++bj) { const f32x4 v0 = acc[ai][bj][m][0], v1 = acc[ai][bj][m][1];
                    u32x4 w; w.x = cvt_pk_bf16(v0[0], v0[1]); w.y = cvt_pk_bf16(v0[2], v0[3]); w.z = cvt_pk_bf16(v1[0], v1[1]); w.w = cvt_pk_bf16(v1[2], v1[3]);
                    *(u32x4*)(rowp + bj * HALF) = w; } }
    }
};
struct EpiGlu {
    static constexpr bool PERM = false, AFTER_DRAIN = false;
    bf16_t* O; const float* gb;
    __device__ __forceinline__ void operator()(const f32x4 (&acc)[2][2][4][2], const Unit& u, int wr, int wc, int fr, int fq) const {
#pragma unroll
        for (int ai = 0; ai < 2; ++ai)
#pragma unroll
            for (int m = 0; m < 4; ++m) { const int row = u.pm * BM + ai * HALF + wr * 64 + m * 16 + fr;
#pragma unroll
                for (int n = 0; n < 2; ++n) { const int ch = u.pn * 128 + wc * 32 + n * 16 + 4 * fq;
                    const float* gp = gb; asm volatile("" : "+s"(gp));
                    const f32x4 bv = *(const f32x4*)(gp + ch), bg = *(const f32x4*)(gp + 256 + ch);
                    const f32x4 v = acc[ai][0][m][n] + bv, g = acc[ai][1][m][n] + bg; float o[4];
#pragma unroll
                    for (int e = 0; e < 4; ++e) o[e] = v[e] * __builtin_amdgcn_rcpf(1.0f + __expf(-g[e]));
                    unsigned lo = cvt_pk_bf16(o[0], o[1]), hi = cvt_pk_bf16(o[2], o[3]);
                    *(unsigned long long*)(O + (size_t)row * 1024 + 768 + ch) = (unsigned long long)lo | ((unsigned long long)hi << 32); } }
    }
};
struct EpiRes {
    static constexpr bool PERM = false, AFTER_DRAIN = false;
    const float* baseL; const float* baseC; const float* gate; float* out;
    __device__ __forceinline__ void operator()(const f32x4 (&acc)[2][2][4][2], const Unit& u, int wr, int wc, int fr, int fq) const {
        const int rowt = u.pm * BM; const int mr = rowt < 16384 ? (rowt >> 11) : 8;
        const float* grow = gate + (size_t)mr * 6144;
#pragma unroll
        for (int bj = 0; bj < 2; ++bj)
#pragma unroll
            for (int n = 0; n < 2; ++n) { const int col = u.pn * BM + bj * HALF + wc * 32 + n * 16 + 4 * fq; const f32x4 gv = *(const f32x4*)(grow + col);
#pragma unroll
                for (int ai = 0; ai < 2; ++ai)
#pragma unroll
                    for (int m = 0; m < 4; ++m) { const int row = rowt + ai * HALF + wr * 64 + m * 16 + fr;
                        const float* bp = row < 16384 ? baseL + (size_t)row * 1024 + col : baseC + (size_t)(row - 16384) * 1024 + col;
                        const f32x4 bs = *(const f32x4*)bp; *(f32x4*)(out + (size_t)row * 1024 + col) = bs + gv * acc[ai][bj][m][n]; } }
    }
};
struct EpiF32 {
    static constexpr bool PERM = false, AFTER_DRAIN = false;
    float* O; int ldc;
    __device__ __forceinline__ void operator()(const f32x4 (&acc)[2][2][4][2], const Unit& u, int wr, int wc, int fr, int fq) const {
#pragma unroll
        for (int ai = 0; ai < 2; ++ai)
#pragma unroll
            for (int m = 0; m < 4; ++m) { const int row = u.pm * BM + ai * HALF + wr * 64 + m * 16 + fr;
#pragma unroll
                for (int bj = 0; bj < 2; ++bj)
#pragma unroll
                    for (int n = 0; n < 2; ++n) { const int col = u.pn * BM + bj * HALF + wc * 32 + n * 16 + 4 * fq;
                        *(f32x4*)(O + (size_t)row * ldc + col) = acc[ai][bj][m][n]; } }
    }
};

template <class Epi, class Sched, bool ALIGN_EPI = false, bool SP2 = false>
__device__ __forceinline__ void gemm_phase(PG8_LAS unsigned char* lds, const Gemm g, const Sched& S, const Epi& E) {
    int tid_ = threadIdx.x; asm volatile("" : "+v"(tid_));
    const int tid = tid_, wid = __builtin_amdgcn_readfirstlane(tid >> 6), lane = tid & 63, wr = wid >> 2, wc = wid & 3, fr = lane & 15, fq = lane >> 4;
    const int K = g.K, nt = K / BK;
    unsigned voffA[2], voffB[2];
#pragma unroll
    for (int i = 0; i < 2; ++i) { int R, C; stage_rc(tid * 16 + i * 8192, R, C); const int Rb = Epi::PERM ? ((R & ~31) + perm32(R & 31)) : R;
        voffA[i] = (unsigned)(R * K + C) * 2u; voffB[i] = (unsigned)(Rb * K + C) * 2u; }
    const size_t kstep = (size_t)(BK * 2);
    const size_t hstep = (size_t)HALF * K * 2;
    const size_t tstep = 2 * hstep;
    const unsigned ldsw = (unsigned)wid * 1024u;
    const int aoff = lds_byte(wr * 64 + fr, fq * 8), boff = lds_byte(wc * 32 + fr, fq * 8);
#define PG8_SA(b, h) (((b) * 2 + (h)) * HTB)
#define PG8_SB(b, h) ((4 + (b) * 2 + (h)) * HTB)
#define PG8_STAGE(bufoff, gbase, voff) do { _Pragma("unroll") for (int _i = 0; _i < 2; ++_i) \
        __builtin_amdgcn_global_load_lds((const unsigned*)((const char*)(gbase) + (voff)[_i]), (PG8_LAS unsigned*)(lds + (bufoff) + ldsw + _i * 8192), 16, 0, 0); } while (0)
#define PG8_LDA(dst, b, h) do { _Pragma("unroll") for (int m = 0; m < 4; ++m) _Pragma("unroll") for (int k = 0; k < 2; ++k) dst[m][k] = *(const PG8_LAS bf16x8*)(lds + PG8_SA(b, h) + aoff + m * 2048 + k * 1024); } while (0)
#define PG8_LDB(dst, b, h) do { _Pragma("unroll") for (int n = 0; n < 2; ++n) _Pragma("unroll") for (int k = 0; k < 2; ++k) dst[n][k] = *(const PG8_LAS bf16x8*)(lds + PG8_SB(b, h) + boff + n * 2048 + k * 1024); } while (0)
#define PG8_MMA(ai, bj, At, Bt) do { __builtin_amdgcn_s_setprio(1); _Pragma("unroll") for (int m = 0; m < 4; ++m) _Pragma("unroll") for (int n = 0; n < 2; ++n) _Pragma("unroll") for (int k = 0; k < 2; ++k) \
        acc[ai][bj][m][n] = __builtin_amdgcn_mfma_f32_16x16x32_bf16(Bt[n][k], At[m][k], acc[ai][bj][m][n], 0, 0, 0); __builtin_amdgcn_s_setprio(0); } while (0)
#define PG8_WAIT_V(n) asm volatile("s_waitcnt vmcnt(" #n ")" ::: "memory")
#define PG8_WAIT_L(n) asm volatile("s_waitcnt lgkmcnt(" #n ")" ::: "memory")
#define PG8_BAR __builtin_amdgcn_s_barrier()
#define PG8_SCHED __builtin_amdgcn_sched_barrier(0)
    Unit cur, nxt; int ui = 0;
    if (!S.next(0, cur)) return;
    f32x4 acc[2][2][4][2];
#pragma unroll
    for (int a = 0; a < 2; ++a)
#pragma unroll
        for (int b = 0; b < 2; ++b)
#pragma unroll
            for (int m = 0; m < 4; ++m)
#pragma unroll
                for (int n = 0; n < 2; ++n) acc[a][b][m][n] = (f32x4){0.f, 0.f, 0.f, 0.f};
    bf16x8 At[4][2], B0[2][2], B1[2][2];
    const char* cA = (const char*)g.A + (size_t)cur.pm * tstep; const char* cB = (const char*)g.Bt + (size_t)cur.pn * tstep;
    S.a_ready(cur);
    if constexpr (SP2) {
        PG8_STAGE(PG8_SB(0, 0), cB, voffB); PG8_STAGE(PG8_SB(0, 1), cB + hstep, voffB); PG8_STAGE(PG8_SA(0, 0), cA, voffA); PG8_STAGE(PG8_SA(0, 1), cA + hstep, voffA);
        if (wr == 1) PG8_BAR;
        PG8_WAIT_V(2); PG8_BAR;
        PG8_STAGE(PG8_SB(1, 0), cB + kstep, voffB); PG8_STAGE(PG8_SA(1, 0), cA + kstep, voffA); PG8_STAGE(PG8_SB(1, 1), cB + hstep + kstep, voffB);
        PG8_WAIT_V(6); PG8_BAR;
    } else {
        PG8_STAGE(PG8_SB(0, 0), cB, voffB); PG8_STAGE(PG8_SA(0, 0), cA, voffA); PG8_STAGE(PG8_SB(0, 1), cB + hstep, voffB); PG8_STAGE(PG8_SA(0, 1), cA + hstep, voffA);
        if (wr == 1) PG8_BAR;
        PG8_WAIT_V(4); PG8_BAR;
        PG8_STAGE(PG8_SB(1, 0), cB + kstep, voffB); PG8_STAGE(PG8_SA(1, 0), cA + kstep, voffA); PG8_STAGE(PG8_SB(1, 1), cB + hstep + kstep, voffB);
        PG8_WAIT_V(6); PG8_BAR;
    }
    for (;;) {
        const bool has_next = S.next(ui + 1, nxt);
        const char* nA = has_next ? (const char*)g.A + (size_t)nxt.pm * tstep : cA; const char* nB = has_next ? (const char*)g.Bt + (size_t)nxt.pn * tstep : cB;
        for (int t = 0; t < nt; t += 2) {
            const bool last = (t == nt - 2);
            const char* a1 = cA + (size_t)(t + 1) * kstep;
            const char* a2 = last ? nA : cA + (size_t)(t + 2) * kstep; const char* b2 = last ? nB : cB + (size_t)(t + 2) * kstep;
            const char* a3 = a2 + kstep; const char* b3 = b2 + kstep;
            if (last && has_next) S.a_ready(nxt);
            if constexpr (SP2) {
            PG8_LDB(B0, 0, 0); PG8_LDB(B1, 0, 1); PG8_SCHED; PG8_LDA(At, 0, 0); PG8_STAGE(PG8_SA(1, 1), a1 + hstep, voffA);
            PG8_WAIT_V(8); PG8_WAIT_L(0); PG8_BAR; PG8_MMA(0, 0, At, B0); PG8_MMA(0, 1, At, B1); PG8_BAR; PG8_SCHED;
            PG8_LDA(At, 0, 1); PG8_STAGE(PG8_SB(0, 0), b2, voffB); PG8_STAGE(PG8_SB(0, 1), b2 + hstep, voffB); PG8_STAGE(PG8_SA(0, 0), a2, voffA);
            PG8_WAIT_V(8); PG8_WAIT_L(0); PG8_BAR; PG8_MMA(1, 0, At, B0); PG8_MMA(1, 1, At, B1); PG8_BAR; PG8_SCHED;
            PG8_LDB(B0, 1, 0); PG8_LDB(B1, 1, 1); PG8_SCHED; PG8_LDA(At, 1, 0); PG8_STAGE(PG8_SA(0, 1), a2 + hstep, voffA);
            PG8_WAIT_V(8); PG8_WAIT_L(0); PG8_BAR; PG8_MMA(0, 0, At, B0); PG8_MMA(0, 1, At, B1); PG8_BAR; PG8_SCHED;
            PG8_LDA(At, 1, 1); PG8_STAGE(PG8_SB(1, 0), b3, voffB); PG8_STAGE(PG8_SB(1, 1), b3 + hstep, voffB); PG8_STAGE(PG8_SA(1, 0), a3, voffA);
            PG8_WAIT_V(8); PG8_WAIT_L(0); PG8_BAR; PG8_MMA(1, 0, At, B0); PG8_MMA(1, 1, At, B1); PG8_BAR; PG8_SCHED;
            } else {
            PG8_LDB(B0, 0, 0); PG8_SCHED; PG8_LDA(At, 0, 0); PG8_STAGE(PG8_SA(1, 1), a1 + hstep, voffA);
            PG8_WAIT_L(8); PG8_BAR; PG8_WAIT_L(0); PG8_MMA(0, 0, At, B0); PG8_BAR; PG8_SCHED;
            PG8_LDB(B1, 0, 1); PG8_STAGE(PG8_SB(0, 0), b2, voffB);
            PG8_BAR; PG8_WAIT_L(0); PG8_MMA(0, 1, At, B1); PG8_BAR;
            PG8_LDA(At, 0, 1); PG8_STAGE(PG8_SA(0, 0), a2, voffA);
            PG8_BAR; PG8_WAIT_L(0); PG8_MMA(1, 0, At, B0); PG8_BAR; PG8_SCHED;
            PG8_STAGE(PG8_SB(0, 1), b2 + hstep, voffB);
            PG8_WAIT_V(6); PG8_BAR; PG8_MMA(1, 1, At, B1); PG8_BAR;
            PG8_LDB(B0, 1, 0); PG8_SCHED; PG8_LDA(At, 1, 0); PG8_STAGE(PG8_SA(0, 1), a2 + hstep, voffA);
            PG8_WAIT_L(8); PG8_BAR; PG8_WAIT_L(0); PG8_MMA(0, 0, At, B0); PG8_BAR; PG8_SCHED;
            PG8_LDB(B1, 1, 1); PG8_STAGE(PG8_SB(1, 0), b3, voffB);
            PG8_BAR; PG8_WAIT_L(0); PG8_MMA(0, 1, At, B1); PG8_BAR;
            PG8_LDA(At, 1, 1); PG8_STAGE(PG8_SA(1, 0), a3, voffA);
            PG8_BAR; PG8_WAIT_L(0); PG8_MMA(1, 0, At, B0); PG8_BAR; PG8_SCHED;
            PG8_STAGE(PG8_SB(1, 1), b3 + hstep, voffB);
            PG8_WAIT_V(6); PG8_BAR; PG8_MMA(1, 1, At, B1); PG8_BAR;
            }
        }
        if constexpr (ALIGN_EPI) { if (wr == 0) PG8_BAR; }
        if constexpr (!Epi::AFTER_DRAIN) { E(acc, cur, wr, wc, fr, fq); S.done(cur); }
        if (!has_next) break;
#pragma unroll
        for (int a = 0; a < 2; ++a)
#pragma unroll
            for (int b = 0; b < 2; ++b)
#pragma unroll
                for (int m = 0; m < 4; ++m)
#pragma unroll
                    for (int n = 0; n < 2; ++n) acc[a][b][m][n] = (f32x4){0.f, 0.f, 0.f, 0.f};
        cur = nxt; cA = nA; cB = nB; ++ui;
        if constexpr (ALIGN_EPI) { if (wr == 1) PG8_BAR; }
    }
    PG8_WAIT_V(0);
    if constexpr (!ALIGN_EPI) { if (wr == 0) PG8_BAR; }
    PG8_BAR;
    if constexpr (Epi::AFTER_DRAIN) { E.fused(acc, cur, wr, wc, fr, fq, lds, wid, lane); S.done(cur); }
#undef PG8_SA
#undef PG8_SB
#undef PG8_STAGE
#undef PG8_LDA
#undef PG8_LDB
#undef PG8_MMA
#undef PG8_WAIT_V
#undef PG8_WAIT_L
#undef PG8_BAR
#undef PG8_SCHED
}
}
#ifndef PROBE_DUP
#define PROBE_DUP 0
#endif

template <class PT> __device__ __forceinline__ void load_row16(PT p, int lane, float (&x)[16]) {
    const f32x4 a = *(const GAS f32x4*)(p + 8 * lane), b = *(const GAS f32x4*)(p + 8 * lane + 4), c = *(const GAS f32x4*)(p + 512 + 8 * lane), d = *(const GAS f32x4*)(p + 512 + 8 * lane + 4);
#pragma unroll
    for (int e = 0; e < 4; ++e) { x[e] = a[e]; x[4 + e] = b[e]; x[8 + e] = c[e]; x[12 + e] = d[e]; }
}
__device__ __forceinline__ void store_row16_f32(float* p, int lane, const float (&x)[16]) {
    *(f32x4*)(p + 8 * lane) = (f32x4){x[0], x[1], x[2], x[3]}; *(f32x4*)(p + 8 * lane + 4) = (f32x4){x[4], x[5], x[6], x[7]};
    *(f32x4*)(p + 512 + 8 * lane) = (f32x4){x[8], x[9], x[10], x[11]}; *(f32x4*)(p + 512 + 8 * lane + 4) = (f32x4){x[12], x[13], x[14], x[15]};
}
template <class PT> __device__ __forceinline__ void store_row16_bf16(PT p, int lane, const float (&y)[16]) {
    u32x4 a, b; a.x = pk2(y[0], y[1]); a.y = pk2(y[2], y[3]); a.z = pk2(y[4], y[5]); a.w = pk2(y[6], y[7]);
    b.x = pk2(y[8], y[9]); b.y = pk2(y[10], y[11]); b.z = pk2(y[12], y[13]); b.w = pk2(y[14], y[15]);
    *(GAS u32x4*)(p + 8 * lane) = a; *(GAS u32x4*)(p + 512 + 8 * lane) = b;
}
template <class G1, class G2> __device__ __forceinline__ void norm_mod16(const float (&x)[16], G1 g, G2 shift, G2 scale, int lane, float (&y)[16]) {
    float ss = 0.f;
#pragma unroll
    for (int e = 0; e < 16; ++e) ss += x[e] * x[e];
    ss = wave_sum(ss);
    const float r = rsqrtf(ss * (1.0f / 1024.0f) + 1e-6f);
    float gg[16]; load_row16(g, lane, gg);
    if (shift) { float sh[16], sc[16]; load_row16(shift, lane, sh); load_row16(scale, lane, sc);
#pragma unroll
        for (int e = 0; e < 16; ++e) y[e] = x[e] * r * gg[e] * (1.0f + sc[e]) + sh[e];
    } else {
#pragma unroll
        for (int e = 0; e < 16; ++e) y[e] = x[e] * r * gg[e];
    }
}

template <int MODE>
__device__ __forceinline__ void transpose_item(const float* W, int K, int N, bf16_t* WT, LAS float* scr, int item, int lane) {
    const int nblk = N / 32, kb = item / nblk, nb = item % nblk, k0 = 64 * kb, n0 = 32 * nb;
#pragma unroll 8
    for (int i = 0; i < 32; ++i) { const int kk = 2 * i + (lane >> 5); scr[kk * 33 + (lane & 31)] = W[(size_t)(k0 + kk) * N + n0 + (lane & 31)]; }
    asm volatile("s_waitcnt lgkmcnt(0)" ::: "memory");
    const int c = lane & 7;
#pragma unroll
    for (int j = 0; j < 4; ++j) { const int n = (lane >> 3) + 8 * j; const LAS float* s = scr + (8 * c) * 33 + n;
        u32x4 o; o.x = pk2(s[0 * 33], s[1 * 33]); o.y = pk2(s[2 * 33], s[3 * 33]); o.z = pk2(s[4 * 33], s[5 * 33]); o.w = pk2(s[6 * 33], s[7 * 33]);
        int row = n0 + n;
        if (MODE == 1) { const int ch = row & 255, gatepart = row >> 8; row = (ch >> 7) * 256 + gatepart * 128 + (ch & 127); }
        *(u32x4*)(WT + (size_t)row * K + k0 + 8 * c) = o; }
    asm volatile("s_waitcnt lgkmcnt(0)" ::: "memory");
}

__device__ __forceinline__ void p0_transposes(const PV& P, int l, int part, int nparts, LAS unsigned char* lds) {
    const int tid = otid(), lane = tid & 63, w = tid >> 6;
    unsigned char* ws = P.ws;
    LAS float* scr = (LAS float*)(lds + w * 8448);
    const int gw = part * 8 + w, NGW = nparts * 8;
    constexpr int I_IN = 16 * (INC / 32), I_OUT = 16 * 32, I_GL = 4 * 16, PER_L = I_IN + I_OUT + I_GL;
    for (int it = gw; it < PER_L; it += NGW) { int r = it;
        if (r < I_IN) { transpose_item<0>(PIN(I_WIN) + (size_t)l * 1024 * INC, 1024, INC, (bf16_t*)(ws + WS_WIN) + (size_t)l * ZW * 1024, scr, r, lane); continue; } r -= I_IN;
        if (r < I_OUT) { transpose_item<0>(PIN(I_WOUT) + (size_t)l * 1024 * 1024, 1024, 1024, (bf16_t*)(ws + WS_WOUT) + (size_t)l * 1024 * 1024, scr, r, lane); continue; } r -= I_OUT;
        transpose_item<1>(PIN(I_GLUW) + (size_t)l * 256 * 512, 256, 512, (bf16_t*)(ws + WS_GLU) + (size_t)l * 512 * 256, scr, r, lane); }
    for (int i = part * 512 + tid; i < 8192; i += nparts * 512) *(GAS u32x4*)((bf16_t*)(ws + WS_WIN) + ((size_t)l * ZW + INC) * 1024 + (size_t)i * 8) = (u32x4){0u, 0u, 0u, 0u};
}
__device__ __forceinline__ void p0_tables(const PV& P, int l, int part, int nparts) {
    const int tid = otid();
    const size_t n16 = (size_t)NEXP * 1024 / 16, stride = (size_t)nparts * 512;
    const GAS f32x4* su = (const GAS f32x4*)(PIN(I_PU) + (size_t)l * NEXP * 1024); const GAS f32x4* sv = (const GAS f32x4*)(PIN(I_PV) + (size_t)l * NEXP * 1024);
    GAS u32x4* du = (GAS u32x4*)(P.ws + WS_U8 + (size_t)l * NEXP * 1024); GAS u32x4* dv = (GAS u32x4*)(P.ws + WS_V8 + (size_t)l * NEXP * 1024);
#pragma unroll 2
    for (size_t i = (size_t)part * 512 + tid; i < n16; i += stride) {
        u32x4 o, q;
#pragma unroll
        for (int k = 0; k < 4; ++k) { const f32x4 a = su[4 * i + k] * 32.0f, c = sv[4 * i + k] * 2.0f;
            int wa = __builtin_amdgcn_cvt_pk_fp8_f32(a[0], a[1], 0, false); wa = __builtin_amdgcn_cvt_pk_fp8_f32(a[2], a[3], wa, true);
            int wc = __builtin_amdgcn_cvt_pk_fp8_f32(c[0], c[1], 0, false); wc = __builtin_amdgcn_cvt_pk_fp8_f32(c[2], c[3], wc, true);
            o[k] = (unsigned)wa; q[k] = (unsigned)wc; }
        du[i] = o; dv[i] = q;
    }
}
__device__ __forceinline__ void p0_weff(const PV& P, int l, int part, int nparts, LAS unsigned char* lds) {
    const int tid = otid(), lane = tid & 63, w = tid >> 6;
    for (int u = part; u < 128; u += nparts) {
        const int hp = (u >> 3) & 15, dmb = u & 7;
        LAS bf16_t* As = (LAS bf16_t*)lds; LAS bf16_t* Bs = As + 128 * 136;
        const float* kp = PIN(I_KEYS) + (size_t)(l * 16 + hp) * 128 * 128;
        const float* qp = PIN(I_WQ) + ((size_t)l * 1024 + dmb * 128) * 2048 + hp * 128;
        __syncthreads();
        for (int idx = tid; idx < 16384; idx += 512) { const int n = idx >> 7, d = idx & 127;
            As[n * 136 + d] = (bf16_t)f2bf(kp[idx]); Bs[n * 136 + d] = (bf16_t)f2bf(qp[(size_t)n * 2048 + d]); }
        __syncthreads();
        f32x4 acc[1][8]; zero_acc<1, 8>(acc);
        lds_mma<1, 8, 4>(acc, As + 16 * w * 136, 136, Bs, 136, lane);
        bf16_t* op = (bf16_t*)(P.ws + WS_WEFF) + ((size_t)l * 2048 + hp * 128 + 16 * w + (lane & 15)) * 1024 + dmb * 128 + 4 * (lane >> 4);
#pragma unroll
        for (int n = 0; n < 8; ++n) { const f32x4 v = acc[0][n]; *(unsigned long long*)(op + 16 * n) = (unsigned long long)pk2(v[0], v[1]) | ((unsigned long long)pk2(v[2], v[3]) << 32); }
    }
    __syncthreads();
}
__device__ __forceinline__ void p0_prologue(const PV& P, LAS unsigned char* lds) {
    const int tid = otid(), lane = tid & 63, w = tid >> 6;
    const int G = gridDim.x, bx = blockIdx.x;
    unsigned char* ws = P.ws;
    p0_transposes(P, 0, bx, G, lds);
    p0_tables(P, 0, bx, G);
    __syncthreads();
    for (int u = bx; u < 48; u += G) {
        const int l = u / 24, cb = u % 24;
        LAS float* sc = (LAS float*)lds;
        LAS float* red = sc + 9216;
        __syncthreads();
        for (int idx = tid; idx < 9216; idx += 512) { const int r = idx >> 10, k = idx & 1023; const float v = r < 8 ? PIN(I_C)[r * 1024 + k] : PIN(I_CCTX)[k]; sc[idx] = siluf_(v); }
        __syncthreads();
        f32x4 acc[9];
#pragma unroll
        for (int r = 0; r < 9; ++r) acc[r] = (f32x4){0.f, 0.f, 0.f, 0.f};
        const float* wp = PIN(I_ADAW) + ((size_t)l * 1024 + 128 * w) * 6144 + cb * 256 + 4 * lane;
#pragma unroll 16
        for (int k = 0; k < 128; ++k) { const f32x4 wv = *(const GAS f32x4*)(wp + (size_t)k * 6144);
#pragma unroll
            for (int r = 0; r < 9; ++r) acc[r] += sc[r * 1024 + 128 * w + k] * wv; }
#pragma unroll
        for (int r = 0; r < 9; ++r) *(LAS f32x4*)(red + (w * 9 + r) * 256 + 4 * lane) = acc[r];
        __syncthreads();
        for (int idx = tid; idx < 9 * 256; idx += 512) { const int r = idx >> 8, cc = idx & 255; float sacc = 0.f;
#pragma unroll
            for (int ww = 0; ww < 8; ++ww) sacc += red[(ww * 9 + r) * 256 + cc];
            ((float*)(ws + WS_MOD))[(size_t)(l * 9 + r) * 6144 + cb * 256 + cc] = sacc + PIN(I_ADAB)[l * 6144 + cb * 256 + cc]; }
    }
    __syncthreads();
    p0_weff(P, 0, bx, G, lds);
    (void)lane; (void)w; (void)ws;
}

__device__ __forceinline__ void p0b_ain(const PV& P) {
    const int tid = otid(), lane = tid & 63, gw = blockIdx.x * 8 + (tid >> 6), NGW = gridDim.x * 8;
    const float* mod = (const float*)(P.ws + WS_MOD);
    bf16_t* act = (bf16_t*)(P.ws + WS_ACT);
    for (int row = gw; row < TT; row += NGW) {
        const float* xp = row < TL ? PIN(I_X) + (size_t)row * 1024 : PIN(I_CTX) + (size_t)(row - TL) * 1024;
        const int mr = row < TL ? (row >> 11) : 8;
        float x[16], y[16]; load_row16(xp, lane, x);
        norm_mod16(x, PIN(I_N1G), mod + (size_t)mr * 6144, mod + (size_t)mr * 6144 + 1024, lane, y);
        store_row16_bf16(act + (size_t)row * 1024, lane, y);
    }
}

__device__ __forceinline__ int rwkv_col(int gc, int h, int dir) {
    const int seg = gc >> 6;
    if (seg == 0) return h * 64 + gc;
    if (seg == 1) return 256 + h * 64 + (gc - 64);
    if (seg == 2) return 512 + h * 64 + (gc - 128);
    const int o = gc - 192; return o < 32 ? 832 + dir * 32 + o : 896 + dir * 32 + (o - 32);
}

constexpr int R_AT = 0, R_RT = 4608, R_BT = 9216, R_TL = 14336, R_MRB = 16896, R_G = 19456, R_YV = 23552, R_HV = 27648, R_GAM = 35840, REC_BYTES = 36096;

__device__ __forceinline__ void rwkv_pre(const PV& P, int l, LAS unsigned char* lds) {
    const int tid = otid(), lane = tid & 63, w = tid >> 6;
    LAS bf16_t* WUt = (LAS bf16_t*)lds;
    LAS bf16_t* AUt = WUt + 2560;
    LAS float* s_mu = (LAS float*)(AUt + 2560);
    LAS float* s_par = s_mu + 512;
    LAS bf16_t* raw = (LAS bf16_t*)(s_par + 256);
    LAS float* f_r = (LAS float*)(raw + 34 * 256);
    LAS float* f_k = f_r + 2048;
    LAS float* f_v = f_k + 2048;
    LAS bf16_t* WLb = (LAS bf16_t*)(f_v + 2048);
    LAS bf16_t* ALb = WLb + 1280;
    LAS float* lor = (LAS float*)raw;
    LAS bf16_t* Bn = ALb + 1280;
    LAS bf16_t* Kn = Bn + 2304;
    LAS bf16_t* Ktt = Kn + 2304;
    LAS bf16_t* Vt = Ktt + 2560;
    LAS float* Mabf = (LAS float*)(Vt + 2560);
    LAS bf16_t* Makb = (LAS bf16_t*)(Mabf + 1152);
    LAS bf16_t* Mrkb = Makb + 1280;
    LAS float* Ltot = (LAS float*)(Mrkb + 1280);
    LAS bf16_t* iA1 = (LAS bf16_t*)(Ltot + 512);
    LAS bf16_t* iB1 = iA1 + 640;
    LAS bf16_t* iA2 = iB1 + 640;
    LAS bf16_t* iWt = iA2 + 640;
    LAS unsigned char* rec = (LAS unsigned char*)(iWt + 640);
    LAS bf16_t* At = (LAS bf16_t*)(rec + R_AT); LAS bf16_t* Rt = (LAS bf16_t*)(rec + R_RT); LAS bf16_t* Btt = (LAS bf16_t*)(rec + R_BT);
    const GAS bf16_t* z = (const GAS bf16_t*)(P.ws + WS_Z);
    GAS unsigned char* recg = (GAS unsigned char*)(P.ws + WS_REC);
    for (int idx = tid; idx < 4 * 640 / 2; idx += 512) ((LAS unsigned*)iA1)[idx] = 0u;
    for (int idx = tid; idx < 2 * 1280 / 2; idx += 512) ((LAS unsigned*)WLb)[idx] = 0u;
    for (int idx = tid; idx < 2 * 2560 / 2; idx += 512) ((LAS unsigned*)WUt)[idx] = 0u;
    for (int idx = tid; idx < 1280 / 2; idx += 512) ((LAS unsigned*)(rec + R_TL))[idx] = 0u;
    int cur_hd = -1;
    u32x4 pre[3];
    auto geo = [&](int u, int& hd, int& b, int& c, int& tlo, int& seqlen, size_t& rb) { hd = u & 7; const int rest = u >> 3; b = rest / 72; c = rest % 72; const int dir = hd & 1;
        const bool isctx = c < 8; const int cc = isctx ? c : c - 8; seqlen = isctx ? CTX : SEQ; tlo = dir ? seqlen - 32 - 32 * cc : 32 * cc; rb = isctx ? (size_t)TL + b * CTX : (size_t)b * SEQ; };
    auto issue = [&](int u, int tid) { int hd, b, c, tlo, seqlen; size_t rb; geo(u, hd, b, c, tlo, seqlen, rb);
#pragma unroll
        for (int k = 0; k < 3; ++k) { const int v = tid + 512 * k; pre[k] = (u32x4){0u, 0u, 0u, 0u};
            if (v < 1088) { const int rr = v >> 5, vc = v & 31, t = tlo - 1 + rr; if (t >= 0 && t < seqlen) pre[k] = *(const GAS u32x4*)(z + (rb + t) * ZW + rwkv_col(vc * 8, hd >> 1, hd & 1)); } } };
    if ((int)blockIdx.x < 4608) issue(blockIdx.x, tid);
    for (int u = blockIdx.x; u < 4608; u += gridDim.x) {
        const int tid = otid(), lane = tid & 63, w = tid >> 6;
        int hd, b, c, tlo, seqlen; size_t rb; geo(u, hd, b, c, tlo, seqlen, rb); const int h = hd >> 1, dir = hd & 1;
        LDS_BARRIER();
        if (hd != cur_hd) { cur_hd = hd;
            for (int idx = tid; idx < 2048; idx += 512) { const int m = idx >> 6, j = idx & 63; const size_t o = ((size_t)(l * 2 + dir) * 32 + m) * 256 + h * 64 + j;
                WUt[j * 40 + m] = (bf16_t)f2bf(PIN(I_WUP)[o]); AUt[j * 40 + m] = (bf16_t)f2bf(PIN(I_AUP)[o]); }
            { const int which = tid >> 8, gc = tid & 255; s_mu[tid] = PIN(I_MU)[(size_t)(l * 2 + which) * 960 + rwkv_col(gc, h, dir)]; }
            if (tid < 256) { const int k = tid >> 6, j = tid & 63; float v;
                if (k == 0) v = PIN(I_W0)[(l * 2 + dir) * 256 + h * 64 + j]; else if (k == 1) v = PIN(I_A0)[(l * 2 + dir) * 256 + h * 64 + j];
                else if (k == 2) v = PIN(I_KK)[l * 256 + h * 64 + j]; else v = PIN(I_KA)[l * 256 + h * 64 + j];
                s_par[tid] = v; } }
#pragma unroll
        for (int k = 0; k < 3; ++k) { const int v = tid + 512 * k; if (v < 1088) *(LAS u32x4*)(raw + (size_t)v * 8) = pre[k]; }
        LDS_BARRIER();
        if (u + (int)gridDim.x < 4608) issue(u + gridDim.x, tid);
        { const int gc = tid & 255, th = tid >> 8; const float mu0 = s_mu[gc], mu1 = s_mu[256 + gc];
            const int r0 = th * 16 + 1;
            float zm = bf2f(raw[(r0 - 1) * 256 + gc]), z0 = bf2f(raw[r0 * 256 + gc]);
#pragma unroll 4
            for (int ii = 0; ii < 16; ++ii) { const int rr = r0 + ii, i = dir ? 32 - rr : rr - 1;
                const float zp = bf2f(raw[(rr + 1) * 256 + gc]);
                const float val = z0 + mu0 * (zm - z0) + mu1 * (zp - z0);
                zm = z0; z0 = zp;
                if (gc < 64) f_r[i * 64 + gc] = val; else if (gc < 128) f_k[i * 64 + gc - 64] = val; else if (gc < 192) f_v[i * 64 + gc - 128] = val;
                else if (gc < 224) WLb[i * 40 + gc - 192] = (bf16_t)f2bf(tanhf_(val)); else ALb[i * 40 + gc - 224] = (bf16_t)f2bf(val); } }
        LDS_BARRIER();
        { const int which = w >> 2, mt = (w >> 1) & 1, np = (w & 1) * 2; f32x4 acc[1][2]; zero_acc<1, 2>(acc);
            lds_mma<1, 2, 1>(acc, (which ? ALb : WLb) + 16 * mt * 40, 40, (which ? AUt : WUt) + 16 * np * 40, 40, lane);
#pragma unroll
            for (int n = 0; n < 2; ++n) *(LAS f32x4*)(lor + which * 2176 + (16 * mt + (lane & 15)) * 68 + 16 * (np + n) + 4 * (lane >> 4)) = acc[0][n]; }
        { const int row = tid & 63, ig = tid >> 6;
#pragma unroll
            for (int e = 0; e < 4; ++e) Vt[row * 40 + 4 * ig + e] = (bf16_t)f2bf(f_v[(4 * ig + e) * 64 + row]); }
        LDS_BARRIER();
        float Lloc[4], lwv[4], agv[4], kkv[4], kdv[4]; float Lrun = 0.f;
#pragma unroll
        for (int ii = 0; ii < 4; ++ii) { const int i = 4 * w + ii, j = lane;
            const float wv = s_par[j] + lor[i * 68 + j], av = s_par[64 + j] + lor[2176 + i * 68 + j];
            const float wlog = -softplusf_(-wv) - 0.5f, lw = -__expf(wlog);
            Lrun += lw; Lloc[ii] = Lrun; lwv[ii] = lw; agv[ii] = sigmoidf_(av);
            const float kx = f_k[i * 64 + j], kkj = kx * s_par[128 + j];
            const float ss = wave_sum(kkj * kkj); kkv[ii] = kkj * __builtin_amdgcn_rcpf(fmaxf(sqrtf(ss), 1e-12f));
            kdv[ii] = kx * (1.0f + (agv[ii] - 1.0f) * s_par[192 + j]); }
        Ltot[w * 64 + lane] = Lrun;
        LDS_BARRIER();
        { float off = 0.f;
#pragma unroll
            for (int ww = 0; ww < 7; ++ww) if (ww < w) off += Ltot[ww * 64 + lane];
#pragma unroll
            for (int ii = 0; ii < 4; ++ii) { const int i = 4 * w + ii, j = lane; const float L = off + Lloc[ii], eP = __expf(L - lwv[ii]), eL = __expf(L), eN = __expf(-L);
                const unsigned bb = f2bf(kkv[ii] * agv[ii] * eN), kb = f2bf(kdv[ii] * eN);
                At[i * 72 + j] = (bf16_t)f2bf(-kkv[ii] * eP); Rt[i * 72 + j] = (bf16_t)f2bf(f_r[i * 64 + j] * eL);
                Bn[i * 72 + j] = (bf16_t)bb; Kn[i * 72 + j] = (bf16_t)kb; Btt[j * 40 + i] = (bf16_t)bb; Ktt[j * 40 + i] = (bf16_t)kb;
                if (i == 31) ((LAS float*)(rec + R_GAM))[j] = eL; } }
        LDS_BARRIER();
        { const int mat = w >> 1, mt = w & 1; f32x4 acc[1][2]; zero_acc<1, 2>(acc);
            lds_mma<1, 2, 2>(acc, (mat < 2 ? At : Rt) + 16 * mt * 72, 72, (mat & 1) ? Kn : Bn, 72, lane);
            const int t = 16 * mt + (lane & 15);
#pragma unroll
            for (int n = 0; n < 2; ++n) { f32x4 o;
#pragma unroll
                for (int e = 0; e < 4; ++e) { const int j = 16 * n + 4 * (lane >> 4) + e; const bool keep = mat < 2 ? j < t : j <= t; o[e] = keep ? acc[0][n][e] : 0.f; }
                if (mat == 0) { *(LAS f32x4*)(Mabf + t * 36 + 16 * n + 4 * (lane >> 4)) = o;
                    if (mt == 1 && n == 0) *(LAS unsigned long long*)(iA1 + (lane & 15) * 40 + 4 * (lane >> 4)) = (unsigned long long)pk2(o[0], o[1]) | ((unsigned long long)pk2(o[2], o[3]) << 32);
                } else { LAS bf16_t* dst = mat == 1 ? Makb : (mat == 2 ? (LAS bf16_t*)(rec + R_MRB) : Mrkb);
                    *(LAS unsigned long long*)(dst + t * 40 + 16 * n + 4 * (lane >> 4)) = (unsigned long long)pk2(o[0], o[1]) | ((unsigned long long)pk2(o[2], o[3]) << 32); } } }
        LDS_BARRIER();
        if (w < 2) {
            const int cidx = lane & 15, o16 = 16 * w; float T[16];
            int vz = 0; asm volatile("" : "+v"(vz)); const LAS float* mb = Mabf + vz + o16 * 36 + o16;
#pragma unroll
            for (int t = 0; t < 16; ++t) { float row = cidx == t ? 1.0f : 0.f;
                float mrow[16];
#pragma unroll
                for (int q = 0; q < 4; ++q) if (4 * q < t) { const f32x4 mv = *(const LAS f32x4*)(mb + t * 36 + 4 * q); mrow[4 * q] = mv[0]; mrow[4 * q + 1] = mv[1]; mrow[4 * q + 2] = mv[2]; mrow[4 * q + 3] = mv[3]; }
#pragma unroll
                for (int j = 0; j < t; ++j) row += mrow[j] * T[j];
                T[t] = row; }
            if (lane < 16) {
                LAS bf16_t* tl = (LAS bf16_t*)(rec + R_TL);
#pragma unroll
                for (int t = 0; t < 16; ++t) tl[(o16 + t) * 40 + o16 + cidx] = (bf16_t)f2bf(T[t]);
                if (w == 0) {
#pragma unroll
                    for (int t = 0; t < 16; ++t) iB1[cidx * 40 + t] = (bf16_t)f2bf(T[t]);
                } else {
#pragma unroll
                    for (int t = 0; t < 16; ++t) iA2[t * 40 + cidx] = (bf16_t)f2bf(T[t]);
                } }
        } else {
            for (int tt = w - 2; tt < 32; tt += 6) { f32x4 acc[1][1]; zero_acc<1, 1>(acc);
                int m, n; const LAS bf16_t* bt; LAS bf16_t* dst; int pitch;
                if (tt < 8) { m = tt >> 1; n = tt & 1; bt = Makb + 16 * n * 40; dst = (LAS bf16_t*)(rec + R_G); pitch = 32; }
                else if (tt < 16) { m = (tt - 8) >> 1; n = (tt - 8) & 1; bt = Mrkb + 16 * n * 40; dst = (LAS bf16_t*)(rec + R_YV); pitch = 32; }
                else { m = (tt - 16) >> 2; n = (tt - 16) & 3; bt = Ktt + 16 * n * 40; dst = (LAS bf16_t*)(rec + R_HV); pitch = 64; }
                lds_mma<1, 1, 1>(acc, Vt + 16 * m * 40, 40, bt, 40, lane);
                const f32x4 v = acc[0][0];
                *(LAS unsigned long long*)(dst + (16 * m + (lane & 15)) * pitch + 16 * n + 4 * (lane >> 4)) = (unsigned long long)pk2(v[0], v[1]) | ((unsigned long long)pk2(v[2], v[3]) << 32); } }
        LDS_BARRIER();
        if (w == 0) {
            f32x4 acc[1][1]; zero_acc<1, 1>(acc);
            lds_mma<1, 1, 1>(acc, iA1, 40, iB1, 40, lane);
#pragma unroll
            for (int e = 0; e < 4; ++e) iWt[(4 * (lane >> 4) + e) * 40 + (lane & 15)] = (bf16_t)f2bf(acc[0][0][e]);
            asm volatile("s_waitcnt lgkmcnt(0)" ::: "memory");
            zero_acc<1, 1>(acc);
            lds_mma<1, 1, 1>(acc, iA2, 40, iWt, 40, lane);
            const f32x4 v = acc[0][0];
            *(LAS unsigned long long*)((LAS bf16_t*)(rec + R_TL) + (16 + (lane & 15)) * 40 + 4 * (lane >> 4)) = (unsigned long long)pk2(v[0], v[1]) | ((unsigned long long)pk2(v[2], v[3]) << 32);
        }
        LDS_BARRIER();
        { GAS u32x4* dst = (GAS u32x4*)(recg + ((size_t)(b * 8 + hd) * 72 + c) * REC_BYTES);
            for (int p = tid; p < REC_BYTES / 16; p += 512) dst[p] = *(const LAS u32x4*)(rec + (size_t)p * 16); }
    }
    __syncthreads();
}

__device__ __forceinline__ void rwkv_seq(const PV& P, int l, int unit, LAS unsigned char* lds) {
    const int tid = otid(), lane = tid & 63, w = tid >> 6, fr = lane & 15, fq = lane >> 4;
    const int dir = unit & 1, h = (unit >> 1) & 3, b = unit >> 3;
    LAS unsigned char* recb = lds;
    LAS bf16_t* S0b = (LAS bf16_t*)(lds + 2 * REC_BYTES);
    LAS bf16_t* Xb = S0b + 4608;
    LAS bf16_t* SAb = Xb + 2560;
    LAS float* Ys = (LAS float*)(SAb + 2560);
    GAS bf16_t* yout = (GAS bf16_t*)(P.ws + WS_Y) + (size_t)(0 * 2 + dir) * YSZ;
    const GAS u32x4* recg = (const GAS u32x4*)(P.ws + WS_REC + (size_t)unit * 72 * REC_BYTES);
    for (int idx = tid; idx < 4608 / 2; idx += 512) ((LAS unsigned*)S0b)[idx] = 0u;
    f32x4 Sacc[1][2]; zero_acc<1, 2>(Sacc);
    const int ms = w >> 1, nbs = (w & 1) * 2;
    const int m1 = w & 3;
    u32x4 pre[5];
    auto issue = [&](int c) {
#pragma unroll
        for (int k = 0; k < 5; ++k) { const int p = tid + 512 * k; pre[k] = (u32x4){0u, 0u, 0u, 0u}; if (p < REC_BYTES / 16) pre[k] = recg[(size_t)c * (REC_BYTES / 16) + p]; } };
    issue(0);
    for (int c = 0; c < 72; ++c) {
        LAS unsigned char* rec = recb + (c & 1) * REC_BYTES;
#pragma unroll
        for (int k = 0; k < 5; ++k) { const int p = tid + 512 * k; if (p < REC_BYTES / 16) *(LAS u32x4*)(rec + (size_t)p * 16) = pre[k]; }
        LDS_BARRIER();
        if (c + 1 < 72) issue(c + 1);
        if (c > 0) {
            const int cp = c - 1; const bool isctx = cp < 8; const int cc = isctx ? cp : cp - 8, seqlen = isctx ? CTX : SEQ;
            const int tlo = dir ? seqlen - 32 - 32 * cc : 32 * cc; const size_t rb = isctx ? (size_t)TL + b * CTX : (size_t)b * SEQ;
            const int i = tid >> 4, rg = tid & 15, t = dir ? tlo + 31 - i : tlo + i;
            const f32x4 v = *(const LAS f32x4*)(Ys + i * 64 + 4 * rg);
            *(GAS unsigned long long*)(yout + (rb + t) * 256 + h * 64 + 4 * rg) = (unsigned long long)pk2(v[0], v[1]) | ((unsigned long long)pk2(v[2], v[3]) << 32); }
        f32x4 aPQ[1][2]; zero_acc<1, 2>(aPQ);
        lds_mma<1, 2, 2>(aPQ, S0b + 16 * m1 * 72, 72, (const LAS bf16_t*)(rec + (w < 4 ? R_AT : R_RT)), 72, lane);
        if (w < 4) {
#pragma unroll
            for (int n = 0; n < 2; ++n) { const u32x2 gw = *(const LAS u32x2*)(rec + R_G + ((16 * m1 + fr) * 32 + 16 * n + 4 * fq) * 2);
                const float x0 = aPQ[0][n][0] + bflo(gw.x), x1 = aPQ[0][n][1] + bfhi(gw.x), x2 = aPQ[0][n][2] + bflo(gw.y), x3 = aPQ[0][n][3] + bfhi(gw.y);
                *(LAS unsigned long long*)(Xb + (16 * m1 + fr) * 40 + 16 * n + 4 * fq) = (unsigned long long)pk2(x0, x1) | ((unsigned long long)pk2(x2, x3) << 32); } }
        LDS_BARRIER();
        { const int n2 = w >> 2; f32x4 aSA[1][1]; zero_acc<1, 1>(aSA);
            lds_mma<1, 1, 1>(aSA, Xb + 16 * m1 * 40, 40, (const LAS bf16_t*)(rec + R_TL) + 16 * n2 * 40, 40, lane);
            const f32x4 v = aSA[0][0];
            *(LAS unsigned long long*)(SAb + (16 * m1 + fr) * 40 + 16 * n2 + 4 * fq) = (unsigned long long)pk2(v[0], v[1]) | ((unsigned long long)pk2(v[2], v[3]) << 32); }
        LDS_BARRIER();
        if (w >= 4) { lds_mma<1, 2, 1>(aPQ, SAb + 16 * m1 * 40, 40, (const LAS bf16_t*)(rec + R_MRB), 40, lane);
#pragma unroll
            for (int n = 0; n < 2; ++n) { const u32x2 yw = *(const LAS u32x2*)(rec + R_YV + ((16 * m1 + fr) * 32 + 16 * n + 4 * fq) * 2);
                const int t0 = 16 * n + 4 * fq, row = 16 * m1 + fr;
                Ys[(t0 + 0) * 64 + row] = aPQ[0][n][0] + bflo(yw.x); Ys[(t0 + 1) * 64 + row] = aPQ[0][n][1] + bfhi(yw.x);
                Ys[(t0 + 2) * 64 + row] = aPQ[0][n][2] + bflo(yw.y); Ys[(t0 + 3) * 64 + row] = aPQ[0][n][3] + bfhi(yw.y); } }
        { f32x4 aS[1][2]; zero_acc<1, 2>(aS);
            lds_mma<1, 2, 1>(aS, SAb + 16 * ms * 40, 40, (const LAS bf16_t*)(rec + R_BT) + 16 * nbs * 40, 40, lane);
#pragma unroll
            for (int n = 0; n < 2; ++n) { const int k0 = 16 * (nbs + n) + 4 * fq, row = 16 * ms + fr;
                const u32x2 hw = *(const LAS u32x2*)(rec + R_HV + (row * 64 + k0) * 2); const f32x4 gm = *(const LAS f32x4*)(rec + R_GAM + k0 * 4);
                f32x4 sn; sn[0] = gm[0] * (Sacc[0][n][0] + aS[0][n][0] + bflo(hw.x)); sn[1] = gm[1] * (Sacc[0][n][1] + aS[0][n][1] + bfhi(hw.x));
                sn[2] = gm[2] * (Sacc[0][n][2] + aS[0][n][2] + bflo(hw.y)); sn[3] = gm[3] * (Sacc[0][n][3] + aS[0][n][3] + bfhi(hw.y));
                Sacc[0][n] = sn;
                *(LAS unsigned long long*)(S0b + row * 72 + k0) = (unsigned long long)pk2(sn[0], sn[1]) | ((unsigned long long)pk2(sn[2], sn[3]) << 32); } }
    }
    LDS_BARRIER();
    { const int cp = 71; const int seqlen = SEQ, cc = cp - 8; const int tlo = dir ? seqlen - 32 - 32 * cc : 32 * cc; const size_t rb = (size_t)b * SEQ;
        const int i = tid >> 4, rg = tid & 15, t = dir ? tlo + 31 - i : tlo + i;
        const f32x4 v = *(const LAS f32x4*)(Ys + i * 64 + 4 * rg);
        *(GAS unsigned long long*)(yout + (rb + t) * 256 + h * 64 + 4 * rg) = (unsigned long long)pk2(v[0], v[1]) | ((unsigned long long)pk2(v[2], v[3]) << 32); }
    __syncthreads();
}

__device__ __forceinline__ void ret_unit(const PV& P, int l, int unit, LAS unsigned char* lds) {
    const int tid = otid(), lane = tid & 63, w = tid >> 6;
    const int dir = unit & 1, h = (unit >> 1) & 3, b = unit >> 3;
    LAS bf16_t* Qs = (LAS bf16_t*)lds; LAS bf16_t* Ks = Qs + 4608; LAS bf16_t* Kt = Ks + 4608; LAS bf16_t* Vt = Kt + 4608; LAS bf16_t* Att = Vt + 4608; LAS bf16_t* St = Att + 4608;
    const GAS bf16_t* z = (const GAS bf16_t*)(P.ws + WS_Z);
    GAS bf16_t* yout = (GAS bf16_t*)(P.ws + WS_Y) + (size_t)(1 * 2 + dir) * YSZ;
    const float lg = __logf(1.0f - exp2f(-((dir ? 5.5f : 5.0f) + (float)h)));
    for (int idx = tid; idx < 4608; idx += 512) St[idx] = 0;
    f32x4 Sacc[1][2]; zero_acc<1, 2>(Sacc);
    const int m = w >> 1, nb = (w & 1) * 2, fr = lane & 15, fq = lane >> 4;
    const float cdec = __expf(lg * 64.0f);
    u32x4 pre[3];
    auto tok = [&](int c, int i, size_t& rb, int& pos) -> int {
        const bool isctx = c < 4; const int cc = isctx ? c : c - 4, seqlen = isctx ? CTX : SEQ;
        const int tlo = dir ? seqlen - 64 - 64 * cc : 64 * cc; rb = isctx ? (size_t)TL + b * CTX : (size_t)b * SEQ;
        const int t = dir ? tlo + 63 - i : tlo + i; pos = (isctx ? 0 : CTX) + t; return t;
    };
    auto issue_loads = [&](int c) { const int i = tid >> 3, vc = tid & 7; size_t rb; int pos; const int t = tok(c, i, rb, pos);
#pragma unroll
        for (int k = 0; k < 3; ++k) pre[k] = *(const GAS u32x4*)(z + (rb + t) * ZW + CB_ + k * 256 + h * 64 + vc * 8); };
    issue_loads(0);
    for (int c = 0; c < 36; ++c) {
        LDS_BARRIER();
        { const int i = tid >> 3, vc = tid & 7;
            *(LAS u32x4*)(Qs + i * 72 + vc * 8) = pre[0]; *(LAS u32x4*)(Ks + i * 72 + vc * 8) = pre[1];
            const unsigned vw[4] = {pre[2].x, pre[2].y, pre[2].z, pre[2].w};
#pragma unroll
            for (int e = 0; e < 4; ++e) { Vt[(vc * 8 + 2 * e) * 72 + i] = (bf16_t)(vw[e] & 0xffffu); Vt[(vc * 8 + 2 * e + 1) * 72 + i] = (bf16_t)(vw[e] >> 16); } }
        LDS_BARRIER();
        if (c + 1 < 36) issue_loads(c + 1);
#pragma unroll
        for (int k = 0; k < 4; ++k) { const int idx = tid + 512 * k, i = idx >> 5, d = idx & 31; size_t rb; int pos; tok(c, i, rb, pos);
            float rev = (float)pos * (exp2f(-(float)d * (13.287712379549449f / 32.0f)) * 0.15915494309189535f); rev -= floorf(rev);
            const float sn = __builtin_amdgcn_sinf(rev), cs = __builtin_amdgcn_cosf(rev);
            const float q1 = bf2f(Qs[i * 72 + d]), q2 = bf2f(Qs[i * 72 + d + 32]), k1 = bf2f(Ks[i * 72 + d]), k2 = bf2f(Ks[i * 72 + d + 32]);
            Qs[i * 72 + d] = (bf16_t)f2bf((q1 * cs - q2 * sn) * 0.125f); Qs[i * 72 + d + 32] = (bf16_t)f2bf((q1 * sn + q2 * cs) * 0.125f);
            const float o1 = k1 * cs - k2 * sn, o2 = k1 * sn + k2 * cs, wd = __expf(lg * (float)(63 - i));
            Ks[i * 72 + d] = (bf16_t)f2bf(o1); Ks[i * 72 + d + 32] = (bf16_t)f2bf(o2);
            Kt[d * 72 + i] = (bf16_t)f2bf(o1 * wd); Kt[(d + 32) * 72 + i] = (bf16_t)f2bf(o2 * wd); }
        LDS_BARRIER();
        f32x4 aS[1][2], aO2[1][2]; zero_acc<1, 2>(aS); zero_acc<1, 2>(aO2);
        lds_mma<1, 2, 2>(aS, Qs + 16 * m * 72, 72, Ks + 16 * nb * 72, 72, lane);
        lds_mma<1, 2, 2>(aO2, Qs + 16 * m * 72, 72, St + 16 * nb * 72, 72, lane);
        const int i = 16 * m + fr;
#pragma unroll
        for (int n = 0; n < 2; ++n) { float o[4];
#pragma unroll
            for (int e = 0; e < 4; ++e) { const int j = 16 * (nb + n) + 4 * fq + e, diff = i - j; const bool keep = dir ? diff > 0 : diff >= 0;
                o[e] = keep ? aS[0][n][e] * __expf(lg * (float)diff) : 0.f; }
            *(LAS unsigned long long*)(Att + i * 72 + 16 * (nb + n) + 4 * fq) = (unsigned long long)pk2(o[0], o[1]) | ((unsigned long long)pk2(o[2], o[3]) << 32); }
        LDS_BARRIER();
        f32x4 aO1[1][2], aT[1][2]; zero_acc<1, 2>(aO1); zero_acc<1, 2>(aT);
        lds_mma<1, 2, 2>(aO1, Att + 16 * m * 72, 72, Vt + 16 * nb * 72, 72, lane);
        lds_mma<1, 2, 2>(aT, Vt + 16 * m * 72, 72, Kt + 16 * nb * 72, 72, lane);
        { size_t rb; int pos; const int t = tok(c, i, rb, pos); const float rd = __expf(lg * (float)(i + 1));
#pragma unroll
            for (int n = 0; n < 2; ++n) { const f32x4 o = aO1[0][n] + rd * aO2[0][n];
                *(GAS unsigned long long*)(yout + (rb + t) * 256 + h * 64 + 16 * (nb + n) + 4 * fq) = (unsigned long long)pk2(o[0], o[1]) | ((unsigned long long)pk2(o[2], o[3]) << 32); } }
#pragma unroll
        for (int n = 0; n < 2; ++n) { Sacc[0][n] = cdec * Sacc[0][n] + aT[0][n]; const f32x4 s = Sacc[0][n];
            *(LAS unsigned long long*)(St + i * 72 + 16 * (nb + n) + 4 * fq) = (unsigned long long)pk2(s[0], s[1]) | ((unsigned long long)pk2(s[2], s[3]) << 32); }
    }
    __syncthreads();
}

__device__ __forceinline__ void lru_items(const PV& P, int l, LAS unsigned char* lds) {
    const int tid0 = otid();
    LAS bf16_t* waT = (LAS bf16_t*)lds; LAS bf16_t* wxT = waT + 4608; LAS bf16_t* xcb = wxT + 4608;
    LAS float* xraw = (LAS float*)(lds + 27648);
    LAS float* xcf = xraw + 67 * 64;
    LAS float* a_s = xcf + 4352; LAS float* b_s = a_s + 4352;
    LAS float* segA = b_s + 4352; LAS float* segH = segA + 512; LAS float* par = segH + 512;
    const GAS bf16_t* z = (const GAS bf16_t*)(P.ws + WS_Z);
    int cur_key = -1;
    u32x4 pre[2];
    auto geo = [&](int u, int& key, int& b, int& c, int& tlo, int& seqlen, size_t& rb) { key = u & 7; const int rest = u >> 3; b = rest / 36; c = rest % 36; const int dir = key >> 2;
        const bool isctx = c < 4; const int cc = isctx ? c : c - 4; seqlen = isctx ? CTX : SEQ; tlo = dir ? seqlen - 64 - 64 * cc : 64 * cc; rb = isctx ? (size_t)TL + b * CTX : (size_t)b * SEQ; };
    auto issue = [&](int u, int tid) { int key, b, c, tlo, seqlen; size_t rb; geo(u, key, b, c, tlo, seqlen, rb);
#pragma unroll
        for (int k = 0; k < 2; ++k) { const int v = tid + 512 * k; pre[k] = (u32x4){0u, 0u, 0u, 0u};
            if (v < 536) { const int rr = v >> 3, vc = v & 7, t = tlo - 2 + rr; if (t >= 0 && t < seqlen) pre[k] = *(const GAS u32x4*)(z + (rb + t) * ZW + CC_ + (key & 3) * 64 + vc * 8); } } };
    if ((int)blockIdx.x < 2304) issue(blockIdx.x, tid0);
    for (int u = blockIdx.x; u < 2304; u += gridDim.x) {
        const int tid = otid(), lane = tid & 63, w = tid >> 6;
        int key, b, c, tlo, seqlen; size_t rb; geo(u, key, b, c, tlo, seqlen, rb); const int dir = key >> 2, blk = key & 3;
        GAS bf16_t* hout = (GAS bf16_t*)(P.ws + WS_Y) + (size_t)(2 * 2 + dir) * YSZ; GAS bf16_t* aout = (GAS bf16_t*)(P.ws + WS_ACU) + (size_t)dir * YSZ;
        LDS_BARRIER();
        if (key != cur_key) { cur_key = key;
            for (int idx = tid; idx < 4096; idx += 512) { const int i = idx >> 6, j = idx & 63; const size_t o = ((size_t)((l * 2 + dir) * 4 + blk) * 64 + i) * 64 + j;
                waT[j * 72 + i] = (bf16_t)f2bf(PIN(I_WA)[o]); wxT[j * 72 + i] = (bf16_t)f2bf(PIN(I_WX)[o]); }
            { const int k = tid >> 6, cc = tid & 63, ch = blk * 64 + cc; float v;
                if (k < 4) v = PIN(I_CVW)[(l * 4 + k) * 256 + ch]; else if (k == 4) v = PIN(I_CVB)[l * 256 + ch];
                else if (k == 5) v = PIN(I_BA)[(l * 2 + dir) * 256 + ch]; else if (k == 6) v = PIN(I_BX)[(l * 2 + dir) * 256 + ch];
                else v = softplusf_(-PIN(I_LAM)[(l * 2 + dir) * 256 + ch]);
                par[tid] = v; } }
#pragma unroll
        for (int k = 0; k < 2; ++k) { const int v = tid + 512 * k; if (v < 536) { const unsigned ww[4] = {pre[k].x, pre[k].y, pre[k].z, pre[k].w};
#pragma unroll
                for (int e = 0; e < 4; ++e) { xraw[v * 8 + 2 * e] = bflo(ww[e]); xraw[v * 8 + 2 * e + 1] = bfhi(ww[e]); } } }
        LDS_BARRIER();
        if (u + (int)gridDim.x < 2304) issue(u + gridDim.x, tid);
        { const int ch = tid & 63, tg = tid >> 6;
#pragma unroll
            for (int e = 0; e < 8; ++e) { const int tt = tg * 8 + e;
                const float xc = par[256 + ch] + par[ch] * xraw[tt * 64 + ch] + par[64 + ch] * xraw[(tt + 1) * 64 + ch] + par[128 + ch] * xraw[(tt + 2) * 64 + ch] + par[192 + ch] * xraw[(tt + 3) * 64 + ch];
                const int i = dir ? 63 - tt : tt; xcf[i * 68 + ch] = xc; xcb[i * 72 + ch] = (bf16_t)f2bf(xc); } }
        LDS_BARRIER();
        { const int m = w >> 1, nb = (w & 1) * 2, fr = lane & 15, fq = lane >> 4;
            f32x4 aR[1][2], aI[1][2]; zero_acc<1, 2>(aR); zero_acc<1, 2>(aI);
            lds_mma<1, 2, 2>(aR, xcb + 16 * m * 72, 72, waT + 16 * nb * 72, 72, lane);
            lds_mma<1, 2, 2>(aI, xcb + 16 * m * 72, 72, wxT + 16 * nb * 72, 72, lane);
            const int i = 16 * m + fr;
#pragma unroll
            for (int n = 0; n < 2; ++n) { f32x4 av, bv;
#pragma unroll
                for (int e = 0; e < 4; ++e) { const int ch = 16 * (nb + n) + 4 * fq + e;
                    const float r = sigmoidf_(aR[0][n][e] + par[320 + ch]), ig = sigmoidf_(aI[0][n][e] + par[384 + ch]);
                    const float la = -8.0f * r * par[448 + ch]; av[e] = __expf(la);
                    const float y2 = 2.0f * la;
                    const float om = y2 > -0.125f ? -y2 * (1.0f + y2 * (0.5f + y2 * (0.16666667f + y2 * (0.041666668f + y2 * 0.0083333338f)))) : 1.0f - __expf(y2);
                    bv[e] = sqrtf(fmaxf(om, 0.f)) * ig * xcf[i * 68 + ch]; }
                *(LAS f32x4*)(a_s + i * 68 + 16 * (nb + n) + 4 * fq) = av; *(LAS f32x4*)(b_s + i * 68 + 16 * (nb + n) + 4 * fq) = bv; } }
        LDS_BARRIER();
        const int ch = tid & 63, seg = tid >> 6;
        float av[8], bv[8];
        { float A = 1.f, H = 0.f;
#pragma unroll
            for (int e = 0; e < 8; ++e) { const int i = seg * 8 + e; av[e] = a_s[i * 68 + ch]; bv[e] = b_s[i * 68 + ch]; }
#pragma unroll
            for (int e = 0; e < 8; ++e) { H = av[e] * H + bv[e]; A *= av[e]; av[e] = A; bv[e] = H; }
            segA[seg * 64 + ch] = A; segH[seg * 64 + ch] = H; }
        LDS_BARRIER();
        float hin = 0.f, ap = 1.f;
#pragma unroll
        for (int s2 = 0; s2 < 7; ++s2) if (s2 < seg) { const float sa = segA[s2 * 64 + ch]; hin = sa * hin + segH[s2 * 64 + ch]; ap *= sa; }
#pragma unroll
        for (int e = 0; e < 8; ++e) { const int i = seg * 8 + e; const int t = dir ? tlo + 63 - i : tlo + i;
            const float hl = bv[e] + av[e] * hin, ac = av[e] * ap;
            hout[(rb + t) * 256 + blk * 64 + ch] = (bf16_t)f2bf(hl); aout[(rb + t) * 256 + blk * 64 + ch] = (bf16_t)f2bf(ac);
            if (i == 63) { GAS float* ag = (GAS float*)(P.ws + WS_AGG) + ((size_t)((b * 2 + dir) * 36 + c) * 2) * 256 + blk * 64 + ch; ag[0] = ac; ag[256] = hl; } }
    }
    __syncthreads();
}
__device__ __forceinline__ void lru_carry_unit(const PV& P, int unit) {
    const int tid = otid();
    if (tid < 256) { const float* ag = (const float*)(P.ws + WS_AGG) + (size_t)unit * 36 * 512 + tid; float* ci = (float*)(P.ws + WS_CIN) + (size_t)unit * 36 * 256 + tid;
        float A[36], H[36];
#pragma unroll
        for (int c = 0; c < 36; ++c) { A[c] = ag[c * 512]; H[c] = ag[c * 512 + 256]; }
        float carry = 0.f;
#pragma unroll
        for (int c = 0; c < 36; ++c) { ci[c * 256] = carry; carry = A[c] * carry + H[c]; } }
}

__device__ __forceinline__ void s5_unit(const PV& P, int l, int unit, LAS unsigned char* lds) {
    const int tid = otid(), lane = tid & 63, w = tid >> 6;
    const int gp = unit & 7, dir = (unit >> 3) & 1, b = unit >> 4;
    LAS float* bu0 = (LAS float*)lds;
    LAS bf16_t* Hs0 = (LAS bf16_t*)(lds + 66560);
    LAS bf16_t* Us0 = (LAS bf16_t*)(lds + 100352);
    LAS bf16_t* Bbu = (LAS bf16_t*)(lds + 105472);
    LAS bf16_t* By = (LAS bf16_t*)(lds + 125952);
    const GAS bf16_t* z = (const GAS bf16_t*)(P.ws + WS_Z);
    GAS bf16_t* yout = (GAS bf16_t*)(P.ws + WS_Y) + (size_t)(3 * 2 + dir) * YSZ;
    for (int idx = tid; idx < 256 * 40 / 2; idx += 512) ((LAS unsigned*)Bbu)[idx] = 0u;
    __syncthreads();
    float lr = 0.f, li = 0.f, hr = 0.f, hi = 0.f;
    if (tid < 128) { const int gl = tid >> 6, p = tid & 63, g = 2 * gp + gl; const size_t pidx = ((size_t)(l * 2 + dir) * 16 + g) * 64 + p;
        const float are = PIN(I_SARE)[pidx], aim = PIN(I_SAIM)[pidx], dt = __expf(PIN(I_SLDT)[(l * 2 + dir) * 16 + g]);
        const float mag = __expf(are * dt); float rev = aim * dt * 0.15915494309189535f; rev -= floorf(rev);
        lr = mag * __builtin_amdgcn_cosf(rev); li = mag * __builtin_amdgcn_sinf(rev);
        const float nre = lr - 1.0f, nim = li, den = 1.0f / (are * are + aim * aim);
        const float cre = (nre * are + nim * aim) * den, cim = (nim * are - nre * aim) * den;
#pragma unroll
        for (int c = 0; c < 16; ++c) { const float bre = PIN(I_SBRE)[pidx * 16 + c], bim = PIN(I_SBIM)[pidx * 16 + c];
            Bbu[(gl * 128 + p) * 40 + gl * 16 + c] = (bf16_t)f2bf(cre * bre - cim * bim); Bbu[(gl * 128 + 64 + p) * 40 + gl * 16 + c] = (bf16_t)f2bf(cre * bim + cim * bre); } }
    for (int idx = tid; idx < 4096; idx += 512) { const int gl = idx >> 11, c = (idx >> 7) & 15, kk = idx & 127, part = kk >> 6, p = kk & 63, g = 2 * gp + gl;
        const size_t src = (((size_t)(l * 2 + dir) * 16 + g) * 16 + c) * 64 + p;
        By[(gl * 16 + c) * 136 + kk] = (bf16_t)f2bf(part ? -PIN(I_SCIM)[src] : PIN(I_SCRE)[src]); }
    auto rowof = [&](int c, int i) -> size_t {
        if (c < 8) { const int s = 32 * c + i, t = dir ? 255 - s : s; return (size_t)TL + b * CTX + t; }
        const int sl = 32 * (c - 8) + i, slr = dir ? 2047 - sl : sl, col = slr >> 5, rg = slr & 31; return (size_t)b * SEQ + rg * 64 + col; };
    const int t6 = tid - 384;
    u32x4 pre = (u32x4){0u, 0u, 0u, 0u};
    if (w >= 6) { pre = *(const GAS u32x4*)(z + rowof(0, t6 >> 2) * ZW + CD_ + gp * 32 + (t6 & 3) * 8); *(LAS u32x4*)(Us0 + (t6 >> 2) * 40 + (t6 & 3) * 8) = pre;
        pre = *(const GAS u32x4*)(z + rowof(1, t6 >> 2) * ZW + CD_ + gp * 32 + (t6 & 3) * 8); }
    __syncthreads();
#pragma unroll 1
    for (int k = 0; k < 74; ++k) {
        if (w < 2) {
            const float hr_s = hr, hi_s = hi;
            for (int r3 = 0; r3 < ((PROBE_DUP & 524288) ? 2 : 1); ++r3)
            if (k >= 1 && k <= 72) { const LAS float* bu = bu0 + ((k - 1) & 1) * 8320; LAS bf16_t* Hs = Hs0 + ((k - 1) & 1) * 8448; hr = hr_s; hi = hi_s;
                const int cr = (tid >> 6) * 128 + (tid & 63), ci = cr + 64;
#pragma unroll 1
                for (int i0 = 0; i0 < 32; i0 += 8) { float br[8], bi[8];
#pragma unroll
                    for (int e = 0; e < 8; ++e) { br[e] = bu[(i0 + e) * 260 + cr]; bi[e] = bu[(i0 + e) * 260 + ci]; }
                    unsigned orr[8];
#pragma unroll
                    for (int e = 0; e < 8; ++e) { const float nr = lr * hr - li * hi + br[e], ni = lr * hi + li * hr + bi[e]; hr = nr; hi = ni; orr[e] = pk2a(nr, ni); }
#pragma unroll
                    for (int e = 0; e < 8; ++e) { Hs[(i0 + e) * 264 + cr] = (bf16_t)(orr[e] & 0xffffu); Hs[(i0 + e) * 264 + ci] = (bf16_t)(orr[e] >> 16); } } }
        } else if (w < 6) {
            for (int r3 = 0; r3 < ((PROBE_DUP & 131072) ? 2 : 1); ++r3)
            if (k <= 71) { LAS float* bu = bu0 + (k & 1) * 8320; const LAS bf16_t* Us = Us0 + (k & 1) * 1280; const int wq = w - 2;
                f32x4 acc[2][4]; zero_acc<2, 4>(acc);
                lds_mma<2, 4, 1>(acc, Us, 40, Bbu + 64 * wq * 40, 40, lane);
#pragma unroll
                for (int mm = 0; mm < 2; ++mm)
#pragma unroll
                    for (int n = 0; n < 4; ++n) *(LAS f32x4*)(bu + (16 * mm + (lane & 15)) * 260 + 64 * wq + 16 * n + 4 * (lane >> 4)) = acc[mm][n]; }
        } else {
            for (int r3 = 0; r3 < ((PROBE_DUP & 262144) ? 2 : 1); ++r3)
            if (k >= 2) { const LAS bf16_t* Hs = Hs0 + (k & 1) * 8448; const int gl = w - 6, cy = k - 2;
                f32x4 acc[2][1]; zero_acc<2, 1>(acc);
                lds_mma<2, 1, 4>(acc, Hs + gl * 128, 264, By + gl * 16 * 136, 136, lane);
#pragma unroll
                for (int mm = 0; mm < 2; ++mm) { const int i = 16 * mm + (lane & 15); const f32x4 v = acc[mm][0];
                    *(GAS unsigned long long*)(yout + rowof(cy, i) * 256 + gp * 32 + gl * 16 + 4 * (lane >> 4)) = (unsigned long long)pk2(v[0], v[1]) | ((unsigned long long)pk2(v[2], v[3]) << 32); } }
            if (k + 1 <= 71) { *(LAS u32x4*)(Us0 + ((k + 1) & 1) * 1280 + (t6 >> 2) * 40 + (t6 & 3) * 8) = pre;
                if (k + 2 <= 71) pre = *(const GAS u32x4*)(z + rowof(k + 2, t6 >> 2) * ZW + CD_ + gp * 32 + (t6 & 3) * 8); }
        }
        LDS_BARRIER();
    }
    __syncthreads();
}

__device__ __forceinline__ float sum16(float v) { v = sum8(v); return v + dppf<0x140>(v); }
struct CmbRow { u32x2 zr[3], zk[3], zv[3], zg[3], gB, gC, uD, y[8], ac[2]; f32x4 ci[2]; };
__device__ __forceinline__ void p3_combine(const PV& P, int l, int nrows, LAS unsigned char* lds) {
    const int tid = otid(), lane = tid & 63, w = tid >> 6, c4 = 4 * lane, hh = lane >> 4;
    LAS float* gup = (LAS float*)lds;
    LAS float* smu = gup + 16384;
    LAS float* spar = smu + 1664;
    LAS float* sgs = spar + 1280 + w * 64;
    for (int idx = tid; idx < 16384; idx += 512) gup[idx] = PIN(I_GUP)[(size_t)l * 16384 + idx];
    for (int idx = tid; idx < 1664; idx += 512) { const int which = idx / 832, col = idx % 832; smu[idx] = PIN(I_MU)[(size_t)(l * 2 + which) * 960 + col]; }
    for (int idx = tid; idx < 1280; idx += 512) { const int k = idx >> 8, c = idx & 255;
        spar[idx] = k == 0 ? PIN(I_LNG)[l * 256 + c] : k == 1 ? PIN(I_LNB)[l * 256 + c] : k == 2 ? PIN(I_RK)[l * 256 + c] : k == 3 ? PIN(I_GNG)[l * 256 + c] : PIN(I_SD)[l * 256 + c]; }
    __syncthreads();
    const GAS bf16_t* z = (const GAS bf16_t*)(P.ws + WS_Z); const GAS bf16_t* Y = (const GAS bf16_t*)(P.ws + WS_Y);
    GAS bf16_t* mix = (GAS bf16_t*)(P.ws + WS_ACT); GAS bf16_t* s5g = (GAS bf16_t*)(P.ws + WS_S5G);
    const int gw = blockIdx.x * 8 + w, NGW = gridDim.x * 8;
    auto ld = [&](int row, CmbRow& L) {
        const bool isctx = row >= TL; const int t = isctx ? ((row - TL) & 255) : (row & 2047), seqlen = isctx ? CTX : SEQ;
        const GAS bf16_t* zr = z + (size_t)row * ZW;
#pragma unroll
        for (int d = 0; d < 3; ++d) { const bool ok = d == 1 || (d == 0 ? t > 0 : t < seqlen - 1); const GAS bf16_t* zz = zr + (d - 1) * ZW; const u32x2 zero = (u32x2){0u, 0u};
            L.zr[d] = ok ? *(const GAS u32x2*)(zz + c4) : zero; L.zk[d] = ok ? *(const GAS u32x2*)(zz + 256 + c4) : zero; L.zv[d] = ok ? *(const GAS u32x2*)(zz + 512 + c4) : zero;
            L.zg[d] = (ok && lane < 16) ? *(const GAS u32x2*)(zz + 768 + c4) : zero; }
        L.gB = *(const GAS u32x2*)(zr + CB_ + 768 + c4); L.gC = *(const GAS u32x2*)(zr + CC_ + 256 + c4); L.uD = *(const GAS u32x2*)(zr + CD_ + c4);
#pragma unroll
        for (int k = 0; k < 8; ++k) L.y[k] = *(const GAS u32x2*)(Y + (size_t)k * YSZ + (size_t)row * 256 + c4);
        const int bb = isctx ? (row - TL) >> 8 : row >> 11;
#pragma unroll
        for (int d = 0; d < 2; ++d) { const int ts = d ? seqlen - 1 - t : t, ck = (isctx ? 0 : 4) + (ts >> 6);
            L.ac[d] = *(const GAS u32x2*)((const GAS bf16_t*)(P.ws + WS_ACU) + (size_t)d * YSZ + (size_t)row * 256 + c4);
            L.ci[d] = *(const GAS f32x4*)((const GAS float*)(P.ws + WS_CIN) + ((size_t)(bb * 2 + d) * 36 + ck) * 256 + c4); }
    };
    auto up4 = [](const u32x2 v, float (&o)[4]) { o[0] = bflo(v.x); o[1] = bfhi(v.x); o[2] = bflo(v.y); o[3] = bfhi(v.y); };
    auto st4 = [](GAS bf16_t* p, const float (&o)[4]) { *(GAS unsigned long long*)p = (unsigned long long)pk2(o[0], o[1]) | ((unsigned long long)pk2(o[2], o[3]) << 32); };
    auto shift4 = [&](const u32x2 (&zz)[3], int col, float (&o)[4]) { float a[4], m[4], n[4]; up4(zz[1], a); up4(zz[0], m); up4(zz[2], n);
        const f32x4 u0 = *(const LAS f32x4*)(smu + col), u1 = *(const LAS f32x4*)(smu + 832 + col);
#pragma unroll
        for (int e = 0; e < 4; ++e) o[e] = a[e] + u0[e] * (m[e] - a[e]) + u1[e] * (n[e] - a[e]); };
    auto cmp = [&](int row, const CmbRow& L) {
        if (lane < 16) { float gl[4]; shift4(L.zg, 768 + c4, gl);
            *(LAS f32x4*)(sgs + c4) = (f32x4){sigmoidf_(gl[0]), sigmoidf_(gl[1]), sigmoidf_(gl[2]), sigmoidf_(gl[3])}; }
        asm volatile("s_waitcnt lgkmcnt(0)" ::: "memory");
        f32x4 g = (f32x4){0.f, 0.f, 0.f, 0.f};
#pragma unroll 8
        for (int i = 0; i < 64; ++i) g += sgs[i] * *(const LAS f32x4*)(gup + i * 256 + c4);
        float r[4], k[4], v[4]; shift4(L.zr, c4, r); shift4(L.zk, 256 + c4, k); shift4(L.zv, 512 + c4, v);
        const f32x4 lng = *(const LAS f32x4*)(spar + c4), lnb = *(const LAS f32x4*)(spar + 256 + c4), rk = *(const LAS f32x4*)(spar + 512 + c4), gng = *(const LAS f32x4*)(spar + 768 + c4), sd = *(const LAS f32x4*)(spar + 1024 + c4);
        float ya[4], yb[4], t0[4], t1[4];
        up4(L.y[0], t0); up4(L.y[1], t1);
#pragma unroll
        for (int e = 0; e < 4; ++e) ya[e] = t0[e] + t1[e];
        { const float mean = sum16((ya[0] + ya[1]) + (ya[2] + ya[3])) * (1.0f / 64.0f); float q = 0.f, bsum = 0.f;
#pragma unroll
            for (int e = 0; e < 4; ++e) { ya[e] -= mean; q += ya[e] * ya[e]; bsum += r[e] * k[e] * rk[e]; }
            const float rs = rsqrtf(sum16(q) * (1.0f / 64.0f) + 64e-5f); bsum = sum16(bsum); float o[4];
#pragma unroll
            for (int e = 0; e < 4; ++e) o[e] = (ya[e] * rs * lng[e] + lnb[e] + bsum * v[e]) * g[e];
            st4(mix + (size_t)row * 1024 + c4, o); }
        up4(L.y[2], t0); up4(L.y[3], t1);
#pragma unroll
        for (int e = 0; e < 4; ++e) yb[e] = t0[e] + t1[e];
        { const float mean = sum16((yb[0] + yb[1]) + (yb[2] + yb[3])) * (1.0f / 64.0f); float q = 0.f;
#pragma unroll
            for (int e = 0; e < 4; ++e) { yb[e] -= mean; q += yb[e] * yb[e]; }
            const float rs = rsqrtf(sum16(q) * (1.0f / 64.0f) + 1e-5f); float gt[4], o[4]; up4(L.gB, gt);
#pragma unroll
            for (int e = 0; e < 4; ++e) o[e] = siluf_(gt[e]) * (yb[e] * rs * gng[e]);
            st4(mix + (size_t)row * 1024 + 256 + c4, o); }
        { float gt[4], o[4], a0[4], a1[4]; up4(L.gC, gt); up4(L.y[4], t0); up4(L.y[5], t1); up4(L.ac[0], a0); up4(L.ac[1], a1);
#pragma unroll
            for (int e = 0; e < 4; ++e) o[e] = geluf_(gt[e]) * ((t0[e] + a0[e] * L.ci[0][e]) + (t1[e] + a1[e] * L.ci[1][e]));
            st4(mix + (size_t)row * 1024 + 512 + c4, o); }
        { float uu[4], o[4]; up4(L.uD, uu); up4(L.y[6], t0); up4(L.y[7], t1);
#pragma unroll
            for (int e = 0; e < 4; ++e) o[e] = geluf_(sd[e] * uu[e] + t0[e] + t1[e]);
            st4(s5g + (size_t)row * 256 + c4, o); }
    };
    (void)hh;
    for (int row = gw; row < nrows; row += 2 * NGW) {
        CmbRow LA, LB; const int rowB = row + NGW; const bool hasB = rowB < nrows;
        ld(row, LA); if (hasB) ld(rowB, LB);
        cmp(row, LA); if (hasB) cmp(rowB, LB);
    }
}

__device__ __forceinline__ void p6_h2(const PV& P, int l, int nrows) {
    const int tid = otid(), lane = tid & 63, gw = blockIdx.x * 8 + (tid >> 6), NGW = gridDim.x * 8;
    const float* mod = (const float*)(P.ws + WS_MOD) + (size_t)l * 9 * 6144; const float* X1 = (const float*)(P.ws + WS_X1);
    bf16_t* act = (bf16_t*)(P.ws + WS_ACT);
    for (int row = gw; row < nrows; row += NGW) { const int mr = row < TL ? (row >> 11) : 8;
        float x[16], y[16]; load_row16(X1 + (size_t)row * 1024, lane, x);
        norm_mod16(x, PIN(I_N2G) + l * 1024, mod + (size_t)mr * 6144 + 3 * 1024, mod + (size_t)mr * 6144 + 4 * 1024, lane, y);
        store_row16_bf16(act + (size_t)row * 1024, lane, y); }
}

__device__ __forceinline__ unsigned skey(float f) { const unsigned u = __builtin_bit_cast(unsigned, f); return u ^ ((unsigned)((int)u >> 31) | 0x80000000u); }
__device__ __forceinline__ float unskey(unsigned s) { const unsigned u = (s & 0x80000000u) ? (s ^ 0x80000000u) : ~s; return __builtin_bit_cast(float, u); }

__device__ __forceinline__ void ce_(unsigned& a, unsigned& b) { const unsigned hi = max(a, b), lo = min(a, b); a = hi; b = lo; }
__device__ __forceinline__ void sort16_(unsigned (&v)[16]) {
#pragma unroll
    for (int k = 2; k <= 16; k <<= 1)
#pragma unroll
        for (int j = k >> 1; j > 0; j >>= 1)
#pragma unroll
            for (int i = 0; i < 16; ++i) { const int p = i ^ j; if (p > i) { if ((i & k) == 0) ce_(v[i], v[p]); else ce_(v[p], v[i]); } }
}
__device__ __forceinline__ void merge16_(unsigned (&a)[16], const unsigned (&b)[16]) {
#pragma unroll
    for (int i = 0; i < 16; ++i) a[i] = max(a[i], b[15 - i]);
#pragma unroll
    for (int j = 8; j > 0; j >>= 1)
#pragma unroll
        for (int i = 0; i < 16; ++i) { const int p = i ^ j; if (p > i) ce_(a[i], a[p]); }
}
__device__ __forceinline__ void p8a_topk(const PV& P, int nrows, LAS unsigned char* lds) {
    const int tid = otid();
    LAS unsigned* tb = (LAS unsigned*)lds;
    const GAS float* sc = (const GAS float*)(P.ws + WS_SC); GAS u32x2* list = (GAS u32x2*)(P.ws + WS_LIST);
    const int items = nrows * 16, nth = gridDim.x * 512;
    for (int item = blockIdx.x * 512 + tid; item < items; item += nth) {
        const int row = item >> 4, hp = item & 15, hh = hp >> 1, p = hp & 1;
        const GAS f32x4* sp = (const GAS f32x4*)(sc + (size_t)row * 2048 + hp * 128);
        unsigned top[16];
#pragma unroll 1
        for (int bk = 0; bk < 8; ++bk) { unsigned cur[16];
#pragma unroll
            for (int q = 0; q < 4; ++q) { const f32x4 v = sp[bk * 4 + q];
#pragma unroll
                for (int k = 0; k < 4; ++k) cur[q * 4 + k] = (skey(v[k]) & 0xFFFFFF80u) | (unsigned)(bk * 16 + q * 4 + k); }
            sort16_(cur);
            if (bk == 0) {
#pragma unroll
                for (int s = 0; s < 16; ++s) top[s] = cur[s];
            } else merge16_(top, cur); }
        float v1[16], v2[16]; unsigned i1[16], i2[16];
#pragma unroll
        for (int s = 0; s < 16; ++s) { const float mv = unskey(top[s] & 0xFFFFFF80u); const unsigned mi = top[s] & 127u;
            const float ov = dppf<0xB1>(mv); const unsigned oi = dppu<0xB1>(mi);
            v1[s] = p ? ov : mv; i1[s] = p ? oi : mi; v2[s] = p ? mv : ov; i2[s] = p ? mi : oi; }
        unsigned k2[16];
        { unsigned cand[64]; int n = 0;
#pragma unroll
            for (int a = 0; a < 16; ++a)
#pragma unroll
                for (int bb = 0; bb < 16; ++bb) if ((a + 1) * (bb + 1) <= 16) { cand[n] = (skey(v1[a] + v2[bb]) & 0xFFFFFF00u) | (unsigned)(a * 16 + bb); ++n; }
#pragma unroll
            for (int q = 50; q < 64; ++q) cand[q] = 0u;
#pragma unroll
            for (int bk = 0; bk < 4; ++bk) { unsigned cur[16];
#pragma unroll
                for (int s = 0; s < 16; ++s) cur[s] = cand[bk * 16 + s];
                sort16_(cur);
                if (bk == 0) {
#pragma unroll
                    for (int s = 0; s < 16; ++s) k2[s] = cur[s];
                } else merge16_(k2, cur); } }
#pragma unroll
        for (int s = 0; s < 16; ++s) { tb[s * 512 + tid] = i1[s]; tb[(16 + s) * 512 + tid] = i2[s]; }
        const float mx = unskey(k2[0] & 0xFFFFFF00u); float ev[16], sum = 0.f; unsigned pl[16];
#pragma unroll
        for (int s = 0; s < 16; ++s) { ev[s] = __expf(unskey(k2[s] & 0xFFFFFF00u) - mx); sum += ev[s];
            const unsigned a = (k2[s] >> 4) & 15u, bb = k2[s] & 15u; pl[s] = (tb[a * 512 + tid] << 7) | tb[(16 + bb) * 512 + tid]; }
        const float inv = __builtin_amdgcn_rcpf(sum);
        if (p == 0) { GAS u32x2* lp = list + (size_t)row * 128 + hh * 16;
#pragma unroll
            for (int s = 0; s < 16; ++s) lp[s] = (u32x2){pl[s], __builtin_bit_cast(unsigned, ev[s] * inv)}; }
    }
}

template <class PT> __device__ __forceinline__ void load_row16c(PT p, int lane, float (&x)[16]) {
#pragma unroll
    for (int k = 0; k < 4; ++k) { const f32x4 a = *(const GAS f32x4*)(p + 16 * lane + 4 * k);
#pragma unroll
        for (int e = 0; e < 4; ++e) x[4 * k + e] = a[e]; }
}
template <class PT> __device__ __forceinline__ void store_row16c_f32(PT p, int lane, const float (&x)[16]) {
#pragma unroll
    for (int k = 0; k < 4; ++k) *(GAS f32x4*)(p + 16 * lane + 4 * k) = (f32x4){x[4 * k], x[4 * k + 1], x[4 * k + 2], x[4 * k + 3]};
}
template <class PT> __device__ __forceinline__ void store_row16c_bf16(PT p, int lane, const float (&y)[16]) {
    u32x4 a, b; a.x = pk2(y[0], y[1]); a.y = pk2(y[2], y[3]); a.z = pk2(y[4], y[5]); a.w = pk2(y[6], y[7]);
    b.x = pk2(y[8], y[9]); b.y = pk2(y[10], y[11]); b.z = pk2(y[12], y[13]); b.w = pk2(y[14], y[15]);
    *(GAS u32x4*)(p + 16 * lane) = a; *(GAS u32x4*)(p + 16 * lane + 8) = b;
}
template <class G1, class G2> __device__ __forceinline__ void norm_mod16c(const float (&x)[16], G1 g, G2 shift, G2 scale, int lane, float (&y)[16]) {
    float ss = 0.f;
#pragma unroll
    for (int e = 0; e < 16; ++e) ss += x[e] * x[e];
    ss = wave_sum(ss);
    const float r = rsqrtf(ss * (1.0f / 1024.0f) + 1e-6f);
    float gg[16]; load_row16c(g, lane, gg);
    if (shift) { float sh[16], sc[16]; load_row16c(shift, lane, sh); load_row16c(scale, lane, sc);
#pragma unroll
        for (int e = 0; e < 16; ++e) y[e] = x[e] * r * gg[e] * (1.0f + sc[e]) + sh[e];
    } else {
#pragma unroll
        for (int e = 0; e < 16; ++e) y[e] = x[e] * r * gg[e];
    }
}
__device__ __forceinline__ void p8u_dots(const PV& P, int l, int nrows) {
    const int tid = otid(), lane = tid & 63, w = tid >> 6, eg = lane >> 3, cs = lane & 7;
    const bool sliced = (gridDim.x & 7) == 0;
    const int x0 = sliced ? (blockIdx.x & 7) : 0, xstep = sliced ? 8 : 1;
    const int gwx = sliced ? (blockIdx.x >> 3) * 8 + w : blockIdx.x * 8 + w, nW = sliced ? (gridDim.x >> 3) * 8 : gridDim.x * 8;
    const GAS unsigned* listw = (const GAS unsigned*)(P.ws + WS_LIST); const GAS bf16_t* h2 = (const GAS bf16_t*)(P.ws + WS_ACT);
    GAS float* pd = (GAS float*)(P.ws + WS_SC);
    for (int x = x0; x < 8; x += xstep) {
        const GAS unsigned char* U8 = (const GAS unsigned char*)P.ws + WS_U8 + (size_t)l * NEXP * 1024 + 128 * x + 16 * cs;
        unsigned idn[16]; u32x4 uu[16]; u32x4 hc0, hc1, hn0, hn1;
        int row = gwx;
        if (row < nrows) {
#pragma unroll
            for (int g = 0; g < 16; ++g) idn[g] = listw[((size_t)row * 128 + 8 * g + eg) * 2];
            hc0 = *(const GAS u32x4*)(h2 + (size_t)row * 1024 + 128 * x + 16 * cs); hc1 = *(const GAS u32x4*)(h2 + (size_t)row * 1024 + 128 * x + 16 * cs + 8);
#pragma unroll
            for (int g = 0; g < 16; ++g) uu[g] = *(const GAS u32x4*)(U8 + (size_t)idn[g] * 1024);
            const int rn = row + nW < nrows ? row + nW : row;
#pragma unroll
            for (int g = 0; g < 16; ++g) idn[g] = listw[((size_t)rn * 128 + 8 * g + eg) * 2];
            hn0 = *(const GAS u32x4*)(h2 + (size_t)rn * 1024 + 128 * x + 16 * cs); hn1 = *(const GAS u32x4*)(h2 + (size_t)rn * 1024 + 128 * x + 16 * cs + 8);
        }
        for (; row < nrows; row += nW) {
            f32x2 hx[8];
            hx[0] = (f32x2){bflo(hc0.x), bfhi(hc0.x)}; hx[1] = (f32x2){bflo(hc0.y), bfhi(hc0.y)}; hx[2] = (f32x2){bflo(hc0.z), bfhi(hc0.z)}; hx[3] = (f32x2){bflo(hc0.w), bfhi(hc0.w)};
            hx[4] = (f32x2){bflo(hc1.x), bfhi(hc1.x)}; hx[5] = (f32x2){bflo(hc1.y), bfhi(hc1.y)}; hx[6] = (f32x2){bflo(hc1.z), bfhi(hc1.z)}; hx[7] = (f32x2){bflo(hc1.w), bfhi(hc1.w)};
            GAS float* pdr = pd + ((size_t)x * nrows + row) * 128 + eg;
#pragma unroll
            for (int g = 0; g < 16; ++g) { f32x2 a2 = (f32x2){0.f, 0.f};
#pragma unroll
                for (int q = 0; q < 4; ++q) { const f32x2 lo = __builtin_amdgcn_cvt_pk_f32_fp8((int)uu[g][q], false), hi = __builtin_amdgcn_cvt_pk_f32_fp8((int)uu[g][q], true);
                    a2 += lo * hx[2 * q]; a2 += hi * hx[2 * q + 1]; }
                uu[g] = *(const GAS u32x4*)(U8 + (size_t)idn[g] * 1024);
                const float d = sum8(a2[0] + a2[1]);
                if (cs == 0) pdr[8 * g] = d; }
            hc0 = hn0; hc1 = hn1;
            const int r2 = row + 2 * nW < nrows ? row + 2 * nW : row;
#pragma unroll
            for (int g = 0; g < 16; ++g) idn[g] = listw[((size_t)r2 * 128 + 8 * g + eg) * 2];
            hn0 = *(const GAS u32x4*)(h2 + (size_t)r2 * 1024 + 128 * x + 16 * cs); hn1 = *(const GAS u32x4*)(h2 + (size_t)r2 * 1024 + 128 * x + 16 * cs + 8);
        }
    }
}
__device__ __forceinline__ void p8c_coef(const PV& P, int nrows) {
    const int tid = otid();
    GAS unsigned* listw = (GAS unsigned*)(P.ws + WS_LIST); const GAS float* pd = (const GAS float*)(P.ws + WS_SC);
    const int n = nrows * 128, nth = gridDim.x * 512;
    for (int i = blockIdx.x * 512 + tid; i < n; i += nth) { float s = 0.f;
#pragma unroll
        for (int xx = 0; xx < 8; ++xx) s += pd[(size_t)xx * n + i];
        const float g = __builtin_bit_cast(float, listw[(size_t)i * 2 + 1]);
        listw[(size_t)i * 2 + 1] = __builtin_bit_cast(unsigned, g * geluf_(s * (1.0f / 32.0f)) * 0.5f); }
}
__device__ __forceinline__ void p8v_accum(const PV& P, int l, int nrows, LAS unsigned char* lds) {
    const int tid = otid(), lane = tid & 63, w = tid >> 6, eg = lane >> 3, cs = lane & 7;
    const bool sliced = (gridDim.x & 7) == 0;
    const int x0 = sliced ? (blockIdx.x & 7) : 0, xstep = sliced ? 8 : 1;
    const int gwx = sliced ? (blockIdx.x >> 3) * 8 + w : blockIdx.x * 8 + w, nW = sliced ? (gridDim.x >> 3) * 8 : gridDim.x * 8;
    const GAS unsigned* listw = (const GAS unsigned*)(P.ws + WS_LIST);
    const GAS float* modl = (const GAS float*)(P.ws + WS_MOD) + (size_t)l * 9 * 6144; const GAS float* X1 = (const GAS float*)(P.ws + WS_X1);
    LAS float* cl = (LAS float*)(lds + w * 1024);
    LAS unsigned* il = (LAS unsigned*)(cl + 128);
    const bool b5 = (lane & 32) != 0, b4 = (lane & 16) != 0, b3 = (lane & 8) != 0;
    for (int x = x0; x < 8; x += xstep) {
        const GAS unsigned char* V8 = (const GAS unsigned char*)P.ws + WS_V8 + (size_t)l * NEXP * 1024 + 128 * x + 16 * cs;
        unsigned n_i0, n_i1, n_c0, n_c1;
        u32x4 vv[16]; float cfc[16];
#define V_LOAD1(r) do { const GAS unsigned* lw = listw + ((size_t)(r) * 128 + lane) * 2; n_i0 = lw[0]; n_c0 = lw[1]; n_i1 = lw[128]; n_c1 = lw[129]; } while (0)
#define V_TOLDS() do { cl[lane] = __builtin_bit_cast(float, n_c0); cl[64 + lane] = __builtin_bit_cast(float, n_c1); il[lane] = n_i0; il[64 + lane] = n_i1; asm volatile("s_waitcnt lgkmcnt(0)" ::: "memory"); } while (0)
        int row = gwx;
        if (row < nrows) {
            V_LOAD1(row); V_TOLDS();
#pragma unroll
            for (int g = 0; g < 16; ++g) { const unsigned id = il[8 * g + eg]; cfc[g] = cl[8 * g + eg]; vv[g] = *(const GAS u32x4*)(V8 + (size_t)id * 1024); }
            const int rn = row + nW < nrows ? row + nW : row;
            V_LOAD1(rn); asm volatile("s_waitcnt lgkmcnt(0)" ::: "memory"); V_TOLDS();
            const int r2 = row + 2 * nW < nrows ? row + 2 * nW : row;
            V_LOAD1(r2);
        }
        for (; row < nrows; row += nW) { const int mr = row < TL ? (row >> 11) : 8;
            f32x2 acc[8];
#pragma unroll
            for (int j = 0; j < 8; ++j) acc[j] = (f32x2){0.f, 0.f};
#pragma unroll
            for (int g = 0; g < 16; ++g) { const f32x2 c2 = (f32x2){cfc[g], cfc[g]};
#pragma unroll
                for (int q = 0; q < 4; ++q) { const f32x2 lo = __builtin_amdgcn_cvt_pk_f32_fp8((int)vv[g][q], false), hi = __builtin_amdgcn_cvt_pk_f32_fp8((int)vv[g][q], true);
                    acc[2 * q] += c2 * lo; acc[2 * q + 1] += c2 * hi; }
                const unsigned id = il[8 * g + eg]; cfc[g] = cl[8 * g + eg]; vv[g] = *(const GAS u32x4*)(V8 + (size_t)id * 1024); }
            f32x2 a4[4], a2v[2], a1;
#pragma unroll
            for (int j = 0; j < 4; ++j) { const f32x2 snd = b5 ? acc[j] : acc[j + 4], kp = b5 ? acc[j + 4] : acc[j]; a4[j] = kp + (f32x2){__shfl_xor(snd[0], 32), __shfl_xor(snd[1], 32)}; }
#pragma unroll
            for (int j = 0; j < 2; ++j) { const f32x2 snd = b4 ? a4[j] : a4[j + 2], kp = b4 ? a4[j + 2] : a4[j]; a2v[j] = kp + (f32x2){__shfl_xor(snd[0], 16), __shfl_xor(snd[1], 16)}; }
            { const f32x2 snd = b3 ? a2v[0] : a2v[1], kp = b3 ? a2v[1] : a2v[0]; a1 = kp + (f32x2){__shfl_xor(snd[0], 8), __shfl_xor(snd[1], 8)}; }
            const int col = 128 * x + 16 * cs + 2 * eg;
            const f32x2 xm = *(const GAS f32x2*)(X1 + (size_t)row * 1024 + col), g5 = *(const GAS f32x2*)(modl + (size_t)mr * 6144 + 5 * 1024 + col);
            GAS float* xo = row < TL ? (GAS float*)P.out + (size_t)row * 1024 : (GAS float*)(P.ws + WS_X0C) + (size_t)(row - TL) * 1024;
            *(GAS f32x2*)(xo + col) = xm + g5 * a1;
            V_TOLDS();
            const int r3 = row + 3 * nW < nrows ? row + 3 * nW : row;
            V_LOAD1(r3);
        }
#undef V_LOAD1
#undef V_TOLDS
    }
}
__device__ __forceinline__ void p8w_norm(const PV& P, int l, int nrows) {
    const int tid = otid(), lane = tid & 63, gw = blockIdx.x * 8 + (tid >> 6), NGW = gridDim.x * 8;
    for (int row = gw; row < nrows; row += NGW) { const int mr = row < TL ? (row >> 11) : 8;
        float* xo = row < TL ? P.out + (size_t)row * 1024 : (float*)(P.ws + WS_X0C) + (size_t)(row - TL) * 1024;
        float xn[16], y[16]; load_row16c(xo, lane, xn);
        if (l == 0) { const float* mod1 = (const float*)(P.ws + WS_MOD) + (size_t)9 * 6144 + (size_t)mr * 6144;
            norm_mod16c(xn, PIN(I_N1G) + 1024, mod1, mod1 + 1024, lane, y);
            store_row16c_bf16((bf16_t*)(P.ws + WS_ACT) + (size_t)row * 1024, lane, y);
        } else { norm_mod16c(xn, PIN(I_FNG), (const float*)nullptr, (const float*)nullptr, lane, y); store_row16c_f32(xo, lane, y); }
    }
}

typedef __attribute__((address_space(1))) unsigned gu32;
#define XB_TMO      128
#define XB_XCNT(j)  (256  + 64 * (j))
#define XB_XSUB(j)  (1280 + 64 * (j))
#define XB_XGEN(j)  (2304 + 64 * (j))
#define XB_TOP      3328
#define XB_TOPGEN   3392
#define XCD_BAR_WORDS 3456
#define XB_SPIN_CAP (1u << 18)

__device__ __forceinline__ unsigned xb_ld(unsigned* p)              { return __hip_atomic_load(p, __ATOMIC_RELAXED, __HIP_MEMORY_SCOPE_AGENT); }
__device__ __forceinline__ unsigned xb_add(unsigned* p, unsigned v) { return __hip_atomic_fetch_add(p, v, __ATOMIC_RELAXED, __HIP_MEMORY_SCOPE_AGENT); }
__device__ __forceinline__ unsigned xb_xcc_id() { return (unsigned)__builtin_amdgcn_s_getreg((3 << 11) | 20) & 0xFu; }
#define XB_SPIN(cond, bar) do { unsigned _sp = 0; while (cond) { __builtin_amdgcn_s_sleep(1); \
    if ((++_sp & 255u) == 0u) { if (xb_ld(&(bar)[XB_TMO])) break; if (_sp > XB_SPIN_CAP) { atomicAdd(&(bar)[XB_TMO], 1u); break; } } } } while (0)

struct XcdBarrier {
    unsigned* bar; unsigned x;
    volatile LAS unsigned* st;
};

__device__ __forceinline__ XcdBarrier xcd_barrier_post(unsigned* bar, volatile LAS unsigned* st) {
    XcdBarrier b; b.bar = bar; b.x = xb_xcc_id(); b.st = st;
    if (threadIdx.x == 0) (void)xb_add(&bar[XB_XCNT(b.x)], 1u);
    return b;
}
__device__ __forceinline__ void xcd_barrier_complete(unsigned* bar, unsigned x, unsigned& nloc, unsigned& nx) {
    const unsigned G = gridDim.x * gridDim.y * gridDim.z;
    unsigned sum, cnt, mine, sp = 0u;
    for (;;) {
        sum = 0u; cnt = 0u; mine = 0u;
#pragma unroll
        for (unsigned j = 0; j < 16; ++j) { const unsigned c = xb_ld(&bar[XB_XCNT(j)]); sum += c; cnt += (c > 0u) ? 1u : 0u; mine = (j == x) ? c : mine; }
        if (sum == G) break;
        __builtin_amdgcn_s_sleep(1);
        if ((++sp & 255u) == 0u) { if (xb_ld(&bar[XB_TMO])) break; if (sp > XB_SPIN_CAP) { atomicAdd(&bar[XB_TMO], 1u); break; } }
    }
    nloc = mine > 0u ? mine : 1u; nx = cnt > 0u ? cnt : 1u;
}

__device__ __forceinline__ void xcd_barrier(const XcdBarrier& b) {
    asm volatile("s_waitcnt vmcnt(0)" ::: "memory");
    __syncthreads();
    if (threadIdx.x == 0) {
        unsigned* bar = b.bar;
        __builtin_amdgcn_s_waitcnt(0);
        unsigned nloc = b.st[0], nx = b.st[1];
        if (nloc == 0u) { xcd_barrier_complete(bar, b.x, nloc, nx); b.st[0] = nloc; b.st[1] = nx; }
        const unsigned old = xb_add(&bar[XB_XSUB(b.x)], 1u);
        const unsigned gen = old / nloc;
        if (old + 1u == (gen + 1u) * nloc) {
            __builtin_amdgcn_fence(__ATOMIC_RELEASE, "agent");
            asm volatile("s_waitcnt vmcnt(0)" ::: "memory");
            const unsigned og = xb_add(&bar[XB_TOP], 1u);
            const unsigned tg = og / nx;
            if (og + 1u == (tg + 1u) * nx) xb_add(&bar[XB_TOPGEN], 1u);
            else XB_SPIN(xb_ld(&bar[XB_TOPGEN]) == tg, bar);
            __builtin_amdgcn_fence(__ATOMIC_ACQUIRE, "agent");
            xb_add(&bar[XB_XGEN(b.x)], 1u);
            asm volatile("s_waitcnt vmcnt(0)" ::: "memory");
        } else {
            XB_SPIN(xb_ld(&bar[XB_XGEN(b.x)]) == gen, bar);
            __builtin_amdgcn_fence(__ATOMIC_ACQUIRE, "agent");
            asm volatile("s_waitcnt vmcnt(0)" ::: "memory");
        }
    }
    __syncthreads();
}

#define GSYNC() do { xcd_barrier(xbar); if (PROBE_DUP & 32) xcd_barrier(xbar); } while (0)
template <int l>
__device__ __forceinline__ void run_layer(const PV& P, const XcdBarrier& xbar) {
    const int nrows = l == 0 ? TT : TL;
    for (int rep = 0; rep < ((PROBE_DUP & 8) ? 2 : 1); ++rep) { const PV Q = opq(P);
        pg8::Gemm g{(const bf16_t*)(Q.ws + WS_ACT), (const bf16_t*)(Q.ws + WS_WIN) + (size_t)l * ZW * 1024, TT, ZW, 1024};
        pg8::StaticOrder S; S.init(TT, ZW, gridDim.x, blockIdx.x);
        pg8::EpiZ E{(bf16_t*)(Q.ws + WS_Z), ZW};
        pg8::gemm_phase<pg8::EpiZ, pg8::StaticOrder, true, true>(Q.lds, g, S, E);
        if (l == 0 && (int)gridDim.x == 256 && (int)blockIdx.x >= 24) p0_tables(Q, 1, blockIdx.x - 24, 232);
        else if (l == 0 && (int)gridDim.x != 256) p0_tables(Q, 1, blockIdx.x, gridDim.x); }
    GSYNC();
    for (int rep = 0; rep < ((PROBE_DUP & 128) ? 2 : 1); ++rep) { const PV Q = opq(P); rwkv_pre(Q, l, Q.lds); }
    for (int rep = 0; rep < ((PROBE_DUP & 65536) ? 2 : 1); ++rep) { const PV Q = opq(P); lru_items(Q, l, Q.lds); }
    GSYNC();
    for (int rep = 0; rep < ((PROBE_DUP & 2) ? 2 : 1); ++rep) {
        for (;;) {
            const PV Q = opq(P);
            __syncthreads();
            if (otid() == 0) *(LAS int*)(Q.lds + LDS_BYTES - 16) = (int)atomicAdd((unsigned*)(Q.ws + WS_CTL) + 64 * (1 + l + 2 * rep), 1u);
            __syncthreads();
            const int u = *(LAS int*)(Q.lds + LDS_BYTES - 16);
            if (u >= 272) break;
            if (u < 128) { for (int r2 = 0; r2 < ((PROBE_DUP & 16384) ? 2 : 1); ++r2) s5_unit(Q, l, u, Q.lds); }
            else if (u < 192) { for (int r2 = 0; r2 < ((PROBE_DUP & 4096) ? 2 : 1); ++r2) rwkv_seq(Q, l, u - 128, Q.lds); }
            else if (u < 256) { for (int r2 = 0; r2 < ((PROBE_DUP & 8192) ? 2 : 1); ++r2) ret_unit(Q, l, u - 192, Q.lds); }
            else lru_carry_unit(Q, u - 256);
        }
        if (PROBE_DUP & 2) GSYNC();
    }
    if (!(PROBE_DUP & 2)) GSYNC();
    for (int rep = 0; rep < ((PROBE_DUP & 16) ? 2 : 1); ++rep) { const PV Q = opq(P); p3_combine(Q, l, nrows, Q.lds); __syncthreads(); }
    GSYNC();
    for (int rep = 0; rep < ((PROBE_DUP & 8) ? 2 : 1); ++rep) { const PV Q = opq(P);
        pg8::Gemm g{(const bf16_t*)(Q.ws + WS_S5G), (const bf16_t*)(Q.ws + WS_GLU) + (size_t)l * 512 * 256, nrows, 512, 256};
        pg8::StaticOrder S; S.init(nrows, 512, gridDim.x, blockIdx.x);
        pg8::EpiGlu E{(bf16_t*)(Q.ws + WS_ACT), inp_(Q.tab, I_GLUB) + l * 512};
        pg8::gemm_phase<pg8::EpiGlu, pg8::StaticOrder, true, true>(Q.lds, g, S, E); }
    GSYNC();
    for (int rep = 0; rep < ((PROBE_DUP & 8) ? 2 : 1); ++rep) { const PV Q = opq(P);
        pg8::Gemm g{(const bf16_t*)(Q.ws + WS_ACT), (const bf16_t*)(Q.ws + WS_WOUT) + (size_t)l * 1024 * 1024, nrows, 1024, 1024};
        pg8::StaticOrder S; S.init(nrows, 1024, gridDim.x, blockIdx.x);
        pg8::EpiRes E{l == 0 ? inp_(Q.tab, I_X) : (const float*)Q.out, l == 0 ? inp_(Q.tab, I_CTX) : (const float*)(Q.ws + WS_X0C),
                      (const float*)(Q.ws + WS_MOD) + (size_t)l * 9 * 6144 + 2048, (float*)(Q.ws + WS_X1)};
        pg8::gemm_phase<pg8::EpiRes, pg8::StaticOrder, true, true>(Q.lds, g, S, E);
        if (l == 0 && (int)gridDim.x == 256 && (int)blockIdx.x >= 32) p0_transposes(Q, 1, blockIdx.x - 32, 224, Q.lds);
        else if (l == 0 && (int)gridDim.x != 256) p0_transposes(Q, 1, blockIdx.x, gridDim.x, Q.lds); }
    GSYNC();
    for (int rep = 0; rep < ((PROBE_DUP & 16) ? 2 : 1); ++rep) { const PV Q = opq(P); p6_h2(Q, l, nrows); }
    GSYNC();
    for (int rep = 0; rep < ((PROBE_DUP & 8) ? 2 : 1); ++rep) { const PV Q = opq(P);
        pg8::Gemm g{(const bf16_t*)(Q.ws + WS_ACT), (const bf16_t*)(Q.ws + WS_WEFF) + (size_t)l * 2048 * 1024, nrows, 2048, 1024};
        pg8::StaticOrder S; S.init(nrows, 2048, gridDim.x, blockIdx.x);
        pg8::EpiF32 E{(float*)(Q.ws + WS_SC), 2048};
        pg8::gemm_phase<pg8::EpiF32, pg8::StaticOrder, true, true>(Q.lds, g, S, E);
        if (l == 0 && (int)gridDim.x == 256 && (int)blockIdx.x >= 64) p0_weff(Q, 1, blockIdx.x - 64, 192, Q.lds);
        else if (l == 0 && (int)gridDim.x != 256) p0_weff(Q, 1, blockIdx.x, gridDim.x, Q.lds); }
    GSYNC();
    for (int rep = 0; rep < ((PROBE_DUP & 4) ? 2 : 1); ++rep) { const PV Q = opq(P); p8a_topk(Q, nrows, Q.lds); }
    GSYNC();
    for (int rep = 0; rep < ((PROBE_DUP & 1) ? 2 : 1); ++rep) { const PV Q = opq(P); p8u_dots(Q, l, nrows); }
    GSYNC();
    { const PV Q = opq(P); p8c_coef(Q, nrows); }
    GSYNC();
    for (int rep = 0; rep < ((PROBE_DUP & 2048) ? 2 : 1); ++rep) { const PV Q = opq(P); p8v_accum(Q, l, nrows, Q.lds); }
    GSYNC();
    { const PV Q = opq(P); p8w_norm(Q, l, nrows); }
    if (l == 0) GSYNC();
}

__global__ void __launch_bounds__(512, 2) fwd_mega(Params KP) {
    extern __shared__ __attribute__((aligned(16))) unsigned char lds_raw[];
    LAS unsigned char* lds = (LAS unsigned char*)lds_raw;
    cg::grid_group grid = cg::this_grid();
    const int tid = otid();
    PV P; P.tab = (const LAS unsigned*)(lds + LDS_BYTES - 1024); P.ws = KP.ws; P.out = KP.out; P.lds = lds;
    if (tid < 88) { const unsigned* ka = (const unsigned*)__builtin_amdgcn_kernarg_segment_ptr(); ((LAS unsigned*)(lds + LDS_BYTES - 1024))[tid] = ka[tid]; }
    if (tid < 4) ((LAS unsigned*)(lds + LDS_BYTES - 64))[tid] = 0u;
    __syncthreads();
    const XcdBarrier xbar = xcd_barrier_post((unsigned*)(KP.ws + WS_CTL) + 4096, (volatile LAS unsigned*)(lds + LDS_BYTES - 64));

    for (int rep = 0; rep < ((PROBE_DUP & 64) ? 2 : 1); ++rep) { const PV Q = opq(P); p0_prologue(Q, Q.lds); __syncthreads(); }
    if (KP.ws == nullptr) grid.sync();
    GSYNC();
    { const PV Q = opq(P); p0b_ain(Q); }
    GSYNC();

    run_layer<0>(P, xbar);
    run_layer<1>(P, xbar);
}

extern "C" void kernel_launch(void* const* d_in, const int* in_sizes, int n_in, void* d_out, int out_size, void* d_ws, size_t ws_size, hipStream_t stream) {
    static int grid = 0;
    if (grid == 0) {
        if (n_in != 44 || out_size != TL * DM || ws_size < WS_END) { fprintf(stderr, "kernel_launch: unexpected shapes (n_in %d, out %d, ws %zu; need ws >= %zu)\n", n_in, out_size, ws_size, (size_t)WS_END); grid = -1; return; }
        int dev = 0, cus = 0, per_cu = 0;
        hipGetDevice(&dev); hipDeviceGetAttribute(&cus, hipDeviceAttributeMultiprocessorCount, dev);
        hipFuncSetAttribute((const void*)fwd_mega, hipFuncAttributeMaxDynamicSharedMemorySize, LDS_BYTES);
        hipOccupancyMaxActiveBlocksPerMultiprocessor(&per_cu, (const void*)fwd_mega, 512, LDS_BYTES);
        if (per_cu < 1) { fprintf(stderr, "kernel_launch: occupancy query says %d blocks/CU\n", per_cu); per_cu = 1; }
        grid = cus;
        (void)hipGetLastError();
    }
    if (grid < 0) return;
    hipMemsetAsync((char*)d_ws + WS_CTL, 0, 65536, stream);
    Params p{};
    for (int i = 0; i < 44; ++i) p.in[i] = (const float*)d_in[i];
    p.out = (float*)d_out; p.ws = (unsigned char*)d_ws;
    void* args[] = {&p};
    hipError_t e = hipLaunchCooperativeKernel((const void*)fwd_mega, dim3(grid), dim3(512), args, LDS_BYTES, stream);
    if (e != hipSuccess) fprintf(stderr, "cooperative launch failed: %s (grid %d)\n", hipGetErrorString(e), grid);
}
```

```cpp
#include <hip/hip_runtime.h>
#include <hip/hip_cooperative_groups.h>
#include <hip/hip_fp16.h>
#include <cstdio>
#include <cstdint>
namespace cg = cooperative_groups;

#define LAS __attribute__((address_space(3)))
#define GAS __attribute__((address_space(1)))
typedef unsigned short bf16_t;
typedef short bf16x8 __attribute__((ext_vector_type(8)));
typedef float f32x4 __attribute__((ext_vector_type(4)));
typedef float f32x2 __attribute__((ext_vector_type(2)));
typedef unsigned u32x4 __attribute__((ext_vector_type(4)));
typedef unsigned u32x2 __attribute__((ext_vector_type(2)));
typedef _Float16 h16x2 __attribute__((ext_vector_type(2)));

constexpr int DM = 1024, NB = 8, SEQ = 2048, CTX = 256;
constexpr int TL = NB * SEQ;
constexpr int TC = NB * CTX;
constexpr int TT = TL + TC;
constexpr int ZW = 2816;
constexpr int INC = 2752;
constexpr int CB_ = 960, CC_ = 1984, CD_ = 2496;
constexpr int NEXP = 16384;

constexpr size_t MiB = 1u << 20;
constexpr size_t WS_CTL = 0;
constexpr size_t WS_MOD = 1 * MiB;
constexpr size_t WS_WIN = 2 * MiB;
constexpr size_t WS_WOUT = 14 * MiB;
constexpr size_t WS_WEFF = 18 * MiB;
constexpr size_t WS_GLU = 26 * MiB;
constexpr size_t WS_U8 = 28 * MiB;
constexpr size_t WS_V8 = 60 * MiB;
constexpr size_t WS_REC = 156 * MiB;
constexpr size_t WS_ACT = 156 * MiB;
constexpr size_t WS_S5G = 192 * MiB;
constexpr size_t WS_X1 = 202 * MiB;
constexpr size_t WS_X0C = 274 * MiB;
constexpr size_t WS_Z = 316 * MiB;
constexpr size_t WS_Y = 415 * MiB;
constexpr size_t WS_SC = 316 * MiB;
constexpr size_t WS_LIST = 462 * MiB;
constexpr size_t WS_ACU = 487 * MiB;
constexpr size_t WS_AGG = 505 * MiB;
constexpr size_t WS_CIN = 507 * MiB;
constexpr size_t WS_END = 508 * MiB;
constexpr size_t YSZ = (size_t)TT * 256;
static_assert(WS_SC + (size_t)TT * 2048 * 4 <= WS_LIST && WS_LIST + (size_t)TT * 128 * 8 <= WS_END, "ws map");
static_assert(WS_Y + 8 * YSZ * 2 <= WS_END && WS_Z + (size_t)TT * ZW * 2 <= WS_Y, "ws map");
static_assert(WS_REC + (size_t)64 * 72 * 36096 <= WS_Z, "ws map");

constexpr int LDS_BYTES = 147456;

struct Params { const float* in[44]; float* out; unsigned char* ws; };
struct PV { const LAS unsigned* tab; unsigned char* ws; float* out; LAS unsigned char* lds; };
__device__ __forceinline__ const float* inp_(const LAS unsigned* tab, int i) {
    const unsigned lo = (unsigned)__builtin_amdgcn_readfirstlane((int)tab[2 * i]), hi = (unsigned)__builtin_amdgcn_readfirstlane((int)tab[2 * i + 1]);
    return (const float*)(((unsigned long long)hi << 32) | (unsigned long long)lo);
}
#define PIN(i) inp_(P.tab, (i))
__device__ __forceinline__ PV opq(const PV& P) { PV q = P; unsigned o = 0; asm volatile("" : "+s"(q.ws), "+s"(q.out), "+s"(o)); q.lds = P.lds + o; q.tab = (const LAS unsigned*)(q.lds + LDS_BYTES - 1024); return q; }
enum { I_X = 0, I_C, I_CTX, I_CCTX, I_N1G, I_N2G, I_ADAW, I_ADAB, I_WIN, I_WOUT, I_MU, I_W0, I_WUP, I_A0, I_AUP, I_GUP, I_KK, I_KA, I_RK, I_LNG, I_LNB,
       I_GNG, I_CVW, I_CVB, I_WA, I_BA, I_WX, I_BX, I_LAM, I_SARE, I_SAIM, I_SLDT, I_SBRE, I_SBIM, I_SCRE, I_SCIM, I_SD, I_GLUW, I_GLUB, I_WQ, I_KEYS, I_PU, I_PV, I_FNG };

#define LDS_BARRIER() do { asm volatile("s_waitcnt lgkmcnt(0)" ::: "memory"); __builtin_amdgcn_s_barrier(); asm volatile("" ::: "memory"); } while (0)
__device__ __forceinline__ int otid() { int t = threadIdx.x; asm volatile("" : "+v"(t)); return t; }
__device__ __forceinline__ unsigned f2bf(float f) { unsigned u = __builtin_bit_cast(unsigned, f); return (u + 0x7fffu + ((u >> 16) & 1u)) >> 16; }
__device__ __forceinline__ unsigned pk2(float lo, float hi) { return f2bf(lo) | (f2bf(hi) << 16); }
__device__ __forceinline__ unsigned pk2a(float lo, float hi) { unsigned r; asm("v_cvt_pk_bf16_f32 %0, %1, %2" : "=v"(r) : "v"(lo), "v"(hi)); return r; }
__device__ __forceinline__ float bf2f(unsigned b) { return __builtin_bit_cast(float, b << 16); }
__device__ __forceinline__ float bflo(unsigned w) { return __builtin_bit_cast(float, w << 16); }
__device__ __forceinline__ float bfhi(unsigned w) { return __builtin_bit_cast(float, w & 0xffff0000u); }

template <int CTRL> __device__ __forceinline__ float dppf(float v) {
    return __builtin_bit_cast(float, __builtin_amdgcn_update_dpp(0, __builtin_bit_cast(int, v), CTRL, 0xF, 0xF, true));
}
template <int CTRL> __device__ __forceinline__ unsigned dppu(unsigned v) {
    return (unsigned)__builtin_amdgcn_update_dpp(0, (int)v, CTRL, 0xF, 0xF, true);
}
__device__ __forceinline__ float sum8(float v) {
    v += dppf<0xB1>(v);
    v += dppf<0x4E>(v);
    v += dppf<0x141>(v);
    return v;
}
__device__ __forceinline__ float wave_sum(float v) {
    v = sum8(v); v += dppf<0x140>(v);
    const float s0 = __builtin_bit_cast(float, __builtin_amdgcn_readlane(__builtin_bit_cast(int, v), 0)), s1 = __builtin_bit_cast(float, __builtin_amdgcn_readlane(__builtin_bit_cast(int, v), 16));
    const float s2 = __builtin_bit_cast(float, __builtin_amdgcn_readlane(__builtin_bit_cast(int, v), 32)), s3 = __builtin_bit_cast(float, __builtin_amdgcn_readlane(__builtin_bit_cast(int, v), 48));
    return (s0 + s1) + (s2 + s3);
}
__device__ __forceinline__ float sigmoidf_(float x) { return __builtin_amdgcn_rcpf(1.0f + __expf(-x)); }
__device__ __forceinline__ float tanhf_(float x) { return 1.0f - 2.0f * __builtin_amdgcn_rcpf(1.0f + __expf(2.0f * x)); }
__device__ __forceinline__ float softplusf_(float x) { return fmaxf(x, 0.0f) + __logf(1.0f + __expf(-fabsf(x))); }
__device__ __forceinline__ float geluf_(float x) { return 0.5f * x * (1.0f + tanhf_(0.7978845608f * (x + 0.044715f * x * x * x))); }
__device__ __forceinline__ float siluf_(float x) { return x * sigmoidf_(x); }

template <int MT, int NT, int KS>
__device__ __forceinline__ void lds_mma(f32x4 (&acc)[MT][NT], const LAS bf16_t* A, int lda, const LAS bf16_t* Bt, int ldb, int lane) {
    const int r = lane & 15, q = lane >> 4;
#pragma unroll
    for (int ks = 0; ks < KS; ++ks) {
        bf16x8 a[MT], b[NT];
#pragma unroll
        for (int m = 0; m < MT; ++m) a[m] = *(const LAS bf16x8*)(A + (m * 16 + r) * lda + ks * 32 + q * 8);
#pragma unroll
        for (int n = 0; n < NT; ++n) b[n] = *(const LAS bf16x8*)(Bt + (n * 16 + r) * ldb + ks * 32 + q * 8);
#pragma unroll
        for (int m = 0; m < MT; ++m)
#pragma unroll
            for (int n = 0; n < NT; ++n) acc[m][n] = __builtin_amdgcn_mfma_f32_16x16x32_bf16(b[n], a[m], acc[m][n], 0, 0, 0);
    }
}
template <int MT, int NT> __device__ __forceinline__ void zero_acc(f32x4 (&acc)[MT][NT]) {
#pragma unroll
    for (int m = 0; m < MT; ++m)
#pragma unroll
        for (int n = 0; n < NT; ++n) acc[m][n] = (f32x4){0.f, 0.f, 0.f, 0.f};
}

namespace pg8 {
#define PG8_LAS __attribute__((address_space(3)))
typedef unsigned short bf16_t;
typedef short bf16x8 __attribute__((ext_vector_type(8)));
typedef float f32x4 __attribute__((ext_vector_type(4)));
typedef unsigned u32x4 __attribute__((ext_vector_type(4)));
constexpr int BM = 256, BK = 64, HALF = 128, HTB = HALF * BK * 2  , STAGE_BYTES = 8 * HTB, NXCD = 8, WGM = 8;

__host__ __device__ __forceinline__ int lds_byte(int r, int c) { const int st = (r >> 4) * 2 + (c >> 5), rr = r & 15, cc = c & 31, ob = rr * 64 + cc * 2; return st * 1024 + (ob ^ (((ob >> 9) & 1) << 5)); }
__host__ __device__ __forceinline__ void stage_rc(int b, int& R, int& C) { const int st = b / 1024, sb = b % 1024, swz = sb ^ (((sb >> 9) & 1) << 5); R = (st >> 1) * 16 + swz / 64; C = (st & 1) * 32 + (swz % 64) / 2; }
__host__ __device__ __forceinline__ int perm32(int rho) { const int n = rho >> 4, i = rho & 15; return 8 * (i >> 2) + 4 * n + (i & 3); }

struct Unit { int pm, pn; };
struct Gemm { const bf16_t* A; const bf16_t* Bt; int M, N, K; };

struct StaticOrder {
    int nM, nN, nwg, G, c;
    __host__ __device__ void init(int M, int N, int G_, int c_) { nM = M / BM; nN = N / BM; nwg = nM * nN; G = G_; c = c_; }
    __host__ __device__ bool next(int i, Unit& u) const {
        const long L = (long)i * G + c; if (L >= nwg) return false;
        int wgid = (int)L; { const int q = nwg / NXCD, r = nwg % NXCD, xcd = wgid % NXCD, off = wgid / NXCD; wgid = (xcd < r ? xcd * (q + 1) : r * (q + 1) + (xcd - r) * q) + off; }
        const int nig = WGM * nN, gid = wgid / nig, fm = gid * WGM, gsz = (nM - fm) < WGM ? (nM - fm) : WGM;
        u.pm = fm + ((wgid % nig) % gsz); u.pn = (wgid % nig) / gsz; return true;
    }
    __device__ __forceinline__ void a_ready(const Unit&) const {}
    __device__ __forceinline__ void done(const Unit&) const {}
};


__device__ __forceinline__ unsigned cvt_pk_bf16(float lo, float hi) { unsigned r; asm volatile("v_cvt_pk_bf16_f32 %0, %1, %2" : "=v"(r) : "v"(lo), "v"(hi)); return r; }

struct EpiZ {
    static constexpr bool PERM = true, AFTER_DRAIN = false;
    bf16_t* O; int ldc;
    __device__ __forceinline__ void operator()(const f32x4 (&acc)[2][2][4][2], const Unit& u, int wr, int wc, int fr, int fq) const {
        const int row0 = u.pm * BM + wr * 64 + fr, col0 = u.pn * BM + wc * 32 + 8 * fq;
#pragma unroll
        for (int ai = 0; ai < 2; ++ai)
#pragma unroll
            for (int m = 0; m < 4; ++m) { bf16_t* rowp = O + (size_t)(row0 + ai * HALF + m * 16) * ldc + col0;
#pragma unroll
                for (int bj = 0; bj < 2; ++bj) { const f32x4 v0 = acc[ai][bj][m][0], v1 = acc[ai][bj][m][1];
                    u32x4 w; w.x = cvt_pk_bf16(v0[0], v0[1]); w.y = cvt_pk_bf16(v0[2], v0[3]); w.z = cvt_pk_bf16(v1[0], v1[1]); w.w = cvt_pk_bf16(v1[2], v1[3]);
                    *(u32x4*)(rowp + bj * HALF) = w; } }
    }
};
struct EpiGlu {
    static constexpr bool PERM = false, AFTER_DRAIN = false;
    bf16_t* O; const float* gb;
    __device__ __forceinline__ void operator()(const f32x4 (&acc)[2][2][4][2], const Unit& u, int wr, int wc, int fr, int fq) const {
#pragma unroll
        for (int ai = 0; ai < 2; ++ai)
#pragma unroll
            for (int m = 0; m < 4; ++m) { const int row = u.pm * BM + ai * HALF + wr * 64 + m * 16 + fr;
#pragma unroll
                for (int n = 0; n < 2; ++n) { const int ch = u.pn * 128 + wc * 32 + n * 16 + 4 * fq;
                    const float* gp = gb; asm volatile("" : "+s"(gp));
                    const f32x4 bv = *(const f32x4*)(gp + ch), bg = *(const f32x4*)(gp + 256 + ch);
                    const f32x4 v = acc[ai][0][m][n] + bv, g = acc[ai][1][m][n] + bg; float o[4];
#pragma unroll
                    for (int e = 0; e < 4; ++e) o[e] = v[e] * __builtin_amdgcn_rcpf(1.0f + __expf(-g[e]));
                    unsigned lo = cvt_pk_bf16(o[0], o[1]), hi = cvt_pk_bf16(o[2], o[3]);
                    *(unsigned long long*)(O + (size_t)row * 1024 + 768 + ch) = (unsigned long long)lo | ((unsigned long long)hi << 32); } }
    }
};
struct EpiRes {
    static constexpr bool PERM = false, AFTER_DRAIN = false;
    const float* baseL; const float* baseC; const float* gate; float* out;
    __device__ __forceinline__ void operator()(const f32x4 (&acc)[2][2][4][2], const Unit& u, int wr, int wc, int fr, int fq) const {
        const int rowt = u.pm * BM; const int mr = rowt < 16384 ? (rowt >> 11) : 8;
        const float* grow = gate + (size_t)mr * 6144;
#pragma unroll
        for (int bj = 0; bj < 2; ++bj)
#pragma unroll
            for (int n = 0; n < 2; ++n) { const int col = u.pn * BM + bj * HALF + wc * 32 + n * 16 + 4 * fq; const f32x4 gv = *(const f32x4*)(grow + col);
#pragma unroll
                for (int ai = 0; ai < 2; ++ai)
#pragma unroll
                    for (int m = 0; m < 4; ++m) { const int row = rowt + ai * HALF + wr * 64 + m * 16 + fr;
                        const float* bp = row < 16384 ? baseL + (size_t)row * 1024 + col : baseC + (size_t)(row - 16384) * 1024 + col;
                        const f32x4 bs = *(const f32x4*)bp; *(f32x4*)(out + (size_t)row * 1024 + col) = bs + gv * acc[ai][bj][m][n]; } }
    }
};
struct EpiF32 {
    static constexpr bool PERM = false, AFTER_DRAIN = false;
    float* O; int ldc;
    __device__ __forceinline__ void operator()(const f32x4 (&acc)[2][2][4][2], const Unit& u, int wr, int wc, int fr, int fq) const {
#pragma unroll
        for (int ai = 0; ai < 2; ++ai)
#pragma unroll
            for (int m = 0; m < 4; ++m) { const int row = u.pm * BM + ai * HALF + wr * 64 + m * 16 + fr;
#pragma unroll
                for (int bj = 0; bj < 2; ++bj)
#pragma unroll
                    for (int n = 0; n < 2; ++n) { const int col = u.pn * BM + bj * HALF + wc * 32 + n * 16 + 4 * fq;
                        *(f32x4*)(O + (size_t)row * ldc + col) = acc[ai][bj][m][n]; } }
    }
};

template <class Epi, class Sched, bool ALIGN_EPI = false, bool SP2 = false>
__device__ __forceinline__ void gemm_phase(PG8_LAS unsigned char* lds, const Gemm g, const Sched& S, const Epi& E) {
    int tid_ = threadIdx.x; asm volatile("" : "+v"(tid_));
    const int tid = tid_, wid = __builtin_amdgcn_readfirstlane(tid >> 6), lane = tid & 63, wr = wid >> 2, wc = wid & 3, fr = lane & 15, fq = lane >> 4;
    const int K = g.K, nt = K / BK;
    unsigned voffA[2], voffB[2];
#pragma unroll
    for (int i = 0; i < 2; ++i) { int R, C; stage_rc(tid * 16 + i * 8192, R, C); const int Rb = Epi::PERM ? ((R & ~31) + perm32(R & 31)) : R;
        voffA[i] = (unsigned)(R * K + C) * 2u; voffB[i] = (unsigned)(Rb * K + C) * 2u; }
    const size_t kstep = (size_t)(BK * 2);
    const size_t hstep = (size_t)HALF * K * 2;
    const size_t tstep = 2 * hstep;
    const unsigned ldsw = (unsigned)wid * 1024u;
    const int aoff = lds_byte(wr * 64 + fr, fq * 8), boff = lds_byte(wc * 32 + fr, fq * 8);
#define PG8_SA(b, h) (((b) * 2 + (h)) * HTB)
#define PG8_SB(b, h) ((4 + (b) * 2 + (h)) * HTB)
#define PG8_STAGE(bufoff, gbase, voff) do { _Pragma("unroll") for (int _i = 0; _i < 2; ++_i) \
        __builtin_amdgcn_global_load_lds((const unsigned*)((const char*)(gbase) + (voff)[_i]), (PG8_LAS unsigned*)(lds + (bufoff) + ldsw + _i * 8192), 16, 0, 0); } while (0)
#define PG8_LDA(dst, b, h) do { _Pragma("unroll") for (int m = 0; m < 4; ++m) _Pragma("unroll") for (int k = 0; k < 2; ++k) dst[m][k] = *(const PG8_LAS bf16x8*)(lds + PG8_SA(b, h) + aoff + m * 2048 + k * 1024); } while (0)
#define PG8_LDB(dst, b, h) do { _Pragma("unroll") for (int n = 0; n < 2; ++n) _Pragma("unroll") for (int k = 0; k < 2; ++k) dst[n][k] = *(const PG8_LAS bf16x8*)(lds + PG8_SB(b, h) + boff + n * 2048 + k * 1024); } while (0)
#define PG8_MMA(ai, bj, At, Bt) do { __builtin_amdgcn_s_setprio(1); _Pragma("unroll") for (int m = 0; m < 4; ++m) _Pragma("unroll") for (int n = 0; n < 2; ++n) _Pragma("unroll") for (int k = 0; k < 2; ++k) \
        acc[ai][bj][m][n] = __builtin_amdgcn_mfma_f32_16x16x32_bf16(Bt[n][k], At[m][k], acc[ai][bj][m][n], 0, 0, 0); __builtin_amdgcn_s_setprio(0); } while (0)
#define PG8_WAIT_V(n) asm volatile("s_waitcnt vmcnt(" #n ")" ::: "memory")
#define PG8_WAIT_L(n) asm volatile("s_waitcnt lgkmcnt(" #n ")" ::: "memory")
#define PG8_BAR __builtin_amdgcn_s_barrier()
#define PG8_SCHED __builtin_amdgcn_sched_barrier(0)
    Unit cur, nxt; int ui = 0;
    if (!S.next(0, cur)) return;
    f32x4 acc[2][2][4][2];
#pragma unroll
    for (int a = 0; a < 2; ++a)
#pragma unroll
        for (int b = 0; b < 2; ++b)
#pragma unroll
            for (int m = 0; m < 4; ++m)
#pragma unroll
                for (int n = 0; n < 2; ++n) acc[a][b][m][n] = (f32x4){0.f, 0.f, 0.f, 0.f};
    bf16x8 At[4][2], B0[2][2], B1[2][2];
    const char* cA = (const char*)g.A + (size_t)cur.pm * tstep; const char* cB = (const char*)g.Bt + (size_t)cur.pn * tstep;
    S.a_ready(cur);
    if constexpr (SP2) {
        PG8_STAGE(PG8_SB(0, 0), cB, voffB); PG8_STAGE(PG8_SB(0, 1), cB + hstep, voffB); PG8_STAGE(PG8_SA(0, 0), cA, voffA); PG8_STAGE(PG8_SA(0, 1), cA + hstep, voffA);
        if (wr == 1) PG8_BAR;
        PG8_WAIT_V(2); PG8_BAR;
        PG8_STAGE(PG8_SB(1, 0), cB + kstep, voffB); PG8_STAGE(PG8_SA(1, 0), cA + kstep, voffA); PG8_STAGE(PG8_SB(1, 1), cB + hstep + kstep, voffB);
        PG8_WAIT_V(6); PG8_BAR;
    } else {
        PG8_STAGE(PG8_SB(0, 0), cB, voffB); PG8_STAGE(PG8_SA(0, 0), cA, voffA); PG8_STAGE(PG8_SB(0, 1), cB + hstep, voffB); PG8_STAGE(PG8_SA(0, 1), cA + hstep, voffA);
        if (wr == 1) PG8_BAR;
        PG8_WAIT_V(4); PG8_BAR;
        PG8_STAGE(PG8_SB(1, 0), cB + kstep, voffB); PG8_STAGE(PG8_SA(1, 0), cA + kstep, voffA); PG8_STAGE(PG8_SB(1, 1), cB + hstep + kstep, voffB);
        PG8_WAIT_V(6); PG8_BAR;
    }
    for (;;) {
        const bool has_next = S.next(ui + 1, nxt);
        const char* nA = has_next ? (const char*)g.A + (size_t)nxt.pm * tstep : cA; const char* nB = has_next ? (const char*)g.Bt + (size_t)nxt.pn * tstep : cB;
        for (int t = 0; t < nt; t += 2) {
            const bool last = (t == nt - 2);
            const char* a1 = cA + (size_t)(t + 1) * kstep;
            const char* a2 = last ? nA : cA + (size_t)(t + 2) * kstep; const char* b2 = last ? nB : cB + (size_t)(t + 2) * kstep;
            const char* a3 = a2 + kstep; const char* b3 = b2 + kstep;
            if (last && has_next) S.a_ready(nxt);
            if constexpr (SP2) {
            PG8_LDB(B0, 0, 0); PG8_LDB(B1, 0, 1); PG8_SCHED; PG8_LDA(At, 0, 0); PG8_STAGE(PG8_SA(1, 1), a1 + hstep, voffA);
            PG8_WAIT_V(8); PG8_WAIT_L(0); PG8_BAR; PG8_MMA(0, 0, At, B0); PG8_MMA(0, 1, At, B1); PG8_BAR; PG8_SCHED;
            PG8_LDA(At, 0, 1); PG8_STAGE(PG8_SB(0, 0), b2, voffB); PG8_STAGE(PG8_SB(0, 1), b2 + hstep, voffB); PG8_STAGE(PG8_SA(0, 0), a2, voffA);
            PG8_WAIT_V(8); PG8_WAIT_L(0); PG8_BAR; PG8_MMA(1, 0, At, B0); PG8_MMA(1, 1, At, B1); PG8_BAR; PG8_SCHED;
            PG8_LDB(B0, 1, 0); PG8_LDB(B1, 1, 1); PG8_SCHED; PG8_LDA(At, 1, 0); PG8_STAGE(PG8_SA(0, 1), a2 + hstep, voffA);
            PG8_WAIT_V(8); PG8_WAIT_L(0); PG8_BAR; PG8_MMA(0, 0, At, B0); PG8_MMA(0, 1, At, B1); PG8_BAR; PG8_SCHED;
            PG8_LDA(At, 1, 1); PG8_STAGE(PG8_SB(1, 0), b3, voffB); PG8_STAGE(PG8_SB(1, 1), b3 + hstep, voffB); PG8_STAGE(PG8_SA(1, 0), a3, voffA);
            PG8_WAIT_V(8); PG8_WAIT_L(0); PG8_BAR; PG8_MMA(1, 0, At, B0); PG8_MMA(1, 1, At, B1); PG8_BAR; PG8_SCHED;
            } else {
            PG8_LDB(B0, 0, 0); PG8_SCHED; PG8_LDA(At, 0, 0); PG8_STAGE(PG8_SA(1, 1), a1 + hstep, voffA);
            PG8_WAIT_L(8); PG8_BAR; PG8_WAIT_L(0); PG8_MMA(0, 0, At, B0); PG8_BAR; PG8_SCHED;
            PG8_LDB(B1, 0, 1); PG8_STAGE(PG8_SB(0, 0), b2, voffB);
            PG8_BAR; PG8_WAIT_L(0); PG8_MMA(0, 1, At, B1); PG8_BAR;
            PG8_LDA(At, 0, 1); PG8_STAGE(PG8_SA(0, 0), a2, voffA);
            PG8_BAR; PG8_WAIT_L(0); PG8_MMA(1, 0, At, B0); PG8_BAR; PG8_SCHED;
            PG8_STAGE(PG8_SB(0, 1), b2 + hstep, voffB);
            PG8_WAIT_V(6); PG8_BAR; PG8_MMA(1, 1, At, B1); PG8_BAR;
            PG8_LDB(B0, 1, 0); PG8_SCHED; PG8_LDA(At, 1, 0); PG8_STAGE(PG8_SA(0, 1), a2 + hstep, voffA);
            PG8_WAIT_L(8); PG8_BAR; PG8_WAIT_L(0); PG8_MMA(0, 0, At, B0); PG8_BAR; PG8_SCHED;
            PG8_LDB(B1, 1, 1); PG8_STAGE(PG8_SB(1, 0), b3, voffB);
            PG8_BAR; PG8_WAIT_L(0); PG8_MMA(0, 1, At, B1); PG8_BAR;
            PG8_LDA(At, 1, 1); PG8_STAGE(PG8_SA(1, 0), a3, voffA);
            PG8_BAR; PG8_WAIT_L(0); PG8_MMA(1, 0, At, B0); PG8_BAR; PG8_SCHED;
            PG8_STAGE(PG8_SB(1, 1), b3 + hstep, voffB);
            PG8_WAIT_V(6); PG8_BAR; PG8_MMA(1, 1, At, B1); PG8_BAR;
            }
        }
        if constexpr (ALIGN_EPI) { if (wr == 0) PG8_BAR; }
        if constexpr (!Epi::AFTER_DRAIN) { E(acc, cur, wr, wc, fr, fq); S.done(cur); }
        if (!has_next) break;
#pragma unroll
        for (int a = 0; a < 2; ++a)
#pragma unroll
            for (int b = 0; b < 2; ++b)
#pragma unroll
                for (int m = 0; m < 4; ++m)
#pragma unroll
                    for (int n = 0; n < 2; ++n) acc[a][b][m][n] = (f32x4){0.f, 0.f, 0.f, 0.f};
        cur = nxt; cA = nA; cB = nB; ++ui;
        if constexpr (ALIGN_EPI) { if (wr == 1) PG8_BAR; }
    }
    PG8_WAIT_V(0);
    if constexpr (!ALIGN_EPI) { if (wr == 0) PG8_BAR; }
    PG8_BAR;
    if constexpr (Epi::AFTER_DRAIN) { E.fused(acc, cur, wr, wc, fr, fq, lds, wid, lane); S.done(cur); }
#undef PG8_SA
#undef PG8_SB
#undef PG8_STAGE
#undef PG8_LDA
#undef PG8_LDB
#undef PG8_MMA
#undef PG8_WAIT_V
#undef PG8_WAIT_L
#undef PG8_BAR
#undef PG8_SCHED
}
}
#ifndef PROBE_DUP
#define PROBE_DUP 0
#endif

template <class PT> __device__ __forceinline__ void load_row16(PT p, int lane, float (&x)[16]) {
    const f32x4 a = *(const GAS f32x4*)(p + 8 * lane), b = *(const GAS f32x4*)(p + 8 * lane + 4), c = *(const GAS f32x4*)(p + 512 + 8 * lane), d = *(const GAS f32x4*)(p + 512 + 8 * lane + 4);
#pragma unroll
    for (int e = 0; e < 4; ++e) { x[e] = a[e]; x[4 + e] = b[e]; x[8 + e] = c[e]; x[12 + e] = d[e]; }
}
__device__ __forceinline__ void store_row16_f32(float* p, int lane, const float (&x)[16]) {
    *(f32x4*)(p + 8 * lane) = (f32x4){x[0], x[1], x[2], x[3]}; *(f32x4*)(p + 8 * lane + 4) = (f32x4){x[4], x[5], x[6], x[7]};
    *(f32x4*)(p + 512 + 8 * lane) = (f32x4){x[8], x[9], x[10], x[11]}; *(f32x4*)(p + 512 + 8 * lane + 4) = (f32x4){x[12], x[13], x[14], x[15]};
}
template <class PT> __device__ __forceinline__ void store_row16_bf16(PT p, int lane, const float (&y)[16]) {
    u32x4 a, b; a.x = pk2(y[0], y[1]); a.y = pk2(y[2], y[3]); a.z = pk2(y[4], y[5]); a.w = pk2(y[6], y[7]);
    b.x = pk2(y[8], y[9]); b.y = pk2(y[10], y[11]); b.z = pk2(y[12], y[13]); b.w = pk2(y[14], y[15]);
    *(GAS u32x4*)(p + 8 * lane) = a; *(GAS u32x4*)(p + 512 + 8 * lane) = b;
}
template <class G1, class G2> __device__ __forceinline__ void norm_mod16(const float (&x)[16], G1 g, G2 shift, G2 scale, int lane, float (&y)[16]) {
    float ss = 0.f;
#pragma unroll
    for (int e = 0; e < 16; ++e) ss += x[e] * x[e];
    ss = wave_sum(ss);
    const float r = rsqrtf(ss * (1.0f / 1024.0f) + 1e-6f);
    float gg[16]; load_row16(g, lane, gg);
    if (shift) { float sh[16], sc[16]; load_row16(shift, lane, sh); load_row16(scale, lane, sc);
#pragma unroll
        for (int e = 0; e < 16; ++e) y[e] = x[e] * r * gg[e] * (1.0f + sc[e]) + sh[e];
    } else {
#pragma unroll
        for (int e = 0; e < 16; ++e) y[e] = x[e] * r * gg[e];
    }
}

template <int MODE>
__device__ __forceinline__ void transpose_item(const float* W, int K, int N, bf16_t* WT, LAS float* scr, int item, int lane) {
    const int nblk = N / 32, kb = item / nblk, nb = item % nblk, k0 = 64 * kb, n0 = 32 * nb;
#pragma unroll 8
    for (int i = 0; i < 32; ++i) { const int kk = 2 * i + (lane >> 5); scr[kk * 33 + (lane & 31)] = W[(size_t)(k0 + kk) * N + n0 + (lane & 31)]; }
    asm volatile("s_waitcnt lgkmcnt(0)" ::: "memory");
    const int c = lane & 7;
#pragma unroll
    for (int j = 0; j < 4; ++j) { const int n = (lane >> 3) + 8 * j; const LAS float* s = scr + (8 * c) * 33 + n;
        u32x4 o; o.x = pk2(s[0 * 33], s[1 * 33]); o.y = pk2(s[2 * 33], s[3 * 33]); o.z = pk2(s[4 * 33], s[5 * 33]); o.w = pk2(s[6 * 33], s[7 * 33]);
        int row = n0 + n;
        if (MODE == 1) { const int ch = row & 255, gatepart = row >> 8; row = (ch >> 7) * 256 + gatepart * 128 + (ch & 127); }
        *(u32x4*)(WT + (size_t)row * K + k0 + 8 * c) = o; }
    asm volatile("s_waitcnt lgkmcnt(0)" ::: "memory");
}

__device__ __forceinline__ void p0_transposes(const PV& P, int l, int part, int nparts, LAS unsigned char* lds) {
    const int tid = otid(), lane = tid & 63, w = tid >> 6;
    unsigned char* ws = P.ws;
    LAS float* scr = (LAS float*)(lds + w * 8448);
    const int gw = part * 8 + w, NGW = nparts * 8;
    constexpr int I_IN = 16 * (INC / 32), I_OUT = 16 * 32, I_GL = 4 * 16, PER_L = I_IN + I_OUT + I_GL;
    for (int it = gw; it < PER_L; it += NGW) { int r = it;
        if (r < I_IN) { transpose_item<0>(PIN(I_WIN) + (size_t)l * 1024 * INC, 1024, INC, (bf16_t*)(ws + WS_WIN) + (size_t)l * ZW * 1024, scr, r, lane); continue; } r -= I_IN;
        if (r < I_OUT) { transpose_item<0>(PIN(I_WOUT) + (size_t)l * 1024 * 1024, 1024, 1024, (bf16_t*)(ws + WS_WOUT) + (size_t)l * 1024 * 1024, scr, r, lane); continue; } r -= I_OUT;
        transpose_item<1>(PIN(I_GLUW) + (size_t)l * 256 * 512, 256, 512, (bf16_t*)(ws + WS_GLU) + (size_t)l * 512 * 256, scr, r, lane); }
    for (int i = part * 512 + tid; i < 8192; i += nparts * 512) *(GAS u32x4*)((bf16_t*)(ws + WS_WIN) + ((size_t)l * ZW + INC) * 1024 + (size_t)i * 8) = (u32x4){0u, 0u, 0u, 0u};
}
__device__ __forceinline__ void p0_tables(const PV& P, int l, int part, int nparts) {
    const int tid = otid();
    const size_t n16 = (size_t)NEXP * 1024 / 16, stride = (size_t)nparts * 512;
    const GAS f32x4* su = (const GAS f32x4*)(PIN(I_PU) + (size_t)l * NEXP * 1024); const GAS f32x4* sv = (const GAS f32x4*)(PIN(I_PV) + (size_t)l * NEXP * 1024);
    GAS u32x4* du = (GAS u32x4*)(P.ws + WS_U8 + (size_t)l * NEXP * 1024); GAS u32x4* dv = (GAS u32x4*)(P.ws + WS_V8 + (size_t)l * NEXP * 1024);
#pragma unroll 2
    for (size_t i = (size_t)part * 512 + tid; i < n16; i += stride) {
        u32x4 o, q;
#pragma unroll
        for (int k = 0; k < 4; ++k) { const f32x4 a = su[4 * i + k] * 32.0f, c = sv[4 * i + k] * 2.0f;
            int wa = __builtin_amdgcn_cvt_pk_fp8_f32(a[0], a[1], 0, false); wa = __builtin_amdgcn_cvt_pk_fp8_f32(a[2], a[3], wa, true);
            int wc = __builtin_amdgcn_cvt_pk_fp8_f32(c[0], c[1], 0, false); wc = __builtin_amdgcn_cvt_pk_fp8_f32(c[2], c[3], wc, true);
            o[k] = (unsigned)wa; q[k] = (unsigned)wc; }
        const size_t e = i >> 6, j16 = i & 63, di = (((j16 >> 3) * NEXP + e) << 3) + (j16 & 7);
        du[di] = o; dv[di] = q;
    }
}
__device__ __forceinline__ void p0_weff(const PV& P, int l, int part, int nparts, LAS unsigned char* lds) {
    const int tid = otid(), lane = tid & 63, w = tid >> 6;
    for (int u = part; u < 128; u += nparts) {
        const int hp = (u >> 3) & 15, dmb = u & 7;
        LAS bf16_t* As = (LAS bf16_t*)lds; LAS bf16_t* Bs = As + 128 * 136;
        const float* kp = PIN(I_KEYS) + (size_t)(l * 16 + hp) * 128 * 128;
        const float* qp = PIN(I_WQ) + ((size_t)l * 1024 + dmb * 128) * 2048 + hp * 128;
        __syncthreads();
        for (int idx = tid; idx < 16384; idx += 512) { const int n = idx >> 7, d = idx & 127;
            As[n * 136 + d] = (bf16_t)f2bf(kp[idx]); Bs[n * 136 + d] = (bf16_t)f2bf(qp[(size_t)n * 2048 + d]); }
        __syncthreads();
        f32x4 acc[1][8]; zero_acc<1, 8>(acc);
        lds_mma<1, 8, 4>(acc, As + 16 * w * 136, 136, Bs, 136, lane);
        bf16_t* op = (bf16_t*)(P.ws + WS_WEFF) + ((size_t)l * 2048 + hp * 128 + 16 * w + (lane & 15)) * 1024 + dmb * 128 + 4 * (lane >> 4);
#pragma unroll
        for (int n = 0; n < 8; ++n) { const f32x4 v = acc[0][n]; *(unsigned long long*)(op + 16 * n) = (unsigned long long)pk2(v[0], v[1]) | ((unsigned long long)pk2(v[2], v[3]) << 32); }
    }
    __syncthreads();
}
__device__ __forceinline__ void p0_prologue(const PV& P, LAS unsigned char* lds) {
    const int tid = otid(), lane = tid & 63, w = tid >> 6;
    const int G = gridDim.x, bx = blockIdx.x;
    unsigned char* ws = P.ws;
    p0_transposes(P, 0, bx, G, lds);
    p0_tables(P, 0, bx, G);
    __syncthreads();
    for (int u = bx; u < 48; u += G) {
        const int l = u / 24, cb = u % 24;
        LAS float* sc = (LAS float*)lds;
        LAS float* red = sc + 9216;
        __syncthreads();
        for (int idx = tid; idx < 9216; idx += 512) { const int r = idx >> 10, k = idx & 1023; const float v = r < 8 ? PIN(I_C)[r * 1024 + k] : PIN(I_CCTX)[k]; sc[idx] = siluf_(v); }
        __syncthreads();
        f32x4 acc[9];
#pragma unroll
        for (int r = 0; r < 9; ++r) acc[r] = (f32x4){0.f, 0.f, 0.f, 0.f};
        const float* wp = PIN(I_ADAW) + ((size_t)l * 1024 + 128 * w) * 6144 + cb * 256 + 4 * lane;
#pragma unroll 16
        for (int k = 0; k < 128; ++k) { const f32x4 wv = *(const GAS f32x4*)(wp + (size_t)k * 6144);
#pragma unroll
            for (int r = 0; r < 9; ++r) acc[r] += sc[r * 1024 + 128 * w + k] * wv; }
#pragma unroll
        for (int r = 0; r < 9; ++r) *(LAS f32x4*)(red + (w * 9 + r) * 256 + 4 * lane) = acc[r];
        __syncthreads();
        for (int idx = tid; idx < 9 * 256; idx += 512) { const int r = idx >> 8, cc = idx & 255; float sacc = 0.f;
#pragma unroll
            for (int ww = 0; ww < 8; ++ww) sacc += red[(ww * 9 + r) * 256 + cc];
            ((float*)(ws + WS_MOD))[(size_t)(l * 9 + r) * 6144 + cb * 256 + cc] = sacc + PIN(I_ADAB)[l * 6144 + cb * 256 + cc]; }
    }
    __syncthreads();
    p0_weff(P, 0, bx, G, lds);
    (void)lane; (void)w; (void)ws;
}

__device__ __forceinline__ void p0b_ain(const PV& P) {
    const int tid = otid(), lane = tid & 63, gw = blockIdx.x * 8 + (tid >> 6), NGW = gridDim.x * 8;
    const float* mod = (const float*)(P.ws + WS_MOD);
    bf16_t* act = (bf16_t*)(P.ws + WS_ACT);
    for (int row = gw; row < TT; row += NGW) {
        const float* xp = row < TL ? PIN(I_X) + (size_t)row * 1024 : PIN(I_CTX) + (size_t)(row - TL) * 1024;
        const int mr = row < TL ? (row >> 11) : 8;
        float x[16], y[16]; load_row16(xp, lane, x);
        norm_mod16(x, PIN(I_N1G), mod + (size_t)mr * 6144, mod + (size_t)mr * 6144 + 1024, lane, y);
        store_row16_bf16(act + (size_t)row * 1024, lane, y);
    }
}

__device__ __forceinline__ int rwkv_col(int gc, int h, int dir) {
    const int seg = gc >> 6;
    if (seg == 0) return h * 64 + gc;
    if (seg == 1) return 256 + h * 64 + (gc - 64);
    if (seg == 2) return 512 + h * 64 + (gc - 128);
    const int o = gc - 192; return o < 32 ? 832 + dir * 32 + o : 896 + dir * 32 + (o - 32);
}

constexpr int R_AT = 0, R_RT = 4608, R_BT = 9216, R_TL = 14336, R_MRB = 16896, R_G = 19456, R_YV = 23552, R_HV = 27648, R_GAM = 35840, REC_BYTES = 36096;

__device__ __forceinline__ void rwkv_pre(const PV& P, int l, LAS unsigned char* lds) {
    const int tid = otid(), lane = tid & 63, w = tid >> 6;
    LAS bf16_t* WUt = (LAS bf16_t*)lds;
    LAS bf16_t* AUt = WUt + 2560;
    LAS float* s_mu = (LAS float*)(AUt + 2560);
    LAS float* s_par = s_mu + 512;
    LAS bf16_t* raw = (LAS bf16_t*)(s_par + 256);
    LAS float* f_r = (LAS float*)(raw + 34 * 256);
    LAS float* f_k = f_r + 2048;
    LAS float* f_v = f_k + 2048;
    LAS bf16_t* WLb = (LAS bf16_t*)(f_v + 2048);
    LAS bf16_t* ALb = WLb + 1280;
    LAS float* lor = (LAS float*)raw;
    LAS bf16_t* Bn = ALb + 1280;
    LAS bf16_t* Kn = Bn + 2304;
    LAS bf16_t* Ktt = Kn + 2304;
    LAS bf16_t* Vt = Ktt + 2560;
    LAS float* Mabf = (LAS float*)(Vt + 2560);
    LAS bf16_t* Makb = (LAS bf16_t*)(Mabf + 1152);
    LAS bf16_t* Mrkb = Makb + 1280;
    LAS float* Ltot = (LAS float*)(Mrkb + 1280);
    LAS bf16_t* iA1 = (LAS bf16_t*)(Ltot + 512);
    LAS bf16_t* iB1 = iA1 + 640;
    LAS bf16_t* iA2 = iB1 + 640;
    LAS bf16_t* iWt = iA2 + 640;
    LAS unsigned char* rec = (LAS unsigned char*)(iWt + 640);
    LAS bf16_t* At = (LAS bf16_t*)(rec + R_AT); LAS bf16_t* Rt = (LAS bf16_t*)(rec + R_RT); LAS bf16_t* Btt = (LAS bf16_t*)(rec + R_BT);
    const GAS bf16_t* z = (const GAS bf16_t*)(P.ws + WS_Z);
    GAS unsigned char* recg = (GAS unsigned char*)(P.ws + WS_REC);
    for (int idx = tid; idx < 4 * 640 / 2; idx += 512) ((LAS unsigned*)iA1)[idx] = 0u;
    for (int idx = tid; idx < 2 * 1280 / 2; idx += 512) ((LAS unsigned*)WLb)[idx] = 0u;
    for (int idx = tid; idx < 2 * 2560 / 2; idx += 512) ((LAS unsigned*)WUt)[idx] = 0u;
    for (int idx = tid; idx < 1280 / 2; idx += 512) ((LAS unsigned*)(rec + R_TL))[idx] = 0u;
    int cur_hd = -1;
    u32x4 pre[3];
    auto geo = [&](int u, int& hd, int& b, int& c, int& tlo, int& seqlen, size_t& rb) { hd = u & 7; const int rest = u >> 3; b = rest / 72; c = rest % 72; const int dir = hd & 1;
        const bool isctx = c < 8; const int cc = isctx ? c : c - 8; seqlen = isctx ? CTX : SEQ; tlo = dir ? seqlen - 32 - 32 * cc : 32 * cc; rb = isctx ? (size_t)TL + b * CTX : (size_t)b * SEQ; };
    auto issue = [&](int u, int tid) { int hd, b, c, tlo, seqlen; size_t rb; geo(u, hd, b, c, tlo, seqlen, rb);
#pragma unroll
        for (int k = 0; k < 3; ++k) { const int v = tid + 512 * k; pre[k] = (u32x4){0u, 0u, 0u, 0u};
            if (v < 1088) { const int rr = v >> 5, vc = v & 31, t = tlo - 1 + rr; if (t >= 0 && t < seqlen) pre[k] = *(const GAS u32x4*)(z + (rb + t) * ZW + rwkv_col(vc * 8, hd >> 1, hd & 1)); } } };
    if ((int)blockIdx.x < 4608) issue(blockIdx.x, tid);
    for (int u = blockIdx.x; u < 4608; u += gridDim.x) {
        const int tid = otid(), lane = tid & 63, w = tid >> 6;
        int hd, b, c, tlo, seqlen; size_t rb; geo(u, hd, b, c, tlo, seqlen, rb); const int h = hd >> 1, dir = hd & 1;
        LDS_BARRIER();
        if (hd != cur_hd) { cur_hd = hd;
            for (int idx = tid; idx < 2048; idx += 512) { const int m = idx >> 6, j = idx & 63; const size_t o = ((size_t)(l * 2 + dir) * 32 + m) * 256 + h * 64 + j;
                WUt[j * 40 + m] = (bf16_t)f2bf(PIN(I_WUP)[o]); AUt[j * 40 + m] = (bf16_t)f2bf(PIN(I_AUP)[o]); }
            { const int which = tid >> 8, gc = tid & 255; s_mu[tid] = PIN(I_MU)[(size_t)(l * 2 + which) * 960 + rwkv_col(gc, h, dir)]; }
            if (tid < 256) { const int k = tid >> 6, j = tid & 63; float v;
                if (k == 0) v = PIN(I_W0)[(l * 2 + dir) * 256 + h * 64 + j]; else if (k == 1) v = PIN(I_A0)[(l * 2 + dir) * 256 + h * 64 + j];
                else if (k == 2) v = PIN(I_KK)[l * 256 + h * 64 + j]; else v = PIN(I_KA)[l * 256 + h * 64 + j];
                s_par[tid] = v; } }
#pragma unroll
        for (int k = 0; k < 3; ++k) { const int v = tid + 512 * k; if (v < 1088) *(LAS u32x4*)(raw + (size_t)v * 8) = pre[k]; }
        LDS_BARRIER();
        if (u + (int)gridDim.x < 4608) issue(u + gridDim.x, tid);
        { const int gc = tid & 255, th = tid >> 8; const float mu0 = s_mu[gc], mu1 = s_mu[256 + gc];
            const int r0 = th * 16 + 1;
            float zm = bf2f(raw[(r0 - 1) * 256 + gc]), z0 = bf2f(raw[r0 * 256 + gc]);
#pragma unroll 4
            for (int ii = 0; ii < 16; ++ii) { const int rr = r0 + ii, i = dir ? 32 - rr : rr - 1;
                const float zp = bf2f(raw[(rr + 1) * 256 + gc]);
                const float val = z0 + mu0 * (zm - z0) + mu1 * (zp - z0);
                zm = z0; z0 = zp;
                if (gc < 64) f_r[i * 64 + gc] = val; else if (gc < 128) f_k[i * 64 + gc - 64] = val; else if (gc < 192) f_v[i * 64 + gc - 128] = val;
                else if (gc < 224) WLb[i * 40 + gc - 192] = (bf16_t)f2bf(tanhf_(val)); else ALb[i * 40 + gc - 224] = (bf16_t)f2bf(val); } }
        LDS_BARRIER();
        { const int which = w >> 2, mt = (w >> 1) & 1, np = (w & 1) * 2; f32x4 acc[1][2]; zero_acc<1, 2>(acc);
            lds_mma<1, 2, 1>(acc, (which ? ALb : WLb) + 16 * mt * 40, 40, (which ? AUt : WUt) + 16 * np * 40, 40, lane);
#pragma unroll
            for (int n = 0; n < 2; ++n) *(LAS f32x4*)(lor + which * 2176 + (16 * mt + (lane & 15)) * 68 + 16 * (np + n) + 4 * (lane >> 4)) = acc[0][n]; }
        { const int row = tid & 63, ig = tid >> 6;
#pragma unroll
            for (int e = 0; e < 4; ++e) Vt[row * 40 + 4 * ig + e] = (bf16_t)f2bf(f_v[(4 * ig + e) * 64 + row]); }
        LDS_BARRIER();
        float Lloc[4], lwv[4], agv[4], kkv[4], kdv[4]; float Lrun = 0.f;
#pragma unroll
        for (int ii = 0; ii < 4; ++ii) { const int i = 4 * w + ii, j = lane;
            const float wv = s_par[j] + lor[i * 68 + j], av = s_par[64 + j] + lor[2176 + i * 68 + j];
            const float wlog = -softplusf_(-wv) - 0.5f, lw = -__expf(wlog);
            Lrun += lw; Lloc[ii] = Lrun; lwv[ii] = lw; agv[ii] = sigmoidf_(av);
            const float kx = f_k[i * 64 + j], kkj = kx * s_par[128 + j];
            const float ss = wave_sum(kkj * kkj); kkv[ii] = kkj * __builtin_amdgcn_rcpf(fmaxf(sqrtf(ss), 1e-12f));
            kdv[ii] = kx * (1.0f + (agv[ii] - 1.0f) * s_par[192 + j]); }
        Ltot[w * 64 + lane] = Lrun;
        LDS_BARRIER();
        { float off = 0.f;
#pragma unroll
            for (int ww = 0; ww < 7; ++ww) if (ww < w) off += Ltot[ww * 64 + lane];
            float bq[4], kq[4];
#pragma unroll
            for (int ii = 0; ii < 4; ++ii) { const int i = 4 * w + ii, j = lane; const float L = off + Lloc[ii], eP = __expf(L - lwv[ii]), eL = __expf(L), eN = __expf(-L);
                bq[ii] = kkv[ii] * agv[ii] * eN; kq[ii] = kdv[ii] * eN;
                const unsigned ar = pk2a(-kkv[ii] * eP, f_r[i * 64 + j] * eL), bk = pk2a(bq[ii], kq[ii]);
                At[i * 72 + j] = (bf16_t)(ar & 0xffffu); Rt[i * 72 + j] = (bf16_t)(ar >> 16);
                Bn[i * 72 + j] = (bf16_t)(bk & 0xffffu); Kn[i * 72 + j] = (bf16_t)(bk >> 16);
                if (i == 31) ((LAS float*)(rec + R_GAM))[j] = eL; }
            *(LAS unsigned long long*)(Btt + lane * 40 + 4 * w) = (unsigned long long)pk2a(bq[0], bq[1]) | ((unsigned long long)pk2a(bq[2], bq[3]) << 32);
            *(LAS unsigned long long*)(Ktt + lane * 40 + 4 * w) = (unsigned long long)pk2a(kq[0], kq[1]) | ((unsigned long long)pk2a(kq[2], kq[3]) << 32); }
        LDS_BARRIER();
        { const int mat = w >> 1, mt = w & 1; f32x4 acc[1][2]; zero_acc<1, 2>(acc);
            lds_mma<1, 2, 2>(acc, (mat < 2 ? At : Rt) + 16 * mt * 72, 72, (mat & 1) ? Kn : Bn, 72, lane);
            const int t = 16 * mt + (lane & 15);
#pragma unroll
            for (int n = 0; n < 2; ++n) { f32x4 o;
#pragma unroll
                for (int e = 0; e < 4; ++e) { const int j = 16 * n + 4 * (lane >> 4) + e; const bool keep = mat < 2 ? j < t : j <= t; o[e] = keep ? acc[0][n][e] : 0.f; }
                if (mat == 0) { *(LAS f32x4*)(Mabf + t * 36 + 16 * n + 4 * (lane >> 4)) = o;
                    if (mt == 1 && n == 0) *(LAS unsigned long long*)(iA1 + (lane & 15) * 40 + 4 * (lane >> 4)) = (unsigned long long)pk2(o[0], o[1]) | ((unsigned long long)pk2(o[2], o[3]) << 32);
                } else { LAS bf16_t* dst = mat == 1 ? Makb : (mat == 2 ? (LAS bf16_t*)(rec + R_MRB) : Mrkb);
                    *(LAS unsigned long long*)(dst + t * 40 + 16 * n + 4 * (lane >> 4)) = (unsigned long long)pk2(o[0], o[1]) | ((unsigned long long)pk2(o[2], o[3]) << 32); } } }
        if (w < 2) {
            asm volatile("s_waitcnt lgkmcnt(0)" ::: "memory");
            const int cidx = lane & 15, o16 = 16 * w; float T[16];
            int vz = 0; asm volatile("" : "+v"(vz)); const LAS float* mb = Mabf + vz + o16 * 36 + o16;
#pragma unroll
            for (int t = 0; t < 16; ++t) { float row = cidx == t ? 1.0f : 0.f;
                float mrow[16];
#pragma unroll
                for (int q = 0; q < 4; ++q) if (4 * q < t) { const f32x4 mv = *(const LAS f32x4*)(mb + t * 36 + 4 * q); mrow[4 * q] = mv[0]; mrow[4 * q + 1] = mv[1]; mrow[4 * q + 2] = mv[2]; mrow[4 * q + 3] = mv[3]; }
#pragma unroll
                for (int j = 0; j < t; ++j) row += mrow[j] * T[j];
                T[t] = row; }
            if (lane < 16) {
                LAS bf16_t* tl = (LAS bf16_t*)(rec + R_TL);
#pragma unroll
                for (int t = 0; t < 16; t += 2) { const unsigned tp = pk2a(T[t], T[t + 1]); const bf16_t lo = (bf16_t)(tp & 0xffffu), hi = (bf16_t)(tp >> 16);
                    tl[(o16 + t) * 40 + o16 + cidx] = lo; tl[(o16 + t + 1) * 40 + o16 + cidx] = hi;
                    if (w == 0) { iB1[cidx * 40 + t] = lo; iB1[cidx * 40 + t + 1] = hi; }
                    else { iA2[t * 40 + cidx] = lo; iA2[(t + 1) * 40 + cidx] = hi; } }
            }
        } else {
            for (int tt = 16 + (w - 2); tt < 32; tt += 6) { f32x4 acc[1][1]; zero_acc<1, 1>(acc);
                const int m = (tt - 16) >> 2, n = (tt - 16) & 3;
                lds_mma<1, 1, 1>(acc, Vt + 16 * m * 40, 40, Ktt + 16 * n * 40, 40, lane);
                const f32x4 v = acc[0][0];
                *(LAS unsigned long long*)((LAS bf16_t*)(rec + R_HV) + (16 * m + (lane & 15)) * 64 + 16 * n + 4 * (lane >> 4)) = (unsigned long long)pk2(v[0], v[1]) | ((unsigned long long)pk2(v[2], v[3]) << 32); } }
        LDS_BARRIER();
        if (w == 0) {
            f32x4 acc[1][1]; zero_acc<1, 1>(acc);
            lds_mma<1, 1, 1>(acc, iA1, 40, iB1, 40, lane);
#pragma unroll
            for (int e = 0; e < 4; ++e) iWt[(4 * (lane >> 4) + e) * 40 + (lane & 15)] = (bf16_t)f2bf(acc[0][0][e]);
            asm volatile("s_waitcnt lgkmcnt(0)" ::: "memory");
            zero_acc<1, 1>(acc);
            lds_mma<1, 1, 1>(acc, iA2, 40, iWt, 40, lane);
            const f32x4 v = acc[0][0];
            *(LAS unsigned long long*)((LAS bf16_t*)(rec + R_TL) + (16 + (lane & 15)) * 40 + 4 * (lane >> 4)) = (unsigned long long)pk2(v[0], v[1]) | ((unsigned long long)pk2(v[2], v[3]) << 32);
        } else {
            for (int tt = w - 1; tt < 16; tt += 7) { f32x4 acc[1][1]; zero_acc<1, 1>(acc);
                const int m = (tt & 7) >> 1, n = tt & 1; const bool isg = tt < 8;
                lds_mma<1, 1, 1>(acc, Vt + 16 * m * 40, 40, (isg ? Makb : Mrkb) + 16 * n * 40, 40, lane);
                const f32x4 v = acc[0][0];
                *(LAS unsigned long long*)((LAS bf16_t*)(rec + (isg ? R_G : R_YV)) + (16 * m + (lane & 15)) * 32 + 16 * n + 4 * (lane >> 4)) = (unsigned long long)pk2(v[0], v[1]) | ((unsigned long long)pk2(v[2], v[3]) << 32); } }
        LDS_BARRIER();
        { GAS u32x4* dst = (GAS u32x4*)(recg + ((size_t)(b * 8 + hd) * 72 + c) * REC_BYTES);
            for (int p = tid; p < REC_BYTES / 16; p += 512) dst[p] = *(const LAS u32x4*)(rec + (size_t)p * 16); }
    }
    __syncthreads();
}

__device__ __forceinline__ void rwkv_seq(const PV& P, int l, int unit, LAS unsigned char* lds) {
    const int tid = otid(), lane = tid & 63, w = tid >> 6, fr = lane & 15, fq = lane >> 4;
    const int dir = unit & 1, h = (unit >> 1) & 3, b = unit >> 3;
    LAS unsigned char* recb = lds;
    LAS bf16_t* S0b = (LAS bf16_t*)(lds + 2 * REC_BYTES);
    LAS bf16_t* Xb = S0b + 4608;
    LAS bf16_t* SAb = Xb + 2560;
    LAS float* Ys = (LAS float*)(SAb + 2560);
    GAS bf16_t* yout = (GAS bf16_t*)(P.ws + WS_Y) + (size_t)(0 * 2 + dir) * YSZ;
    const GAS u32x4* recg = (const GAS u32x4*)(P.ws + WS_REC + (size_t)unit * 72 * REC_BYTES);
    for (int idx = tid; idx < 4608 / 2; idx += 512) ((LAS unsigned*)S0b)[idx] = 0u;
    f32x4 Sacc[1][2]; zero_acc<1, 2>(Sacc);
    const int ms = w >> 1, nbs = (w & 1) * 2;
    const int m1 = w & 3;
    u32x4 pre[5];
    auto issue = [&](int c) {
#pragma unroll
        for (int k = 0; k < 5; ++k) { const int p = tid + 512 * k; pre[k] = (u32x4){0u, 0u, 0u, 0u}; if (p < REC_BYTES / 16) pre[k] = recg[(size_t)c * (REC_BYTES / 16) + p]; } };
    issue(0);
    for (int c = 0; c < 72; ++c) {
        LAS unsigned char* rec = recb + (c & 1) * REC_BYTES;
#pragma unroll
        for (int k = 0; k < 5; ++k) { const int p = tid + 512 * k; if (p < REC_BYTES / 16) *(LAS u32x4*)(rec + (size_t)p * 16) = pre[k]; }
        LDS_BARRIER();
        if (c + 1 < 72) issue(c + 1);
        if (c > 0) {
            const int cp = c - 1; const bool isctx = cp < 8; const int cc = isctx ? cp : cp - 8, seqlen = isctx ? CTX : SEQ;
            const int tlo = dir ? seqlen - 32 - 32 * cc : 32 * cc; const size_t rb = isctx ? (size_t)TL + b * CTX : (size_t)b * SEQ;
            const int i = tid >> 4, rg = tid & 15, t = dir ? tlo + 31 - i : tlo + i;
            const f32x4 v = *(const LAS f32x4*)(Ys + i * 64 + 4 * rg);
            *(GAS unsigned long long*)(yout + (rb + t) * 256 + h * 64 + 4 * rg) = (unsigned long long)pk2(v[0], v[1]) | ((unsigned long long)pk2(v[2], v[3]) << 32); }
        f32x4 aPQ[1][2]; zero_acc<1, 2>(aPQ);
        lds_mma<1, 2, 2>(aPQ, S0b + 16 * m1 * 72, 72, (const LAS bf16_t*)(rec + (w < 4 ? R_AT : R_RT)), 72, lane);
        if (w < 4) {
#pragma unroll
            for (int n = 0; n < 2; ++n) { const u32x2 gw = *(const LAS u32x2*)(rec + R_G + ((16 * m1 + fr) * 32 + 16 * n + 4 * fq) * 2);
                const float x0 = aPQ[0][n][0] + bflo(gw.x), x1 = aPQ[0][n][1] + bfhi(gw.x), x2 = aPQ[0][n][2] + bflo(gw.y), x3 = aPQ[0][n][3] + bfhi(gw.y);
                *(LAS unsigned long long*)(Xb + (16 * m1 + fr) * 40 + 16 * n + 4 * fq) = (unsigned long long)pk2(x0, x1) | ((unsigned long long)pk2(x2, x3) << 32); } }
        LDS_BARRIER();
        { const int n2 = w >> 2; f32x4 aSA[1][1]; zero_acc<1, 1>(aSA);
            lds_mma<1, 1, 1>(aSA, Xb + 16 * m1 * 40, 40, (const LAS bf16_t*)(rec + R_TL) + 16 * n2 * 40, 40, lane);
            const f32x4 v = aSA[0][0];
            *(LAS unsigned long long*)(SAb + (16 * m1 + fr) * 40 + 16 * n2 + 4 * fq) = (unsigned long long)pk2(v[0], v[1]) | ((unsigned long long)pk2(v[2], v[3]) << 32); }
        LDS_BARRIER();
        if (w >= 4) { lds_mma<1, 2, 1>(aPQ, SAb + 16 * m1 * 40, 40, (const LAS bf16_t*)(rec + R_MRB), 40, lane);
#pragma unroll
            for (int n = 0; n < 2; ++n) { const u32x2 yw = *(const LAS u32x2*)(rec + R_YV + ((16 * m1 + fr) * 32 + 16 * n + 4 * fq) * 2);
                const int t0 = 16 * n + 4 * fq, row = 16 * m1 + fr;
                Ys[(t0 + 0) * 64 + row] = aPQ[0][n][0] + bflo(yw.x); Ys[(t0 + 1) * 64 + row] = aPQ[0][n][1] + bfhi(yw.x);
                Ys[(t0 + 2) * 64 + row] = aPQ[0][n][2] + bflo(yw.y); Ys[(t0 + 3) * 64 + row] = aPQ[0][n][3] + bfhi(yw.y); } }
        { f32x4 aS[1][2]; zero_acc<1, 2>(aS);
            lds_mma<1, 2, 1>(aS, SAb + 16 * ms * 40, 40, (const LAS bf16_t*)(rec + R_BT) + 16 * nbs * 40, 40, lane);
#pragma unroll
            for (int n = 0; n < 2; ++n) { const int k0 = 16 * (nbs + n) + 4 * fq, row = 16 * ms + fr;
                const u32x2 hw = *(const LAS u32x2*)(rec + R_HV + (row * 64 + k0) * 2); const f32x4 gm = *(const LAS f32x4*)(rec + R_GAM + k0 * 4);
                f32x4 sn; sn[0] = gm[0] * (Sacc[0][n][0] + aS[0][n][0] + bflo(hw.x)); sn[1] = gm[1] * (Sacc[0][n][1] + aS[0][n][1] + bfhi(hw.x));
                sn[2] = gm[2] * (Sacc[0][n][2] + aS[0][n][2] + bflo(hw.y)); sn[3] = gm[3] * (Sacc[0][n][3] + aS[0][n][3] + bfhi(hw.y));
                Sacc[0][n] = sn;
                *(LAS unsigned long long*)(S0b + row * 72 + k0) = (unsigned long long)pk2(sn[0], sn[1]) | ((unsigned long long)pk2(sn[2], sn[3]) << 32); } }
    }
    LDS_BARRIER();
    { const int cp = 71; const int seqlen = SEQ, cc = cp - 8; const int tlo = dir ? seqlen - 32 - 32 * cc : 32 * cc; const size_t rb = (size_t)b * SEQ;
        const int i = tid >> 4, rg = tid & 15, t = dir ? tlo + 31 - i : tlo + i;
        const f32x4 v = *(const LAS f32x4*)(Ys + i * 64 + 4 * rg);
        *(GAS unsigned long long*)(yout + (rb + t) * 256 + h * 64 + 4 * rg) = (unsigned long long)pk2(v[0], v[1]) | ((unsigned long long)pk2(v[2], v[3]) << 32); }
    __syncthreads();
}

__device__ __forceinline__ void ret_unit(const PV& P, int l, int unit, LAS unsigned char* lds) {
    const int tid = otid(), lane = tid & 63, w = tid >> 6;
    const int dir = unit & 1, h = (unit >> 1) & 3, b = unit >> 3;
    LAS bf16_t* Qs = (LAS bf16_t*)lds; LAS bf16_t* Ks = Qs + 4608; LAS bf16_t* Kt = Ks + 4608; LAS bf16_t* Vt = Kt + 4608; LAS bf16_t* Att = Vt + 4608; LAS bf16_t* St = Att + 4608;
    const GAS bf16_t* z = (const GAS bf16_t*)(P.ws + WS_Z);
    GAS bf16_t* yout = (GAS bf16_t*)(P.ws + WS_Y) + (size_t)(1 * 2 + dir) * YSZ;
    const float lg = __logf(1.0f - exp2f(-((dir ? 5.5f : 5.0f) + (float)h)));
    for (int idx = tid; idx < 4608; idx += 512) St[idx] = 0;
    f32x4 Sacc[1][2]; zero_acc<1, 2>(Sacc);
    const int m = w >> 1, nb = (w & 1) * 2, fr = lane & 15, fq = lane >> 4;
    const float cdec = __expf(lg * 64.0f);
    u32x4 pre[3];
    auto tok = [&](int c, int i, size_t& rb, int& pos) -> int {
        const bool isctx = c < 4; const int cc = isctx ? c : c - 4, seqlen = isctx ? CTX : SEQ;
        const int tlo = dir ? seqlen - 64 - 64 * cc : 64 * cc; rb = isctx ? (size_t)TL + b * CTX : (size_t)b * SEQ;
        const int t = dir ? tlo + 63 - i : tlo + i; pos = (isctx ? 0 : CTX) + t; return t;
    };
    auto issue_loads = [&](int c) { const int i = tid >> 3, vc = tid & 7; size_t rb; int pos; const int t = tok(c, i, rb, pos);
#pragma unroll
        for (int k = 0; k < 3; ++k) pre[k] = *(const GAS u32x4*)(z + (rb + t) * ZW + CB_ + k * 256 + h * 64 + vc * 8); };
    issue_loads(0);
    for (int c = 0; c < 36; ++c) {
        LDS_BARRIER();
        { const int i = tid >> 3, vc = tid & 7;
            *(LAS u32x4*)(Qs + i * 72 + vc * 8) = pre[0]; *(LAS u32x4*)(Ks + i * 72 + vc * 8) = pre[1];
            const unsigned vw[4] = {pre[2].x, pre[2].y, pre[2].z, pre[2].w};
#pragma unroll
            for (int e = 0; e < 4; ++e) { Vt[(vc * 8 + 2 * e) * 72 + i] = (bf16_t)(vw[e] & 0xffffu); Vt[(vc * 8 + 2 * e + 1) * 72 + i] = (bf16_t)(vw[e] >> 16); } }
        LDS_BARRIER();
        if (c + 1 < 36) issue_loads(c + 1);
#pragma unroll
        for (int k = 0; k < 4; ++k) { const int idx = tid + 512 * k, i = idx >> 5, d = idx & 31; size_t rb; int pos; tok(c, i, rb, pos);
            float rev = (float)pos * (exp2f(-(float)d * (13.287712379549449f / 32.0f)) * 0.15915494309189535f); rev -= floorf(rev);
            const float sn = __builtin_amdgcn_sinf(rev), cs = __builtin_amdgcn_cosf(rev);
            const float q1 = bf2f(Qs[i * 72 + d]), q2 = bf2f(Qs[i * 72 + d + 32]), k1 = bf2f(Ks[i * 72 + d]), k2 = bf2f(Ks[i * 72 + d + 32]);
            Qs[i * 72 + d] = (bf16_t)f2bf((q1 * cs - q2 * sn) * 0.125f); Qs[i * 72 + d + 32] = (bf16_t)f2bf((q1 * sn + q2 * cs) * 0.125f);
            const float o1 = k1 * cs - k2 * sn, o2 = k1 * sn + k2 * cs, wd = __expf(lg * (float)(63 - i));
            Ks[i * 72 + d] = (bf16_t)f2bf(o1); Ks[i * 72 + d + 32] = (bf16_t)f2bf(o2);
            Kt[d * 72 + i] = (bf16_t)f2bf(o1 * wd); Kt[(d + 32) * 72 + i] = (bf16_t)f2bf(o2 * wd); }
        LDS_BARRIER();
        f32x4 aS[1][2], aO2[1][2]; zero_acc<1, 2>(aS); zero_acc<1, 2>(aO2);
        lds_mma<1, 2, 2>(aS, Qs + 16 * m * 72, 72, Ks + 16 * nb * 72, 72, lane);
        lds_mma<1, 2, 2>(aO2, Qs + 16 * m * 72, 72, St + 16 * nb * 72, 72, lane);
        const int i = 16 * m + fr;
#pragma unroll
        for (int n = 0; n < 2; ++n) { float o[4];
#pragma unroll
            for (int e = 0; e < 4; ++e) { const int j = 16 * (nb + n) + 4 * fq + e, diff = i - j; const bool keep = dir ? diff > 0 : diff >= 0;
                o[e] = keep ? aS[0][n][e] * __expf(lg * (float)diff) : 0.f; }
            *(LAS unsigned long long*)(Att + i * 72 + 16 * (nb + n) + 4 * fq) = (unsigned long long)pk2(o[0], o[1]) | ((unsigned long long)pk2(o[2], o[3]) << 32); }
        LDS_BARRIER();
        f32x4 aO1[1][2], aT[1][2]; zero_acc<1, 2>(aO1); zero_acc<1, 2>(aT);
        lds_mma<1, 2, 2>(aO1, Att + 16 * m * 72, 72, Vt + 16 * nb * 72, 72, lane);
        lds_mma<1, 2, 2>(aT, Vt + 16 * m * 72, 72, Kt + 16 * nb * 72, 72, lane);
        { size_t rb; int pos; const int t = tok(c, i, rb, pos); const float rd = __expf(lg * (float)(i + 1));
#pragma unroll
            for (int n = 0; n < 2; ++n) { const f32x4 o = aO1[0][n] + rd * aO2[0][n];
                *(GAS unsigned long long*)(yout + (rb + t) * 256 + h * 64 + 16 * (nb + n) + 4 * fq) = (unsigned long long)pk2(o[0], o[1]) | ((unsigned long long)pk2(o[2], o[3]) << 32); } }
#pragma unroll
        for (int n = 0; n < 2; ++n) { Sacc[0][n] = cdec * Sacc[0][n] + aT[0][n]; const f32x4 s = Sacc[0][n];
            *(LAS unsigned long long*)(St + i * 72 + 16 * (nb + n) + 4 * fq) = (unsigned long long)pk2(s[0], s[1]) | ((unsigned long long)pk2(s[2], s[3]) << 32); }
    }
    __syncthreads();
}

__device__ __forceinline__ void lru_items(const PV& P, int l, LAS unsigned char* lds) {
    const int tid0 = otid();
    LAS bf16_t* waT = (LAS bf16_t*)lds; LAS bf16_t* wxT = waT + 4608; LAS bf16_t* xcb = wxT + 4608;
    LAS float* xraw = (LAS float*)(lds + 27648);
    LAS float* xcf = xraw + 67 * 64;
    LAS float* a_s = xcf + 4352; LAS float* b_s = a_s + 4352;
    LAS float* segA = b_s + 4352; LAS float* segH = segA + 512; LAS float* par = segH + 512;
    const GAS bf16_t* z = (const GAS bf16_t*)(P.ws + WS_Z);
    int cur_key = -1;
    u32x4 pre[2];
    auto geo = [&](int u, int& key, int& b, int& c, int& tlo, int& seqlen, size_t& rb) { key = u & 7; const int rest = u >> 3; b = rest / 36; c = rest % 36; const int dir = key >> 2;
        const bool isctx = c < 4; const int cc = isctx ? c : c - 4; seqlen = isctx ? CTX : SEQ; tlo = dir ? seqlen - 64 - 64 * cc : 64 * cc; rb = isctx ? (size_t)TL + b * CTX : (size_t)b * SEQ; };
    auto issue = [&](int u, int tid) { int key, b, c, tlo, seqlen; size_t rb; geo(u, key, b, c, tlo, seqlen, rb);
#pragma unroll
        for (int k = 0; k < 2; ++k) { const int v = tid + 512 * k; pre[k] = (u32x4){0u, 0u, 0u, 0u};
            if (v < 536) { const int rr = v >> 3, vc = v & 7, t = tlo - 2 + rr; if (t >= 0 && t < seqlen) pre[k] = *(const GAS u32x4*)(z + (rb + t) * ZW + CC_ + (key & 3) * 64 + vc * 8); } } };
    if ((int)blockIdx.x < 2304) issue(blockIdx.x, tid0);
    for (int u = blockIdx.x; u < 2304; u += gridDim.x) {
        const int tid = otid(), lane = tid & 63, w = tid >> 6;
        int key, b, c, tlo, seqlen; size_t rb; geo(u, key, b, c, tlo, seqlen, rb); const int dir = key >> 2, blk = key & 3;
        GAS bf16_t* hout = (GAS bf16_t*)(P.ws + WS_Y) + (size_t)(2 * 2 + dir) * YSZ; GAS bf16_t* aout = (GAS bf16_t*)(P.ws + WS_ACU) + (size_t)dir * YSZ;
        LDS_BARRIER();
        if (key != cur_key) { cur_key = key;
            for (int idx = tid; idx < 4096; idx += 512) { const int i = idx >> 6, j = idx & 63; const size_t o = ((size_t)((l * 2 + dir) * 4 + blk) * 64 + i) * 64 + j;
                waT[j * 72 + i] = (bf16_t)f2bf(PIN(I_WA)[o]); wxT[j * 72 + i] = (bf16_t)f2bf(PIN(I_WX)[o]); }
            { const int k = tid >> 6, cc = tid & 63, ch = blk * 64 + cc; float v;
                if (k < 4) v = PIN(I_CVW)[(l * 4 + k) * 256 + ch]; else if (k == 4) v = PIN(I_CVB)[l * 256 + ch];
                else if (k == 5) v = PIN(I_BA)[(l * 2 + dir) * 256 + ch]; else if (k == 6) v = PIN(I_BX)[(l * 2 + dir) * 256 + ch];
                else v = softplusf_(-PIN(I_LAM)[(l * 2 + dir) * 256 + ch]);
                par[tid] = v; } }
#pragma unroll
        for (int k = 0; k < 2; ++k) { const int v = tid + 512 * k; if (v < 536) { const unsigned ww[4] = {pre[k].x, pre[k].y, pre[k].z, pre[k].w};
#pragma unroll
                for (int e = 0; e < 4; ++e) { xraw[v * 8 + 2 * e] = bflo(ww[e]); xraw[v * 8 + 2 * e + 1] = bfhi(ww[e]); } } }
        LDS_BARRIER();
        if (u + (int)gridDim.x < 2304) issue(u + gridDim.x, tid);
        { const int ch = tid & 63, tg = tid >> 6;
#pragma unroll
            for (int e = 0; e < 8; ++e) { const int tt = tg * 8 + e;
                const float xc = par[256 + ch] + par[ch] * xraw[tt * 64 + ch] + par[64 + ch] * xraw[(tt + 1) * 64 + ch] + par[128 + ch] * xraw[(tt + 2) * 64 + ch] + par[192 + ch] * xraw[(tt + 3) * 64 + ch];
                const int i = dir ? 63 - tt : tt; xcf[i * 68 + ch] = xc; xcb[i * 72 + ch] = (bf16_t)f2bf(xc); } }
        LDS_BARRIER();
        { const int m = w >> 1, nb = (w & 1) * 2, fr = lane & 15, fq = lane >> 4;
            f32x4 aR[1][2], aI[1][2]; zero_acc<1, 2>(aR); zero_acc<1, 2>(aI);
            lds_mma<1, 2, 2>(aR, xcb + 16 * m * 72, 72, waT + 16 * nb * 72, 72, lane);
            lds_mma<1, 2, 2>(aI, xcb + 16 * m * 72, 72, wxT + 16 * nb * 72, 72, lane);
            const int i = 16 * m + fr;
#pragma unroll
            for (int n = 0; n < 2; ++n) { f32x4 av, bv;
#pragma unroll
                for (int e = 0; e < 4; ++e) { const int ch = 16 * (nb + n) + 4 * fq + e;
                    const float r = sigmoidf_(aR[0][n][e] + par[320 + ch]), ig = sigmoidf_(aI[0][n][e] + par[384 + ch]);
                    const float la = -8.0f * r * par[448 + ch]; av[e] = __expf(la);
                    const float y2 = 2.0f * la;
                    const float om = y2 > -0.125f ? -y2 * (1.0f + y2 * (0.5f + y2 * (0.16666667f + y2 * (0.041666668f + y2 * 0.0083333338f)))) : 1.0f - __expf(y2);
                    bv[e] = sqrtf(fmaxf(om, 0.f)) * ig * xcf[i * 68 + ch]; }
                *(LAS f32x4*)(a_s + i * 68 + 16 * (nb + n) + 4 * fq) = av; *(LAS f32x4*)(b_s + i * 68 + 16 * (nb + n) + 4 * fq) = bv; } }
        LDS_BARRIER();
        const int ch = tid & 63, seg = tid >> 6;
        float av[8], bv[8];
        { float A = 1.f, H = 0.f;
#pragma unroll
            for (int e = 0; e < 8; ++e) { const int i = seg * 8 + e; av[e] = a_s[i * 68 + ch]; bv[e] = b_s[i * 68 + ch]; }
#pragma unroll
            for (int e = 0; e < 8; ++e) { H = av[e] * H + bv[e]; A *= av[e]; av[e] = A; bv[e] = H; }
            segA[seg * 64 + ch] = A; segH[seg * 64 + ch] = H; }
        LDS_BARRIER();
        float hin = 0.f, ap = 1.f;
#pragma unroll
        for (int s2 = 0; s2 < 7; ++s2) if (s2 < seg) { const float sa = segA[s2 * 64 + ch]; hin = sa * hin + segH[s2 * 64 + ch]; ap *= sa; }
#pragma unroll
        for (int e = 0; e < 8; ++e) { const int i = seg * 8 + e; const int t = dir ? tlo + 63 - i : tlo + i;
            const float hl = bv[e] + av[e] * hin, ac = av[e] * ap;
            hout[(rb + t) * 256 + blk * 64 + ch] = (bf16_t)f2bf(hl); aout[(rb + t) * 256 + blk * 64 + ch] = (bf16_t)f2bf(ac);
            if (i == 63) { GAS float* ag = (GAS float*)(P.ws + WS_AGG) + ((size_t)((b * 2 + dir) * 36 + c) * 2) * 256 + blk * 64 + ch; ag[0] = ac; ag[256] = hl; } }
    }
    __syncthreads();
}
__device__ __forceinline__ void lru_carry_unit(const PV& P, int unit) {
    const int tid = otid();
    if (tid < 256) { const float* ag = (const float*)(P.ws + WS_AGG) + (size_t)unit * 36 * 512 + tid; float* ci = (float*)(P.ws + WS_CIN) + (size_t)unit * 36 * 256 + tid;
        float A[36], H[36];
#pragma unroll
        for (int c = 0; c < 36; ++c) { A[c] = ag[c * 512]; H[c] = ag[c * 512 + 256]; }
        float carry = 0.f;
#pragma unroll
        for (int c = 0; c < 36; ++c) { ci[c * 256] = carry; carry = A[c] * carry + H[c]; } }
}

__device__ __forceinline__ void s5_unit(const PV& P, int l, int unit, LAS unsigned char* lds) {
    const int tid = otid(), lane = tid & 63, w = tid >> 6;
    const int gp = unit & 7, dir = (unit >> 3) & 1, b = unit >> 4;
    LAS float* bu0 = (LAS float*)lds;
    LAS bf16_t* Hs0 = (LAS bf16_t*)(lds + 66560);
    LAS bf16_t* Us0 = (LAS bf16_t*)(lds + 100352);
    LAS bf16_t* Bbu = (LAS bf16_t*)(lds + 105472);
    LAS bf16_t* By = (LAS bf16_t*)(lds + 125952);
    const GAS bf16_t* z = (const GAS bf16_t*)(P.ws + WS_Z);
    GAS bf16_t* yout = (GAS bf16_t*)(P.ws + WS_Y) + (size_t)(3 * 2 + dir) * YSZ;
    for (int idx = tid; idx < 256 * 40 / 2; idx += 512) ((LAS unsigned*)Bbu)[idx] = 0u;
    __syncthreads();
    float lr = 0.f, li = 0.f, hr = 0.f, hi = 0.f;
    if (tid < 128) { const int gl = tid >> 6, p = tid & 63, g = 2 * gp + gl; const size_t pidx = ((size_t)(l * 2 + dir) * 16 + g) * 64 + p;
        const float are = PIN(I_SARE)[pidx], aim = PIN(I_SAIM)[pidx], dt = __expf(PIN(I_SLDT)[(l * 2 + dir) * 16 + g]);
        const float mag = __expf(are * dt); float rev = aim * dt * 0.15915494309189535f; rev -= floorf(rev);
        lr = mag * __builtin_amdgcn_cosf(rev); li = mag * __builtin_amdgcn_sinf(rev);
        const float nre = lr - 1.0f, nim = li, den = 1.0f / (are * are + aim * aim);
        const float cre = (nre * are + nim * aim) * den, cim = (nim * are - nre * aim) * den;
#pragma unroll
        for (int c = 0; c < 16; ++c) { const float bre = PIN(I_SBRE)[pidx * 16 + c], bim = PIN(I_SBIM)[pidx * 16 + c];
            Bbu[(gl * 128 + 2 * p) * 40 + gl * 16 + c] = (bf16_t)f2bf(cre * bre - cim * bim); Bbu[(gl * 128 + 2 * p + 1) * 40 + gl * 16 + c] = (bf16_t)f2bf(cre * bim + cim * bre); } }
    for (int idx = tid; idx < 4096; idx += 512) { const int gl = idx >> 11, c = (idx >> 7) & 15, kk = idx & 127, part = kk >> 6, p = kk & 63, g = 2 * gp + gl;
        const size_t src = (((size_t)(l * 2 + dir) * 16 + g) * 16 + c) * 64 + p;
        By[(gl * 16 + c) * 136 + 2 * p + part] = (bf16_t)f2bf(part ? -PIN(I_SCIM)[src] : PIN(I_SCRE)[src]); }
    auto rowof = [&](int c, int i) -> size_t {
        if (c < 8) { const int s = 32 * c + i, t = dir ? 255 - s : s; return (size_t)TL + b * CTX + t; }
        const int sl = 32 * (c - 8) + i, slr = dir ? 2047 - sl : sl, col = slr >> 5, rg = slr & 31; return (size_t)b * SEQ + rg * 64 + col; };
    const int t6 = tid - 384;
    u32x4 pre = (u32x4){0u, 0u, 0u, 0u};
    if (w >= 6) { pre = *(const GAS u32x4*)(z + rowof(0, t6 >> 2) * ZW + CD_ + gp * 32 + (t6 & 3) * 8); *(LAS u32x4*)(Us0 + (t6 >> 2) * 40 + (t6 & 3) * 8) = pre;
        pre = *(const GAS u32x4*)(z + rowof(1, t6 >> 2) * ZW + CD_ + gp * 32 + (t6 & 3) * 8); }
    __syncthreads();
#pragma unroll 1
    for (int k = 0; k < 74; ++k) {
        if (w < 2) {
            const float hr_s = hr, hi_s = hi;
            for (int r3 = 0; r3 < ((PROBE_DUP & 524288) ? 2 : 1); ++r3)
            if (k >= 1 && k <= 72) { const LAS float* bu = bu0 + ((k - 1) & 1) * 8320; LAS bf16_t* Hs = Hs0 + ((k - 1) & 1) * 8448; hr = hr_s; hi = hi_s;
                const int cr = (tid >> 6) * 128 + 2 * (tid & 63);
#pragma unroll 1
                for (int i0 = 0; i0 < 32; i0 += 8) { f32x2 bb[8];
#pragma unroll
                    for (int e = 0; e < 8; ++e) bb[e] = *(const LAS f32x2*)(bu + (i0 + e) * 260 + cr);
                    unsigned orr[8];
#pragma unroll
                    for (int e = 0; e < 8; ++e) { const float nr = lr * hr - li * hi + bb[e][0], ni = lr * hi + li * hr + bb[e][1]; hr = nr; hi = ni; orr[e] = pk2a(nr, ni); }
#pragma unroll
                    for (int e = 0; e < 8; ++e) *(LAS unsigned*)(Hs + (i0 + e) * 264 + cr) = orr[e]; } }
        } else if (w < 6) {
            for (int r3 = 0; r3 < ((PROBE_DUP & 131072) ? 2 : 1); ++r3)
            if (k <= 71) { LAS float* bu = bu0 + (k & 1) * 8320; const LAS bf16_t* Us = Us0 + (k & 1) * 1280; const int wq = w - 2;
                f32x4 acc[2][4]; zero_acc<2, 4>(acc);
                lds_mma<2, 4, 1>(acc, Us, 40, Bbu + 64 * wq * 40, 40, lane);
#pragma unroll
                for (int mm = 0; mm < 2; ++mm)
#pragma unroll
                    for (int n = 0; n < 4; ++n) *(LAS f32x4*)(bu + (16 * mm + (lane & 15)) * 260 + 64 * wq + 16 * n + 4 * (lane >> 4)) = acc[mm][n]; }
        } else {
            for (int r3 = 0; r3 < ((PROBE_DUP & 262144) ? 2 : 1); ++r3)
            if (k >= 2) { const LAS bf16_t* Hs = Hs0 + (k & 1) * 8448; const int gl = w - 6, cy = k - 2;
                f32x4 acc[2][1]; zero_acc<2, 1>(acc);
                lds_mma<2, 1, 4>(acc, Hs + gl * 128, 264, By + gl * 16 * 136, 136, lane);
#pragma unroll
                for (int mm = 0; mm < 2; ++mm) { const int i = 16 * mm + (lane & 15); const f32x4 v = acc[mm][0];
                    *(GAS unsigned long long*)(yout + rowof(cy, i) * 256 + gp * 32 + gl * 16 + 4 * (lane >> 4)) = (unsigned long long)pk2(v[0], v[1]) | ((unsigned long long)pk2(v[2], v[3]) << 32); } }
            if (k + 1 <= 71) { *(LAS u32x4*)(Us0 + ((k + 1) & 1) * 1280 + (t6 >> 2) * 40 + (t6 & 3) * 8) = pre;
                if (k + 2 <= 71) pre = *(const GAS u32x4*)(z + rowof(k + 2, t6 >> 2) * ZW + CD_ + gp * 32 + (t6 & 3) * 8); }
        }
        LDS_BARRIER();
    }
    __syncthreads();
}

__device__ __forceinline__ float sum16(float v) { v = sum8(v); return v + dppf<0x140>(v); }
struct CmbRow { u32x2 zr[3], zk[3], zv[3], zg[3], gB, gC, uD, y[8], ac[2]; f32x4 ci[2]; };
__device__ __forceinline__ void p3_combine(const PV& P, int l, int nrows, LAS unsigned char* lds) {
    const int tid = otid(), lane = tid & 63, w = tid >> 6, c4 = 4 * lane, hh = lane >> 4;
    LAS float* gup = (LAS float*)lds;
    LAS float* smu = gup + 16384;
    LAS float* spar = smu + 1664;
    LAS float* sgs = spar + 1280 + w * 64;
    for (int idx = tid; idx < 16384; idx += 512) gup[idx] = PIN(I_GUP)[(size_t)l * 16384 + idx];
    for (int idx = tid; idx < 1664; idx += 512) { const int which = idx / 832, col = idx % 832; smu[idx] = PIN(I_MU)[(size_t)(l * 2 + which) * 960 + col]; }
    for (int idx = tid; idx < 1280; idx += 512) { const int k = idx >> 8, c = idx & 255;
        spar[idx] = k == 0 ? PIN(I_LNG)[l * 256 + c] : k == 1 ? PIN(I_LNB)[l * 256 + c] : k == 2 ? PIN(I_RK)[l * 256 + c] : k == 3 ? PIN(I_GNG)[l * 256 + c] : PIN(I_SD)[l * 256 + c]; }
    __syncthreads();
    const GAS bf16_t* z = (const GAS bf16_t*)(P.ws + WS_Z); const GAS bf16_t* Y = (const GAS bf16_t*)(P.ws + WS_Y);
    GAS bf16_t* mix = (GAS bf16_t*)(P.ws + WS_ACT); GAS bf16_t* s5g = (GAS bf16_t*)(P.ws + WS_S5G);
    const int gw = blockIdx.x * 8 + w, NGW = gridDim.x * 8;
    auto ld = [&](int row, CmbRow& L) {
        const bool isctx = row >= TL; const int t = isctx ? ((row - TL) & 255) : (row & 2047), seqlen = isctx ? CTX : SEQ;
        const GAS bf16_t* zr = z + (size_t)row * ZW;
#pragma unroll
        for (int d = 0; d < 3; ++d) { const bool ok = d == 1 || (d == 0 ? t > 0 : t < seqlen - 1); const GAS bf16_t* zz = zr + (d - 1) * ZW; const u32x2 zero = (u32x2){0u, 0u};
            L.zr[d] = ok ? *(const GAS u32x2*)(zz + c4) : zero; L.zk[d] = ok ? *(const GAS u32x2*)(zz + 256 + c4) : zero; L.zv[d] = ok ? *(const GAS u32x2*)(zz + 512 + c4) : zero;
            L.zg[d] = (ok && lane < 16) ? *(const GAS u32x2*)(zz + 768 + c4) : zero; }
        L.gB = *(const GAS u32x2*)(zr + CB_ + 768 + c4); L.gC = *(const GAS u32x2*)(zr + CC_ + 256 + c4); L.uD = *(const GAS u32x2*)(zr + CD_ + c4);
#pragma unroll
        for (int k = 0; k < 8; ++k) L.y[k] = *(const GAS u32x2*)(Y + (size_t)k * YSZ + (size_t)row * 256 + c4);
        const int bb = isctx ? (row - TL) >> 8 : row >> 11;
#pragma unroll
        for (int d = 0; d < 2; ++d) { const int ts = d ? seqlen - 1 - t : t, ck = (isctx ? 0 : 4) + (ts >> 6);
            L.ac[d] = *(const GAS u32x2*)((const GAS bf16_t*)(P.ws + WS_ACU) + (size_t)d * YSZ + (size_t)row * 256 + c4);
            L.ci[d] = *(const GAS f32x4*)((const GAS float*)(P.ws + WS_CIN) + ((size_t)(bb * 2 + d) * 36 + ck) * 256 + c4); }
    };
    auto up4 = [](const u32x2 v, float (&o)[4]) { o[0] = bflo(v.x); o[1] = bfhi(v.x); o[2] = bflo(v.y); o[3] = bfhi(v.y); };
    auto st4 = [](GAS bf16_t* p, const float (&o)[4]) { *(GAS unsigned long long*)p = (unsigned long long)pk2(o[0], o[1]) | ((unsigned long long)pk2(o[2], o[3]) << 32); };
    auto shift4 = [&](const u32x2 (&zz)[3], int col, float (&o)[4]) { float a[4], m[4], n[4]; up4(zz[1], a); up4(zz[0], m); up4(zz[2], n);
        const f32x4 u0 = *(const LAS f32x4*)(smu + col), u1 = *(const LAS f32x4*)(smu + 832 + col);
#pragma unroll
        for (int e = 0; e < 4; ++e) o[e] = a[e] + u0[e] * (m[e] - a[e]) + u1[e] * (n[e] - a[e]); };
    auto cmp = [&](int row, const CmbRow& L) {
        if (lane < 16) { float gl[4]; shift4(L.zg, 768 + c4, gl);
            *(LAS f32x4*)(sgs + c4) = (f32x4){sigmoidf_(gl[0]), sigmoidf_(gl[1]), sigmoidf_(gl[2]), sigmoidf_(gl[3])}; }
        asm volatile("s_waitcnt lgkmcnt(0)" ::: "memory");
        f32x4 g = (f32x4){0.f, 0.f, 0.f, 0.f};
#pragma unroll 8
        for (int i = 0; i < 64; ++i) g += sgs[i] * *(const LAS f32x4*)(gup + i * 256 + c4);
        float r[4], k[4], v[4]; shift4(L.zr, c4, r); shift4(L.zk, 256 + c4, k); shift4(L.zv, 512 + c4, v);
        const f32x4 lng = *(const LAS f32x4*)(spar + c4), lnb = *(const LAS f32x4*)(spar + 256 + c4), rk = *(const LAS f32x4*)(spar + 512 + c4), gng = *(const LAS f32x4*)(spar + 768 + c4), sd = *(const LAS f32x4*)(spar + 1024 + c4);
        float ya[4], yb[4], t0[4], t1[4];
        up4(L.y[0], t0); up4(L.y[1], t1);
#pragma unroll
        for (int e = 0; e < 4; ++e) ya[e] = t0[e] + t1[e];
        { const float mean = sum16((ya[0] + ya[1]) + (ya[2] + ya[3])) * (1.0f / 64.0f); float q = 0.f, bsum = 0.f;
#pragma unroll
            for (int e = 0; e < 4; ++e) { ya[e] -= mean; q += ya[e] * ya[e]; bsum += r[e] * k[e] * rk[e]; }
            const float rs = rsqrtf(sum16(q) * (1.0f / 64.0f) + 64e-5f); bsum = sum16(bsum); float o[4];
#pragma unroll
            for (int e = 0; e < 4; ++e) o[e] = (ya[e] * rs * lng[e] + lnb[e] + bsum * v[e]) * g[e];
            st4(mix + (size_t)row * 1024 + c4, o); }
        up4(L.y[2], t0); up4(L.y[3], t1);
#pragma unroll
        for (int e = 0; e < 4; ++e) yb[e] = t0[e] + t1[e];
        { const float mean = sum16((yb[0] + yb[1]) + (yb[2] + yb[3])) * (1.0f / 64.0f); float q = 0.f;
#pragma unroll
            for (int e = 0; e < 4; ++e) { yb[e] -= mean; q += yb[e] * yb[e]; }
            const float rs = rsqrtf(sum16(q) * (1.0f / 64.0f) + 1e-5f); float gt[4], o[4]; up4(L.gB, gt);
#pragma unroll
            for (int e = 0; e < 4; ++e) o[e] = siluf_(gt[e]) * (yb[e] * rs * gng[e]);
            st4(mix + (size_t)row * 1024 + 256 + c4, o); }
        { float gt[4], o[4], a0[4], a1[4]; up4(L.gC, gt); up4(L.y[4], t0); up4(L.y[5], t1); up4(L.ac[0], a0); up4(L.ac[1], a1);
#pragma unroll
            for (int e = 0; e < 4; ++e) o[e] = geluf_(gt[e]) * ((t0[e] + a0[e] * L.ci[0][e]) + (t1[e] + a1[e] * L.ci[1][e]));
            st4(mix + (size_t)row * 1024 + 512 + c4, o); }
        { float uu[4], o[4]; up4(L.uD, uu); up4(L.y[6], t0); up4(L.y[7], t1);
#pragma unroll
            for (int e = 0; e < 4; ++e) o[e] = geluf_(sd[e] * uu[e] + t0[e] + t1[e]);
            st4(s5g + (size_t)row * 256 + c4, o); }
    };
    (void)hh;
    for (int row = gw; row < nrows; row += 2 * NGW) {
        CmbRow LA, LB; const int rowB = row + NGW; const bool hasB = rowB < nrows;
        ld(row, LA); if (hasB) ld(rowB, LB);
        cmp(row, LA); if (hasB) cmp(rowB, LB);
    }
}

__device__ __forceinline__ void p6_h2(const PV& P, int l, int nrows) {
    const int tid = otid(), lane = tid & 63, gw = blockIdx.x * 8 + (tid >> 6), NGW = gridDim.x * 8;
    const float* mod = (const float*)(P.ws + WS_MOD) + (size_t)l * 9 * 6144; const float* X1 = (const float*)(P.ws + WS_X1);
    bf16_t* act = (bf16_t*)(P.ws + WS_ACT);
    for (int row = gw; row < nrows; row += NGW) { const int mr = row < TL ? (row >> 11) : 8;
        float x[16], y[16]; load_row16(X1 + (size_t)row * 1024, lane, x);
        norm_mod16(x, PIN(I_N2G) + l * 1024, mod + (size_t)mr * 6144 + 3 * 1024, mod + (size_t)mr * 6144 + 4 * 1024, lane, y);
        store_row16_bf16(act + (size_t)row * 1024, lane, y); }
}

__device__ __forceinline__ unsigned skey(float f) { const unsigned u = __builtin_bit_cast(unsigned, f); return u ^ ((unsigned)((int)u >> 31) | 0x80000000u); }
__device__ __forceinline__ float unskey(unsigned s) { const unsigned u = (s & 0x80000000u) ? (s ^ 0x80000000u) : ~s; return __builtin_bit_cast(float, u); }

__device__ __forceinline__ void ce_(unsigned& a, unsigned& b) { const unsigned hi = max(a, b), lo = min(a, b); a = hi; b = lo; }
__device__ __forceinline__ void sort16_(unsigned (&v)[16]) {
#pragma unroll
    for (int k = 2; k <= 16; k <<= 1)
#pragma unroll
        for (int j = k >> 1; j > 0; j >>= 1)
#pragma unroll
            for (int i = 0; i < 16; ++i) { const int p = i ^ j; if (p > i) { if ((i & k) == 0) ce_(v[i], v[p]); else ce_(v[p], v[i]); } }
}
__device__ __forceinline__ void merge16_(unsigned (&a)[16], const unsigned (&b)[16]) {
#pragma unroll
    for (int i = 0; i < 16; ++i) a[i] = max(a[i], b[15 - i]);
#pragma unroll
    for (int j = 8; j > 0; j >>= 1)
#pragma unroll
        for (int i = 0; i < 16; ++i) { const int p = i ^ j; if (p > i) ce_(a[i], a[p]); }
}
__device__ __forceinline__ void p8a_topk(const PV& P, int nrows, LAS unsigned char* lds) {
    const int tid = otid();
    LAS unsigned* tb = (LAS unsigned*)lds;
    const GAS float* sc = (const GAS float*)(P.ws + WS_SC); GAS u32x2* list = (GAS u32x2*)(P.ws + WS_LIST);
    const int items = nrows * 16, nth = gridDim.x * 512;
    for (int item = blockIdx.x * 512 + tid; item < items; item += nth) {
        const int row = item >> 4, hp = item & 15, hh = hp >> 1, p = hp & 1;
        const GAS f32x4* sp = (const GAS f32x4*)(sc + (size_t)row * 2048 + hp * 128);
        unsigned top[16];
#pragma unroll 1
        for (int bk = 0; bk < 8; ++bk) { unsigned cur[16];
#pragma unroll
            for (int q = 0; q < 4; ++q) { const f32x4 v = sp[bk * 4 + q];
#pragma unroll
                for (int k = 0; k < 4; ++k) cur[q * 4 + k] = (skey(v[k]) & 0xFFFFFF80u) | (unsigned)(bk * 16 + q * 4 + k); }
            sort16_(cur);
            if (bk == 0) {
#pragma unroll
                for (int s = 0; s < 16; ++s) top[s] = cur[s];
            } else merge16_(top, cur); }
        float v1[16], v2[16]; unsigned i1[16], i2[16];
#pragma unroll
        for (int s = 0; s < 16; ++s) { const float mv = unskey(top[s] & 0xFFFFFF80u); const unsigned mi = top[s] & 127u;
            const float ov = dppf<0xB1>(mv); const unsigned oi = dppu<0xB1>(mi);
            v1[s] = p ? ov : mv; i1[s] = p ? oi : mi; v2[s] = p ? mv : ov; i2[s] = p ? mi : oi; }
        unsigned k2[16];
        { unsigned cand[64]; int n = 0;
#pragma unroll
            for (int a = 0; a < 16; ++a)
#pragma unroll
                for (int bb = 0; bb < 16; ++bb) if ((a + 1) * (bb + 1) <= 16) { cand[n] = (skey(v1[a] + v2[bb]) & 0xFFFFFF00u) | (unsigned)(a * 16 + bb); ++n; }
#pragma unroll
            for (int q = 50; q < 64; ++q) cand[q] = 0u;
#pragma unroll
            for (int bk = 0; bk < 4; ++bk) { unsigned cur[16];
#pragma unroll
                for (int s = 0; s < 16; ++s) cur[s] = cand[bk * 16 + s];
                sort16_(cur);
                if (bk == 0) {
#pragma unroll
                    for (int s = 0; s < 16; ++s) k2[s] = cur[s];
                } else merge16_(k2, cur); } }
#pragma unroll
        for (int s = 0; s < 16; ++s) { tb[s * 512 + tid] = i1[s]; tb[(16 + s) * 512 + tid] = i2[s]; }
        const float mx = unskey(k2[0] & 0xFFFFFF00u); float ev[16], sum = 0.f; unsigned pl[16];
#pragma unroll
        for (int s = 0; s < 16; ++s) { ev[s] = __expf(unskey(k2[s] & 0xFFFFFF00u) - mx); sum += ev[s];
            const unsigned a = (k2[s] >> 4) & 15u, bb = k2[s] & 15u; pl[s] = (tb[a * 512 + tid] << 7) | tb[(16 + bb) * 512 + tid]; }
        const float inv = __builtin_amdgcn_rcpf(sum);
        if (p == 0) { GAS u32x2* lp = list + (size_t)row * 128 + hh * 16;
#pragma unroll
            for (int s = 0; s < 16; ++s) lp[s] = (u32x2){pl[s], __builtin_bit_cast(unsigned, ev[s] * inv)}; }
    }
}

template <class PT> __device__ __forceinline__ void load_row16c(PT p, int lane, float (&x)[16]) {
#pragma unroll
    for (int k = 0; k < 4; ++k) { const f32x4 a = *(const GAS f32x4*)(p + 16 * lane + 4 * k);
#pragma unroll
        for (int e = 0; e < 4; ++e) x[4 * k + e] = a[e]; }
}
template <class PT> __device__ __forceinline__ void store_row16c_f32(PT p, int lane, const float (&x)[16]) {
#pragma unroll
    for (int k = 0; k < 4; ++k) *(GAS f32x4*)(p + 16 * lane + 4 * k) = (f32x4){x[4 * k], x[4 * k + 1], x[4 * k + 2], x[4 * k + 3]};
}
template <class PT> __device__ __forceinline__ void store_row16c_bf16(PT p, int lane, const float (&y)[16]) {
    u32x4 a, b; a.x = pk2(y[0], y[1]); a.y = pk2(y[2], y[3]); a.z = pk2(y[4], y[5]); a.w = pk2(y[6], y[7]);
    b.x = pk2(y[8], y[9]); b.y = pk2(y[10], y[11]); b.z = pk2(y[12], y[13]); b.w = pk2(y[14], y[15]);
    *(GAS u32x4*)(p + 16 * lane) = a; *(GAS u32x4*)(p + 16 * lane + 8) = b;
}
template <class G1, class G2> __device__ __forceinline__ void norm_mod16c(const float (&x)[16], G1 g, G2 shift, G2 scale, int lane, float (&y)[16]) {
    float ss = 0.f;
#pragma unroll
    for (int e = 0; e < 16; ++e) ss += x[e] * x[e];
    ss = wave_sum(ss);
    const float r = rsqrtf(ss * (1.0f / 1024.0f) + 1e-6f);
    float gg[16]; load_row16c(g, lane, gg);
    if (shift) { float sh[16], sc[16]; load_row16c(shift, lane, sh); load_row16c(scale, lane, sc);
#pragma unroll
        for (int e = 0; e < 16; ++e) y[e] = x[e] * r * gg[e] * (1.0f + sc[e]) + sh[e];
    } else {
#pragma unroll
        for (int e = 0; e < 16; ++e) y[e] = x[e] * r * gg[e];
    }
}
__device__ __forceinline__ void p8u_dots(const PV& P, int l, int nrows) {
    const int tid = otid(), lane = tid & 63, w = tid >> 6, eg = lane >> 3, cs = lane & 7;
    const bool sliced = (gridDim.x & 7) == 0;
    const int x0 = sliced ? (blockIdx.x & 7) : 0, xstep = sliced ? 8 : 1;
    const int gwx = sliced ? (blockIdx.x >> 3) * 8 + w : blockIdx.x * 8 + w, nW = sliced ? (gridDim.x >> 3) * 8 : gridDim.x * 8;
    const GAS unsigned* listw = (const GAS unsigned*)(P.ws + WS_LIST); const GAS bf16_t* h2 = (const GAS bf16_t*)(P.ws + WS_ACT);
    GAS float* pd = (GAS float*)(P.ws + WS_SC);
    for (int x = x0; x < 8; x += xstep) {
        const GAS unsigned char* U8 = (const GAS unsigned char*)P.ws + WS_U8 + (size_t)l * NEXP * 1024 + (size_t)x * NEXP * 128 + 16 * cs;
        unsigned idn[16]; u32x4 uu[16]; u32x4 hc0, hc1, hn0, hn1;
        int row = gwx;
        if (row < nrows) {
#pragma unroll
            for (int g = 0; g < 16; ++g) idn[g] = listw[((size_t)row * 128 + 8 * g + eg) * 2];
            hc0 = *(const GAS u32x4*)(h2 + (size_t)row * 1024 + 128 * x + 16 * cs); hc1 = *(const GAS u32x4*)(h2 + (size_t)row * 1024 + 128 * x + 16 * cs + 8);
#pragma unroll
            for (int g = 0; g < 16; ++g) uu[g] = *(const GAS u32x4*)(U8 + (size_t)idn[g] * 128);
            const int rn = row + nW < nrows ? row + nW : row;
#pragma unroll
            for (int g = 0; g < 16; ++g) idn[g] = listw[((size_t)rn * 128 + 8 * g + eg) * 2];
            hn0 = *(const GAS u32x4*)(h2 + (size_t)rn * 1024 + 128 * x + 16 * cs); hn1 = *(const GAS u32x4*)(h2 + (size_t)rn * 1024 + 128 * x + 16 * cs + 8);
        }
        for (; row < nrows; row += nW) {
            f32x2 hx[8];
            hx[0] = (f32x2){bflo(hc0.x), bfhi(hc0.x)}; hx[1] = (f32x2){bflo(hc0.y), bfhi(hc0.y)}; hx[2] = (f32x2){bflo(hc0.z), bfhi(hc0.z)}; hx[3] = (f32x2){bflo(hc0.w), bfhi(hc0.w)};
            hx[4] = (f32x2){bflo(hc1.x), bfhi(hc1.x)}; hx[5] = (f32x2){bflo(hc1.y), bfhi(hc1.y)}; hx[6] = (f32x2){bflo(hc1.z), bfhi(hc1.z)}; hx[7] = (f32x2){bflo(hc1.w), bfhi(hc1.w)};
#pragma unroll
            for (int k = 0; k < 8; ++k) asm volatile("" : "+v"(hx[k]));
            GAS float* pdr = pd + ((size_t)x * nrows + row) * 128 + 8 * cs + eg;
#pragma unroll
            for (int half = 0; half < 2; ++half) { float d[8];
#pragma unroll
                for (int gg = 0; gg < 8; ++gg) { const int g = 8 * half + gg; f32x2 a2 = (f32x2){0.f, 0.f};
#pragma unroll
                    for (int q = 0; q < 4; ++q) { const f32x2 lo = __builtin_amdgcn_cvt_pk_f32_fp8((int)uu[g][q], false), hi = __builtin_amdgcn_cvt_pk_f32_fp8((int)uu[g][q], true);
                        a2 += lo * hx[2 * q]; a2 += hi * hx[2 * q + 1]; }
                    uu[g] = *(const GAS u32x4*)(U8 + (size_t)idn[g] * 128);
                    d[gg] = a2[0] + a2[1]; }
                const bool c4 = (cs & 4) != 0, c2 = (cs & 2) != 0, c1 = (cs & 1) != 0;
                float e4[4], e2[2];
#pragma unroll
                for (int j = 0; j < 4; ++j) { const float snd = c4 ? d[j] : d[j + 4], kp = c4 ? d[j + 4] : d[j]; e4[j] = kp + dppf<0x141>(snd); }
#pragma unroll
                for (int j = 0; j < 2; ++j) { const float snd = c2 ? e4[j] : e4[j + 2], kp = c2 ? e4[j + 2] : e4[j]; e2[j] = kp + dppf<0x4E>(snd); }
                { const float snd = c1 ? e2[0] : e2[1], kp = c1 ? e2[1] : e2[0]; pdr[64 * half] = kp + dppf<0xB1>(snd); } }
            hc0 = hn0; hc1 = hn1;
            const int r2 = row + 2 * nW < nrows ? row + 2 * nW : row;
#pragma unroll
            for (int g = 0; g < 16; ++g) idn[g] = listw[((size_t)r2 * 128 + 8 * g + eg) * 2];
            hn0 = *(const GAS u32x4*)(h2 + (size_t)r2 * 1024 + 128 * x + 16 * cs); hn1 = *(const GAS u32x4*)(h2 + (size_t)r2 * 1024 + 128 * x + 16 * cs + 8);
        }
    }
}
__device__ __forceinline__ void p8c_coef(const PV& P, int nrows) {
    const int tid = otid();
    GAS unsigned* listw = (GAS unsigned*)(P.ws + WS_LIST); const GAS float* pd = (const GAS float*)(P.ws + WS_SC);
    const int n = nrows * 128, nth = gridDim.x * 512;
    for (int i = blockIdx.x * 512 + tid; i < n; i += nth) { float s = 0.f;
#pragma unroll
        for (int xx = 0; xx < 8; ++xx) s += pd[(size_t)xx * n + i];
        const float g = __builtin_bit_cast(float, listw[(size_t)i * 2 + 1]);
        listw[(size_t)i * 2 + 1] = __builtin_bit_cast(unsigned, g * geluf_(s * (1.0f / 32.0f)) * 0.5f); }
}
__device__ __forceinline__ void p8v_accum(const PV& P, int l, int nrows, LAS unsigned char* lds) {
    const int tid = otid(), lane = tid & 63, w = tid >> 6, eg = lane >> 3, cs = lane & 7;
    const bool sliced = (gridDim.x & 7) == 0;
    const int x0 = sliced ? (blockIdx.x & 7) : 0, xstep = sliced ? 8 : 1;
    const int gwx = sliced ? (blockIdx.x >> 3) * 8 + w : blockIdx.x * 8 + w, nW = sliced ? (gridDim.x >> 3) * 8 : gridDim.x * 8;
    const GAS unsigned* listw = (const GAS unsigned*)(P.ws + WS_LIST);
    const GAS float* modl = (const GAS float*)(P.ws + WS_MOD) + (size_t)l * 9 * 6144; const GAS float* X1 = (const GAS float*)(P.ws + WS_X1);
    LAS float* cl = (LAS float*)(lds + w * 1024);
    LAS unsigned* il = (LAS unsigned*)(cl + 128);
    const bool b5 = (lane & 32) != 0, b4 = (lane & 16) != 0, b3 = (lane & 8) != 0;
    for (int x = x0; x < 8; x += xstep) {
        const GAS unsigned char* V8 = (const GAS unsigned char*)P.ws + WS_V8 + (size_t)l * NEXP * 1024 + (size_t)x * NEXP * 128 + 16 * cs;
        unsigned n_i0, n_i1, n_c0, n_c1;
        u32x4 vv[16]; float cfc[16];
#define V_LOAD1(r) do { const GAS unsigned* lw = listw + ((size_t)(r) * 128 + lane) * 2; n_i0 = lw[0]; n_c0 = lw[1]; n_i1 = lw[128]; n_c1 = lw[129]; } while (0)
#define V_TOLDS() do { cl[lane] = __builtin_bit_cast(float, n_c0); cl[64 + lane] = __builtin_bit_cast(float, n_c1); il[lane] = n_i0; il[64 + lane] = n_i1; asm volatile("s_waitcnt lgkmcnt(0)" ::: "memory"); } while (0)
        int row = gwx;
        if (row < nrows) {
            V_LOAD1(row); V_TOLDS();
#pragma unroll
            for (int g = 0; g < 16; ++g) { const unsigned id = il[8 * g + eg]; cfc[g] = cl[8 * g + eg]; vv[g] = *(const GAS u32x4*)(V8 + (size_t)id * 128); }
            const int rn = row + nW < nrows ? row + nW : row;
            V_LOAD1(rn); asm volatile("s_waitcnt lgkmcnt(0)" ::: "memory"); V_TOLDS();
            const int r2 = row + 2 * nW < nrows ? row + 2 * nW : row;
            V_LOAD1(r2);
        }
        for (; row < nrows; row += nW) { const int mr = row < TL ? (row >> 11) : 8;
            f32x2 acc[8];
#pragma unroll
            for (int j = 0; j < 8; ++j) acc[j] = (f32x2){0.f, 0.f};
#pragma unroll
            for (int g = 0; g < 16; ++g) { const f32x2 c2 = (f32x2){cfc[g], cfc[g]};
#pragma unroll
                for (int q = 0; q < 4; ++q) { const f32x2 lo = __builtin_amdgcn_cvt_pk_f32_fp8((int)vv[g][q], false), hi = __builtin_amdgcn_cvt_pk_f32_fp8((int)vv[g][q], true);
                    acc[2 * q] += c2 * lo; acc[2 * q + 1] += c2 * hi; }
                const unsigned id = il[8 * g + eg]; cfc[g] = cl[8 * g + eg]; vv[g] = *(const GAS u32x4*)(V8 + (size_t)id * 128); }
            f32x2 a4[4], a2v[2], a1;
#pragma unroll
            for (int j = 0; j < 4; ++j) { const f32x2 snd = b5 ? acc[j] : acc[j + 4], kp = b5 ? acc[j + 4] : acc[j]; a4[j] = kp + (f32x2){__shfl_xor(snd[0], 32), __shfl_xor(snd[1], 32)}; }
#pragma unroll
            for (int j = 0; j < 2; ++j) { const f32x2 snd = b4 ? a4[j] : a4[j + 2], kp = b4 ? a4[j + 2] : a4[j]; a2v[j] = kp + (f32x2){__shfl_xor(snd[0], 16), __shfl_xor(snd[1], 16)}; }
            { const f32x2 snd = b3 ? a2v[0] : a2v[1], kp = b3 ? a2v[1] : a2v[0]; a1 = kp + (f32x2){__shfl_xor(snd[0], 8), __shfl_xor(snd[1], 8)}; }
            const int col = 128 * x + 16 * cs + 2 * eg;
            const f32x2 xm = *(const GAS f32x2*)(X1 + (size_t)row * 1024 + col), g5 = *(const GAS f32x2*)(modl + (size_t)mr * 6144 + 5 * 1024 + col);
            GAS float* xo = row < TL ? (GAS float*)P.out + (size_t)row * 1024 : (GAS float*)(P.ws + WS_X0C) + (size_t)(row - TL) * 1024;
            *(GAS f32x2*)(xo + col) = xm + g5 * a1;
            V_TOLDS();
            const int r3 = row + 3 * nW < nrows ? row + 3 * nW : row;
            V_LOAD1(r3);
        }
#undef V_LOAD1
#undef V_TOLDS
    }
}
__device__ __forceinline__ void p8w_norm(const PV& P, int l, int nrows) {
    const int tid = otid(), lane = tid & 63, gw = blockIdx.x * 8 + (tid >> 6), NGW = gridDim.x * 8;
    for (int row = gw; row < nrows; row += NGW) { const int mr = row < TL ? (row >> 11) : 8;
        float* xo = row < TL ? P.out + (size_t)row * 1024 : (float*)(P.ws + WS_X0C) + (size_t)(row - TL) * 1024;
        float xn[16], y[16]; load_row16c(xo, lane, xn);
        if (l == 0) { const float* mod1 = (const float*)(P.ws + WS_MOD) + (size_t)9 * 6144 + (size_t)mr * 6144;
            norm_mod16c(xn, PIN(I_N1G) + 1024, mod1, mod1 + 1024, lane, y);
            store_row16c_bf16((bf16_t*)(P.ws + WS_ACT) + (size_t)row * 1024, lane, y);
        } else { norm_mod16c(xn, PIN(I_FNG), (const float*)nullptr, (const float*)nullptr, lane, y); store_row16c_f32(xo, lane, y); }
    }
}

typedef __attribute__((address_space(1))) unsigned gu32;
#define XB_TMO      128
#define XB_XCNT(j)  (256  + 64 * (j))
#define XB_XSUB(j)  (1280 + 64 * (j))
#define XB_XGEN(j)  (2304 + 64 * (j))
#define XB_TOP      3328
#define XB_TOPGEN   3392
#define XCD_BAR_WORDS 3456
#define XB_SPIN_CAP (1u << 18)

__device__ __forceinline__ unsigned xb_ld(unsigned* p)              { return __hip_atomic_load(p, __ATOMIC_RELAXED, __HIP_MEMORY_SCOPE_AGENT); }
__device__ __forceinline__ unsigned xb_add(unsigned* p, unsigned v) { return __hip_atomic_fetch_add(p, v, __ATOMIC_RELAXED, __HIP_MEMORY_SCOPE_AGENT); }
__device__ __forceinline__ unsigned xb_xcc_id() { return (unsigned)__builtin_amdgcn_s_getreg((3 << 11) | 20) & 0xFu; }
#define XB_SPIN(cond, bar) do { unsigned _sp = 0; while (cond) { __builtin_amdgcn_s_sleep(1); \
    if ((++_sp & 255u) == 0u) { if (xb_ld(&(bar)[XB_TMO])) break; if (_sp > XB_SPIN_CAP) { atomicAdd(&(bar)[XB_TMO], 1u); break; } } } } while (0)

struct XcdBarrier {
    unsigned* bar; unsigned x;
    volatile LAS unsigned* st;
};

__device__ __forceinline__ XcdBarrier xcd_barrier_post(unsigned* bar, volatile LAS unsigned* st) {
    XcdBarrier b; b.bar = bar; b.x = xb_xcc_id(); b.st = st;
    if (threadIdx.x == 0) (void)xb_add(&bar[XB_XCNT(b.x)], 1u);
    return b;
}
__device__ __forceinline__ void xcd_barrier_complete(unsigned* bar, unsigned x, unsigned& nloc, unsigned& nx) {
    const unsigned G = gridDim.x * gridDim.y * gridDim.z;
    unsigned sum, cnt, mine, sp = 0u;
    for (;;) {
        sum = 0u; cnt = 0u; mine = 0u;
#pragma unroll
        for (unsigned j = 0; j < 16; ++j) { const unsigned c = xb_ld(&bar[XB_XCNT(j)]); sum += c; cnt += (c > 0u) ? 1u : 0u; mine = (j == x) ? c : mine; }
        if (sum == G) break;
        __builtin_amdgcn_s_sleep(1);
        if ((++sp & 255u) == 0u) { if (xb_ld(&bar[XB_TMO])) break; if (sp > XB_SPIN_CAP) { atomicAdd(&bar[XB_TMO], 1u); break; } }
    }
    nloc = mine > 0u ? mine : 1u; nx = cnt > 0u ? cnt : 1u;
}

__device__ __forceinline__ void xcd_barrier(const XcdBarrier& b) {
    asm volatile("s_waitcnt vmcnt(0)" ::: "memory");
    __syncthreads();
    if (threadIdx.x == 0) {
        unsigned* bar = b.bar;
        __builtin_amdgcn_s_waitcnt(0);
        unsigned nloc = b.st[0], nx = b.st[1];
        if (nloc == 0u) { xcd_barrier_complete(bar, b.x, nloc, nx); b.st[0] = nloc; b.st[1] = nx; }
        const unsigned old = xb_add(&bar[XB_XSUB(b.x)], 1u);
        const unsigned gen = old / nloc;
        if (old + 1u == (gen + 1u) * nloc) {
            __builtin_amdgcn_fence(__ATOMIC_RELEASE, "agent");
            asm volatile("s_waitcnt vmcnt(0)" ::: "memory");
            const unsigned og = xb_add(&bar[XB_TOP], 1u);
            const unsigned tg = og / nx;
            if (og + 1u == (tg + 1u) * nx) xb_add(&bar[XB_TOPGEN], 1u);
            else XB_SPIN(xb_ld(&bar[XB_TOPGEN]) == tg, bar);
            __builtin_amdgcn_fence(__ATOMIC_ACQUIRE, "agent");
            xb_add(&bar[XB_XGEN(b.x)], 1u);
            asm volatile("s_waitcnt vmcnt(0)" ::: "memory");
        } else {
            XB_SPIN(xb_ld(&bar[XB_XGEN(b.x)]) == gen, bar);
            __builtin_amdgcn_fence(__ATOMIC_ACQUIRE, "agent");
            asm volatile("s_waitcnt vmcnt(0)" ::: "memory");
        }
    }
    __syncthreads();
}

#define GSYNC() do { xcd_barrier(xbar); if (PROBE_DUP & 32) xcd_barrier(xbar); } while (0)
template <int l>
__device__ __forceinline__ void run_layer(const PV& P, const XcdBarrier& xbar) {
    const int nrows = l == 0 ? TT : TL;
    for (int rep = 0; rep < ((PROBE_DUP & 8) ? 2 : 1); ++rep) { const PV Q = opq(P);
        pg8::Gemm g{(const bf16_t*)(Q.ws + WS_ACT), (const bf16_t*)(Q.ws + WS_WIN) + (size_t)l * ZW * 1024, TT, ZW, 1024};
        pg8::StaticOrder S; S.init(TT, ZW, gridDim.x, blockIdx.x);
        pg8::EpiZ E{(bf16_t*)(Q.ws + WS_Z), ZW};
        pg8::gemm_phase<pg8::EpiZ, pg8::StaticOrder, true, true>(Q.lds, g, S, E);
        if (l == 0 && (int)gridDim.x == 256 && (int)blockIdx.x >= 24) p0_tables(Q, 1, blockIdx.x - 24, 232);
        else if (l == 0 && (int)gridDim.x != 256) p0_tables(Q, 1, blockIdx.x, gridDim.x); }
    GSYNC();
    for (int rep = 0; rep < ((PROBE_DUP & 128) ? 2 : 1); ++rep) { const PV Q = opq(P); rwkv_pre(Q, l, Q.lds); }
    for (int rep = 0; rep < ((PROBE_DUP & 65536) ? 2 : 1); ++rep) { const PV Q = opq(P); lru_items(Q, l, Q.lds); }
    GSYNC();
    for (int rep = 0; rep < ((PROBE_DUP & 2) ? 2 : 1); ++rep) {
        for (;;) {
            const PV Q = opq(P);
            __syncthreads();
            if (otid() == 0) *(LAS int*)(Q.lds + LDS_BYTES - 16) = (int)atomicAdd((unsigned*)(Q.ws + WS_CTL) + 64 * (1 + l + 2 * rep), 1u);
            __syncthreads();
            const int u = *(LAS int*)(Q.lds + LDS_BYTES - 16);
            if (u >= 272) break;
            if (u < 128) { for (int r2 = 0; r2 < ((PROBE_DUP & 16384) ? 2 : 1); ++r2) s5_unit(Q, l, u, Q.lds); }
            else if (u < 192) { for (int r2 = 0; r2 < ((PROBE_DUP & 4096) ? 2 : 1); ++r2) rwkv_seq(Q, l, u - 128, Q.lds); }
            else if (u < 256) { for (int r2 = 0; r2 < ((PROBE_DUP & 8192) ? 2 : 1); ++r2) ret_unit(Q, l, u - 192, Q.lds); }
            else lru_carry_unit(Q, u - 256);
        }
        if (PROBE_DUP & 2) GSYNC();
    }
    if (!(PROBE_DUP & 2)) GSYNC();
    for (int rep = 0; rep < ((PROBE_DUP & 16) ? 2 : 1); ++rep) { const PV Q = opq(P); p3_combine(Q, l, nrows, Q.lds); __syncthreads(); }
    GSYNC();
    for (int rep = 0; rep < ((PROBE_DUP & 8) ? 2 : 1); ++rep) { const PV Q = opq(P);
        pg8::Gemm g{(const bf16_t*)(Q.ws + WS_S5G), (const bf16_t*)(Q.ws + WS_GLU) + (size_t)l * 512 * 256, nrows, 512, 256};
        pg8::StaticOrder S; S.init(nrows, 512, gridDim.x, blockIdx.x);
        pg8::EpiGlu E{(bf16_t*)(Q.ws + WS_ACT), inp_(Q.tab, I_GLUB) + l * 512};
        pg8::gemm_phase<pg8::EpiGlu, pg8::StaticOrder, true, true>(Q.lds, g, S, E); }
    GSYNC();
    for (int rep = 0; rep < ((PROBE_DUP & 8) ? 2 : 1); ++rep) { const PV Q = opq(P);
        pg8::Gemm g{(const bf16_t*)(Q.ws + WS_ACT), (const bf16_t*)(Q.ws + WS_WOUT) + (size_t)l * 1024 * 1024, nrows, 1024, 1024};
        pg8::StaticOrder S; S.init(nrows, 1024, gridDim.x, blockIdx.x);
        pg8::EpiRes E{l == 0 ? inp_(Q.tab, I_X) : (const float*)Q.out, l == 0 ? inp_(Q.tab, I_CTX) : (const float*)(Q.ws + WS_X0C),
                      (const float*)(Q.ws + WS_MOD) + (size_t)l * 9 * 6144 + 2048, (float*)(Q.ws + WS_X1)};
        pg8::gemm_phase<pg8::EpiRes, pg8::StaticOrder, true, true>(Q.lds, g, S, E);
        if (l == 0 && (int)gridDim.x == 256 && (int)blockIdx.x >= 32) p0_transposes(Q, 1, blockIdx.x - 32, 224, Q.lds);
        else if (l == 0 && (int)gridDim.x != 256) p0_transposes(Q, 1, blockIdx.x, gridDim.x, Q.lds); }
    GSYNC();
    for (int rep = 0; rep < ((PROBE_DUP & 16) ? 2 : 1); ++rep) { const PV Q = opq(P); p6_h2(Q, l, nrows); }
    GSYNC();
    for (int rep = 0; rep < ((PROBE_DUP & 8) ? 2 : 1); ++rep) { const PV Q = opq(P);
        pg8::Gemm g{(const bf16_t*)(Q.ws + WS_ACT), (const bf16_t*)(Q.ws + WS_WEFF) + (size_t)l * 2048 * 1024, nrows, 2048, 1024};
        pg8::StaticOrder S; S.init(nrows, 2048, gridDim.x, blockIdx.x);
        pg8::EpiF32 E{(float*)(Q.ws + WS_SC), 2048};
        pg8::gemm_phase<pg8::EpiF32, pg8::StaticOrder, true, true>(Q.lds, g, S, E);
        if (l == 0 && (int)gridDim.x == 256 && (int)blockIdx.x >= 64) p0_weff(Q, 1, blockIdx.x - 64, 192, Q.lds);
        else if (l == 0 && (int)gridDim.x != 256) p0_weff(Q, 1, blockIdx.x, gridDim.x, Q.lds); }
    GSYNC();
    for (int rep = 0; rep < ((PROBE_DUP & 4) ? 2 : 1); ++rep) { const PV Q = opq(P); p8a_topk(Q, nrows, Q.lds); }
    GSYNC();
    for (int rep = 0; rep < ((PROBE_DUP & 1) ? 2 : 1); ++rep) { const PV Q = opq(P); p8u_dots(Q, l, nrows); }
    GSYNC();
    { const PV Q = opq(P); p8c_coef(Q, nrows); }
    GSYNC();
    for (int rep = 0; rep < ((PROBE_DUP & 2048) ? 2 : 1); ++rep) { const PV Q = opq(P); p8v_accum(Q, l, nrows, Q.lds); }
    GSYNC();
    { const PV Q = opq(P); p8w_norm(Q, l, nrows); }
    if (l == 0) GSYNC();
}

__global__ void __launch_bounds__(512, 2) fwd_mega(Params KP) {
    extern __shared__ __attribute__((aligned(16))) unsigned char lds_raw[];
    LAS unsigned char* lds = (LAS unsigned char*)lds_raw;
    cg::grid_group grid = cg::this_grid();
    const int tid = otid();
    PV P; P.tab = (const LAS unsigned*)(lds + LDS_BYTES - 1024); P.ws = KP.ws; P.out = KP.out; P.lds = lds;
    if (tid < 88) { const unsigned* ka = (const unsigned*)__builtin_amdgcn_kernarg_segment_ptr(); ((LAS unsigned*)(lds + LDS_BYTES - 1024))[tid] = ka[tid]; }
    if (tid < 4) ((LAS unsigned*)(lds + LDS_BYTES - 64))[tid] = 0u;
    __syncthreads();
    const XcdBarrier xbar = xcd_barrier_post((unsigned*)(KP.ws + WS_CTL) + 4096, (volatile LAS unsigned*)(lds + LDS_BYTES - 64));

    for (int rep = 0; rep < ((PROBE_DUP & 64) ? 2 : 1); ++rep) { const PV Q = opq(P); p0_prologue(Q, Q.lds); __syncthreads(); }
    if (KP.ws == nullptr) grid.sync();
    GSYNC();
    { const PV Q = opq(P); p0b_ain(Q); }
    GSYNC();

    run_layer<0>(P, xbar);
    run_layer<1>(P, xbar);
}

extern "C" void kernel_launch(void* const* d_in, const int* in_sizes, int n_in, void* d_out, int out_size, void* d_ws, size_t ws_size, hipStream_t stream) {
    static int grid = 0;
    if (grid == 0) {
        if (n_in != 44 || out_size != TL * DM || ws_size < WS_END) { fprintf(stderr, "kernel_launch: unexpected shapes (n_in %d, out %d, ws %zu; need ws >= %zu)\n", n_in, out_size, ws_size, (size_t)WS_END); grid = -1; return; }
        int dev = 0, cus = 0, per_cu = 0;
        hipGetDevice(&dev); hipDeviceGetAttribute(&cus, hipDeviceAttributeMultiprocessorCount, dev);
        hipFuncSetAttribute((const void*)fwd_mega, hipFuncAttributeMaxDynamicSharedMemorySize, LDS_BYTES);
        hipOccupancyMaxActiveBlocksPerMultiprocessor(&per_cu, (const void*)fwd_mega, 512, LDS_BYTES);
        if (per_cu < 1) { fprintf(stderr, "kernel_launch: occupancy query says %d blocks/CU\n", per_cu); per_cu = 1; }
        grid = cus;
        (void)hipGetLastError();
    }
    if (grid < 0) return;
    hipMemsetAsync((char*)d_ws + WS_CTL, 0, 65536, stream);
    Params p{};
    for (int i = 0; i < 44; ++i) p.in[i] = (const float*)d_in[i];
    p.out = (float*)d_out; p.ws = (unsigned char*)d_ws;
    void* args[] = {&p};
    hipError_t e = hipLaunchCooperativeKernel((const void*)fwd_mega, dim3(grid), dim3(512), args, LDS_BYTES, stream);
    if (e != hipSuccess) fprintf(stderr, "cooperative launch failed: %s (grid %d)\n", hipGetErrorString(e), grid);
}
```

```cpp
#include <hip/hip_runtime.h>
#include <hip/hip_cooperative_groups.h>
#include <hip/hip_fp16.h>
#include <cstdio>
#include <cstdint>
namespace cg = cooperative_groups;

#define LAS __attribute__((address_space(3)))
#define GAS __attribute__((address_space(1)))
typedef unsigned short bf16_t;
typedef short bf16x8 __attribute__((ext_vector_type(8)));
typedef float f32x4 __attribute__((ext_vector_type(4)));
typedef float f32x2 __attribute__((ext_vector_type(2)));
typedef unsigned u32x4 __attribute__((ext_vector_type(4)));
typedef unsigned u32x2 __attribute__((ext_vector_type(2)));
typedef _Float16 h16x2 __attribute__((ext_vector_type(2)));

constexpr int DM = 1024, NB = 8, SEQ = 2048, CTX = 256;
constexpr int TL = NB * SEQ;
constexpr int TC = NB * CTX;
constexpr int TT = TL + TC;
constexpr int ZW = 2816;
constexpr int INC = 2752;
constexpr int CB_ = 960, CC_ = 1984, CD_ = 2496;
constexpr int NEXP = 16384;

constexpr size_t MiB = 1u << 20;
constexpr size_t WS_CTL = 0;
constexpr size_t WS_MOD = 1 * MiB;
constexpr size_t WS_WIN = 2 * MiB;
constexpr size_t WS_WOUT = 14 * MiB;
constexpr size_t WS_WEFF = 18 * MiB;
constexpr size_t WS_GLU = 26 * MiB;
constexpr size_t WS_U8 = 28 * MiB;
constexpr size_t WS_V8 = 60 * MiB;
constexpr size_t WS_REC = 156 * MiB;
constexpr size_t WS_ACT = 156 * MiB;
constexpr size_t WS_S5G = 192 * MiB;
constexpr size_t WS_X1 = 202 * MiB;
constexpr size_t WS_X0C = 274 * MiB;
constexpr size_t WS_Z = 316 * MiB;
constexpr size_t WS_Y = 415 * MiB;
constexpr size_t WS_SC = 316 * MiB;
constexpr size_t WS_LIST = 462 * MiB;
constexpr size_t WS_ACU = 487 * MiB;
constexpr size_t WS_AGG = 505 * MiB;
constexpr size_t WS_CIN = 507 * MiB;
constexpr size_t WS_END = 508 * MiB;
constexpr size_t YSZ = (size_t)TT * 256;
static_assert(WS_SC + (size_t)TT * 2048 * 4 <= WS_LIST && WS_LIST + (size_t)TT * 128 * 8 <= WS_END, "ws map");
static_assert(WS_Y + 8 * YSZ * 2 <= WS_END && WS_Z + (size_t)TT * ZW * 2 <= WS_Y, "ws map");
static_assert(WS_REC + (size_t)64 * 72 * 36096 <= WS_Z, "ws map");

constexpr int LDS_BYTES = 147456;

struct Params { const float* in[44]; float* out; unsigned char* ws; };
struct PV { const LAS unsigned* tab; unsigned char* ws; float* out; LAS unsigned char* lds; };
__device__ __forceinline__ const float* inp_(const LAS unsigned* tab, int i) {
    const unsigned lo = (unsigned)__builtin_amdgcn_readfirstlane((int)tab[2 * i]), hi = (unsigned)__builtin_amdgcn_readfirstlane((int)tab[2 * i + 1]);
    return (const float*)(((unsigned long long)hi << 32) | (unsigned long long)lo);
}
#define PIN(i) inp_(P.tab, (i))
__device__ __forceinline__ PV opq(const PV& P) { PV q = P; unsigned o = 0; asm volatile("" : "+s"(q.ws), "+s"(q.out), "+s"(o)); q.lds = P.lds + o; q.tab = (const LAS unsigned*)(q.lds + LDS_BYTES - 1024); return q; }
enum { I_X = 0, I_C, I_CTX, I_CCTX, I_N1G, I_N2G, I_ADAW, I_ADAB, I_WIN, I_WOUT, I_MU, I_W0, I_WUP, I_A0, I_AUP, I_GUP, I_KK, I_KA, I_RK, I_LNG, I_LNB,
       I_GNG, I_CVW, I_CVB, I_WA, I_BA, I_WX, I_BX, I_LAM, I_SARE, I_SAIM, I_SLDT, I_SBRE, I_SBIM, I_SCRE, I_SCIM, I_SD, I_GLUW, I_GLUB, I_WQ, I_KEYS, I_PU, I_PV, I_FNG };

#define LDS_BARRIER() do { asm volatile("s_waitcnt lgkmcnt(0)" ::: "memory"); __builtin_amdgcn_s_barrier(); asm volatile("" ::: "memory"); } while (0)
__device__ __forceinline__ int otid() { int t = threadIdx.x; asm volatile("" : "+v"(t)); return t; }
__device__ __forceinline__ unsigned f2bf(float f) { unsigned u = __builtin_bit_cast(unsigned, f); return (u + 0x7fffu + ((u >> 16) & 1u)) >> 16; }
__device__ __forceinline__ unsigned pk2(float lo, float hi) { return f2bf(lo) | (f2bf(hi) << 16); }
__device__ __forceinline__ unsigned pk2a(float lo, float hi) { unsigned r; asm("v_cvt_pk_bf16_f32 %0, %1, %2" : "=v"(r) : "v"(lo), "v"(hi)); return r; }
__device__ __forceinline__ float bf2f(unsigned b) { return __builtin_bit_cast(float, b << 16); }
__device__ __forceinline__ float bflo(unsigned w) { return __builtin_bit_cast(float, w << 16); }
__device__ __forceinline__ float bfhi(unsigned w) { return __builtin_bit_cast(float, w & 0xffff0000u); }

template <int CTRL> __device__ __forceinline__ float dppf(float v) {
    return __builtin_bit_cast(float, __builtin_amdgcn_update_dpp(0, __builtin_bit_cast(int, v), CTRL, 0xF, 0xF, true));
}
template <int CTRL> __device__ __forceinline__ unsigned dppu(unsigned v) {
    return (unsigned)__builtin_amdgcn_update_dpp(0, (int)v, CTRL, 0xF, 0xF, true);
}
__device__ __forceinline__ float sum8(float v) {
    v += dppf<0xB1>(v);
    v += dppf<0x4E>(v);
    v += dppf<0x141>(v);
    return v;
}
__device__ __forceinline__ float wave_sum(float v) {
    v = sum8(v); v += dppf<0x140>(v);
    const float s0 = __builtin_bit_cast(float, __builtin_amdgcn_readlane(__builtin_bit_cast(int, v), 0)), s1 = __builtin_bit_cast(float, __builtin_amdgcn_readlane(__builtin_bit_cast(int, v), 16));
    const float s2 = __builtin_bit_cast(float, __builtin_amdgcn_readlane(__builtin_bit_cast(int, v), 32)), s3 = __builtin_bit_cast(float, __builtin_amdgcn_readlane(__builtin_bit_cast(int, v), 48));
    return (s0 + s1) + (s2 + s3);
}
__device__ __forceinline__ float sigmoidf_(float x) { return __builtin_amdgcn_rcpf(1.0f + __expf(-x)); }
__device__ __forceinline__ float tanhf_(float x) { return 1.0f - 2.0f * __builtin_amdgcn_rcpf(1.0f + __expf(2.0f * x)); }
__device__ __forceinline__ float softplusf_(float x) { return fmaxf(x, 0.0f) + __logf(1.0f + __expf(-fabsf(x))); }
__device__ __forceinline__ float geluf_(float x) { return 0.5f * x * (1.0f + tanhf_(0.7978845608f * (x + 0.044715f * x * x * x))); }
__device__ __forceinline__ float siluf_(float x) { return x * sigmoidf_(x); }

template <int MT, int NT, int KS>
__device__ __forceinline__ void lds_mma(f32x4 (&acc)[MT][NT], const LAS bf16_t* A, int lda, const LAS bf16_t* Bt, int ldb, int lane) {
    const int r = lane & 15, q = lane >> 4;
#pragma unroll
    for (int ks = 0; ks < KS; ++ks) {
        bf16x8 a[MT], b[NT];
#pragma unroll
        for (int m = 0; m < MT; ++m) a[m] = *(const LAS bf16x8*)(A + (m * 16 + r) * lda + ks * 32 + q * 8);
#pragma unroll
        for (int n = 0; n < NT; ++n) b[n] = *(const LAS bf16x8*)(Bt + (n * 16 + r) * ldb + ks * 32 + q * 8);
#pragma unroll
        for (int m = 0; m < MT; ++m)
#pragma unroll
            for (int n = 0; n < NT; ++n) acc[m][n] = __builtin_amdgcn_mfma_f32_16x16x32_bf16(b[n], a[m], acc[m][n], 0, 0, 0);
    }
}
template <int MT, int NT> __device__ __forceinline__ void zero_acc(f32x4 (&acc)[MT][NT]) {
#pragma unroll
    for (int m = 0; m < MT; ++m)
#pragma unroll
        for (int n = 0; n < NT; ++n) acc[m][n] = (f32x4){0.f, 0.f, 0.f, 0.f};
}

namespace pg8 {
#define PG8_LAS __attribute__((address_space(3)))
typedef unsigned short bf16_t;
typedef short bf16x8 __attribute__((ext_vector_type(8)));
typedef float f32x4 __attribute__((ext_vector_type(4)));
typedef unsigned u32x4 __attribute__((ext_vector_type(4)));
constexpr int BM = 256, BK = 64, HALF = 128, HTB = HALF * BK * 2  , STAGE_BYTES = 8 * HTB, NXCD = 8, WGM = 8;

__host__ __device__ __forceinline__ int lds_byte(int r, int c) { const int st = (r >> 4) * 2 + (c >> 5), rr = r & 15, cc = c & 31, ob = rr * 64 + cc * 2; return st * 1024 + (ob ^ (((ob >> 9) & 1) << 5)); }
__host__ __device__ __forceinline__ void stage_rc(int b, int& R, int& C) { const int st = b / 1024, sb = b % 1024, swz = sb ^ (((sb >> 9) & 1) << 5); R = (st >> 1) * 16 + swz / 64; C = (st & 1) * 32 + (swz % 64) / 2; }
__host__ __device__ __forceinline__ int perm32(int rho) { const int n = rho >> 4, i = rho & 15; return 8 * (i >> 2) + 4 * n + (i & 3); }

struct Unit { int pm, pn; };
struct Gemm { const bf16_t* A; const bf16_t* Bt; int M, N, K; };

struct StaticOrder {
    int nM, nN, nwg, G, c;
    __host__ __device__ void init(int M, int N, int G_, int c_) { nM = M / BM; nN = N / BM; nwg = nM * nN; G = G_; c = c_; }
    __host__ __device__ bool next(int i, Unit& u) const {
        const long L = (long)i * G + c; if (L >= nwg) return false;
        int wgid = (int)L; { const int q = nwg / NXCD, r = nwg % NXCD, xcd = wgid % NXCD, off = wgid / NXCD; wgid = (xcd < r ? xcd * (q + 1) : r * (q + 1) + (xcd - r) * q) + off; }
        const int nig = WGM * nN, gid = wgid / nig, fm = gid * WGM, gsz = (nM - fm) < WGM ? (nM - fm) : WGM;
        u.pm = fm + ((wgid % nig) % gsz); u.pn = (wgid % nig) / gsz; return true;
    }
    __device__ __forceinline__ void a_ready(const Unit&) const {}
    __device__ __forceinline__ void done(const Unit&) const {}
};


__device__ __forceinline__ unsigned cvt_pk_bf16(float lo, float hi) { unsigned r; asm volatile("v_cvt_pk_bf16_f32 %0, %1, %2" : "=v"(r) : "v"(lo), "v"(hi)); return r; }

struct EpiZ {
    static constexpr bool PERM = true, AFTER_DRAIN = false;
    bf16_t* O; int ldc;
    __device__ __forceinline__ void operator()(const f32x4 (&acc)[2][2][4][2], const Unit& u, int wr, int wc, int fr, int fq) const {
        const int row0 = u.pm * BM + wr * 64 + fr, col0 = u.pn * BM + wc * 32 + 8 * fq;
#pragma unroll
        for (int ai = 0; ai < 2; ++ai)
#pragma unroll
            for (int m = 0; m < 4; ++m) { bf16_t* rowp = O + (size_t)(row0 + ai * HALF + m * 16) * ldc + col0;
#pragma unroll
                for (int bj = 0; bj < 2; ++bj) { const f32x4 v0 = acc[ai][bj][m][0], v1 = acc[ai][bj][m][1];
                    u32x4 w; w.x = cvt_pk_bf16(v0[0], v0[1]); w.y = cvt_pk_bf16(v0[2], v0[3]); w.z = cvt_pk_bf16(v1[0], v1[1]); w.w = cvt_pk_bf16(v1[2], v1[3]);
                    *(u32x4*)(rowp + bj * HALF) = w; } }
    }
};
struct EpiGlu {
    static constexpr bool PERM = false, AFTER_DRAIN = false;
    bf16_t* O; const float* gb;
    __device__ __forceinline__ void operator()(const f32x4 (&acc)[2][2][4][2], const Unit& u, int wr, int wc, int fr, int fq) const {
#pragma unroll
        for (int ai = 0; ai < 2; ++ai)
#pragma unroll
            for (int m = 0; m < 4; ++m) { const int row = u.pm * BM + ai * HALF + wr * 64 + m * 16 + fr;
#pragma unroll
                for (int n = 0; n < 2; ++n) { const int ch = u.pn * 128 + wc * 32 + n * 16 + 4 * fq;
                    const float* gp = gb; asm volatile("" : "+s"(gp));
                    const f32x4 bv = *(const f32x4*)(gp + ch), bg = *(const f32x4*)(gp + 256 + ch);
                    const f32x4 v = acc[ai][0][m][n] + bv, g = acc[ai][1][m][n] + bg; float o[4];
#pragma unroll
                    for (int e = 0; e < 4; ++e) o[e] = v[e] * __builtin_amdgcn_rcpf(1.0f + __expf(-g[e]));
                    unsigned lo = cvt_pk_bf16(o[0], o[1]), hi = cvt_pk_bf16(o[2], o[3]);
                    *(unsigned long long*)(O + (size_t)row * 1024 + 768 + ch) = (unsigned long long)lo | ((unsigned long long)hi << 32); } }
    }
};
struct EpiRes {
    static constexpr bool PERM = false, AFTER_DRAIN = false;
    const float* baseL; const float* baseC; const float* gate; float* out;
    __device__ __forceinline__ void operator()(const f32x4 (&acc)[2][2][4][2], const Unit& u, int wr, int wc, int fr, int fq) const {
        const int rowt = u.pm * BM; const int mr = rowt < 16384 ? (rowt >> 11) : 8;
        const float* grow = gate + (size_t)mr * 6144;
#pragma unroll
        for (int bj = 0; bj < 2; ++bj)
#pragma unroll
            for (int n = 0; n < 2; ++n) { const int col = u.pn * BM + bj * HALF + wc * 32 + n * 16 + 4 * fq; const f32x4 gv = *(const f32x4*)(grow + col);
#pragma unroll
                for (int ai = 0; ai < 2; ++ai)
#pragma unroll
                    for (int m = 0; m < 4; ++m) { const int row = rowt + ai * HALF + wr * 64 + m * 16 + fr;
                        const float* bp = row < 16384 ? baseL + (size_t)row * 1024 + col : baseC + (size_t)(row - 16384) * 1024 + col;
                        const f32x4 bs = *(const f32x4*)bp; *(f32x4*)(out + (size_t)row * 1024 + col) = bs + gv * acc[ai][bj][m][n]; } }
    }
};
struct EpiF32 {
    static constexpr bool PERM = false, AFTER_DRAIN = false;
    float* O; int ldc;
    __device__ __forceinline__ void operator()(const f32x4 (&acc)[2][2][4][2], const Unit& u, int wr, int wc, int fr, int fq) const {
#pragma unroll
        for (int ai = 0; ai < 2; ++ai)
#pragma unroll
            for (int m = 0; m < 4; ++m) { const int row = u.pm * BM + ai * HALF + wr * 64 + m * 16 + fr;
#pragma unroll
                for (int bj = 0; bj < 2; ++bj)
#pragma unroll
                    for (int n = 0; n < 2; ++n) { const int col = u.pn * BM + bj * HALF + wc * 32 + n * 16 + 4 * fq;
                        *(f32x4*)(O + (size_t)row * ldc + col) = acc[ai][bj][m][n]; } }
    }
};

template <class Epi, class Sched, bool ALIGN_EPI = false, bool SP2 = false>
__device__ __forceinline__ void gemm_phase(PG8_LAS unsigned char* lds, const Gemm g, const Sched& S, const Epi& E) {
    int tid_ = threadIdx.x; asm volatile("" : "+v"(tid_));
    const int tid = tid_, wid = __builtin_amdgcn_readfirstlane(tid >> 6), lane = tid & 63, wr = wid >> 2, wc = wid & 3, fr = lane & 15, fq = lane >> 4;
    const int K = g.K, nt = K / BK;
    unsigned voffA[2], voffB[2];
#pragma unroll
    for (int i = 0; i < 2; ++i) { int R, C; stage_rc(tid * 16 + i * 8192, R, C); const int Rb = Epi::PERM ? ((R & ~31) + perm32(R & 31)) : R;
        voffA[i] = (unsigned)(R * K + C) * 2u; voffB[i] = (unsigned)(Rb * K + C) * 2u; }
    const size_t kstep = (size_t)(BK * 2);
    const size_t hstep = (size_t)HALF * K * 2;
    const size_t tstep = 2 * hstep;
    const unsigned ldsw = (unsigned)wid * 1024u;
    const int aoff = lds_byte(wr * 64 + fr, fq * 8), boff = lds_byte(wc * 32 + fr, fq * 8);
#define PG8_SA(b, h) (((b) * 2 + (h)) * HTB)
#define PG8_SB(b, h) ((4 + (b) * 2 + (h)) * HTB)
#define PG8_STAGE(bufoff, gbase, voff) do { _Pragma("unroll") for (int _i = 0; _i < 2; ++_i) \
        __builtin_amdgcn_global_load_lds((const unsigned*)((const char*)(gbase) + (voff)[_i]), (PG8_LAS unsigned*)(lds + (bufoff) + ldsw + _i * 8192), 16, 0, 0); } while (0)
#define PG8_LDA(dst, b, h) do { _Pragma("unroll") for (int m = 0; m < 4; ++m) _Pragma("unroll") for (int k = 0; k < 2; ++k) dst[m][k] = *(const PG8_LAS bf16x8*)(lds + PG8_SA(b, h) + aoff + m * 2048 + k * 1024); } while (0)
#define PG8_LDB(dst, b, h) do { _Pragma("unroll") for (int n = 0; n < 2; ++n) _Pragma("unroll") for (int k = 0; k < 2; ++k) dst[n][k] = *(const PG8_LAS bf16x8*)(lds + PG8_SB(b, h) + boff + n * 2048 + k * 1024); } while (0)
#define PG8_MMA(ai, bj, At, Bt) do { __builtin_amdgcn_s_setprio(1); _Pragma("unroll") for (int m = 0; m < 4; ++m) _Pragma("unroll") for (int n = 0; n < 2; ++n) _Pragma("unroll") for (int k = 0; k < 2; ++k) \
        acc[ai][bj][m][n] = __builtin_amdgcn_mfma_f32_16x16x32_bf16(Bt[n][k], At[m][k], acc[ai][bj][m][n], 0, 0, 0); __builtin_amdgcn_s_setprio(0); } while (0)
#define PG8_WAIT_V(n) asm volatile("s_waitcnt vmcnt(" #n ")" ::: "memory")
#define PG8_WAIT_L(n) asm volatile("s_waitcnt lgkmcnt(" #n ")" ::: "memory")
#define PG8_BAR __builtin_amdgcn_s_barrier()
#define PG8_SCHED __builtin_amdgcn_sched_barrier(0)
    Unit cur, nxt; int ui = 0;
    if (!S.next(0, cur)) return;
    f32x4 acc[2][2][4][2];
#pragma unroll
    for (int a = 0; a < 2; ++a)
#pragma unroll
        for (int b = 0; b < 2; ++b)
#pragma unroll
            for (int m = 0; m < 4; ++m)
#pragma unroll
                for (int n = 0; n < 2; ++n) acc[a][b][m][n] = (f32x4){0.f, 0.f, 0.f, 0.f};
    bf16x8 At[4][2], B0[2][2], B1[2][2];
    const char* cA = (const char*)g.A + (size_t)cur.pm * tstep; const char* cB = (const char*)g.Bt + (size_t)cur.pn * tstep;
    S.a_ready(cur);
    if constexpr (SP2) {
        PG8_STAGE(PG8_SB(0, 0), cB, voffB); PG8_STAGE(PG8_SB(0, 1), cB + hstep, voffB); PG8_STAGE(PG8_SA(0, 0), cA, voffA); PG8_STAGE(PG8_SA(0, 1), cA + hstep, voffA);
        if (wr == 1) PG8_BAR;
        PG8_WAIT_V(2); PG8_BAR;
        PG8_STAGE(PG8_SB(1, 0), cB + kstep, voffB); PG8_STAGE(PG8_SA(1, 0), cA + kstep, voffA); PG8_STAGE(PG8_SB(1, 1), cB + hstep + kstep, voffB);
        PG8_WAIT_V(6); PG8_BAR;
    } else {
        PG8_STAGE(PG8_SB(0, 0), cB, voffB); PG8_STAGE(PG8_SA(0, 0), cA, voffA); PG8_STAGE(PG8_SB(0, 1), cB + hstep, voffB); PG8_STAGE(PG8_SA(0, 1), cA + hstep, voffA);
        if (wr == 1) PG8_BAR;
        PG8_WAIT_V(4); PG8_BAR;
        PG8_STAGE(PG8_SB(1, 0), cB + kstep, voffB); PG8_STAGE(PG8_SA(1, 0), cA + kstep, voffA); PG8_STAGE(PG8_SB(1, 1), cB + hstep + kstep, voffB);
        PG8_WAIT_V(6); PG8_BAR;
    }
    for (;;) {
        const bool has_next = S.next(ui + 1, nxt);
        const char* nA = has_next ? (const char*)g.A + (size_t)nxt.pm * tstep : cA; const char* nB = has_next ? (const char*)g.Bt + (size_t)nxt.pn * tstep : cB;
        for (int t = 0; t < nt; t += 2) {
            const bool last = (t == nt - 2);
            const char* a1 = cA + (size_t)(t + 1) * kstep;
            const char* a2 = last ? nA : cA + (size_t)(t + 2) * kstep; const char* b2 = last ? nB : cB + (size_t)(t + 2) * kstep;
            const char* a3 = a2 + kstep; const char* b3 = b2 + kstep;
            if (last && has_next) S.a_ready(nxt);
            if constexpr (SP2) {
            PG8_LDB(B0, 0, 0); PG8_LDB(B1, 0, 1); PG8_SCHED; PG8_LDA(At, 0, 0); PG8_STAGE(PG8_SA(1, 1), a1 + hstep, voffA);
            PG8_WAIT_V(8); PG8_WAIT_L(0); PG8_BAR; PG8_MMA(0, 0, At, B0); PG8_MMA(0, 1, At, B1); PG8_BAR; PG8_SCHED;
            PG8_LDA(At, 0, 1); PG8_STAGE(PG8_SB(0, 0), b2, voffB); PG8_STAGE(PG8_SB(0, 1), b2 + hstep, voffB); PG8_STAGE(PG8_SA(0, 0), a2, voffA);
            PG8_WAIT_V(8); PG8_WAIT_L(0); PG8_BAR; PG8_MMA(1, 0, At, B0); PG8_MMA(1, 1, At, B1); PG8_BAR; PG8_SCHED;
            PG8_LDB(B0, 1, 0); PG8_LDB(B1, 1, 1); PG8_SCHED; PG8_LDA(At, 1, 0); PG8_STAGE(PG8_SA(0, 1), a2 + hstep, voffA);
            PG8_WAIT_V(8); PG8_WAIT_L(0); PG8_BAR; PG8_MMA(0, 0, At, B0); PG8_MMA(0, 1, At, B1); PG8_BAR; PG8_SCHED;
            PG8_LDA(At, 1, 1); PG8_STAGE(PG8_SB(1, 0), b3, voffB); PG8_STAGE(PG8_SB(1, 1), b3 + hstep, voffB); PG8_STAGE(PG8_SA(1, 0), a3, voffA);
            PG8_WAIT_V(8); PG8_WAIT_L(0); PG8_BAR; PG8_MMA(1, 0, At, B0); PG8_MMA(1, 1, At, B1); PG8_BAR; PG8_SCHED;
            } else {
            PG8_LDB(B0, 0, 0); PG8_SCHED; PG8_LDA(At, 0, 0); PG8_STAGE(PG8_SA(1, 1), a1 + hstep, voffA);
            PG8_WAIT_L(8); PG8_BAR; PG8_WAIT_L(0); PG8_MMA(0, 0, At, B0); PG8_BAR; PG8_SCHED;
            PG8_LDB(B1, 0, 1); PG8_STAGE(PG8_SB(0, 0), b2, voffB);
            PG8_BAR; PG8_WAIT_L(0); PG8_MMA(0, 1, At, B1); PG8_BAR;
            PG8_LDA(At, 0, 1); PG8_STAGE(PG8_SA(0, 0), a2, voffA);
            PG8_BAR; PG8_WAIT_L(0); PG8_MMA(1, 0, At, B0); PG8_BAR; PG8_SCHED;
            PG8_STAGE(PG8_SB(0, 1), b2 + hstep, voffB);
            PG8_WAIT_V(6); PG8_BAR; PG8_MMA(1, 1, At, B1); PG8_BAR;
            PG8_LDB(B0, 1, 0); PG8_SCHED; PG8_LDA(At, 1, 0); PG8_STAGE(PG8_SA(0, 1), a2 + hstep, voffA);
            PG8_WAIT_L(8); PG8_BAR; PG8_WAIT_L(0); PG8_MMA(0, 0, At, B0); PG8_BAR; PG8_SCHED;
            PG8_LDB(B1, 1, 1); PG8_STAGE(PG8_SB(1, 0), b3, voffB);
            PG8_BAR; PG8_WAIT_L(0); PG8_MMA(0, 1, At, B1); PG8_BAR;
            PG8_LDA(At, 1, 1); PG8_STAGE(PG8_SA(1, 0), a3, voffA);
            PG8_BAR; PG8_WAIT_L(0); PG8_MMA(1, 0, At, B0); PG8_BAR; PG8_SCHED;
            PG8_STAGE(PG8_SB(1, 1), b3 + hstep, voffB);
            PG8_WAIT_V(6); PG8_BAR; PG8_MMA(1, 1, At, B1); PG8_BAR;
            }
        }
        if constexpr (ALIGN_EPI) { if (wr == 0) PG8_BAR; }
        if constexpr (!Epi::AFTER_DRAIN) { E(acc, cur, wr, wc, fr, fq); S.done(cur); }
        if (!has_next) break;
#pragma unroll
        for (int a = 0; a < 2; ++a)
#pragma unroll
            for (int b = 0; b < 2; ++b)
#pragma unroll
                for (int m = 0; m < 4; ++m)
#pragma unroll
                    for (int n = 0; n < 2; ++n) acc[a][b][m][n] = (f32x4){0.f, 0.f, 0.f, 0.f};
        cur = nxt; cA = nA; cB = nB; ++ui;
        if constexpr (ALIGN_EPI) { if (wr == 1) PG8_BAR; }
    }
    PG8_WAIT_V(0);
    if constexpr (!ALIGN_EPI) { if (wr == 0) PG8_BAR; }
    PG8_BAR;
    if constexpr (Epi::AFTER_DRAIN) { E.fused(acc, cur, wr, wc, fr, fq, lds, wid, lane); S.done(cur); }
#undef PG8_SA
#undef PG8_SB
#undef PG8_STAGE
#undef PG8_LDA
#undef PG8_LDB
#undef PG8_MMA
#undef PG8_WAIT_V
#undef PG8_WAIT_L
#undef PG8_BAR
#undef PG8_SCHED
}
}
#ifndef PROBE_DUP
#define PROBE_DUP 0
#endif

template <class PT> __device__ __forceinline__ void load_row16(PT p, int lane, float (&x)[16]) {
    const f32x4 a = *(const GAS f32x4*)(p + 8 * lane), b = *(const GAS f32x4*)(p + 8 * lane + 4), c = *(const GAS f32x4*)(p + 512 + 8 * lane), d = *(const GAS f32x4*)(p + 512 + 8 * lane + 4);
#pragma unroll
    for (int e = 0; e < 4; ++e) { x[e] = a[e]; x[4 + e] = b[e]; x[8 + e] = c[e]; x[12 + e] = d[e]; }
}
__device__ __forceinline__ void store_row16_f32(float* p, int lane, const float (&x)[16]) {
    *(f32x4*)(p + 8 * lane) = (f32x4){x[0], x[1], x[2], x[3]}; *(f32x4*)(p + 8 * lane + 4) = (f32x4){x[4], x[5], x[6], x[7]};
    *(f32x4*)(p + 512 + 8 * lane) = (f32x4){x[8], x[9], x[10], x[11]}; *(f32x4*)(p + 512 + 8 * lane + 4) = (f32x4){x[12], x[13], x[14], x[15]};
}
template <class PT> __device__ __forceinline__ void store_row16_bf16(PT p, int lane, const float (&y)[16]) {
    u32x4 a, b; a.x = pk2(y[0], y[1]); a.y = pk2(y[2], y[3]); a.z = pk2(y[4], y[5]); a.w = pk2(y[6], y[7]);
    b.x = pk2(y[8], y[9]); b.y = pk2(y[10], y[11]); b.z = pk2(y[12], y[13]); b.w = pk2(y[14], y[15]);
    *(GAS u32x4*)(p + 8 * lane) = a; *(GAS u32x4*)(p + 512 + 8 * lane) = b;
}
template <class G1, class G2> __device__ __forceinline__ void norm_mod16(const float (&x)[16], G1 g, G2 shift, G2 scale, int lane, float (&y)[16]) {
    float ss = 0.f;
#pragma unroll
    for (int e = 0; e < 16; ++e) ss += x[e] * x[e];
    ss = wave_sum(ss);
    const float r = rsqrtf(ss * (1.0f / 1024.0f) + 1e-6f);
    float gg[16]; load_row16(g, lane, gg);
    if (shift) { float sh[16], sc[16]; load_row16(shift, lane, sh); load_row16(scale, lane, sc);
#pragma unroll
        for (int e = 0; e < 16; ++e) y[e] = x[e] * r * gg[e] * (1.0f + sc[e]) + sh[e];
    } else {
#pragma unroll
        for (int e = 0; e < 16; ++e) y[e] = x[e] * r * gg[e];
    }
}

template <int MODE>
__device__ __forceinline__ void transpose_item(const float* W, int K, int N, bf16_t* WT, LAS float* scr, int item, int lane) {
    const int nblk = N / 32, kb = item / nblk, nb = item % nblk, k0 = 64 * kb, n0 = 32 * nb;
#pragma unroll 8
    for (int i = 0; i < 32; ++i) { const int kk = 2 * i + (lane >> 5); scr[kk * 33 + (lane & 31)] = W[(size_t)(k0 + kk) * N + n0 + (lane & 31)]; }
    asm volatile("s_waitcnt lgkmcnt(0)" ::: "memory");
    const int c = lane & 7;
#pragma unroll
    for (int j = 0; j < 4; ++j) { const int n = (lane >> 3) + 8 * j; const LAS float* s = scr + (8 * c) * 33 + n;
        u32x4 o; o.x = pk2(s[0 * 33], s[1 * 33]); o.y = pk2(s[2 * 33], s[3 * 33]); o.z = pk2(s[4 * 33], s[5 * 33]); o.w = pk2(s[6 * 33], s[7 * 33]);
        int row = n0 + n;
        if (MODE == 1) { const int ch = row & 255, gatepart = row >> 8; row = (ch >> 7) * 256 + gatepart * 128 + (ch & 127); }
        *(u32x4*)(WT + (size_t)row * K + k0 + 8 * c) = o; }
    asm volatile("s_waitcnt lgkmcnt(0)" ::: "memory");
}

__device__ __forceinline__ void p0_transposes(const PV& P, int l, int part, int nparts, LAS unsigned char* lds) {
    const int tid = otid(), lane = tid & 63, w = tid >> 6;
    unsigned char* ws = P.ws;
    LAS float* scr = (LAS float*)(lds + w * 8448);
    const int gw = part * 8 + w, NGW = nparts * 8;
    constexpr int I_IN = 16 * (INC / 32), I_OUT = 16 * 32, I_GL = 4 * 16, PER_L = I_IN + I_OUT + I_GL;
    for (int it = gw; it < PER_L; it += NGW) { int r = it;
        if (r < I_IN) { transpose_item<0>(PIN(I_WIN) + (size_t)l * 1024 * INC, 1024, INC, (bf16_t*)(ws + WS_WIN) + (size_t)l * ZW * 1024, scr, r, lane); continue; } r -= I_IN;
        if (r < I_OUT) { transpose_item<0>(PIN(I_WOUT) + (size_t)l * 1024 * 1024, 1024, 1024, (bf16_t*)(ws + WS_WOUT) + (size_t)l * 1024 * 1024, scr, r, lane); continue; } r -= I_OUT;
        transpose_item<1>(PIN(I_GLUW) + (size_t)l * 256 * 512, 256, 512, (bf16_t*)(ws + WS_GLU) + (size_t)l * 512 * 256, scr, r, lane); }
    for (int i = part * 512 + tid; i < 8192; i += nparts * 512) *(GAS u32x4*)((bf16_t*)(ws + WS_WIN) + ((size_t)l * ZW + INC) * 1024 + (size_t)i * 8) = (u32x4){0u, 0u, 0u, 0u};
}
__device__ __forceinline__ void p0_tables(const PV& P, int l, int part, int nparts) {
    const int tid = otid();
    const size_t n16 = (size_t)NEXP * 1024 / 16, stride = (size_t)nparts * 512;
    const GAS f32x4* su = (const GAS f32x4*)(PIN(I_PU) + (size_t)l * NEXP * 1024); const GAS f32x4* sv = (const GAS f32x4*)(PIN(I_PV) + (size_t)l * NEXP * 1024);
    GAS u32x4* du = (GAS u32x4*)(P.ws + WS_U8 + (size_t)l * NEXP * 1024); GAS u32x4* dv = (GAS u32x4*)(P.ws + WS_V8 + (size_t)l * NEXP * 1024);
#pragma unroll 2
    for (size_t i = (size_t)part * 512 + tid; i < n16; i += stride) {
        u32x4 o, q;
#pragma unroll
        for (int k = 0; k < 4; ++k) { const f32x4 a = su[4 * i + k] * 32.0f, c = sv[4 * i + k] * 2.0f;
            int wa = __builtin_amdgcn_cvt_pk_fp8_f32(a[0], a[1], 0, false); wa = __builtin_amdgcn_cvt_pk_fp8_f32(a[2], a[3], wa, true);
            int wc = __builtin_amdgcn_cvt_pk_fp8_f32(c[0], c[1], 0, false); wc = __builtin_amdgcn_cvt_pk_fp8_f32(c[2], c[3], wc, true);
            o[k] = (unsigned)wa; q[k] = (unsigned)wc; }
        const size_t e = i >> 6, j16 = i & 63, di = (((j16 >> 3) * NEXP + e) << 3) + (j16 & 7);
        du[di] = o; dv[di] = q;
    }
}
__device__ __forceinline__ void p0_weff(const PV& P, int l, int part, int nparts, LAS unsigned char* lds) {
    const int tid = otid(), lane = tid & 63, w = tid >> 6;
    for (int u = part; u < 128; u += nparts) {
        const int hp = (u >> 3) & 15, dmb = u & 7;
        LAS bf16_t* As = (LAS bf16_t*)lds; LAS bf16_t* Bs = As + 128 * 136;
        const float* kp = PIN(I_KEYS) + (size_t)(l * 16 + hp) * 128 * 128;
        const float* qp = PIN(I_WQ) + ((size_t)l * 1024 + dmb * 128) * 2048 + hp * 128;
        __syncthreads();
        for (int idx = tid; idx < 16384; idx += 512) { const int n = idx >> 7, d = idx & 127;
            As[n * 136 + d] = (bf16_t)f2bf(kp[idx]); Bs[n * 136 + d] = (bf16_t)f2bf(qp[(size_t)n * 2048 + d]); }
        __syncthreads();
        f32x4 acc[1][8]; zero_acc<1, 8>(acc);
        lds_mma<1, 8, 4>(acc, As + 16 * w * 136, 136, Bs, 136, lane);
        bf16_t* op = (bf16_t*)(P.ws + WS_WEFF) + ((size_t)l * 2048 + hp * 128 + 16 * w + (lane & 15)) * 1024 + dmb * 128 + 4 * (lane >> 4);
#pragma unroll
        for (int n = 0; n < 8; ++n) { const f32x4 v = acc[0][n]; *(unsigned long long*)(op + 16 * n) = (unsigned long long)pk2(v[0], v[1]) | ((unsigned long long)pk2(v[2], v[3]) << 32); }
    }
    __syncthreads();
}
__device__ __forceinline__ void p0_prologue(const PV& P, LAS unsigned char* lds) {
    const int tid = otid(), lane = tid & 63, w = tid >> 6;
    const int G = gridDim.x, bx = blockIdx.x;
    unsigned char* ws = P.ws;
    p0_transposes(P, 0, bx, G, lds);
    if (G > 96) { if (bx >= 48) p0_tables(P, 0, bx - 48, G - 48); }
    else p0_tables(P, 0, bx, G);
    __syncthreads();
    for (int u = bx; u < 48; u += G) {
        const int l = u / 24, cb = u % 24;
        LAS float* sc = (LAS float*)lds;
        LAS float* red = sc + 9216;
        __syncthreads();
        for (int idx = tid; idx < 9216; idx += 512) { const int r = idx >> 10, k = idx & 1023; const float v = r < 8 ? PIN(I_C)[r * 1024 + k] : PIN(I_CCTX)[k]; sc[idx] = siluf_(v); }
        __syncthreads();
        f32x4 acc[9];
#pragma unroll
        for (int r = 0; r < 9; ++r) acc[r] = (f32x4){0.f, 0.f, 0.f, 0.f};
        const float* wp = PIN(I_ADAW) + ((size_t)l * 1024 + 128 * w) * 6144 + cb * 256 + 4 * lane;
#pragma unroll 16
        for (int k = 0; k < 128; ++k) { const f32x4 wv = *(const GAS f32x4*)(wp + (size_t)k * 6144);
#pragma unroll
            for (int r = 0; r < 9; ++r) acc[r] += sc[r * 1024 + 128 * w + k] * wv; }
#pragma unroll
        for (int r = 0; r < 9; ++r) *(LAS f32x4*)(red + (w * 9 + r) * 256 + 4 * lane) = acc[r];
        __syncthreads();
        for (int idx = tid; idx < 9 * 256; idx += 512) { const int r = idx >> 8, cc = idx & 255; float sacc = 0.f;
#pragma unroll
            for (int ww = 0; ww < 8; ++ww) sacc += red[(ww * 9 + r) * 256 + cc];
            ((float*)(ws + WS_MOD))[(size_t)(l * 9 + r) * 6144 + cb * 256 + cc] = sacc + PIN(I_ADAB)[l * 6144 + cb * 256 + cc]; }
    }
    __syncthreads();
    p0_weff(P, 0, bx, G, lds);
    (void)lane; (void)w; (void)ws;
}

__device__ __forceinline__ void p0b_ain(const PV& P) {
    const int tid = otid(), lane = tid & 63, gw = blockIdx.x * 8 + (tid >> 6), NGW = gridDim.x * 8;
    const float* mod = (const float*)(P.ws + WS_MOD);
    bf16_t* act = (bf16_t*)(P.ws + WS_ACT);
    for (int row = gw; row < TT; row += NGW) {
        const float* xp = row < TL ? PIN(I_X) + (size_t)row * 1024 : PIN(I_CTX) + (size_t)(row - TL) * 1024;
        const int mr = row < TL ? (row >> 11) : 8;
        float x[16], y[16]; load_row16(xp, lane, x);
        norm_mod16(x, PIN(I_N1G), mod + (size_t)mr * 6144, mod + (size_t)mr * 6144 + 1024, lane, y);
        store_row16_bf16(act + (size_t)row * 1024, lane, y);
    }
}

__device__ __forceinline__ int rwkv_col(int gc, int h, int dir) {
    const int seg = gc >> 6;
    if (seg == 0) return h * 64 + gc;
    if (seg == 1) return 256 + h * 64 + (gc - 64);
    if (seg == 2) return 512 + h * 64 + (gc - 128);
    const int o = gc - 192; return o < 32 ? 832 + dir * 32 + o : 896 + dir * 32 + (o - 32);
}

constexpr int R_AT = 0, R_RT = 4608, R_BT = 9216, R_TL = 14336, R_MRB = 16896, R_G = 19456, R_YV = 23552, R_HV = 27648, R_GAM = 35840, REC_BYTES = 36096;

__device__ __forceinline__ void rwkv_pre(const PV& P, int l, LAS unsigned char* lds) {
    const int tid = otid(), lane = tid & 63, w = tid >> 6;
    LAS bf16_t* WUt = (LAS bf16_t*)lds;
    LAS bf16_t* AUt = WUt + 2560;
    LAS float* s_mu = (LAS float*)(AUt + 2560);
    LAS float* s_par = s_mu + 512;
    LAS bf16_t* raw = (LAS bf16_t*)(s_par + 256);
    LAS float* f_r = (LAS float*)(raw + 34 * 256);
    LAS float* f_k = f_r + 2048;
    LAS float* f_v = f_k + 2048;
    LAS bf16_t* WLb = (LAS bf16_t*)(f_v + 2048);
    LAS bf16_t* ALb = WLb + 1280;
    LAS float* lor = (LAS float*)raw;
    LAS bf16_t* Bn = ALb + 1280;
    LAS bf16_t* Kn = Bn + 2304;
    LAS bf16_t* Ktt = Kn + 2304;
    LAS bf16_t* Vt = Ktt + 2560;
    LAS float* Mabf = (LAS float*)(Vt + 2560);
    LAS bf16_t* Makb = (LAS bf16_t*)(Mabf + 1152);
    LAS bf16_t* Mrkb = Makb + 1280;
    LAS float* Ltot = (LAS float*)(Mrkb + 1280);
    LAS bf16_t* iA1 = (LAS bf16_t*)(Ltot + 512);
    LAS bf16_t* iB1 = iA1 + 640;
    LAS bf16_t* iA2 = iB1 + 640;
    LAS bf16_t* iWt = iA2 + 640;
    LAS unsigned char* rec = (LAS unsigned char*)(iWt + 640);
    LAS bf16_t* At = (LAS bf16_t*)(rec + R_AT); LAS bf16_t* Rt = (LAS bf16_t*)(rec + R_RT); LAS bf16_t* Btt = (LAS bf16_t*)(rec + R_BT);
    const GAS bf16_t* z = (const GAS bf16_t*)(P.ws + WS_Z);
    GAS unsigned char* recg = (GAS unsigned char*)(P.ws + WS_REC);
    for (int idx = tid; idx < 4 * 640 / 2; idx += 512) ((LAS unsigned*)iA1)[idx] = 0u;
    for (int idx = tid; idx < 2 * 1280 / 2; idx += 512) ((LAS unsigned*)WLb)[idx] = 0u;
    for (int idx = tid; idx < 2 * 2560 / 2; idx += 512) ((LAS unsigned*)WUt)[idx] = 0u;
    for (int idx = tid; idx < 1280 / 2; idx += 512) ((LAS unsigned*)(rec + R_TL))[idx] = 0u;
    int cur_hd = -1;
    u32x4 pre[3];
    auto geo = [&](int u, int& hd, int& b, int& c, int& tlo, int& seqlen, size_t& rb) { hd = u & 7; const int rest = u >> 3; b = rest / 72; c = rest % 72; const int dir = hd & 1;
        const bool isctx = c < 8; const int cc = isctx ? c : c - 8; seqlen = isctx ? CTX : SEQ; tlo = dir ? seqlen - 32 - 32 * cc : 32 * cc; rb = isctx ? (size_t)TL + b * CTX : (size_t)b * SEQ; };
    auto issue = [&](int u, int tid) { int hd, b, c, tlo, seqlen; size_t rb; geo(u, hd, b, c, tlo, seqlen, rb);
#pragma unroll
        for (int k = 0; k < 3; ++k) { const int v = tid + 512 * k; pre[k] = (u32x4){0u, 0u, 0u, 0u};
            if (v < 1088) { const int rr = v >> 5, vc = v & 31, t = tlo - 1 + rr; if (t >= 0 && t < seqlen) pre[k] = *(const GAS u32x4*)(z + (rb + t) * ZW + rwkv_col(vc * 8, hd >> 1, hd & 1)); } } };
    if ((int)blockIdx.x < 4608) issue(blockIdx.x, tid);
    for (int u = blockIdx.x; u < 4608; u += gridDim.x) {
        const int tid = otid(), lane = tid & 63, w = tid >> 6;
        int hd, b, c, tlo, seqlen; size_t rb; geo(u, hd, b, c, tlo, seqlen, rb); const int h = hd >> 1, dir = hd & 1;
        LDS_BARRIER();
        if (hd != cur_hd) { cur_hd = hd;
            for (int idx = tid; idx < 2048; idx += 512) { const int m = idx >> 6, j = idx & 63; const size_t o = ((size_t)(l * 2 + dir) * 32 + m) * 256 + h * 64 + j;
                WUt[j * 40 + m] = (bf16_t)f2bf(PIN(I_WUP)[o]); AUt[j * 40 + m] = (bf16_t)f2bf(PIN(I_AUP)[o]); }
            { const int which = tid >> 8, gc = tid & 255; s_mu[tid] = PIN(I_MU)[(size_t)(l * 2 + which) * 960 + rwkv_col(gc, h, dir)]; }
            if (tid < 256) { const int k = tid >> 6, j = tid & 63; float v;
                if (k == 0) v = PIN(I_W0)[(l * 2 + dir) * 256 + h * 64 + j]; else if (k == 1) v = PIN(I_A0)[(l * 2 + dir) * 256 + h * 64 + j];
                else if (k == 2) v = PIN(I_KK)[l * 256 + h * 64 + j]; else v = PIN(I_KA)[l * 256 + h * 64 + j];
                s_par[tid] = v; } }
#pragma unroll
        for (int k = 0; k < 3; ++k) { const int v = tid + 512 * k; if (v < 1088) *(LAS u32x4*)(raw + (size_t)v * 8) = pre[k]; }
        LDS_BARRIER();
        if (u + (int)gridDim.x < 4608) issue(u + gridDim.x, tid);
        { const int gc = tid & 255, th = tid >> 8; const float mu0 = s_mu[gc], mu1 = s_mu[256 + gc];
            const int r0 = th * 16 + 1;
            float zm = bf2f(raw[(r0 - 1) * 256 + gc]), z0 = bf2f(raw[r0 * 256 + gc]);
#pragma unroll 4
            for (int ii = 0; ii < 16; ++ii) { const int rr = r0 + ii, i = dir ? 32 - rr : rr - 1;
                const float zp = bf2f(raw[(rr + 1) * 256 + gc]);
                const float val = z0 + mu0 * (zm - z0) + mu1 * (zp - z0);
                zm = z0; z0 = zp;
                if (gc < 64) f_r[i * 64 + gc] = val; else if (gc < 128) f_k[i * 64 + gc - 64] = val; else if (gc < 192) f_v[i * 64 + gc - 128] = val;
                else if (gc < 224) WLb[i * 40 + gc - 192] = (bf16_t)f2bf(tanhf_(val)); else ALb[i * 40 + gc - 224] = (bf16_t)f2bf(val); } }
        LDS_BARRIER();
        { const int which = w >> 2, mt = (w >> 1) & 1, np = (w & 1) * 2; f32x4 acc[1][2]; zero_acc<1, 2>(acc);
            lds_mma<1, 2, 1>(acc, (which ? ALb : WLb) + 16 * mt * 40, 40, (which ? AUt : WUt) + 16 * np * 40, 40, lane);
#pragma unroll
            for (int n = 0; n < 2; ++n) *(LAS f32x4*)(lor + which * 2176 + (16 * mt + (lane & 15)) * 68 + 16 * (np + n) + 4 * (lane >> 4)) = acc[0][n]; }
        { const int row = tid & 63, ig = tid >> 6;
#pragma unroll
            for (int e = 0; e < 4; ++e) Vt[row * 40 + 4 * ig + e] = (bf16_t)f2bf(f_v[(4 * ig + e) * 64 + row]); }
        LDS_BARRIER();
        float Lloc[4], lwv[4], agv[4], kkv[4], kdv[4]; float Lrun = 0.f;
#pragma unroll
        for (int ii = 0; ii < 4; ++ii) { const int i = 4 * w + ii, j = lane;
            const float wv = s_par[j] + lor[i * 68 + j], av = s_par[64 + j] + lor[2176 + i * 68 + j];
            const float wlog = -softplusf_(-wv) - 0.5f, lw = -__expf(wlog);
            Lrun += lw; Lloc[ii] = Lrun; lwv[ii] = lw; agv[ii] = sigmoidf_(av);
            const float kx = f_k[i * 64 + j], kkj = kx * s_par[128 + j];
            const float ss = wave_sum(kkj * kkj); kkv[ii] = kkj * __builtin_amdgcn_rcpf(fmaxf(sqrtf(ss), 1e-12f));
            kdv[ii] = kx * (1.0f + (agv[ii] - 1.0f) * s_par[192 + j]); }
        Ltot[w * 64 + lane] = Lrun;
        LDS_BARRIER();
        { float off = 0.f;
#pragma unroll
            for (int ww = 0; ww < 7; ++ww) if (ww < w) off += Ltot[ww * 64 + lane];
            float bq[4], kq[4];
#pragma unroll
            for (int ii = 0; ii < 4; ++ii) { const int i = 4 * w + ii, j = lane; const float L = off + Lloc[ii], eP = __expf(L - lwv[ii]), eL = __expf(L), eN = __expf(-L);
                bq[ii] = kkv[ii] * agv[ii] * eN; kq[ii] = kdv[ii] * eN;
                const unsigned ar = pk2a(-kkv[ii] * eP, f_r[i * 64 + j] * eL), bk = pk2a(bq[ii], kq[ii]);
                At[i * 72 + j] = (bf16_t)(ar & 0xffffu); Rt[i * 72 + j] = (bf16_t)(ar >> 16);
                Bn[i * 72 + j] = (bf16_t)(bk & 0xffffu); Kn[i * 72 + j] = (bf16_t)(bk >> 16);
                if (i == 31) ((LAS float*)(rec + R_GAM))[j] = eL; }
            *(LAS unsigned long long*)(Btt + lane * 40 + 4 * w) = (unsigned long long)pk2a(bq[0], bq[1]) | ((unsigned long long)pk2a(bq[2], bq[3]) << 32);
            *(LAS unsigned long long*)(Ktt + lane * 40 + 4 * w) = (unsigned long long)pk2a(kq[0], kq[1]) | ((unsigned long long)pk2a(kq[2], kq[3]) << 32); }
        LDS_BARRIER();
        { const int mat = w >> 1, mt = w & 1; f32x4 acc[1][2]; zero_acc<1, 2>(acc);
            lds_mma<1, 2, 2>(acc, (mat < 2 ? At : Rt) + 16 * mt * 72, 72, (mat & 1) ? Kn : Bn, 72, lane);
            const int t = 16 * mt + (lane & 15);
#pragma unroll
            for (int n = 0; n < 2; ++n) { f32x4 o;
#pragma unroll
                for (int e = 0; e < 4; ++e) { const int j = 16 * n + 4 * (lane >> 4) + e; const bool keep = mat < 2 ? j < t : j <= t; o[e] = keep ? acc[0][n][e] : 0.f; }
                if (mat == 0) { *(LAS f32x4*)(Mabf + t * 36 + 16 * n + 4 * (lane >> 4)) = o;
                    if (mt == 1 && n == 0) *(LAS unsigned long long*)(iA1 + (lane & 15) * 40 + 4 * (lane >> 4)) = (unsigned long long)pk2(o[0], o[1]) | ((unsigned long long)pk2(o[2], o[3]) << 32);
                } else { LAS bf16_t* dst = mat == 1 ? Makb : (mat == 2 ? (LAS bf16_t*)(rec + R_MRB) : Mrkb);
                    *(LAS unsigned long long*)(dst + t * 40 + 16 * n + 4 * (lane >> 4)) = (unsigned long long)pk2(o[0], o[1]) | ((unsigned long long)pk2(o[2], o[3]) << 32); } } }
        if (w < 2) {
            asm volatile("s_waitcnt lgkmcnt(0)" ::: "memory");
            const int cidx = lane & 15, o16 = 16 * w; float T[16];
            int vz = 0; asm volatile("" : "+v"(vz)); const LAS float* mb = Mabf + vz + o16 * 36 + o16;
#pragma unroll
            for (int t = 0; t < 16; ++t) { float row = cidx == t ? 1.0f : 0.f;
                float mrow[16];
#pragma unroll
                for (int q = 0; q < 4; ++q) if (4 * q < t) { const f32x4 mv = *(const LAS f32x4*)(mb + t * 36 + 4 * q); mrow[4 * q] = mv[0]; mrow[4 * q + 1] = mv[1]; mrow[4 * q + 2] = mv[2]; mrow[4 * q + 3] = mv[3]; }
#pragma unroll
                for (int j = 0; j < t; ++j) row += mrow[j] * T[j];
                T[t] = row; }
            if (lane < 16) {
                LAS bf16_t* tl = (LAS bf16_t*)(rec + R_TL);
#pragma unroll
                for (int t = 0; t < 16; t += 2) { const unsigned tp = pk2a(T[t], T[t + 1]); const bf16_t lo = (bf16_t)(tp & 0xffffu), hi = (bf16_t)(tp >> 16);
                    tl[(o16 + t) * 40 + o16 + cidx] = lo; tl[(o16 + t + 1) * 40 + o16 + cidx] = hi;
                    if (w == 0) { iB1[cidx * 40 + t] = lo; iB1[cidx * 40 + t + 1] = hi; }
                    else { iA2[t * 40 + cidx] = lo; iA2[(t + 1) * 40 + cidx] = hi; } }
            }
        } else {
            for (int tt = 16 + (w - 2); tt < 32; tt += 6) { f32x4 acc[1][1]; zero_acc<1, 1>(acc);
                const int m = (tt - 16) >> 2, n = (tt - 16) & 3;
                lds_mma<1, 1, 1>(acc, Vt + 16 * m * 40, 40, Ktt + 16 * n * 40, 40, lane);
                const f32x4 v = acc[0][0];
                *(LAS unsigned long long*)((LAS bf16_t*)(rec + R_HV) + (16 * m + (lane & 15)) * 64 + 16 * n + 4 * (lane >> 4)) = (unsigned long long)pk2(v[0], v[1]) | ((unsigned long long)pk2(v[2], v[3]) << 32); } }
        LDS_BARRIER();
        if (w == 0) {
            f32x4 acc[1][1]; zero_acc<1, 1>(acc);
            lds_mma<1, 1, 1>(acc, iA1, 40, iB1, 40, lane);
#pragma unroll
            for (int e = 0; e < 4; ++e) iWt[(4 * (lane >> 4) + e) * 40 + (lane & 15)] = (bf16_t)f2bf(acc[0][0][e]);
            asm volatile("s_waitcnt lgkmcnt(0)" ::: "memory");
            zero_acc<1, 1>(acc);
            lds_mma<1, 1, 1>(acc, iA2, 40, iWt, 40, lane);
            const f32x4 v = acc[0][0];
            *(LAS unsigned long long*)((LAS bf16_t*)(rec + R_TL) + (16 + (lane & 15)) * 40 + 4 * (lane >> 4)) = (unsigned long long)pk2(v[0], v[1]) | ((unsigned long long)pk2(v[2], v[3]) << 32);
        } else {
            for (int tt = w - 1; tt < 16; tt += 7) { f32x4 acc[1][1]; zero_acc<1, 1>(acc);
                const int m = (tt & 7) >> 1, n = tt & 1; const bool isg = tt < 8;
                lds_mma<1, 1, 1>(acc, Vt + 16 * m * 40, 40, (isg ? Makb : Mrkb) + 16 * n * 40, 40, lane);
                const f32x4 v = acc[0][0];
                *(LAS unsigned long long*)((LAS bf16_t*)(rec + (isg ? R_G : R_YV)) + (16 * m + (lane & 15)) * 32 + 16 * n + 4 * (lane >> 4)) = (unsigned long long)pk2(v[0], v[1]) | ((unsigned long long)pk2(v[2], v[3]) << 32); } }
        LDS_BARRIER();
        { GAS u32x4* dst = (GAS u32x4*)(recg + ((size_t)(b * 8 + hd) * 72 + c) * REC_BYTES);
            for (int p = tid; p < REC_BYTES / 16; p += 512) dst[p] = *(const LAS u32x4*)(rec + (size_t)p * 16); }
    }
    __syncthreads();
}

__device__ __forceinline__ void rwkv_seq(const PV& P, int l, int unit, LAS unsigned char* lds) {
    const int tid = otid(), lane = tid & 63, w = tid >> 6, fr = lane & 15, fq = lane >> 4;
    const int dir = unit & 1, h = (unit >> 1) & 3, b = unit >> 3;
    LAS unsigned char* recb = lds;
    LAS bf16_t* S0b = (LAS bf16_t*)(lds + 2 * REC_BYTES);
    LAS bf16_t* Xb = S0b + 4608;
    LAS bf16_t* SAb = Xb + 2560;
    LAS float* Ys = (LAS float*)(SAb + 2560);
    GAS bf16_t* yout = (GAS bf16_t*)(P.ws + WS_Y) + (size_t)(0 * 2 + dir) * YSZ;
    const GAS u32x4* recg = (const GAS u32x4*)(P.ws + WS_REC + (size_t)unit * 72 * REC_BYTES);
    for (int idx = tid; idx < 4608 / 2; idx += 512) ((LAS unsigned*)S0b)[idx] = 0u;
    f32x4 Sacc[1][2]; zero_acc<1, 2>(Sacc);
    const int ms = w >> 1, nbs = (w & 1) * 2;
    const int m1 = w & 3;
    u32x4 pre[5];
    auto issue = [&](int c) {
#pragma unroll
        for (int k = 0; k < 5; ++k) { const int p = tid + 512 * k; pre[k] = (u32x4){0u, 0u, 0u, 0u}; if (p < REC_BYTES / 16) pre[k] = recg[(size_t)c * (REC_BYTES / 16) + p]; } };
    issue(0);
    for (int c = 0; c < 72; ++c) {
        LAS unsigned char* rec = recb + (c & 1) * REC_BYTES;
#pragma unroll
        for (int k = 0; k < 5; ++k) { const int p = tid + 512 * k; if (p < REC_BYTES / 16) *(LAS u32x4*)(rec + (size_t)p * 16) = pre[k]; }
        LDS_BARRIER();
        if (c + 1 < 72) issue(c + 1);
        if (c > 0) {
            const int cp = c - 1; const bool isctx = cp < 8; const int cc = isctx ? cp : cp - 8, seqlen = isctx ? CTX : SEQ;
            const int tlo = dir ? seqlen - 32 - 32 * cc : 32 * cc; const size_t rb = isctx ? (size_t)TL + b * CTX : (size_t)b * SEQ;
            const int i = tid >> 4, rg = tid & 15, t = dir ? tlo + 31 - i : tlo + i;
            const f32x4 v = *(const LAS f32x4*)(Ys + i * 64 + 4 * rg);
            *(GAS unsigned long long*)(yout + (rb + t) * 256 + h * 64 + 4 * rg) = (unsigned long long)pk2(v[0], v[1]) | ((unsigned long long)pk2(v[2], v[3]) << 32); }
        f32x4 aPQ[1][2]; zero_acc<1, 2>(aPQ);
        lds_mma<1, 2, 2>(aPQ, S0b + 16 * m1 * 72, 72, (const LAS bf16_t*)(rec + (w < 4 ? R_AT : R_RT)), 72, lane);
        if (w < 4) {
#pragma unroll
            for (int n = 0; n < 2; ++n) { const u32x2 gw = *(const LAS u32x2*)(rec + R_G + ((16 * m1 + fr) * 32 + 16 * n + 4 * fq) * 2);
                const float x0 = aPQ[0][n][0] + bflo(gw.x), x1 = aPQ[0][n][1] + bfhi(gw.x), x2 = aPQ[0][n][2] + bflo(gw.y), x3 = aPQ[0][n][3] + bfhi(gw.y);
                *(LAS unsigned long long*)(Xb + (16 * m1 + fr) * 40 + 16 * n + 4 * fq) = (unsigned long long)pk2(x0, x1) | ((unsigned long long)pk2(x2, x3) << 32); }
            asm volatile("s_waitcnt lgkmcnt(0)" ::: "memory");
            f32x4 aSA[1][2]; zero_acc<1, 2>(aSA);
            lds_mma<1, 2, 1>(aSA, Xb + 16 * m1 * 40, 40, (const LAS bf16_t*)(rec + R_TL), 40, lane);
#pragma unroll
            for (int n = 0; n < 2; ++n) { const f32x4 v = aSA[0][n];
                *(LAS unsigned long long*)(SAb + (16 * m1 + fr) * 40 + 16 * n + 4 * fq) = (unsigned long long)pk2(v[0], v[1]) | ((unsigned long long)pk2(v[2], v[3]) << 32); } }
        LDS_BARRIER();
        if (w >= 4) { lds_mma<1, 2, 1>(aPQ, SAb + 16 * m1 * 40, 40, (const LAS bf16_t*)(rec + R_MRB), 40, lane);
#pragma unroll
            for (int n = 0; n < 2; ++n) { const u32x2 yw = *(const LAS u32x2*)(rec + R_YV + ((16 * m1 + fr) * 32 + 16 * n + 4 * fq) * 2);
                const int t0 = 16 * n + 4 * fq, row = 16 * m1 + fr;
                Ys[(t0 + 0) * 64 + row] = aPQ[0][n][0] + bflo(yw.x); Ys[(t0 + 1) * 64 + row] = aPQ[0][n][1] + bfhi(yw.x);
                Ys[(t0 + 2) * 64 + row] = aPQ[0][n][2] + bflo(yw.y); Ys[(t0 + 3) * 64 + row] = aPQ[0][n][3] + bfhi(yw.y); } }
        { f32x4 aS[1][2]; zero_acc<1, 2>(aS);
            lds_mma<1, 2, 1>(aS, SAb + 16 * ms * 40, 40, (const LAS bf16_t*)(rec + R_BT) + 16 * nbs * 40, 40, lane);
#pragma unroll
            for (int n = 0; n < 2; ++n) { const int k0 = 16 * (nbs + n) + 4 * fq, row = 16 * ms + fr;
                const u32x2 hw = *(const LAS u32x2*)(rec + R_HV + (row * 64 + k0) * 2); const f32x4 gm = *(const LAS f32x4*)(rec + R_GAM + k0 * 4);
                f32x4 sn; sn[0] = gm[0] * (Sacc[0][n][0] + aS[0][n][0] + bflo(hw.x)); sn[1] = gm[1] * (Sacc[0][n][1] + aS[0][n][1] + bfhi(hw.x));
                sn[2] = gm[2] * (Sacc[0][n][2] + aS[0][n][2] + bflo(hw.y)); sn[3] = gm[3] * (Sacc[0][n][3] + aS[0][n][3] + bfhi(hw.y));
                Sacc[0][n] = sn;
                *(LAS unsigned long long*)(S0b + row * 72 + k0) = (unsigned long long)pk2(sn[0], sn[1]) | ((unsigned long long)pk2(sn[2], sn[3]) << 32); } }
    }
    LDS_BARRIER();
    { const int cp = 71; const int seqlen = SEQ, cc = cp - 8; const int tlo = dir ? seqlen - 32 - 32 * cc : 32 * cc; const size_t rb = (size_t)b * SEQ;
        const int i = tid >> 4, rg = tid & 15, t = dir ? tlo + 31 - i : tlo + i;
        const f32x4 v = *(const LAS f32x4*)(Ys + i * 64 + 4 * rg);
        *(GAS unsigned long long*)(yout + (rb + t) * 256 + h * 64 + 4 * rg) = (unsigned long long)pk2(v[0], v[1]) | ((unsigned long long)pk2(v[2], v[3]) << 32); }
    __syncthreads();
}

__device__ __forceinline__ void ret_unit(const PV& P, int l, int unit, LAS unsigned char* lds) {
    const int tid = otid(), lane = tid & 63, w = tid >> 6;
    const int dir = unit & 1, h = (unit >> 1) & 3, b = unit >> 3;
    LAS bf16_t* Qs = (LAS bf16_t*)lds; LAS bf16_t* Ks = Qs + 4608; LAS bf16_t* Kt = Ks + 4608; LAS bf16_t* Vt = Kt + 4608; LAS bf16_t* Att = Vt + 4608; LAS bf16_t* St = Att + 4608;
    const GAS bf16_t* z = (const GAS bf16_t*)(P.ws + WS_Z);
    GAS bf16_t* yout = (GAS bf16_t*)(P.ws + WS_Y) + (size_t)(1 * 2 + dir) * YSZ;
    const float lg = __logf(1.0f - exp2f(-((dir ? 5.5f : 5.0f) + (float)h)));
    for (int idx = tid; idx < 4608; idx += 512) St[idx] = 0;
    f32x4 Sacc[1][2]; zero_acc<1, 2>(Sacc);
    const int m = w >> 1, nb = (w & 1) * 2, fr = lane & 15, fq = lane >> 4;
    const float cdec = __expf(lg * 64.0f);
    u32x4 pre[3];
    auto tok = [&](int c, int i, size_t& rb, int& pos) -> int {
        const bool isctx = c < 4; const int cc = isctx ? c : c - 4, seqlen = isctx ? CTX : SEQ;
        const int tlo = dir ? seqlen - 64 - 64 * cc : 64 * cc; rb = isctx ? (size_t)TL + b * CTX : (size_t)b * SEQ;
        const int t = dir ? tlo + 63 - i : tlo + i; pos = (isctx ? 0 : CTX) + t; return t;
    };
    auto issue_loads = [&](int c) { const int i = tid >> 3, vc = tid & 7; size_t rb; int pos; const int t = tok(c, i, rb, pos);
#pragma unroll
        for (int k = 0; k < 3; ++k) pre[k] = *(const GAS u32x4*)(z + (rb + t) * ZW + CB_ + k * 256 + h * 64 + vc * 8); };
    issue_loads(0);
    for (int c = 0; c < 36; ++c) {
        LDS_BARRIER();
        { const int i = tid >> 3, vc = tid & 7;
            *(LAS u32x4*)(Qs + i * 72 + vc * 8) = pre[0]; *(LAS u32x4*)(Ks + i * 72 + vc * 8) = pre[1];
            const unsigned vw[4] = {pre[2].x, pre[2].y, pre[2].z, pre[2].w};
#pragma unroll
            for (int e = 0; e < 4; ++e) { Vt[(vc * 8 + 2 * e) * 72 + i] = (bf16_t)(vw[e] & 0xffffu); Vt[(vc * 8 + 2 * e + 1) * 72 + i] = (bf16_t)(vw[e] >> 16); } }
        LDS_BARRIER();
        if (c + 1 < 36) issue_loads(c + 1);
#pragma unroll
        for (int k = 0; k < 4; ++k) { const int idx = tid + 512 * k, i = idx >> 5, d = idx & 31; size_t rb; int pos; tok(c, i, rb, pos);
            float rev = (float)pos * (exp2f(-(float)d * (13.287712379549449f / 32.0f)) * 0.15915494309189535f); rev -= floorf(rev);
            const float sn = __builtin_amdgcn_sinf(rev), cs = __builtin_amdgcn_cosf(rev);
            const float q1 = bf2f(Qs[i * 72 + d]), q2 = bf2f(Qs[i * 72 + d + 32]), k1 = bf2f(Ks[i * 72 + d]), k2 = bf2f(Ks[i * 72 + d + 32]);
            Qs[i * 72 + d] = (bf16_t)f2bf((q1 * cs - q2 * sn) * 0.125f); Qs[i * 72 + d + 32] = (bf16_t)f2bf((q1 * sn + q2 * cs) * 0.125f);
            const float o1 = k1 * cs - k2 * sn, o2 = k1 * sn + k2 * cs, wd = __expf(lg * (float)(63 - i));
            Ks[i * 72 + d] = (bf16_t)f2bf(o1); Ks[i * 72 + d + 32] = (bf16_t)f2bf(o2);
            Kt[d * 72 + i] = (bf16_t)f2bf(o1 * wd); Kt[(d + 32) * 72 + i] = (bf16_t)f2bf(o2 * wd); }
        LDS_BARRIER();
        f32x4 aS[1][2], aO2[1][2]; zero_acc<1, 2>(aS); zero_acc<1, 2>(aO2);
        lds_mma<1, 2, 2>(aS, Qs + 16 * m * 72, 72, Ks + 16 * nb * 72, 72, lane);
        lds_mma<1, 2, 2>(aO2, Qs + 16 * m * 72, 72, St + 16 * nb * 72, 72, lane);
        const int i = 16 * m + fr;
#pragma unroll
        for (int n = 0; n < 2; ++n) { float o[4];
#pragma unroll
            for (int e = 0; e < 4; ++e) { const int j = 16 * (nb + n) + 4 * fq + e, diff = i - j; const bool keep = dir ? diff > 0 : diff >= 0;
                o[e] = keep ? aS[0][n][e] * __expf(lg * (float)diff) : 0.f; }
            *(LAS unsigned long long*)(Att + i * 72 + 16 * (nb + n) + 4 * fq) = (unsigned long long)pk2(o[0], o[1]) | ((unsigned long long)pk2(o[2], o[3]) << 32); }
        LDS_BARRIER();
        f32x4 aO1[1][2], aT[1][2]; zero_acc<1, 2>(aO1); zero_acc<1, 2>(aT);
        lds_mma<1, 2, 2>(aO1, Att + 16 * m * 72, 72, Vt + 16 * nb * 72, 72, lane);
        lds_mma<1, 2, 2>(aT, Vt + 16 * m * 72, 72, Kt + 16 * nb * 72, 72, lane);
        { size_t rb; int pos; const int t = tok(c, i, rb, pos); const float rd = __expf(lg * (float)(i + 1));
#pragma unroll
            for (int n = 0; n < 2; ++n) { const f32x4 o = aO1[0][n] + rd * aO2[0][n];
                *(GAS unsigned long long*)(yout + (rb + t) * 256 + h * 64 + 16 * (nb + n) + 4 * fq) = (unsigned long long)pk2(o[0], o[1]) | ((unsigned long long)pk2(o[2], o[3]) << 32); } }
#pragma unroll
        for (int n = 0; n < 2; ++n) { Sacc[0][n] = cdec * Sacc[0][n] + aT[0][n]; const f32x4 s = Sacc[0][n];
            *(LAS unsigned long long*)(St + i * 72 + 16 * (nb + n) + 4 * fq) = (unsigned long long)pk2(s[0], s[1]) | ((unsigned long long)pk2(s[2], s[3]) << 32); }
    }
    __syncthreads();
}

__device__ __forceinline__ void lru_items(const PV& P, int l, LAS unsigned char* lds) {
    const int tid0 = otid();
    LAS bf16_t* waT = (LAS bf16_t*)lds; LAS bf16_t* wxT = waT + 4608; LAS bf16_t* xcb = wxT + 4608;
    LAS float* xraw = (LAS float*)(lds + 27648);
    LAS float* xcf = xraw + 67 * 64;
    LAS float* a_s = xcf + 4352; LAS float* b_s = a_s + 4352;
    LAS float* segA = b_s + 4352; LAS float* segH = segA + 512; LAS float* par = segH + 512;
    const GAS bf16_t* z = (const GAS bf16_t*)(P.ws + WS_Z);
    int cur_key = -1;
    u32x4 pre[2];
    auto geo = [&](int u, int& key, int& b, int& c, int& tlo, int& seqlen, size_t& rb) { key = u & 7; const int rest = u >> 3; b = rest / 36; c = rest % 36; const int dir = key >> 2;
        const bool isctx = c < 4; const int cc = isctx ? c : c - 4; seqlen = isctx ? CTX : SEQ; tlo = dir ? seqlen - 64 - 64 * cc : 64 * cc; rb = isctx ? (size_t)TL + b * CTX : (size_t)b * SEQ; };
    auto issue = [&](int u, int tid) { int key, b, c, tlo, seqlen; size_t rb; geo(u, key, b, c, tlo, seqlen, rb);
#pragma unroll
        for (int k = 0; k < 2; ++k) { const int v = tid + 512 * k; pre[k] = (u32x4){0u, 0u, 0u, 0u};
            if (v < 536) { const int rr = v >> 3, vc = v & 7, t = tlo - 2 + rr; if (t >= 0 && t < seqlen) pre[k] = *(const GAS u32x4*)(z + (rb + t) * ZW + CC_ + (key & 3) * 64 + vc * 8); } } };
    if ((int)blockIdx.x < 2304) issue(blockIdx.x, tid0);
    for (int u = blockIdx.x; u < 2304; u += gridDim.x) {
        const int tid = otid(), lane = tid & 63, w = tid >> 6;
        int key, b, c, tlo, seqlen; size_t rb; geo(u, key, b, c, tlo, seqlen, rb); const int dir = key >> 2, blk = key & 3;
        GAS bf16_t* hout = (GAS bf16_t*)(P.ws + WS_Y) + (size_t)(2 * 2 + dir) * YSZ; GAS bf16_t* aout = (GAS bf16_t*)(P.ws + WS_ACU) + (size_t)dir * YSZ;
        LDS_BARRIER();
        if (key != cur_key) { cur_key = key;
            for (int idx = tid; idx < 4096; idx += 512) { const int i = idx >> 6, j = idx & 63; const size_t o = ((size_t)((l * 2 + dir) * 4 + blk) * 64 + i) * 64 + j;
                waT[j * 72 + i] = (bf16_t)f2bf(PIN(I_WA)[o]); wxT[j * 72 + i] = (bf16_t)f2bf(PIN(I_WX)[o]); }
            { const int k = tid >> 6, cc = tid & 63, ch = blk * 64 + cc; float v;
                if (k < 4) v = PIN(I_CVW)[(l * 4 + k) * 256 + ch]; else if (k == 4) v = PIN(I_CVB)[l * 256 + ch];
                else if (k == 5) v = PIN(I_BA)[(l * 2 + dir) * 256 + ch]; else if (k == 6) v = PIN(I_BX)[(l * 2 + dir) * 256 + ch];
                else v = softplusf_(-PIN(I_LAM)[(l * 2 + dir) * 256 + ch]);
                par[tid] = v; } }
#pragma unroll
        for (int k = 0; k < 2; ++k) { const int v = tid + 512 * k; if (v < 536) { const unsigned ww[4] = {pre[k].x, pre[k].y, pre[k].z, pre[k].w};
#pragma unroll
                for (int e = 0; e < 4; ++e) { xraw[v * 8 + 2 * e] = bflo(ww[e]); xraw[v * 8 + 2 * e + 1] = bfhi(ww[e]); } } }
        LDS_BARRIER();
        if (u + (int)gridDim.x < 2304) issue(u + gridDim.x, tid);
        { const int ch = tid & 63, tg = tid >> 6;
#pragma unroll
            for (int e = 0; e < 8; ++e) { const int tt = tg * 8 + e;
                const float xc = par[256 + ch] + par[ch] * xraw[tt * 64 + ch] + par[64 + ch] * xraw[(tt + 1) * 64 + ch] + par[128 + ch] * xraw[(tt + 2) * 64 + ch] + par[192 + ch] * xraw[(tt + 3) * 64 + ch];
                const int i = dir ? 63 - tt : tt; xcf[i * 68 + ch] = xc; xcb[i * 72 + ch] = (bf16_t)f2bf(xc); } }
        LDS_BARRIER();
        { const int m = w >> 1, nb = (w & 1) * 2, fr = lane & 15, fq = lane >> 4;
            f32x4 aR[1][2], aI[1][2]; zero_acc<1, 2>(aR); zero_acc<1, 2>(aI);
            lds_mma<1, 2, 2>(aR, xcb + 16 * m * 72, 72, waT + 16 * nb * 72, 72, lane);
            lds_mma<1, 2, 2>(aI, xcb + 16 * m * 72, 72, wxT + 16 * nb * 72, 72, lane);
            const int i = 16 * m + fr;
#pragma unroll
            for (int n = 0; n < 2; ++n) { f32x4 av, bv;
#pragma unroll
                for (int e = 0; e < 4; ++e) { const int ch = 16 * (nb + n) + 4 * fq + e;
                    const float r = sigmoidf_(aR[0][n][e] + par[320 + ch]), ig = sigmoidf_(aI[0][n][e] + par[384 + ch]);
                    const float la = -8.0f * r * par[448 + ch]; av[e] = __expf(la);
                    const float y2 = 2.0f * la;
                    const float om = y2 > -0.125f ? -y2 * (1.0f + y2 * (0.5f + y2 * (0.16666667f + y2 * (0.041666668f + y2 * 0.0083333338f)))) : 1.0f - __expf(y2);
                    bv[e] = sqrtf(fmaxf(om, 0.f)) * ig * xcf[i * 68 + ch]; }
                *(LAS f32x4*)(a_s + i * 68 + 16 * (nb + n) + 4 * fq) = av; *(LAS f32x4*)(b_s + i * 68 + 16 * (nb + n) + 4 * fq) = bv; } }
        LDS_BARRIER();
        const int ch = tid & 63, seg = tid >> 6;
        float av[8], bv[8];
        { float A = 1.f, H = 0.f;
#pragma unroll
            for (int e = 0; e < 8; ++e) { const int i = seg * 8 + e; av[e] = a_s[i * 68 + ch]; bv[e] = b_s[i * 68 + ch]; }
#pragma unroll
            for (int e = 0; e < 8; ++e) { H = av[e] * H + bv[e]; A *= av[e]; av[e] = A; bv[e] = H; }
            segA[seg * 64 + ch] = A; segH[seg * 64 + ch] = H; }
        LDS_BARRIER();
        float hin = 0.f, ap = 1.f;
#pragma unroll
        for (int s2 = 0; s2 < 7; ++s2) if (s2 < seg) { const float sa = segA[s2 * 64 + ch]; hin = sa * hin + segH[s2 * 64 + ch]; ap *= sa; }
#pragma unroll
        for (int e = 0; e < 8; ++e) { const int i = seg * 8 + e; const int t = dir ? tlo + 63 - i : tlo + i;
            const float hl = bv[e] + av[e] * hin, ac = av[e] * ap;
            hout[(rb + t) * 256 + blk * 64 + ch] = (bf16_t)f2bf(hl); aout[(rb + t) * 256 + blk * 64 + ch] = (bf16_t)f2bf(ac);
            if (i == 63) { GAS float* ag = (GAS float*)(P.ws + WS_AGG) + ((size_t)((b * 2 + dir) * 36 + c) * 2) * 256 + blk * 64 + ch; ag[0] = ac; ag[256] = hl; } }
    }
    __syncthreads();
}
__device__ __forceinline__ void lru_carry_unit(const PV& P, int unit) {
    const int tid = otid();
    if (tid < 256) { const float* ag = (const float*)(P.ws + WS_AGG) + (size_t)unit * 36 * 512 + tid; float* ci = (float*)(P.ws + WS_CIN) + (size_t)unit * 36 * 256 + tid;
        float A[36], H[36];
#pragma unroll
        for (int c = 0; c < 36; ++c) { A[c] = ag[c * 512]; H[c] = ag[c * 512 + 256]; }
        float carry = 0.f;
#pragma unroll
        for (int c = 0; c < 36; ++c) { ci[c * 256] = carry; carry = A[c] * carry + H[c]; } }
}

__device__ __forceinline__ void s5_unit(const PV& P, int l, int unit, LAS unsigned char* lds) {
    const int tid = otid(), lane = tid & 63, w = tid >> 6;
    const int gp = unit & 7, dir = (unit >> 3) & 1, b = unit >> 4;
    LAS float* bu0 = (LAS float*)lds;
    LAS bf16_t* Hs0 = (LAS bf16_t*)(lds + 66560);
    LAS bf16_t* Us0 = (LAS bf16_t*)(lds + 100352);
    LAS bf16_t* Bbu = (LAS bf16_t*)(lds + 105472);
    LAS bf16_t* By = (LAS bf16_t*)(lds + 125952);
    const GAS bf16_t* z = (const GAS bf16_t*)(P.ws + WS_Z);
    GAS bf16_t* yout = (GAS bf16_t*)(P.ws + WS_Y) + (size_t)(3 * 2 + dir) * YSZ;
    for (int idx = tid; idx < 256 * 40 / 2; idx += 512) ((LAS unsigned*)Bbu)[idx] = 0u;
    __syncthreads();
    float lr = 0.f, li = 0.f, hr = 0.f, hi = 0.f;
    if (tid < 128) { const int gl = tid >> 6, p = tid & 63, g = 2 * gp + gl; const size_t pidx = ((size_t)(l * 2 + dir) * 16 + g) * 64 + p;
        const float are = PIN(I_SARE)[pidx], aim = PIN(I_SAIM)[pidx], dt = __expf(PIN(I_SLDT)[(l * 2 + dir) * 16 + g]);
        const float mag = __expf(are * dt); float rev = aim * dt * 0.15915494309189535f; rev -= floorf(rev);
        lr = mag * __builtin_amdgcn_cosf(rev); li = mag * __builtin_amdgcn_sinf(rev);
        const float nre = lr - 1.0f, nim = li, den = 1.0f / (are * are + aim * aim);
        const float cre = (nre * are + nim * aim) * den, cim = (nim * are - nre * aim) * den;
#pragma unroll
        for (int c = 0; c < 16; ++c) { const float bre = PIN(I_SBRE)[pidx * 16 + c], bim = PIN(I_SBIM)[pidx * 16 + c];
            Bbu[(gl * 128 + 2 * p) * 40 + gl * 16 + c] = (bf16_t)f2bf(cre * bre - cim * bim); Bbu[(gl * 128 + 2 * p + 1) * 40 + gl * 16 + c] = (bf16_t)f2bf(cre * bim + cim * bre); } }
    for (int idx = tid; idx < 4096; idx += 512) { const int gl = idx >> 11, c = (idx >> 7) & 15, kk = idx & 127, part = kk >> 6, p = kk & 63, g = 2 * gp + gl;
        const size_t src = (((size_t)(l * 2 + dir) * 16 + g) * 16 + c) * 64 + p;
        By[(gl * 16 + c) * 136 + 2 * p + part] = (bf16_t)f2bf(part ? -PIN(I_SCIM)[src] : PIN(I_SCRE)[src]); }
    auto rowof = [&](int c, int i) -> size_t {
        if (c < 8) { const int s = 32 * c + i, t = dir ? 255 - s : s; return (size_t)TL + b * CTX + t; }
        const int sl = 32 * (c - 8) + i, slr = dir ? 2047 - sl : sl, col = slr >> 5, rg = slr & 31; return (size_t)b * SEQ + rg * 64 + col; };
    const int t6 = tid - 384;
    u32x4 pre = (u32x4){0u, 0u, 0u, 0u};
    if (w >= 6) { pre = *(const GAS u32x4*)(z + rowof(0, t6 >> 2) * ZW + CD_ + gp * 32 + (t6 & 3) * 8); *(LAS u32x4*)(Us0 + (t6 >> 2) * 40 + (t6 & 3) * 8) = pre;
        pre = *(const GAS u32x4*)(z + rowof(1, t6 >> 2) * ZW + CD_ + gp * 32 + (t6 & 3) * 8); }
    __syncthreads();
#pragma unroll 1
    for (int k = 0; k < 74; ++k) {
        if (w < 2) {
            const float hr_s = hr, hi_s = hi;
            for (int r3 = 0; r3 < ((PROBE_DUP & 524288) ? 2 : 1); ++r3)
            if (k >= 1 && k <= 72) { const LAS float* bu = bu0 + ((k - 1) & 1) * 8320; LAS bf16_t* Hs = Hs0 + ((k - 1) & 1) * 8448; hr = hr_s; hi = hi_s;
                const int cr = (tid >> 6) * 128 + 2 * (tid & 63);
#pragma unroll 1
                for (int i0 = 0; i0 < 32; i0 += 8) { f32x2 bb[8];
#pragma unroll
                    for (int e = 0; e < 8; ++e) bb[e] = *(const LAS f32x2*)(bu + (i0 + e) * 260 + cr);
                    unsigned orr[8];
#pragma unroll
                    for (int e = 0; e < 8; ++e) { const float nr = lr * hr - li * hi + bb[e][0], ni = lr * hi + li * hr + bb[e][1]; hr = nr; hi = ni; orr[e] = pk2a(nr, ni); }
#pragma unroll
                    for (int e = 0; e < 8; ++e) *(LAS unsigned*)(Hs + (i0 + e) * 264 + cr) = orr[e]; } }
        } else if (w < 6) {
            for (int r3 = 0; r3 < ((PROBE_DUP & 131072) ? 2 : 1); ++r3)
            if (k <= 71) { LAS float* bu = bu0 + (k & 1) * 8320; const LAS bf16_t* Us = Us0 + (k & 1) * 1280; const int wq = w - 2;
                f32x4 acc[2][4]; zero_acc<2, 4>(acc);
                lds_mma<2, 4, 1>(acc, Us, 40, Bbu + 64 * wq * 40, 40, lane);
#pragma unroll
                for (int mm = 0; mm < 2; ++mm)
#pragma unroll
                    for (int n = 0; n < 4; ++n) *(LAS f32x4*)(bu + (16 * mm + (lane & 15)) * 260 + 64 * wq + 16 * n + 4 * (lane >> 4)) = acc[mm][n]; }
        } else {
            for (int r3 = 0; r3 < ((PROBE_DUP & 262144) ? 2 : 1); ++r3)
            if (k >= 2) { const LAS bf16_t* Hs = Hs0 + (k & 1) * 8448; const int gl = w - 6, cy = k - 2;
                f32x4 acc[2][1]; zero_acc<2, 1>(acc);
                lds_mma<2, 1, 4>(acc, Hs + gl * 128, 264, By + gl * 16 * 136, 136, lane);
#pragma unroll
                for (int mm = 0; mm < 2; ++mm) { const int i = 16 * mm + (lane & 15); const f32x4 v = acc[mm][0];
                    *(GAS unsigned long long*)(yout + rowof(cy, i) * 256 + gp * 32 + gl * 16 + 4 * (lane >> 4)) = (unsigned long long)pk2(v[0], v[1]) | ((unsigned long long)pk2(v[2], v[3]) << 32); } }
            if (k + 1 <= 71) { *(LAS u32x4*)(Us0 + ((k + 1) & 1) * 1280 + (t6 >> 2) * 40 + (t6 & 3) * 8) = pre;
                if (k + 2 <= 71) pre = *(const GAS u32x4*)(z + rowof(k + 2, t6 >> 2) * ZW + CD_ + gp * 32 + (t6 & 3) * 8); }
        }
        LDS_BARRIER();
    }
    __syncthreads();
}

__device__ __forceinline__ float sum16(float v) { v = sum8(v); return v + dppf<0x140>(v); }
struct CmbRow { u32x2 zr[3], zk[3], zv[3], zg[3], gB, gC, uD, y[8], ac[2]; f32x4 ci[2]; };
__device__ __forceinline__ void p3_combine(const PV& P, int l, int nrows, LAS unsigned char* lds) {
    const int tid = otid(), lane = tid & 63, w = tid >> 6, c4 = 4 * lane, hh = lane >> 4;
    LAS float* gup = (LAS float*)lds;
    LAS float* smu = gup + 16384;
    LAS float* spar = smu + 1664;
    LAS float* sgs = spar + 1280 + w * 64;
    for (int idx = tid; idx < 16384; idx += 512) gup[idx] = PIN(I_GUP)[(size_t)l * 16384 + idx];
    for (int idx = tid; idx < 1664; idx += 512) { const int which = idx / 832, col = idx % 832; smu[idx] = PIN(I_MU)[(size_t)(l * 2 + which) * 960 + col]; }
    for (int idx = tid; idx < 1280; idx += 512) { const int k = idx >> 8, c = idx & 255;
        spar[idx] = k == 0 ? PIN(I_LNG)[l * 256 + c] : k == 1 ? PIN(I_LNB)[l * 256 + c] : k == 2 ? PIN(I_RK)[l * 256 + c] : k == 3 ? PIN(I_GNG)[l * 256 + c] : PIN(I_SD)[l * 256 + c]; }
    __syncthreads();
    const GAS bf16_t* z = (const GAS bf16_t*)(P.ws + WS_Z); const GAS bf16_t* Y = (const GAS bf16_t*)(P.ws + WS_Y);
    GAS bf16_t* mix = (GAS bf16_t*)(P.ws + WS_ACT); GAS bf16_t* s5g = (GAS bf16_t*)(P.ws + WS_S5G);
    const int gw = blockIdx.x * 8 + w, NGW = gridDim.x * 8;
    auto ld = [&](int row, CmbRow& L) {
        const bool isctx = row >= TL; const int t = isctx ? ((row - TL) & 255) : (row & 2047), seqlen = isctx ? CTX : SEQ;
        const GAS bf16_t* zr = z + (size_t)row * ZW;
#pragma unroll
        for (int d = 0; d < 3; ++d) { const bool ok = d == 1 || (d == 0 ? t > 0 : t < seqlen - 1); const GAS bf16_t* zz = zr + (d - 1) * ZW; const u32x2 zero = (u32x2){0u, 0u};
            L.zr[d] = ok ? *(const GAS u32x2*)(zz + c4) : zero; L.zk[d] = ok ? *(const GAS u32x2*)(zz + 256 + c4) : zero; L.zv[d] = ok ? *(const GAS u32x2*)(zz + 512 + c4) : zero;
            L.zg[d] = (ok && lane < 16) ? *(const GAS u32x2*)(zz + 768 + c4) : zero; }
        L.gB = *(const GAS u32x2*)(zr + CB_ + 768 + c4); L.gC = *(const GAS u32x2*)(zr + CC_ + 256 + c4); L.uD = *(const GAS u32x2*)(zr + CD_ + c4);
#pragma unroll
        for (int k = 0; k < 8; ++k) L.y[k] = *(const GAS u32x2*)(Y + (size_t)k * YSZ + (size_t)row * 256 + c4);
        const int bb = isctx ? (row - TL) >> 8 : row >> 11;
#pragma unroll
        for (int d = 0; d < 2; ++d) { const int ts = d ? seqlen - 1 - t : t, ck = (isctx ? 0 : 4) + (ts >> 6);
            L.ac[d] = *(const GAS u32x2*)((const GAS bf16_t*)(P.ws + WS_ACU) + (size_t)d * YSZ + (size_t)row * 256 + c4);
            L.ci[d] = *(const GAS f32x4*)((const GAS float*)(P.ws + WS_CIN) + ((size_t)(bb * 2 + d) * 36 + ck) * 256 + c4); }
    };
    auto up4 = [](const u32x2 v, float (&o)[4]) { o[0] = bflo(v.x); o[1] = bfhi(v.x); o[2] = bflo(v.y); o[3] = bfhi(v.y); };
    auto st4 = [](GAS bf16_t* p, const float (&o)[4]) { *(GAS unsigned long long*)p = (unsigned long long)pk2(o[0], o[1]) | ((unsigned long long)pk2(o[2], o[3]) << 32); };
    auto shift4 = [&](const u32x2 (&zz)[3], int col, float (&o)[4]) { float a[4], m[4], n[4]; up4(zz[1], a); up4(zz[0], m); up4(zz[2], n);
        const f32x4 u0 = *(const LAS f32x4*)(smu + col), u1 = *(const LAS f32x4*)(smu + 832 + col);
#pragma unroll
        for (int e = 0; e < 4; ++e) o[e] = a[e] + u0[e] * (m[e] - a[e]) + u1[e] * (n[e] - a[e]); };
    auto cmp = [&](int row, const CmbRow& L) {
        if (lane < 16) { float gl[4]; shift4(L.zg, 768 + c4, gl);
            *(LAS f32x4*)(sgs + c4) = (f32x4){sigmoidf_(gl[0]), sigmoidf_(gl[1]), sigmoidf_(gl[2]), sigmoidf_(gl[3])}; }
        asm volatile("s_waitcnt lgkmcnt(0)" ::: "memory");
        f32x4 g = (f32x4){0.f, 0.f, 0.f, 0.f};
#pragma unroll 8
        for (int i = 0; i < 64; ++i) g += sgs[i] * *(const LAS f32x4*)(gup + i * 256 + c4);
        float r[4], k[4], v[4]; shift4(L.zr, c4, r); shift4(L.zk, 256 + c4, k); shift4(L.zv, 512 + c4, v);
        const f32x4 lng = *(const LAS f32x4*)(spar + c4), lnb = *(const LAS f32x4*)(spar + 256 + c4), rk = *(const LAS f32x4*)(spar + 512 + c4), gng = *(const LAS f32x4*)(spar + 768 + c4), sd = *(const LAS f32x4*)(spar + 1024 + c4);
        float ya[4], yb[4], t0[4], t1[4];
        up4(L.y[0], t0); up4(L.y[1], t1);
#pragma unroll
        for (int e = 0; e < 4; ++e) ya[e] = t0[e] + t1[e];
        { const float mean = sum16((ya[0] + ya[1]) + (ya[2] + ya[3])) * (1.0f / 64.0f); float q = 0.f, bsum = 0.f;
#pragma unroll
            for (int e = 0; e < 4; ++e) { ya[e] -= mean; q += ya[e] * ya[e]; bsum += r[e] * k[e] * rk[e]; }
            const float rs = rsqrtf(sum16(q) * (1.0f / 64.0f) + 64e-5f); bsum = sum16(bsum); float o[4];
#pragma unroll
            for (int e = 0; e < 4; ++e) o[e] = (ya[e] * rs * lng[e] + lnb[e] + bsum * v[e]) * g[e];
            st4(mix + (size_t)row * 1024 + c4, o); }
        up4(L.y[2], t0); up4(L.y[3], t1);
#pragma unroll
        for (int e = 0; e < 4; ++e) yb[e] = t0[e] + t1[e];
        { const float mean = sum16((yb[0] + yb[1]) + (yb[2] + yb[3])) * (1.0f / 64.0f); float q = 0.f;
#pragma unroll
            for (int e = 0; e < 4; ++e) { yb[e] -= mean; q += yb[e] * yb[e]; }
            const float rs = rsqrtf(sum16(q) * (1.0f / 64.0f) + 1e-5f); float gt[4], o[4]; up4(L.gB, gt);
#pragma unroll
            for (int e = 0; e < 4; ++e) o[e] = siluf_(gt[e]) * (yb[e] * rs * gng[e]);
            st4(mix + (size_t)row * 1024 + 256 + c4, o); }
        { float gt[4], o[4], a0[4], a1[4]; up4(L.gC, gt); up4(L.y[4], t0); up4(L.y[5], t1); up4(L.ac[0], a0); up4(L.ac[1], a1);
#pragma unroll
            for (int e = 0; e < 4; ++e) o[e] = geluf_(gt[e]) * ((t0[e] + a0[e] * L.ci[0][e]) + (t1[e] + a1[e] * L.ci[1][e]));
            st4(mix + (size_t)row * 1024 + 512 + c4, o); }
        { float uu[4], o[4]; up4(L.uD, uu); up4(L.y[6], t0); up4(L.y[7], t1);
#pragma unroll
            for (int e = 0; e < 4; ++e) o[e] = geluf_(sd[e] * uu[e] + t0[e] + t1[e]);
            st4(s5g + (size_t)row * 256 + c4, o); }
    };
    (void)hh;
    for (int row = gw; row < nrows; row += 2 * NGW) {
        CmbRow LA, LB; const int rowB = row + NGW; const bool hasB = rowB < nrows;
        ld(row, LA); if (hasB) ld(rowB, LB);
        cmp(row, LA); if (hasB) cmp(rowB, LB);
    }
}

__device__ __forceinline__ void p6_h2(const PV& P, int l, int nrows) {
    const int tid = otid(), lane = tid & 63, gw = blockIdx.x * 8 + (tid >> 6), NGW = gridDim.x * 8;
    const float* mod = (const float*)(P.ws + WS_MOD) + (size_t)l * 9 * 6144; const float* X1 = (const float*)(P.ws + WS_X1);
    bf16_t* act = (bf16_t*)(P.ws + WS_ACT);
    for (int row = gw; row < nrows; row += NGW) { const int mr = row < TL ? (row >> 11) : 8;
        float x[16], y[16]; load_row16(X1 + (size_t)row * 1024, lane, x);
        norm_mod16(x, PIN(I_N2G) + l * 1024, mod + (size_t)mr * 6144 + 3 * 1024, mod + (size_t)mr * 6144 + 4 * 1024, lane, y);
        store_row16_bf16(act + (size_t)row * 1024, lane, y); }
}

__device__ __forceinline__ unsigned skey(float f) { const unsigned u = __builtin_bit_cast(unsigned, f); return u ^ ((unsigned)((int)u >> 31) | 0x80000000u); }
__device__ __forceinline__ float unskey(unsigned s) { const unsigned u = (s & 0x80000000u) ? (s ^ 0x80000000u) : ~s; return __builtin_bit_cast(float, u); }

__device__ __forceinline__ void ce_(unsigned& a, unsigned& b) { const unsigned hi = max(a, b), lo = min(a, b); a = hi; b = lo; }
__device__ __forceinline__ void sort16_(unsigned (&v)[16]) {
#pragma unroll
    for (int k = 2; k <= 16; k <<= 1)
#pragma unroll
        for (int j = k >> 1; j > 0; j >>= 1)
#pragma unroll
            for (int i = 0; i < 16; ++i) { const int p = i ^ j; if (p > i) { if ((i & k) == 0) ce_(v[i], v[p]); else ce_(v[p], v[i]); } }
}
__device__ __forceinline__ void merge16_(unsigned (&a)[16], const unsigned (&b)[16]) {
#pragma unroll
    for (int i = 0; i < 16; ++i) a[i] = max(a[i], b[15 - i]);
#pragma unroll
    for (int j = 8; j > 0; j >>= 1)
#pragma unroll
        for (int i = 0; i < 16; ++i) { const int p = i ^ j; if (p > i) ce_(a[i], a[p]); }
}
__device__ __forceinline__ void p8a_topk(const PV& P, int nrows, LAS unsigned char* lds) {
    const int tid = otid();
    LAS unsigned* tb = (LAS unsigned*)lds;
    const GAS float* sc = (const GAS float*)(P.ws + WS_SC); GAS u32x2* list = (GAS u32x2*)(P.ws + WS_LIST);
    const int items = nrows * 16, nth = gridDim.x * 512;
    for (int item = blockIdx.x * 512 + tid; item < items; item += nth) {
        const int row = item >> 4, hp = item & 15, hh = hp >> 1, p = hp & 1;
        const GAS f32x4* sp = (const GAS f32x4*)(sc + (size_t)row * 2048 + hp * 128);
        unsigned top[16];
        f32x4 nx[4];
#pragma unroll
        for (int q = 0; q < 4; ++q) nx[q] = sp[q];
#pragma unroll 1
        for (int bk = 0; bk < 8; ++bk) { unsigned cur[16];
#pragma unroll
            for (int q = 0; q < 4; ++q) { const f32x4 v = nx[q];
#pragma unroll
                for (int k = 0; k < 4; ++k) cur[q * 4 + k] = (skey(v[k]) & 0xFFFFFF80u) | (unsigned)(bk * 16 + q * 4 + k); }
            { const int nb = bk < 7 ? bk + 1 : 7;
#pragma unroll
                for (int q = 0; q < 4; ++q) nx[q] = sp[nb * 4 + q]; }
            sort16_(cur);
            if (bk == 0) {
#pragma unroll
                for (int s = 0; s < 16; ++s) top[s] = cur[s];
            } else merge16_(top, cur); }
        float v1[16], v2[16]; unsigned i1[16], i2[16];
#pragma unroll
        for (int s = 0; s < 16; ++s) { const float mv = unskey(top[s] & 0xFFFFFF80u); const unsigned mi = top[s] & 127u;
            const float ov = dppf<0xB1>(mv); const unsigned oi = dppu<0xB1>(mi);
            v1[s] = p ? ov : mv; i1[s] = p ? oi : mi; v2[s] = p ? mv : ov; i2[s] = p ? mi : oi; }
        unsigned k2[16];
        { unsigned cand[64]; int n = 0;
#pragma unroll
            for (int a = 0; a < 16; ++a)
#pragma unroll
                for (int bb = 0; bb < 16; ++bb) if ((a + 1) * (bb + 1) <= 16) { cand[n] = (skey(v1[a] + v2[bb]) & 0xFFFFFF00u) | (unsigned)(a * 16 + bb); ++n; }
#pragma unroll
            for (int q = 50; q < 64; ++q) cand[q] = 0u;
#pragma unroll
            for (int bk = 0; bk < 4; ++bk) { unsigned cur[16];
#pragma unroll
                for (int s = 0; s < 16; ++s) cur[s] = cand[bk * 16 + s];
                sort16_(cur);
                if (bk == 0) {
#pragma unroll
                    for (int s = 0; s < 16; ++s) k2[s] = cur[s];
                } else merge16_(k2, cur); } }
#pragma unroll
        for (int s = 0; s < 16; ++s) { tb[s * 512 + tid] = i1[s]; tb[(16 + s) * 512 + tid] = i2[s]; }
        const float mx = unskey(k2[0] & 0xFFFFFF00u); float ev[16], sum = 0.f; unsigned pl[16];
#pragma unroll
        for (int s = 0; s < 16; ++s) { ev[s] = __expf(unskey(k2[s] & 0xFFFFFF00u) - mx); sum += ev[s];
            const unsigned a = (k2[s] >> 4) & 15u, bb = k2[s] & 15u; pl[s] = (tb[a * 512 + tid] << 7) | tb[(16 + bb) * 512 + tid]; }
        const float inv = __builtin_amdgcn_rcpf(sum);
        if (p == 0) { GAS u32x2* lp = list + (size_t)row * 128 + hh * 16;
#pragma unroll
            for (int s = 0; s < 16; ++s) lp[s] = (u32x2){pl[s], __builtin_bit_cast(unsigned, ev[s] * inv)}; }
    }
}

template <class PT> __device__ __forceinline__ void load_row16c(PT p, int lane, float (&x)[16]) {
#pragma unroll
    for (int k = 0; k < 4; ++k) { const f32x4 a = *(const GAS f32x4*)(p + 16 * lane + 4 * k);
#pragma unroll
        for (int e = 0; e < 4; ++e) x[4 * k + e] = a[e]; }
}
template <class PT> __device__ __forceinline__ void store_row16c_f32(PT p, int lane, const float (&x)[16]) {
#pragma unroll
    for (int k = 0; k < 4; ++k) *(GAS f32x4*)(p + 16 * lane + 4 * k) = (f32x4){x[4 * k], x[4 * k + 1], x[4 * k + 2], x[4 * k + 3]};
}
template <class PT> __device__ __forceinline__ void store_row16c_bf16(PT p, int lane, const float (&y)[16]) {
    u32x4 a, b; a.x = pk2(y[0], y[1]); a.y = pk2(y[2], y[3]); a.z = pk2(y[4], y[5]); a.w = pk2(y[6], y[7]);
    b.x = pk2(y[8], y[9]); b.y = pk2(y[10], y[11]); b.z = pk2(y[12], y[13]); b.w = pk2(y[14], y[15]);
    *(GAS u32x4*)(p + 16 * lane) = a; *(GAS u32x4*)(p + 16 * lane + 8) = b;
}
template <class G1, class G2> __device__ __forceinline__ void norm_mod16c(const float (&x)[16], G1 g, G2 shift, G2 scale, int lane, float (&y)[16]) {
    float ss = 0.f;
#pragma unroll
    for (int e = 0; e < 16; ++e) ss += x[e] * x[e];
    ss = wave_sum(ss);
    const float r = rsqrtf(ss * (1.0f / 1024.0f) + 1e-6f);
    float gg[16]; load_row16c(g, lane, gg);
    if (shift) { float sh[16], sc[16]; load_row16c(shift, lane, sh); load_row16c(scale, lane, sc);
#pragma unroll
        for (int e = 0; e < 16; ++e) y[e] = x[e] * r * gg[e] * (1.0f + sc[e]) + sh[e];
    } else {
#pragma unroll
        for (int e = 0; e < 16; ++e) y[e] = x[e] * r * gg[e];
    }
}
__device__ __forceinline__ void p8u_dots(const PV& P, int l, int nrows) {
    const int tid = otid(), lane = tid & 63, w = tid >> 6, eg = lane >> 3, cs = lane & 7;
    const bool sliced = (gridDim.x & 7) == 0;
    const int x0 = sliced ? (blockIdx.x & 7) : 0, xstep = sliced ? 8 : 1;
    const int gwx = sliced ? (blockIdx.x >> 3) * 8 + w : blockIdx.x * 8 + w, nW = sliced ? (gridDim.x >> 3) * 8 : gridDim.x * 8;
    const GAS unsigned* listw = (const GAS unsigned*)(P.ws + WS_LIST); const GAS bf16_t* h2 = (const GAS bf16_t*)(P.ws + WS_ACT);
    GAS bf16_t* pd = (GAS bf16_t*)(P.ws + WS_SC);
    for (int x = x0; x < 8; x += xstep) {
        const GAS unsigned char* U8 = (const GAS unsigned char*)P.ws + WS_U8 + (size_t)l * NEXP * 1024 + (size_t)x * NEXP * 128 + 16 * cs;
        unsigned idn[16]; u32x4 uu[16]; u32x4 hc0, hc1, hn0, hn1;
        int row = gwx;
        if (row < nrows) {
#pragma unroll
            for (int g = 0; g < 16; ++g) idn[g] = listw[((size_t)row * 128 + 8 * g + eg) * 2];
            hc0 = *(const GAS u32x4*)(h2 + (size_t)row * 1024 + 128 * x + 16 * cs); hc1 = *(const GAS u32x4*)(h2 + (size_t)row * 1024 + 128 * x + 16 * cs + 8);
#pragma unroll
            for (int g = 0; g < 16; ++g) uu[g] = *(const GAS u32x4*)(U8 + (size_t)idn[g] * 128);
            const int rn = row + nW < nrows ? row + nW : row;
#pragma unroll
            for (int g = 0; g < 16; ++g) idn[g] = listw[((size_t)rn * 128 + 8 * g + eg) * 2];
            hn0 = *(const GAS u32x4*)(h2 + (size_t)rn * 1024 + 128 * x + 16 * cs); hn1 = *(const GAS u32x4*)(h2 + (size_t)rn * 1024 + 128 * x + 16 * cs + 8);
        }
        for (; row < nrows; row += nW) {
            f32x2 hx[8];
            hx[0] = (f32x2){bflo(hc0.x), bfhi(hc0.x)}; hx[1] = (f32x2){bflo(hc0.y), bfhi(hc0.y)}; hx[2] = (f32x2){bflo(hc0.z), bfhi(hc0.z)}; hx[3] = (f32x2){bflo(hc0.w), bfhi(hc0.w)};
            hx[4] = (f32x2){bflo(hc1.x), bfhi(hc1.x)}; hx[5] = (f32x2){bflo(hc1.y), bfhi(hc1.y)}; hx[6] = (f32x2){bflo(hc1.z), bfhi(hc1.z)}; hx[7] = (f32x2){bflo(hc1.w), bfhi(hc1.w)};
#pragma unroll
            for (int k = 0; k < 8; ++k) asm volatile("" : "+v"(hx[k]));
            GAS bf16_t* pdr = pd + ((size_t)x * nrows + row) * 128 + 8 * cs + eg;
#pragma unroll
            for (int half = 0; half < 2; ++half) { float d[8];
#pragma unroll
                for (int gg = 0; gg < 8; ++gg) { const int g = 8 * half + gg; f32x2 a2 = (f32x2){0.f, 0.f};
#pragma unroll
                    for (int q = 0; q < 4; ++q) { const f32x2 lo = __builtin_amdgcn_cvt_pk_f32_fp8((int)uu[g][q], false), hi = __builtin_amdgcn_cvt_pk_f32_fp8((int)uu[g][q], true);
                        a2 += lo * hx[2 * q]; a2 += hi * hx[2 * q + 1]; }
                    uu[g] = *(const GAS u32x4*)(U8 + (size_t)idn[g] * 128);
                    d[gg] = a2[0] + a2[1]; }
                const bool c4 = (cs & 4) != 0, c2 = (cs & 2) != 0, c1 = (cs & 1) != 0;
                float e4[4], e2[2];
#pragma unroll
                for (int j = 0; j < 4; ++j) { const float snd = c4 ? d[j] : d[j + 4], kp = c4 ? d[j + 4] : d[j]; e4[j] = kp + dppf<0x141>(snd); }
#pragma unroll
                for (int j = 0; j < 2; ++j) { const float snd = c2 ? e4[j] : e4[j + 2], kp = c2 ? e4[j + 2] : e4[j]; e2[j] = kp + dppf<0x4E>(snd); }
                { const float snd = c1 ? e2[0] : e2[1], kp = c1 ? e2[1] : e2[0]; pdr[64 * half] = (bf16_t)f2bf(kp + dppf<0xB1>(snd)); } }
            hc0 = hn0; hc1 = hn1;
            const int r2 = row + 2 * nW < nrows ? row + 2 * nW : row;
#pragma unroll
            for (int g = 0; g < 16; ++g) idn[g] = listw[((size_t)r2 * 128 + 8 * g + eg) * 2];
            hn0 = *(const GAS u32x4*)(h2 + (size_t)r2 * 1024 + 128 * x + 16 * cs); hn1 = *(const GAS u32x4*)(h2 + (size_t)r2 * 1024 + 128 * x + 16 * cs + 8);
        }
    }
}
__device__ __forceinline__ void p8c_coef(const PV& P, int nrows) {
    const int tid = otid();
    GAS u32x4* list4 = (GAS u32x4*)(P.ws + WS_LIST); const GAS u32x2* pd4 = (const GAS u32x2*)(P.ws + WS_SC);
    const int n4 = nrows * 32, nth = gridDim.x * 512;
    for (int i = blockIdx.x * 512 + tid; i < n4; i += nth) { f32x4 sacc = (f32x4){0.f, 0.f, 0.f, 0.f};
        u32x4 e0 = list4[(size_t)2 * i], e1 = list4[(size_t)2 * i + 1];
#pragma unroll
        for (int xx = 0; xx < 8; ++xx) { const u32x2 pw = pd4[(size_t)xx * n4 + i]; sacc += (f32x4){bflo(pw.x), bfhi(pw.x), bflo(pw.y), bfhi(pw.y)}; }
        const unsigned g0 = e0.y, g1 = e0.w, g2 = e1.y, g3 = e1.w;
        e0.y = __float_as_uint(__uint_as_float(g0) * geluf_(sacc[0] * (1.0f / 32.0f)) * 0.5f);
        e0.w = __float_as_uint(__uint_as_float(g1) * geluf_(sacc[1] * (1.0f / 32.0f)) * 0.5f);
        e1.y = __float_as_uint(__uint_as_float(g2) * geluf_(sacc[2] * (1.0f / 32.0f)) * 0.5f);
        e1.w = __float_as_uint(__uint_as_float(g3) * geluf_(sacc[3] * (1.0f / 32.0f)) * 0.5f);
        list4[(size_t)2 * i] = e0; list4[(size_t)2 * i + 1] = e1; }
}
__device__ __forceinline__ void p8v_accum(const PV& P, int l, int nrows, LAS unsigned char* lds) {
    const int tid = otid(), lane = tid & 63, w = tid >> 6, eg = lane >> 3, cs = lane & 7;
    const bool sliced = (gridDim.x & 7) == 0;
    const int x0 = sliced ? (blockIdx.x & 7) : 0, xstep = sliced ? 8 : 1;
    const int gwx = sliced ? (blockIdx.x >> 3) * 8 + w : blockIdx.x * 8 + w, nW = sliced ? (gridDim.x >> 3) * 8 : gridDim.x * 8;
    const GAS unsigned* listw = (const GAS unsigned*)(P.ws + WS_LIST);
    const GAS float* modl = (const GAS float*)(P.ws + WS_MOD) + (size_t)l * 9 * 6144; const GAS float* X1 = (const GAS float*)(P.ws + WS_X1);
    LAS float* cl = (LAS float*)(lds + w * 1024);
    LAS unsigned* il = (LAS unsigned*)(cl + 128);
    const bool b5 = (lane & 32) != 0, b4 = (lane & 16) != 0, b3 = (lane & 8) != 0;
    for (int x = x0; x < 8; x += xstep) {
        const GAS unsigned char* V8 = (const GAS unsigned char*)P.ws + WS_V8 + (size_t)l * NEXP * 1024 + (size_t)x * NEXP * 128 + 16 * cs;
        unsigned n_i0, n_i1, n_c0, n_c1;
        u32x4 vv[16]; float cfc[16];
#define V_LOAD1(r) do { const GAS unsigned* lw = listw + ((size_t)(r) * 128 + lane) * 2; n_i0 = lw[0]; n_c0 = lw[1]; n_i1 = lw[128]; n_c1 = lw[129]; } while (0)
#define V_TOLDS() do { cl[lane] = __builtin_bit_cast(float, n_c0); cl[64 + lane] = __builtin_bit_cast(float, n_c1); il[lane] = n_i0; il[64 + lane] = n_i1; asm volatile("s_waitcnt lgkmcnt(0)" ::: "memory"); } while (0)
        int row = gwx;
        if (row < nrows) {
            V_LOAD1(row); V_TOLDS();
#pragma unroll
            for (int g = 0; g < 16; ++g) { const unsigned id = il[8 * g + eg]; cfc[g] = cl[8 * g + eg]; vv[g] = *(const GAS u32x4*)(V8 + (size_t)id * 128); }
            const int rn = row + nW < nrows ? row + nW : row;
            V_LOAD1(rn); asm volatile("s_waitcnt lgkmcnt(0)" ::: "memory"); V_TOLDS();
            const int r2 = row + 2 * nW < nrows ? row + 2 * nW : row;
            V_LOAD1(r2);
        }
        for (; row < nrows; row += nW) { const int mr = row < TL ? (row >> 11) : 8;
            f32x2 acc[8];
#pragma unroll
            for (int j = 0; j < 8; ++j) acc[j] = (f32x2){0.f, 0.f};
#pragma unroll
            for (int g = 0; g < 16; ++g) { const f32x2 c2 = (f32x2){cfc[g], cfc[g]};
#pragma unroll
                for (int q = 0; q < 4; ++q) { const f32x2 lo = __builtin_amdgcn_cvt_pk_f32_fp8((int)vv[g][q], false), hi = __builtin_amdgcn_cvt_pk_f32_fp8((int)vv[g][q], true);
                    acc[2 * q] += c2 * lo; acc[2 * q + 1] += c2 * hi; }
                const unsigned id = il[8 * g + eg]; cfc[g] = cl[8 * g + eg]; vv[g] = *(const GAS u32x4*)(V8 + (size_t)id * 128); }
            f32x2 a4[4], a2v[2], a1;
#pragma unroll
            for (int j = 0; j < 4; ++j) { const f32x2 snd = b5 ? acc[j] : acc[j + 4], kp = b5 ? acc[j + 4] : acc[j]; a4[j] = kp + (f32x2){__shfl_xor(snd[0], 32), __shfl_xor(snd[1], 32)}; }
#pragma unroll
            for (int j = 0; j < 2; ++j) { const f32x2 snd = b4 ? a4[j] : a4[j + 2], kp = b4 ? a4[j + 2] : a4[j]; a2v[j] = kp + (f32x2){__shfl_xor(snd[0], 16), __shfl_xor(snd[1], 16)}; }
            { const f32x2 snd = b3 ? a2v[0] : a2v[1], kp = b3 ? a2v[1] : a2v[0]; a1 = kp + (f32x2){__shfl_xor(snd[0], 8), __shfl_xor(snd[1], 8)}; }
            const int col = 128 * x + 16 * cs + 2 * eg;
            const f32x2 xm = *(const GAS f32x2*)(X1 + (size_t)row * 1024 + col), g5 = *(const GAS f32x2*)(modl + (size_t)mr * 6144 + 5 * 1024 + col);
            GAS float* xo = row < TL ? (GAS float*)P.out + (size_t)row * 1024 : (GAS float*)(P.ws + WS_X0C) + (size_t)(row - TL) * 1024;
            *(GAS f32x2*)(xo + col) = xm + g5 * a1;
            V_TOLDS();
            const int r3 = row + 3 * nW < nrows ? row + 3 * nW : row;
            V_LOAD1(r3);
        }
#undef V_LOAD1
#undef V_TOLDS
    }
}
__device__ __forceinline__ void p8w_norm(const PV& P, int l, int nrows) {
    const int tid = otid(), lane = tid & 63, gw = blockIdx.x * 8 + (tid >> 6), NGW = gridDim.x * 8;
    for (int row = gw; row < nrows; row += NGW) { const int mr = row < TL ? (row >> 11) : 8;
        float* xo = row < TL ? P.out + (size_t)row * 1024 : (float*)(P.ws + WS_X0C) + (size_t)(row - TL) * 1024;
        float xn[16], y[16]; load_row16c(xo, lane, xn);
        if (l == 0) { const float* mod1 = (const float*)(P.ws + WS_MOD) + (size_t)9 * 6144 + (size_t)mr * 6144;
            norm_mod16c(xn, PIN(I_N1G) + 1024, mod1, mod1 + 1024, lane, y);
            store_row16c_bf16((bf16_t*)(P.ws + WS_ACT) + (size_t)row * 1024, lane, y);
        } else { norm_mod16c(xn, PIN(I_FNG), (const float*)nullptr, (const float*)nullptr, lane, y); store_row16c_f32(xo, lane, y); }
    }
}

typedef __attribute__((address_space(1))) unsigned gu32;
#define XB_TMO      128
#define XB_XCNT(j)  (256  + 64 * (j))
#define XB_XSUB(j)  (1280 + 64 * (j))
#define XB_XGEN(j)  (2304 + 64 * (j))
#define XB_TOP      3328
#define XB_TOPGEN   3392
#define XCD_BAR_WORDS 3456
#define XB_SPIN_CAP (1u << 18)

__device__ __forceinline__ unsigned xb_ld(unsigned* p)              { return __hip_atomic_load(p, __ATOMIC_RELAXED, __HIP_MEMORY_SCOPE_AGENT); }
__device__ __forceinline__ unsigned xb_add(unsigned* p, unsigned v) { return __hip_atomic_fetch_add(p, v, __ATOMIC_RELAXED, __HIP_MEMORY_SCOPE_AGENT); }
__device__ __forceinline__ unsigned xb_xcc_id() { return (unsigned)__builtin_amdgcn_s_getreg((3 << 11) | 20) & 0xFu; }
#define XB_SPIN(cond, bar) do { unsigned _sp = 0; while (cond) { __builtin_amdgcn_s_sleep(1); \
    if ((++_sp & 255u) == 0u) { if (xb_ld(&(bar)[XB_TMO])) break; if (_sp > XB_SPIN_CAP) { atomicAdd(&(bar)[XB_TMO], 1u); break; } } } } while (0)

struct XcdBarrier {
    unsigned* bar; unsigned x;
    volatile LAS unsigned* st;
};

__device__ __forceinline__ XcdBarrier xcd_barrier_post(unsigned* bar, volatile LAS unsigned* st) {
    XcdBarrier b; b.bar = bar; b.x = xb_xcc_id(); b.st = st;
    if (threadIdx.x == 0) (void)xb_add(&bar[XB_XCNT(b.x)], 1u);
    return b;
}
__device__ __forceinline__ void xcd_barrier_complete(unsigned* bar, unsigned x, unsigned& nloc, unsigned& nx) {
    const unsigned G = gridDim.x * gridDim.y * gridDim.z;
    unsigned sum, cnt, mine, sp = 0u;
    for (;;) {
        sum = 0u; cnt = 0u; mine = 0u;
#pragma unroll
        for (unsigned j = 0; j < 16; ++j) { const unsigned c = xb_ld(&bar[XB_XCNT(j)]); sum += c; cnt += (c > 0u) ? 1u : 0u; mine = (j == x) ? c : mine; }
        if (sum == G) break;
        __builtin_amdgcn_s_sleep(1);
        if ((++sp & 255u) == 0u) { if (xb_ld(&bar[XB_TMO])) break; if (sp > XB_SPIN_CAP) { atomicAdd(&bar[XB_TMO], 1u); break; } }
    }
    nloc = mine > 0u ? mine : 1u; nx = cnt > 0u ? cnt : 1u;
}

__device__ __forceinline__ void xcd_barrier(const XcdBarrier& b) {
    asm volatile("s_waitcnt vmcnt(0)" ::: "memory");
    __syncthreads();
    if (threadIdx.x == 0) {
        unsigned* bar = b.bar;
        __builtin_amdgcn_s_waitcnt(0);
        unsigned nloc = b.st[0], nx = b.st[1];
        if (nloc == 0u) { xcd_barrier_complete(bar, b.x, nloc, nx); b.st[0] = nloc; b.st[1] = nx; }
        const unsigned old = xb_add(&bar[XB_XSUB(b.x)], 1u);
        const unsigned gen = old / nloc;
        if (old + 1u == (gen + 1u) * nloc) {
            __builtin_amdgcn_fence(__ATOMIC_RELEASE, "agent");
            asm volatile("s_waitcnt vmcnt(0)" ::: "memory");
            const unsigned og = xb_add(&bar[XB_TOP], 1u);
            const unsigned tg = og / nx;
            if (og + 1u == (tg + 1u) * nx) xb_add(&bar[XB_TOPGEN], 1u);
            else XB_SPIN(xb_ld(&bar[XB_TOPGEN]) == tg, bar);
            __builtin_amdgcn_fence(__ATOMIC_ACQUIRE, "agent");
            xb_add(&bar[XB_XGEN(b.x)], 1u);
            asm volatile("s_waitcnt vmcnt(0)" ::: "memory");
        } else {
            XB_SPIN(xb_ld(&bar[XB_XGEN(b.x)]) == gen, bar);
            __builtin_amdgcn_fence(__ATOMIC_ACQUIRE, "agent");
            asm volatile("s_waitcnt vmcnt(0)" ::: "memory");
        }
    }
    __syncthreads();
}

#define GSYNC() do { xcd_barrier(xbar); if (PROBE_DUP & 32) xcd_barrier(xbar); } while (0)
template <int l>
__device__ __forceinline__ void run_layer(const PV& P, const XcdBarrier& xbar) {
    const int nrows = l == 0 ? TT : TL;
    for (int rep = 0; rep < ((PROBE_DUP & 8) ? 2 : 1); ++rep) { const PV Q = opq(P);
        pg8::Gemm g{(const bf16_t*)(Q.ws + WS_ACT), (const bf16_t*)(Q.ws + WS_WIN) + (size_t)l * ZW * 1024, TT, ZW, 1024};
        pg8::StaticOrder S; S.init(TT, ZW, gridDim.x, blockIdx.x);
        pg8::EpiZ E{(bf16_t*)(Q.ws + WS_Z), ZW};
        pg8::gemm_phase<pg8::EpiZ, pg8::StaticOrder, true, true>(Q.lds, g, S, E);
        if (l == 0 && (int)gridDim.x == 256 && (int)blockIdx.x >= 24) p0_tables(Q, 1, blockIdx.x - 24, 232);
        else if (l == 0 && (int)gridDim.x != 256) p0_tables(Q, 1, blockIdx.x, gridDim.x); }
    GSYNC();
    for (int rep = 0; rep < ((PROBE_DUP & 128) ? 2 : 1); ++rep) { const PV Q = opq(P); rwkv_pre(Q, l, Q.lds); }
    for (int rep = 0; rep < ((PROBE_DUP & 65536) ? 2 : 1); ++rep) { const PV Q = opq(P); lru_items(Q, l, Q.lds); }
    GSYNC();
    for (int rep = 0; rep < ((PROBE_DUP & 2) ? 2 : 1); ++rep) {
        for (;;) {
            const PV Q = opq(P);
            __syncthreads();
            if (otid() == 0) *(LAS int*)(Q.lds + LDS_BYTES - 16) = (int)atomicAdd((unsigned*)(Q.ws + WS_CTL) + 64 * (1 + l + 2 * rep), 1u);
            __syncthreads();
            const int u = *(LAS int*)(Q.lds + LDS_BYTES - 16);
            if (u >= 272) break;
            if (u < 128) { for (int r2 = 0; r2 < ((PROBE_DUP & 16384) ? 2 : 1); ++r2) s5_unit(Q, l, u, Q.lds); }
            else if (u < 192) { for (int r2 = 0; r2 < ((PROBE_DUP & 4096) ? 2 : 1); ++r2) rwkv_seq(Q, l, u - 128, Q.lds); }
            else if (u < 256) { for (int r2 = 0; r2 < ((PROBE_DUP & 8192) ? 2 : 1); ++r2) ret_unit(Q, l, u - 192, Q.lds); }
            else lru_carry_unit(Q, u - 256);
        }
        if (PROBE_DUP & 2) GSYNC();
    }
    if (!(PROBE_DUP & 2)) GSYNC();
    for (int rep = 0; rep < ((PROBE_DUP & 16) ? 2 : 1); ++rep) { const PV Q = opq(P); p3_combine(Q, l, nrows, Q.lds); __syncthreads(); }
    GSYNC();
    for (int rep = 0; rep < ((PROBE_DUP & 8) ? 2 : 1); ++rep) { const PV Q = opq(P);
        pg8::Gemm g{(const bf16_t*)(Q.ws + WS_S5G), (const bf16_t*)(Q.ws + WS_GLU) + (size_t)l * 512 * 256, nrows, 512, 256};
        pg8::StaticOrder S; S.init(nrows, 512, gridDim.x, blockIdx.x);
        pg8::EpiGlu E{(bf16_t*)(Q.ws + WS_ACT), inp_(Q.tab, I_GLUB) + l * 512};
        pg8::gemm_phase<pg8::EpiGlu, pg8::StaticOrder, true, true>(Q.lds, g, S, E); }
    GSYNC();
    for (int rep = 0; rep < ((PROBE_DUP & 8) ? 2 : 1); ++rep) { const PV Q = opq(P);
        pg8::Gemm g{(const bf16_t*)(Q.ws + WS_ACT), (const bf16_t*)(Q.ws + WS_WOUT) + (size_t)l * 1024 * 1024, nrows, 1024, 1024};
        pg8::StaticOrder S; S.init(nrows, 1024, gridDim.x, blockIdx.x);
        pg8::EpiRes E{l == 0 ? inp_(Q.tab, I_X) : (const float*)Q.out, l == 0 ? inp_(Q.tab, I_CTX) : (const float*)(Q.ws + WS_X0C),
                      (const float*)(Q.ws + WS_MOD) + (size_t)l * 9 * 6144 + 2048, (float*)(Q.ws + WS_X1)};
        pg8::gemm_phase<pg8::EpiRes, pg8::StaticOrder, true, true>(Q.lds, g, S, E);
        if (l == 0 && (int)gridDim.x == 256 && (int)blockIdx.x >= 32) p0_transposes(Q, 1, blockIdx.x - 32, 224, Q.lds);
        else if (l == 0 && (int)gridDim.x != 256) p0_transposes(Q, 1, blockIdx.x, gridDim.x, Q.lds); }
    GSYNC();
    for (int rep = 0; rep < ((PROBE_DUP & 16) ? 2 : 1); ++rep) { const PV Q = opq(P); p6_h2(Q, l, nrows); }
    GSYNC();
    for (int rep = 0; rep < ((PROBE_DUP & 8) ? 2 : 1); ++rep) { const PV Q = opq(P);
        pg8::Gemm g{(const bf16_t*)(Q.ws + WS_ACT), (const bf16_t*)(Q.ws + WS_WEFF) + (size_t)l * 2048 * 1024, nrows, 2048, 1024};
        pg8::StaticOrder S; S.init(nrows, 2048, gridDim.x, blockIdx.x);
        pg8::EpiF32 E{(float*)(Q.ws + WS_SC), 2048};
        pg8::gemm_phase<pg8::EpiF32, pg8::StaticOrder, true, true>(Q.lds, g, S, E);
        if (l == 0 && (int)gridDim.x == 256 && (int)blockIdx.x >= 64) p0_weff(Q, 1, blockIdx.x - 64, 192, Q.lds);
        else if (l == 0 && (int)gridDim.x != 256) p0_weff(Q, 1, blockIdx.x, gridDim.x, Q.lds); }
    GSYNC();
    for (int rep = 0; rep < ((PROBE_DUP & 4) ? 2 : 1); ++rep) { const PV Q = opq(P); p8a_topk(Q, nrows, Q.lds); }
    GSYNC();
    for (int rep = 0; rep < ((PROBE_DUP & 1) ? 2 : 1); ++rep) { const PV Q = opq(P); p8u_dots(Q, l, nrows); }
    GSYNC();
    { const PV Q = opq(P); p8c_coef(Q, nrows); }
    GSYNC();
    for (int rep = 0; rep < ((PROBE_DUP & 2048) ? 2 : 1); ++rep) { const PV Q = opq(P); p8v_accum(Q, l, nrows, Q.lds); }
    GSYNC();
    { const PV Q = opq(P); p8w_norm(Q, l, nrows); }
    if (l == 0) GSYNC();
}

__global__ void __launch_bounds__(512, 2) fwd_mega(Params KP) {
    extern __shared__ __attribute__((aligned(16))) unsigned char lds_raw[];
    LAS unsigned char* lds = (LAS unsigned char*)lds_raw;
    cg::grid_group grid = cg::this_grid();
    const int tid = otid();
    PV P; P.tab = (const LAS unsigned*)(lds + LDS_BYTES - 1024); P.ws = KP.ws; P.out = KP.out; P.lds = lds;
    if (tid < 88) { const unsigned* ka = (const unsigned*)__builtin_amdgcn_kernarg_segment_ptr(); ((LAS unsigned*)(lds + LDS_BYTES - 1024))[tid] = ka[tid]; }
    if (tid < 4) ((LAS unsigned*)(lds + LDS_BYTES - 64))[tid] = 0u;
    __syncthreads();
    const XcdBarrier xbar = xcd_barrier_post((unsigned*)(KP.ws + WS_CTL) + 4096, (volatile LAS unsigned*)(lds + LDS_BYTES - 64));

    for (int rep = 0; rep < ((PROBE_DUP & 64) ? 2 : 1); ++rep) { const PV Q = opq(P); p0_prologue(Q, Q.lds); __syncthreads(); }
    if (KP.ws == nullptr) grid.sync();
    GSYNC();
    { const PV Q = opq(P); p0b_ain(Q); }
    GSYNC();

    run_layer<0>(P, xbar);
    run_layer<1>(P, xbar);
}

extern "C" void kernel_launch(void* const* d_in, const int* in_sizes, int n_in, void* d_out, int out_size, void* d_ws, size_t ws_size, hipStream_t stream) {
    static int grid = 0;
    if (grid == 0) {
        if (n_in != 44 || out_size != TL * DM || ws_size < WS_END) { fprintf(stderr, "kernel_launch: unexpected shapes (n_in %d, out %d, ws %zu; need ws >= %zu)\n", n_in, out_size, ws_size, (size_t)WS_END); grid = -1; return; }
        int dev = 0, cus = 0, per_cu = 0;
        hipGetDevice(&dev); hipDeviceGetAttribute(&cus, hipDeviceAttributeMultiprocessorCount, dev);
        hipFuncSetAttribute((const void*)fwd_mega, hipFuncAttributeMaxDynamicSharedMemorySize, LDS_BYTES);
        hipOccupancyMaxActiveBlocksPerMultiprocessor(&per_cu, (const void*)fwd_mega, 512, LDS_BYTES);
        if (per_cu < 1) { fprintf(stderr, "kernel_launch: occupancy query says %d blocks/CU\n", per_cu); per_cu = 1; }
        grid = cus;
        (void)hipGetLastError();
    }
    if (grid < 0) return;
    hipMemsetAsync((char*)d_ws + WS_CTL, 0, 65536, stream);
    Params p{};
    for (int i = 0; i < 44; ++i) p.in[i] = (const float*)d_in[i];
    p.out = (float*)d_out; p.ws = (unsigned char*)d_ws;
    void* args[] = {&p};
    hipError_t e = hipLaunchCooperativeKernel((const void*)fwd_mega, dim3(grid), dim3(512), args, LDS_BYTES, stream);
    if (e != hipSuccess) fprintf(stderr, "cooperative launch failed: %s (grid %d)\n", hipGetErrorString(e), grid);
}
```

```cpp
#include <hip/hip_runtime.h>
#include <hip/hip_cooperative_groups.h>
#include <hip/hip_fp16.h>
#include <cstdio>
#include <cstdint>
namespace cg = cooperative_groups;

#define LAS __attribute__((address_space(3)))
#define GAS __attribute__((address_space(1)))
typedef unsigned short bf16_t;
typedef short bf16x8 __attribute__((ext_vector_type(8)));
typedef float f32x4 __attribute__((ext_vector_type(4)));
typedef float f32x2 __attribute__((ext_vector_type(2)));
typedef unsigned u32x4 __attribute__((ext_vector_type(4)));
typedef unsigned u32x2 __attribute__((ext_vector_type(2)));
typedef _Float16 h16x2 __attribute__((ext_vector_type(2)));

constexpr int DM = 1024, NB = 8, SEQ = 2048, CTX = 256;
constexpr int TL = NB * SEQ;
constexpr int TC = NB * CTX;
constexpr int TT = TL + TC;
constexpr int ZW = 2816;
constexpr int INC = 2752;
constexpr int CB_ = 960, CC_ = 1984, CD_ = 2496;
constexpr int NEXP = 16384;

constexpr size_t MiB = 1u << 20;
constexpr size_t WS_CTL = 0;
constexpr size_t WS_MOD = 1 * MiB;
constexpr size_t WS_WIN = 2 * MiB;
constexpr size_t WS_WOUT = 14 * MiB;
constexpr size_t WS_WEFF = 18 * MiB;
constexpr size_t WS_GLU = 26 * MiB;
constexpr size_t WS_U8 = 28 * MiB;
constexpr size_t WS_V8 = 60 * MiB;
constexpr size_t WS_REC = 156 * MiB;
constexpr size_t WS_ACT = 156 * MiB;
constexpr size_t WS_S5G = 192 * MiB;
constexpr size_t WS_X1 = 202 * MiB;
constexpr size_t WS_X0C = 274 * MiB;
constexpr size_t WS_Z = 316 * MiB;
constexpr size_t WS_Y = 415 * MiB;
constexpr size_t WS_SC = 316 * MiB;
constexpr size_t WS_LIST = 462 * MiB;
constexpr size_t WS_ACU = 487 * MiB;
constexpr size_t WS_AGG = 505 * MiB;
constexpr size_t WS_CIN = 507 * MiB;
constexpr size_t WS_END = 508 * MiB;
constexpr size_t YSZ = (size_t)TT * 256;
static_assert(WS_SC + (size_t)TT * 2048 * 4 <= WS_LIST && WS_LIST + (size_t)TT * 128 * 8 <= WS_END, "ws map");
static_assert(WS_Y + 8 * YSZ * 2 <= WS_END && WS_Z + (size_t)TT * ZW * 2 <= WS_Y, "ws map");
static_assert(WS_REC + (size_t)64 * 72 * 36096 <= WS_Z, "ws map");

constexpr int LDS_BYTES = 147456;

struct Params { const float* in[44]; float* out; unsigned char* ws; };
struct PV { const LAS unsigned* tab; unsigned char* ws; float* out; LAS unsigned char* lds; };
__device__ __forceinline__ const float* inp_(const LAS unsigned* tab, int i) {
    const unsigned lo = (unsigned)__builtin_amdgcn_readfirstlane((int)tab[2 * i]), hi = (unsigned)__builtin_amdgcn_readfirstlane((int)tab[2 * i + 1]);
    return (const float*)(((unsigned long long)hi << 32) | (unsigned long long)lo);
}
#define PIN(i) inp_(P.tab, (i))
__device__ __forceinline__ PV opq(const PV& P) { PV q = P; unsigned o = 0; asm volatile("" : "+s"(q.ws), "+s"(q.out), "+s"(o)); q.lds = P.lds + o; q.tab = (const LAS unsigned*)(q.lds + LDS_BYTES - 1024); return q; }
enum { I_X = 0, I_C, I_CTX, I_CCTX, I_N1G, I_N2G, I_ADAW, I_ADAB, I_WIN, I_WOUT, I_MU, I_W0, I_WUP, I_A0, I_AUP, I_GUP, I_KK, I_KA, I_RK, I_LNG, I_LNB,
       I_GNG, I_CVW, I_CVB, I_WA, I_BA, I_WX, I_BX, I_LAM, I_SARE, I_SAIM, I_SLDT, I_SBRE, I_SBIM, I_SCRE, I_SCIM, I_SD, I_GLUW, I_GLUB, I_WQ, I_KEYS, I_PU, I_PV, I_FNG };

#define LDS_BARRIER() do { asm volatile("s_waitcnt lgkmcnt(0)" ::: "memory"); __builtin_amdgcn_s_barrier(); asm volatile("" ::: "memory"); } while (0)
__device__ __forceinline__ int otid() { int t = threadIdx.x; asm volatile("" : "+v"(t)); return t; }
__device__ __forceinline__ unsigned f2bf(float f) { unsigned u = __builtin_bit_cast(unsigned, f); return (u + 0x7fffu + ((u >> 16) & 1u)) >> 16; }
__device__ __forceinline__ unsigned pk2(float lo, float hi) { return f2bf(lo) | (f2bf(hi) << 16); }
__device__ __forceinline__ unsigned pk2a(float lo, float hi) { unsigned r; asm("v_cvt_pk_bf16_f32 %0, %1, %2" : "=v"(r) : "v"(lo), "v"(hi)); return r; }
__device__ __forceinline__ float bf2f(unsigned b) { return __builtin_bit_cast(float, b << 16); }
__device__ __forceinline__ float bflo(unsigned w) { return __builtin_bit_cast(float, w << 16); }
__device__ __forceinline__ float bfhi(unsigned w) { return __builtin_bit_cast(float, w & 0xffff0000u); }

template <int CTRL> __device__ __forceinline__ float dppf(float v) {
    return __builtin_bit_cast(float, __builtin_amdgcn_update_dpp(0, __builtin_bit_cast(int, v), CTRL, 0xF, 0xF, true));
}
template <int CTRL> __device__ __forceinline__ unsigned dppu(unsigned v) {
    return (unsigned)__builtin_amdgcn_update_dpp(0, (int)v, CTRL, 0xF, 0xF, true);
}
__device__ __forceinline__ float sum8(float v) {
    v += dppf<0xB1>(v);
    v += dppf<0x4E>(v);
    v += dppf<0x141>(v);
    return v;
}
__device__ __forceinline__ float wave_sum(float v) {
    v = sum8(v); v += dppf<0x140>(v);
    const float s0 = __builtin_bit_cast(float, __builtin_amdgcn_readlane(__builtin_bit_cast(int, v), 0)), s1 = __builtin_bit_cast(float, __builtin_amdgcn_readlane(__builtin_bit_cast(int, v), 16));
    const float s2 = __builtin_bit_cast(float, __builtin_amdgcn_readlane(__builtin_bit_cast(int, v), 32)), s3 = __builtin_bit_cast(float, __builtin_amdgcn_readlane(__builtin_bit_cast(int, v), 48));
    return (s0 + s1) + (s2 + s3);
}
__device__ __forceinline__ float sigmoidf_(float x) { return __builtin_amdgcn_rcpf(1.0f + __expf(-x)); }
__device__ __forceinline__ float tanhf_(float x) { return 1.0f - 2.0f * __builtin_amdgcn_rcpf(1.0f + __expf(2.0f * x)); }
__device__ __forceinline__ float softplusf_(float x) { return fmaxf(x, 0.0f) + __logf(1.0f + __expf(-fabsf(x))); }
__device__ __forceinline__ float geluf_(float x) { return 0.5f * x * (1.0f + tanhf_(0.7978845608f * (x + 0.044715f * x * x * x))); }
__device__ __forceinline__ float siluf_(float x) { return x * sigmoidf_(x); }

template <int MT, int NT, int KS>
__device__ __forceinline__ void lds_mma(f32x4 (&acc)[MT][NT], const LAS bf16_t* A, int lda, const LAS bf16_t* Bt, int ldb, int lane) {
    const int r = lane & 15, q = lane >> 4;
#pragma unroll
    for (int ks = 0; ks < KS; ++ks) {
        bf16x8 a[MT], b[NT];
#pragma unroll
        for (int m = 0; m < MT; ++m) a[m] = *(const LAS bf16x8*)(A + (m * 16 + r) * lda + ks * 32 + q * 8);
#pragma unroll
        for (int n = 0; n < NT; ++n) b[n] = *(const LAS bf16x8*)(Bt + (n * 16 + r) * ldb + ks * 32 + q * 8);
#pragma unroll
        for (int m = 0; m < MT; ++m)
#pragma unroll
            for (int n = 0; n < NT; ++n) acc[m][n] = __builtin_amdgcn_mfma_f32_16x16x32_bf16(b[n], a[m], acc[m][n], 0, 0, 0);
    }
}
template <int MT, int NT> __device__ __forceinline__ void zero_acc(f32x4 (&acc)[MT][NT]) {
#pragma unroll
    for (int m = 0; m < MT; ++m)
#pragma unroll
        for (int n = 0; n < NT; ++n) acc[m][n] = (f32x4){0.f, 0.f, 0.f, 0.f};
}

namespace pg8 {
#define PG8_LAS __attribute__((address_space(3)))
typedef unsigned short bf16_t;
typedef short bf16x8 __attribute__((ext_vector_type(8)));
typedef float f32x4 __attribute__((ext_vector_type(4)));
typedef unsigned u32x4 __attribute__((ext_vector_type(4)));
constexpr int BM = 256, BK = 64, HALF = 128, HTB = HALF * BK * 2  , STAGE_BYTES = 8 * HTB, NXCD = 8, WGM = 8;

__host__ __device__ __forceinline__ int lds_byte(int r, int c) { const int st = (r >> 4) * 2 + (c >> 5), rr = r & 15, cc = c & 31, ob = rr * 64 + cc * 2; return st * 1024 + (ob ^ (((ob >> 9) & 1) << 5)); }
__host__ __device__ __forceinline__ void stage_rc(int b, int& R, int& C) { const int st = b / 1024, sb = b % 1024, swz = sb ^ (((sb >> 9) & 1) << 5); R = (st >> 1) * 16 + swz / 64; C = (st & 1) * 32 + (swz % 64) / 2; }
__host__ __device__ __forceinline__ int perm32(int rho) { const int n = rho >> 4, i = rho & 15; return 8 * (i >> 2) + 4 * n + (i & 3); }

struct Unit { int pm, pn; };
struct Gemm { const bf16_t* A; const bf16_t* Bt; int M, N, K; };

struct StaticOrder {
    int nM, nN, nwg, G, c;
    __host__ __device__ void init(int M, int N, int G_, int c_) { nM = M / BM; nN = N / BM; nwg = nM * nN; G = G_; c = c_; }
    __host__ __device__ bool next(int i, Unit& u) const {
        const long L = (long)i * G + c; if (L >= nwg) return false;
        int wgid = (int)L; { const int q = nwg / NXCD, r = nwg % NXCD, xcd = wgid % NXCD, off = wgid / NXCD; wgid = (xcd < r ? xcd * (q + 1) : r * (q + 1) + (xcd - r) * q) + off; }
        const int nig = WGM * nN, gid = wgid / nig, fm = gid * WGM, gsz = (nM - fm) < WGM ? (nM - fm) : WGM;
        u.pm = fm + ((wgid % nig) % gsz); u.pn = (wgid % nig) / gsz; return true;
    }
    __device__ __forceinline__ void a_ready(const Unit&) const {}
    __device__ __forceinline__ void done(const Unit&) const {}
};


__device__ __forceinline__ unsigned cvt_pk_bf16(float lo, float hi) { unsigned r; asm volatile("v_cvt_pk_bf16_f32 %0, %1, %2" : "=v"(r) : "v"(lo), "v"(hi)); return r; }

struct EpiZ {
    static constexpr bool PERM = true, AFTER_DRAIN = false;
    bf16_t* O; int ldc;
    __device__ __forceinline__ void operator()(const f32x4 (&acc)[2][2][4][2], const Unit& u, int wr, int wc, int fr, int fq) const {
        const int row0 = u.pm * BM + wr * 64 + fr, col0 = u.pn * BM + wc * 32 + 8 * fq;
#pragma unroll
        for (int ai = 0; ai < 2; ++ai)
#pragma unroll
            for (int m = 0; m < 4; ++m) { bf16_t* rowp = O + (size_t)(row0 + ai * HALF + m * 16) * ldc + col0;
#pragma unroll
                for (int bj = 0; bj < 2; ++bj) { const f32x4 v0 = acc[ai][bj][m][0], v1 = acc[ai][bj][m][1];
                    u32x4 w; w.x = cvt_pk_bf16(v0[0], v0[1]); w.y = cvt_pk_bf16(v0[2], v0[3]); w.z = cvt_pk_bf16(v1[0], v1[1]); w.w = cvt_pk_bf16(v1[2], v1[3]);
                    *(u32x4*)(rowp + bj * HALF) = w; } }
    }
};
struct EpiGlu {
    static constexpr bool PERM = false, AFTER_DRAIN = false;
    bf16_t* O; const float* gb;
    __device__ __forceinline__ void operator()(const f32x4 (&acc)[2][2][4][2], const Unit& u, int wr, int wc, int fr, int fq) const {
#pragma unroll
        for (int ai = 0; ai < 2; ++ai)
#pragma unroll
            for (int m = 0; m < 4; ++m) { const int row = u.pm * BM + ai * HALF + wr * 64 + m * 16 + fr;
#pragma unroll
                for (int n = 0; n < 2; ++n) { const int ch = u.pn * 128 + wc * 32 + n * 16 + 4 * fq;
                    const float* gp = gb; asm volatile("" : "+s"(gp));
                    const f32x4 bv = *(const f32x4*)(gp + ch), bg = *(const f32x4*)(gp + 256 + ch);
                    const f32x4 v = acc[ai][0][m][n] + bv, g = acc[ai][1][m][n] + bg; float o[4];
#pragma unroll
                    for (int e = 0; e < 4; ++e) o[e] = v[e] * __builtin_amdgcn_rcpf(1.0f + __expf(-g[e]));
                    unsigned lo = cvt_pk_bf16(o[0], o[1]), hi = cvt_pk_bf16(o[2], o[3]);
                    *(unsigned long long*)(O + (size_t)row * 1024 + 768 + ch) = (unsigned long long)lo | ((unsigned long long)hi << 32); } }
    }
};
struct EpiRes {
    static constexpr bool PERM = false, AFTER_DRAIN = false;
    const float* baseL; const float* baseC; const float* gate; float* out;
    __device__ __forceinline__ void operator()(const f32x4 (&acc)[2][2][4][2], const Unit& u, int wr, int wc, int fr, int fq) const {
        const int rowt = u.pm * BM; const int mr = rowt < 16384 ? (rowt >> 11) : 8;
        const float* grow = gate + (size_t)mr * 6144;
#pragma unroll
        for (int bj = 0; bj < 2; ++bj)
#pragma unroll
            for (int n = 0; n < 2; ++n) { const int col = u.pn * BM + bj * HALF + wc * 32 + n * 16 + 4 * fq; const f32x4 gv = *(const f32x4*)(grow + col);
#pragma unroll
                for (int ai = 0; ai < 2; ++ai)
#pragma unroll
                    for (int m = 0; m < 4; ++m) { const int row = rowt + ai * HALF + wr * 64 + m * 16 + fr;
                        const float* bp = row < 16384 ? baseL + (size_t)row * 1024 + col : baseC + (size_t)(row - 16384) * 1024 + col;
                        const f32x4 bs = *(const f32x4*)bp; *(f32x4*)(out + (size_t)row * 1024 + col) = bs + gv * acc[ai][bj][m][n]; } }
    }
};
struct EpiF32 {
    static constexpr bool PERM = false, AFTER_DRAIN = false;
    float* O; int ldc;
    __device__ __forceinline__ void operator()(const f32x4 (&acc)[2][2][4][2], const Unit& u, int wr, int wc, int fr, int fq) const {
#pragma unroll
        for (int ai = 0; ai < 2; ++ai)
#pragma unroll
            for (int m = 0; m < 4; ++m) { const int row = u.pm * BM + ai * HALF + wr * 64 + m * 16 + fr;
#pragma unroll
                for (int bj = 0; bj < 2; ++bj)
#pragma unroll
                    for (int n = 0; n < 2; ++n) { const int col = u.pn * BM + bj * HALF + wc * 32 + n * 16 + 4 * fq;
                        *(f32x4*)(O + (size_t)row * ldc + col) = acc[ai][bj][m][n]; } }
    }
};

template <class Epi, class Sched, bool ALIGN_EPI = false, bool SP2 = false>
__device__ __forceinline__ void gemm_phase(PG8_LAS unsigned char* lds, const Gemm g, const Sched& S, const Epi& E) {
    int tid_ = threadIdx.x; asm volatile("" : "+v"(tid_));
    const int tid = tid_, wid = __builtin_amdgcn_readfirstlane(tid >> 6), lane = tid & 63, wr = wid >> 2, wc = wid & 3, fr = lane & 15, fq = lane >> 4;
    const int K = g.K, nt = K / BK;
    unsigned voffA[2], voffB[2];
#pragma unroll
    for (int i = 0; i < 2; ++i) { int R, C; stage_rc(tid * 16 + i * 8192, R, C); const int Rb = Epi::PERM ? ((R & ~31) + perm32(R & 31)) : R;
        voffA[i] = (unsigned)(R * K + C) * 2u; voffB[i] = (unsigned)(Rb * K + C) * 2u; }
    const size_t kstep = (size_t)(BK * 2);
    const size_t hstep = (size_t)HALF * K * 2;
    const size_t tstep = 2 * hstep;
    const unsigned ldsw = (unsigned)wid * 1024u;
    const int aoff = lds_byte(wr * 64 + fr, fq * 8), boff = lds_byte(wc * 32 + fr, fq * 8);
#define PG8_SA(b, h) (((b) * 2 + (h)) * HTB)
#define PG8_SB(b, h) ((4 + (b) * 2 + (h)) * HTB)
#define PG8_STAGE(bufoff, gbase, voff) do { _Pragma("unroll") for (int _i = 0; _i < 2; ++_i) \
        __builtin_amdgcn_global_load_lds((const unsigned*)((const char*)(gbase) + (voff)[_i]), (PG8_LAS unsigned*)(lds + (bufoff) + ldsw + _i * 8192), 16, 0, 0); } while (0)
#define PG8_LDA(dst, b, h) do { _Pragma("unroll") for (int m = 0; m < 4; ++m) _Pragma("unroll") for (int k = 0; k < 2; ++k) dst[m][k] = *(const PG8_LAS bf16x8*)(lds + PG8_SA(b, h) + aoff + m * 2048 + k * 1024); } while (0)
#define PG8_LDB(dst, b, h) do { _Pragma("unroll") for (int n = 0; n < 2; ++n) _Pragma("unroll") for (int k = 0; k < 2; ++k) dst[n][k] = *(const PG8_LAS bf16x8*)(lds + PG8_SB(b, h) + boff + n * 2048 + k * 1024); } while (0)
#define PG8_MMA(ai, bj, At, Bt) do { __builtin_amdgcn_s_setprio(1); _Pragma("unroll") for (int m = 0; m < 4; ++m) _Pragma("unroll") for (int n = 0; n < 2; ++n) _Pragma("unroll") for (int k = 0; k < 2; ++k) \
        acc[ai][bj][m][n] = __builtin_amdgcn_mfma_f32_16x16x32_bf16(Bt[n][k], At[m][k], acc[ai][bj][m][n], 0, 0, 0); __builtin_amdgcn_s_setprio(0); } while (0)
#define PG8_WAIT_V(n) asm volatile("s_waitcnt vmcnt(" #n ")" ::: "memory")
#define PG8_WAIT_L(n) asm volatile("s_waitcnt lgkmcnt(" #n ")" ::: "memory")
#define PG8_BAR __builtin_amdgcn_s_barrier()
#define PG8_SCHED __builtin_amdgcn_sched_barrier(0)
    Unit cur, nxt; int ui = 0;
    if (!S.next(0, cur)) return;
    f32x4 acc[2][2][4][2];
#pragma unroll
    for (int a = 0; a < 2; ++a)
#pragma unroll
        for (int b = 0; b < 2; ++b)
#pragma unroll
            for (int m = 0; m < 4; ++m)
#pragma unroll
                for (int n = 0; n < 2; ++n) acc[a][b][m][n] = (f32x4){0.f, 0.f, 0.f, 0.f};
    bf16x8 At[4][2], B0[2][2], B1[2][2];
    const char* cA = (const char*)g.A + (size_t)cur.pm * tstep; const char* cB = (const char*)g.Bt + (size_t)cur.pn * tstep;
    S.a_ready(cur);
    if constexpr (SP2) {
        PG8_STAGE(PG8_SB(0, 0), cB, voffB); PG8_STAGE(PG8_SB(0, 1), cB + hstep, voffB); PG8_STAGE(PG8_SA(0, 0), cA, voffA); PG8_STAGE(PG8_SA(0, 1), cA + hstep, voffA);
        if (wr == 1) PG8_BAR;
        PG8_WAIT_V(2); PG8_BAR;
        PG8_STAGE(PG8_SB(1, 0), cB + kstep, voffB); PG8_STAGE(PG8_SA(1, 0), cA + kstep, voffA); PG8_STAGE(PG8_SB(1, 1), cB + hstep + kstep, voffB);
        PG8_WAIT_V(6); PG8_BAR;
    } else {
        PG8_STAGE(PG8_SB(0, 0), cB, voffB); PG8_STAGE(PG8_SA(0, 0), cA, voffA); PG8_STAGE(PG8_SB(0, 1), cB + hstep, voffB); PG8_STAGE(PG8_SA(0, 1), cA + hstep, voffA);
        if (wr == 1) PG8_BAR;
        PG8_WAIT_V(4); PG8_BAR;
        PG8_STAGE(PG8_SB(1, 0), cB + kstep, voffB); PG8_STAGE(PG8_SA(1, 0), cA + kstep, voffA); PG8_STAGE(PG8_SB(1, 1), cB + hstep + kstep, voffB);
        PG8_WAIT_V(6); PG8_BAR;
    }
    for (;;) {
        const bool has_next = S.next(ui + 1, nxt);
        const char* nA = has_next ? (const char*)g.A + (size_t)nxt.pm * tstep : cA; const char* nB = has_next ? (const char*)g.Bt + (size_t)nxt.pn * tstep : cB;
        for (int t = 0; t < nt; t += 2) {
            const bool last = (t == nt - 2);
            const char* a1 = cA + (size_t)(t + 1) * kstep;
            const char* a2 = last ? nA : cA + (size_t)(t + 2) * kstep; const char* b2 = last ? nB : cB + (size_t)(t + 2) * kstep;
            const char* a3 = a2 + kstep; const char* b3 = b2 + kstep;
            if (last && has_next) S.a_ready(nxt);
            if constexpr (SP2) {
            PG8_LDB(B0, 0, 0); PG8_LDB(B1, 0, 1); PG8_SCHED; PG8_LDA(At, 0, 0); PG8_STAGE(PG8_SA(1, 1), a1 + hstep, voffA);
            PG8_WAIT_V(8); PG8_WAIT_L(0); PG8_BAR; PG8_MMA(0, 0, At, B0); PG8_MMA(0, 1, At, B1); PG8_BAR; PG8_SCHED;
            PG8_LDA(At, 0, 1); PG8_STAGE(PG8_SB(0, 0), b2, voffB); PG8_STAGE(PG8_SB(0, 1), b2 + hstep, voffB); PG8_STAGE(PG8_SA(0, 0), a2, voffA);
            PG8_WAIT_V(8); PG8_WAIT_L(0); PG8_BAR; PG8_MMA(1, 0, At, B0); PG8_MMA(1, 1, At, B1); PG8_BAR; PG8_SCHED;
            PG8_LDB(B0, 1, 0); PG8_LDB(B1, 1, 1); PG8_SCHED; PG8_LDA(At, 1, 0); PG8_STAGE(PG8_SA(0, 1), a2 + hstep, voffA);
            PG8_WAIT_V(8); PG8_WAIT_L(0); PG8_BAR; PG8_MMA(0, 0, At, B0); PG8_MMA(0, 1, At, B1); PG8_BAR; PG8_SCHED;
            PG8_LDA(At, 1, 1); PG8_STAGE(PG8_SB(1, 0), b3, voffB); PG8_STAGE(PG8_SB(1, 1), b3 + hstep, voffB); PG8_STAGE(PG8_SA(1, 0), a3, voffA);
            PG8_WAIT_V(8); PG8_WAIT_L(0); PG8_BAR; PG8_MMA(1, 0, At, B0); PG8_MMA(1, 1, At, B1); PG8_BAR; PG8_SCHED;
            } else {
            PG8_LDB(B0, 0, 0); PG8_SCHED; PG8_LDA(At, 0, 0); PG8_STAGE(PG8_SA(1, 1), a1 + hstep, voffA);
            PG8_WAIT_L(8); PG8_BAR; PG8_WAIT_L(0); PG8_MMA(0, 0, At, B0); PG8_BAR; PG8_SCHED;
            PG8_LDB(B1, 0, 1); PG8_STAGE(PG8_SB(0, 0), b2, voffB);
            PG8_BAR; PG8_WAIT_L(0); PG8_MMA(0, 1, At, B1); PG8_BAR;
            PG8_LDA(At, 0, 1); PG8_STAGE(PG8_SA(0, 0), a2, voffA);
            PG8_BAR; PG8_WAIT_L(0); PG8_MMA(1, 0, At, B0); PG8_BAR; PG8_SCHED;
            PG8_STAGE(PG8_SB(0, 1), b2 + hstep, voffB);
            PG8_WAIT_V(6); PG8_BAR; PG8_MMA(1, 1, At, B1); PG8_BAR;
            PG8_LDB(B0, 1, 0); PG8_SCHED; PG8_LDA(At, 1, 0); PG8_STAGE(PG8_SA(0, 1), a2 + hstep, voffA);
            PG8_WAIT_L(8); PG8_BAR; PG8_WAIT_L(0); PG8_MMA(0, 0, At, B0); PG8_BAR; PG8_SCHED;
            PG8_LDB(B1, 1, 1); PG8_STAGE(PG8_SB(1, 0), b3, voffB);
            PG8_BAR; PG8_WAIT_L(0); PG8_MMA(0, 1, At, B1); PG8_BAR;
            PG8_LDA(At, 1, 1); PG8_STAGE(PG8_SA(1, 0), a3, voffA);
            PG8_BAR; PG8_WAIT_L(0); PG8_MMA(1, 0, At, B0); PG8_BAR; PG8_SCHED;
            PG8_STAGE(PG8_SB(1, 1), b3 + hstep, voffB);
            PG8_WAIT_V(6); PG8_BAR; PG8_MMA(1, 1, At, B1); PG8_BAR;
            }
        }
        if constexpr (ALIGN_EPI) { if (wr == 0) PG8_BAR; }
        if constexpr (!Epi::AFTER_DRAIN) { E(acc, cur, wr, wc, fr, fq); S.done(cur); }
        if (!has_next) break;
#pragma unroll
        for (int a = 0; a < 2; ++a)
#pragma unroll
            for (int b = 0; b < 2; ++b)
#pragma unroll
                for (int m = 0; m < 4; ++m)
#pragma unroll
                    for (int n = 0; n < 2; ++n) acc[a][b][m][n] = (f32x4){0.f, 0.f, 0.f, 0.f};
        cur = nxt; cA = nA; cB = nB; ++ui;
        if constexpr (ALIGN_EPI) { if (wr == 1) PG8_BAR; }
    }
    PG8_WAIT_V(0);
    if constexpr (!ALIGN_EPI) { if (wr == 0) PG8_BAR; }
    PG8_BAR;
    if constexpr (Epi::AFTER_DRAIN) { E.fused(acc, cur, wr, wc, fr, fq, lds, wid, lane); S.done(cur); }
#undef PG8_SA
#undef PG8_SB
#undef PG8_STAGE
#undef PG8_LDA
#undef PG8_LDB
#undef PG8_MMA
#undef PG8_WAIT_V
#undef PG8_WAIT_L
#undef PG8_BAR
#undef PG8_SCHED
}
}
#ifndef PROBE_DUP
#define PROBE_DUP 0
#endif

template <class PT> __device__ __forceinline__ void load_row16(PT p, int lane, float (&x)[16]) {
    const f32x4 a = *(const GAS f32x4*)(p + 8 * lane), b = *(const GAS f32x4*)(p + 8 * lane + 4), c = *(const GAS f32x4*)(p + 512 + 8 * lane), d = *(const GAS f32x4*)(p + 512 + 8 * lane + 4);
#pragma unroll
    for (int e = 0; e < 4; ++e) { x[e] = a[e]; x[4 + e] = b[e]; x[8 + e] = c[e]; x[12 + e] = d[e]; }
}
__device__ __forceinline__ void store_row16_f32(float* p, int lane, const float (&x)[16]) {
    *(f32x4*)(p + 8 * lane) = (f32x4){x[0], x[1], x[2], x[3]}; *(f32x4*)(p + 8 * lane + 4) = (f32x4){x[4], x[5], x[6], x[7]};
    *(f32x4*)(p + 512 + 8 * lane) = (f32x4){x[8], x[9], x[10], x[11]}; *(f32x4*)(p + 512 + 8 * lane + 4) = (f32x4){x[12], x[13], x[14], x[15]};
}
template <class PT> __device__ __forceinline__ void store_row16_bf16(PT p, int lane, const float (&y)[16]) {
    u32x4 a, b; a.x = pk2(y[0], y[1]); a.y = pk2(y[2], y[3]); a.z = pk2(y[4], y[5]); a.w = pk2(y[6], y[7]);
    b.x = pk2(y[8], y[9]); b.y = pk2(y[10], y[11]); b.z = pk2(y[12], y[13]); b.w = pk2(y[14], y[15]);
    *(GAS u32x4*)(p + 8 * lane) = a; *(GAS u32x4*)(p + 512 + 8 * lane) = b;
}
template <class G1, class G2> __device__ __forceinline__ void norm_mod16(const float (&x)[16], G1 g, G2 shift, G2 scale, int lane, float (&y)[16]) {
    float ss = 0.f;
#pragma unroll
    for (int e = 0; e < 16; ++e) ss += x[e] * x[e];
    ss = wave_sum(ss);
    const float r = __builtin_amdgcn_rsqf(ss * (1.0f / 1024.0f) + 1e-6f);
    float gg[16]; load_row16(g, lane, gg);
    if (shift) { float sh[16], sc[16]; load_row16(shift, lane, sh); load_row16(scale, lane, sc);
#pragma unroll
        for (int e = 0; e < 16; ++e) y[e] = x[e] * r * gg[e] * (1.0f + sc[e]) + sh[e];
    } else {
#pragma unroll
        for (int e = 0; e < 16; ++e) y[e] = x[e] * r * gg[e];
    }
}

template <int MODE>
__device__ __forceinline__ void transpose_item(const float* W, int K, int N, bf16_t* WT, LAS float* scr, int item, int lane) {
    const int nblk = N / 32, kb = item / nblk, nb = item % nblk, k0 = 64 * kb, n0 = 32 * nb;
#pragma unroll 8
    for (int i = 0; i < 32; ++i) { const int kk = 2 * i + (lane >> 5); scr[kk * 33 + (lane & 31)] = W[(size_t)(k0 + kk) * N + n0 + (lane & 31)]; }
    asm volatile("s_waitcnt lgkmcnt(0)" ::: "memory");
    const int c = lane & 7;
#pragma unroll
    for (int j = 0; j < 4; ++j) { const int n = (lane >> 3) + 8 * j; const LAS float* s = scr + (8 * c) * 33 + n;
        u32x4 o; o.x = pk2(s[0 * 33], s[1 * 33]); o.y = pk2(s[2 * 33], s[3 * 33]); o.z = pk2(s[4 * 33], s[5 * 33]); o.w = pk2(s[6 * 33], s[7 * 33]);
        int row = n0 + n;
        if (MODE == 1) { const int ch = row & 255, gatepart = row >> 8; row = (ch >> 7) * 256 + gatepart * 128 + (ch & 127); }
        *(u32x4*)(WT + (size_t)row * K + k0 + 8 * c) = o; }
    asm volatile("s_waitcnt lgkmcnt(0)" ::: "memory");
}

__device__ __forceinline__ void p0_transposes(const PV& P, int l, int part, int nparts, LAS unsigned char* lds) {
    const int tid = otid(), lane = tid & 63, w = __builtin_amdgcn_readfirstlane(tid >> 6);
    unsigned char* ws = P.ws;
    LAS float* scr = (LAS float*)(lds + w * 8448);
    const int gw = part * 8 + w, NGW = nparts * 8;
    constexpr int I_IN = 16 * (INC / 32), I_OUT = 16 * 32, I_GL = 4 * 16, PER_L = I_IN + I_OUT + I_GL;
    for (int it = gw; it < PER_L; it += NGW) { int r = it;
        if (r < I_IN) { transpose_item<0>(PIN(I_WIN) + (size_t)l * 1024 * INC, 1024, INC, (bf16_t*)(ws + WS_WIN) + (size_t)l * ZW * 1024, scr, r, lane); continue; } r -= I_IN;
        if (r < I_OUT) { transpose_item<0>(PIN(I_WOUT) + (size_t)l * 1024 * 1024, 1024, 1024, (bf16_t*)(ws + WS_WOUT) + (size_t)l * 1024 * 1024, scr, r, lane); continue; } r -= I_OUT;
        transpose_item<1>(PIN(I_GLUW) + (size_t)l * 256 * 512, 256, 512, (bf16_t*)(ws + WS_GLU) + (size_t)l * 512 * 256, scr, r, lane); }
    for (int i = part * 512 + tid; i < 8192; i += nparts * 512) *(GAS u32x4*)((bf16_t*)(ws + WS_WIN) + ((size_t)l * ZW + INC) * 1024 + (size_t)i * 8) = (u32x4){0u, 0u, 0u, 0u};
}
__device__ __forceinline__ void p0_tables(const PV& P, int l, int part, int nparts) {
    const int tid = otid();
    const size_t n16 = (size_t)NEXP * 1024 / 16, stride = (size_t)nparts * 512;
    const GAS f32x4* su = (const GAS f32x4*)(PIN(I_PU) + (size_t)l * NEXP * 1024); const GAS f32x4* sv = (const GAS f32x4*)(PIN(I_PV) + (size_t)l * NEXP * 1024);
    GAS u32x4* du = (GAS u32x4*)(P.ws + WS_U8 + (size_t)l * NEXP * 1024); GAS u32x4* dv = (GAS u32x4*)(P.ws + WS_V8 + (size_t)l * NEXP * 1024);
#pragma unroll 2
    for (size_t i = (size_t)part * 512 + tid; i < n16; i += stride) {
        u32x4 o, q;
#pragma unroll
        for (int k = 0; k < 4; ++k) { const f32x4 a = su[4 * i + k] * 32.0f, c = sv[4 * i + k] * 2.0f;
            int wa = __builtin_amdgcn_cvt_pk_fp8_f32(a[0], a[1], 0, false); wa = __builtin_amdgcn_cvt_pk_fp8_f32(a[2], a[3], wa, true);
            int wc = __builtin_amdgcn_cvt_pk_fp8_f32(c[0], c[1], 0, false); wc = __builtin_amdgcn_cvt_pk_fp8_f32(c[2], c[3], wc, true);
            o[k] = (unsigned)wa; q[k] = (unsigned)wc; }
        const size_t e = i >> 6, j16 = i & 63, di = (((j16 >> 3) * NEXP + e) << 3) + (j16 & 7);
        du[di] = o; dv[di] = q;
    }
}
__device__ __forceinline__ void p0_weff(const PV& P, int l, int part, int nparts, LAS unsigned char* lds) {
    const int tid = otid(), lane = tid & 63, w = __builtin_amdgcn_readfirstlane(tid >> 6);
    for (int u = part; u < 128; u += nparts) {
        const int hp = (u >> 3) & 15, dmb = u & 7;
        LAS bf16_t* As = (LAS bf16_t*)lds; LAS bf16_t* Bs = As + 128 * 136;
        const float* kp = PIN(I_KEYS) + (size_t)(l * 16 + hp) * 128 * 128;
        const float* qp = PIN(I_WQ) + ((size_t)l * 1024 + dmb * 128) * 2048 + hp * 128;
        __syncthreads();
        for (int idx = tid; idx < 16384; idx += 512) { const int n = idx >> 7, d = idx & 127;
            As[n * 136 + d] = (bf16_t)f2bf(kp[idx]); Bs[n * 136 + d] = (bf16_t)f2bf(qp[(size_t)n * 2048 + d]); }
        __syncthreads();
        f32x4 acc[1][8]; zero_acc<1, 8>(acc);
        lds_mma<1, 8, 4>(acc, As + 16 * w * 136, 136, Bs, 136, lane);
        bf16_t* op = (bf16_t*)(P.ws + WS_WEFF) + ((size_t)l * 2048 + hp * 128 + 16 * w + (lane & 15)) * 1024 + dmb * 128 + 4 * (lane >> 4);
#pragma unroll
        for (int n = 0; n < 8; ++n) { const f32x4 v = acc[0][n]; *(unsigned long long*)(op + 16 * n) = (unsigned long long)pk2(v[0], v[1]) | ((unsigned long long)pk2(v[2], v[3]) << 32); }
    }
    __syncthreads();
}
__device__ __forceinline__ void p0_prologue(const PV& P, LAS unsigned char* lds) {
    const int tid = otid(), lane = tid & 63, w = __builtin_amdgcn_readfirstlane(tid >> 6);
    const int G = gridDim.x, bx = blockIdx.x;
    unsigned char* ws = P.ws;
    p0_transposes(P, 0, bx, G, lds);
    __syncthreads();
    for (int u = bx; u < 48; u += G) {
        const int l = u / 24, cb = u % 24;
        LAS float* sc = (LAS float*)lds;
        LAS float* red = sc + 9216;
        __syncthreads();
        for (int idx = tid; idx < 9216; idx += 512) { const int r = idx >> 10, k = idx & 1023; const float v = r < 8 ? PIN(I_C)[r * 1024 + k] : PIN(I_CCTX)[k]; sc[idx] = siluf_(v); }
        __syncthreads();
        f32x4 acc[9];
#pragma unroll
        for (int r = 0; r < 9; ++r) acc[r] = (f32x4){0.f, 0.f, 0.f, 0.f};
        const float* wp = PIN(I_ADAW) + ((size_t)l * 1024 + 128 * w) * 6144 + cb * 256 + 4 * lane;
#pragma unroll 16
        for (int k = 0; k < 128; ++k) { const f32x4 wv = *(const GAS f32x4*)(wp + (size_t)k * 6144);
#pragma unroll
            for (int r = 0; r < 9; ++r) acc[r] += sc[r * 1024 + 128 * w + k] * wv; }
#pragma unroll
        for (int r = 0; r < 9; ++r) *(LAS f32x4*)(red + (w * 9 + r) * 256 + 4 * lane) = acc[r];
        __syncthreads();
        for (int idx = tid; idx < 9 * 256; idx += 512) { const int r = idx >> 8, cc = idx & 255; float sacc = 0.f;
#pragma unroll
            for (int ww = 0; ww < 8; ++ww) sacc += red[(ww * 9 + r) * 256 + cc];
            ((float*)(ws + WS_MOD))[(size_t)(l * 9 + r) * 6144 + cb * 256 + cc] = sacc + PIN(I_ADAB)[l * 6144 + cb * 256 + cc]; }
    }
    __syncthreads();
    (void)lane; (void)w; (void)ws;
}

__device__ __forceinline__ void p0b_ain(const PV& P) {
    const int tid = otid(), lane = tid & 63, gw = blockIdx.x * 8 + __builtin_amdgcn_readfirstlane(tid >> 6), NGW = gridDim.x * 8;
    const float* mod = (const float*)(P.ws + WS_MOD);
    bf16_t* act = (bf16_t*)(P.ws + WS_ACT);
    for (int row = gw; row < TT; row += NGW) {
        const float* xp = row < TL ? PIN(I_X) + (size_t)row * 1024 : PIN(I_CTX) + (size_t)(row - TL) * 1024;
        const int mr = row < TL ? (row >> 11) : 8;
        float x[16], y[16]; load_row16(xp, lane, x);
        norm_mod16(x, PIN(I_N1G), mod + (size_t)mr * 6144, mod + (size_t)mr * 6144 + 1024, lane, y);
        store_row16_bf16(act + (size_t)row * 1024, lane, y);
    }
}

__device__ __forceinline__ int rwkv_col(int gc, int h, int dir) {
    const int seg = gc >> 6;
    if (seg == 0) return h * 64 + gc;
    if (seg == 1) return 256 + h * 64 + (gc - 64);
    if (seg == 2) return 512 + h * 64 + (gc - 128);
    const int o = gc - 192; return o < 32 ? 832 + dir * 32 + o : 896 + dir * 32 + (o - 32);
}

constexpr int R_AT = 0, R_RT = 4608, R_BT = 9216, R_TL = 14336, R_MRB = 16896, R_G = 19456, R_YV = 23552, R_HV = 27648, R_GAM = 35840, REC_BYTES = 36096;

__device__ __forceinline__ void rwkv_pre(const PV& P, int l, LAS unsigned char* lds) {
    const int tid = otid(), lane = tid & 63, w = __builtin_amdgcn_readfirstlane(tid >> 6);
    LAS bf16_t* WUt = (LAS bf16_t*)lds;
    LAS bf16_t* AUt = WUt + 2560;
    LAS float* s_mu = (LAS float*)(AUt + 2560);
    LAS float* s_par = s_mu + 512;
    LAS bf16_t* raw = (LAS bf16_t*)(s_par + 256);
    LAS float* f_r = (LAS float*)(raw + 34 * 256);
    LAS float* f_k = f_r + 2048;
    LAS float* f_v = f_k + 2048;
    LAS bf16_t* WLb = (LAS bf16_t*)(f_v + 2048);
    LAS bf16_t* ALb = WLb + 1280;
    LAS float* lor = (LAS float*)raw;
    LAS bf16_t* Bn = ALb + 1280;
    LAS bf16_t* Kn = Bn + 2304;
    LAS bf16_t* Ktt = Kn + 2304;
    LAS bf16_t* Vt = Ktt + 2560;
    LAS float* Mabf = (LAS float*)(Vt + 2560);
    LAS bf16_t* Makb = (LAS bf16_t*)(Mabf + 1152);
    LAS bf16_t* Mrkb = Makb + 1280;
    LAS float* Ltot = (LAS float*)(Mrkb + 1280);
    LAS bf16_t* iA1 = (LAS bf16_t*)(Ltot + 512);
    LAS bf16_t* iB1 = iA1 + 640;
    LAS bf16_t* iA2 = iB1 + 640;
    LAS bf16_t* iWt = iA2 + 640;
    LAS unsigned char* rec = (LAS unsigned char*)(iWt + 640);
    LAS bf16_t* At = (LAS bf16_t*)(rec + R_AT); LAS bf16_t* Rt = (LAS bf16_t*)(rec + R_RT); LAS bf16_t* Btt = (LAS bf16_t*)(rec + R_BT);
    const GAS bf16_t* z = (const GAS bf16_t*)(P.ws + WS_Z);
    GAS unsigned char* recg = (GAS unsigned char*)(P.ws + WS_REC);
    for (int idx = tid; idx < 4 * 640 / 2; idx += 512) ((LAS unsigned*)iA1)[idx] = 0u;
    for (int idx = tid; idx < 2 * 1280 / 2; idx += 512) ((LAS unsigned*)WLb)[idx] = 0u;
    for (int idx = tid; idx < 2 * 2560 / 2; idx += 512) ((LAS unsigned*)WUt)[idx] = 0u;
    for (int idx = tid; idx < 1280 / 2; idx += 512) ((LAS unsigned*)(rec + R_TL))[idx] = 0u;
    int cur_hd = -1;
    u32x4 pre[3];
    auto geo = [&](int u, int& hd, int& b, int& c, int& tlo, int& seqlen, size_t& rb) { hd = u & 7; const int rest = u >> 3; b = rest / 72; c = rest % 72; const int dir = hd & 1;
        const bool isctx = c < 8; const int cc = isctx ? c : c - 8; seqlen = isctx ? CTX : SEQ; tlo = dir ? seqlen - 32 - 32 * cc : 32 * cc; rb = isctx ? (size_t)TL + b * CTX : (size_t)b * SEQ; };
    int pcol = 0, pcol_hd = -1;
    auto issue = [&](int u, int tid) { int hd, b, c, tlo, seqlen; size_t rb; geo(u, hd, b, c, tlo, seqlen, rb);
        if (hd != pcol_hd) { pcol_hd = hd; pcol = rwkv_col((tid & 31) * 8, hd >> 1, hd & 1); }
#pragma unroll
        for (int k = 0; k < 3; ++k) { const int v = tid + 512 * k; pre[k] = (u32x4){0u, 0u, 0u, 0u};
            if (v < 1088) { const int t = tlo - 1 + (v >> 5); if (t >= 0 && t < seqlen) pre[k] = *(const GAS u32x4*)(z + (rb + t) * ZW + pcol); } } };
    if ((int)blockIdx.x < 4608) issue(blockIdx.x, tid);
    for (int u = blockIdx.x; u < 4608; u += gridDim.x) {
        const int tid = otid(), lane = tid & 63, w = __builtin_amdgcn_readfirstlane(tid >> 6);
        int hd, b, c, tlo, seqlen; size_t rb; geo(u, hd, b, c, tlo, seqlen, rb); const int h = hd >> 1, dir = hd & 1;
        if (hd != cur_hd) { LDS_BARRIER(); cur_hd = hd;
            for (int idx = tid; idx < 2048; idx += 512) { const int m = idx >> 6, j = idx & 63; const size_t o = ((size_t)(l * 2 + dir) * 32 + m) * 256 + h * 64 + j;
                WUt[j * 40 + m] = (bf16_t)f2bf(PIN(I_WUP)[o]); AUt[j * 40 + m] = (bf16_t)f2bf(PIN(I_AUP)[o]); }
            { const int which = tid >> 8, gc = tid & 255; s_mu[tid] = PIN(I_MU)[(size_t)(l * 2 + which) * 960 + rwkv_col(gc, h, dir)]; }
            if (tid < 256) { const int k = tid >> 6, j = tid & 63; float v;
                if (k == 0) v = PIN(I_W0)[(l * 2 + dir) * 256 + h * 64 + j]; else if (k == 1) v = PIN(I_A0)[(l * 2 + dir) * 256 + h * 64 + j];
                else if (k == 2) v = PIN(I_KK)[l * 256 + h * 64 + j]; else v = PIN(I_KA)[l * 256 + h * 64 + j];
                s_par[tid] = v; } }
#pragma unroll
        for (int k = 0; k < 3; ++k) { const int v = tid + 512 * k; if (v < 1088) *(LAS u32x4*)(raw + (size_t)v * 8) = pre[k]; }
        LDS_BARRIER();
        if (u + (int)gridDim.x < 4608) issue(u + gridDim.x, tid);
        { const int gc = tid & 255, th = tid >> 8; const float mu0 = s_mu[gc], mu1 = s_mu[256 + gc];
            const int r0 = th * 16 + 1;
            float zm = bf2f(raw[(r0 - 1) * 256 + gc]), z0 = bf2f(raw[r0 * 256 + gc]);
            if (gc < 192) { LAS float* dst = gc < 64 ? f_r + gc : (gc < 128 ? f_k + (gc - 64) : f_v + (gc - 128));
#pragma unroll 4
                for (int ii = 0; ii < 16; ++ii) { const int rr = r0 + ii, i = dir ? 32 - rr : rr - 1;
                    const float zp = bf2f(raw[(rr + 1) * 256 + gc]);
                    dst[i * 64] = z0 + mu0 * (zm - z0) + mu1 * (zp - z0);
                    zm = z0; z0 = zp; }
            } else { const bool isw = gc < 224; LAS bf16_t* dstb = isw ? WLb + (gc - 192) : ALb + (gc - 224);
#pragma unroll 4
                for (int ii = 0; ii < 16; ++ii) { const int rr = r0 + ii, i = dir ? 32 - rr : rr - 1;
                    const float zp = bf2f(raw[(rr + 1) * 256 + gc]);
                    const float val = z0 + mu0 * (zm - z0) + mu1 * (zp - z0);
                    dstb[i * 40] = (bf16_t)f2bf(isw ? tanhf_(val) : val);
                    zm = z0; z0 = zp; } } }
        LDS_BARRIER();
        { const int which = w >> 2, mt = (w >> 1) & 1, np = (w & 1) * 2; f32x4 acc[1][2]; zero_acc<1, 2>(acc);
            lds_mma<1, 2, 1>(acc, (which ? ALb : WLb) + 16 * mt * 40, 40, (which ? AUt : WUt) + 16 * np * 40, 40, lane);
#pragma unroll
            for (int n = 0; n < 2; ++n) *(LAS f32x4*)(lor + which * 2176 + (16 * mt + (lane & 15)) * 68 + 16 * (np + n) + 4 * (lane >> 4)) = acc[0][n]; }
        { const int row = tid & 63, ig = tid >> 6;
#pragma unroll
            for (int e = 0; e < 4; ++e) Vt[row * 40 + 4 * ig + e] = (bf16_t)f2bf(f_v[(4 * ig + e) * 64 + row]); }
        LDS_BARRIER();
        float Lloc[4], lwv[4], agv[4], kkv[4], kdv[4]; float Lrun = 0.f;
#pragma unroll
        for (int ii = 0; ii < 4; ++ii) { const int i = 4 * w + ii, j = lane;
            const float wv = s_par[j] + lor[i * 68 + j], av = s_par[64 + j] + lor[2176 + i * 68 + j];
            const float wlog = -softplusf_(-wv) - 0.5f, lw = -__expf(wlog);
            Lrun += lw; Lloc[ii] = Lrun; lwv[ii] = lw; agv[ii] = sigmoidf_(av);
            const float kx = f_k[i * 64 + j], kkj = kx * s_par[128 + j];
            const float ss = wave_sum(kkj * kkj); kkv[ii] = kkj * __builtin_amdgcn_rsqf(fmaxf(ss, 1e-24f));
            kdv[ii] = kx * (1.0f + (agv[ii] - 1.0f) * s_par[192 + j]); }
        Ltot[w * 64 + lane] = Lrun;
        LDS_BARRIER();
        { float off = 0.f;
#pragma unroll
            for (int ww = 0; ww < 7; ++ww) if (ww < w) off += Ltot[ww * 64 + lane];
            float bq[4], kq[4];
#pragma unroll
            for (int ii = 0; ii < 4; ++ii) { const int i = 4 * w + ii, j = lane; const float L = off + Lloc[ii], eP = __expf(L - lwv[ii]), eL = __expf(L), eN = __expf(-L);
                bq[ii] = kkv[ii] * agv[ii] * eN; kq[ii] = kdv[ii] * eN;
                const unsigned ar = pk2a(-kkv[ii] * eP, f_r[i * 64 + j] * eL), bk = pk2a(bq[ii], kq[ii]);
                At[i * 72 + j] = (bf16_t)(ar & 0xffffu); Rt[i * 72 + j] = (bf16_t)(ar >> 16);
                Bn[i * 72 + j] = (bf16_t)(bk & 0xffffu); Kn[i * 72 + j] = (bf16_t)(bk >> 16);
                if (i == 31) ((LAS float*)(rec + R_GAM))[j] = eL; }
            *(LAS unsigned long long*)(Btt + lane * 40 + 4 * w) = (unsigned long long)pk2a(bq[0], bq[1]) | ((unsigned long long)pk2a(bq[2], bq[3]) << 32);
            *(LAS unsigned long long*)(Ktt + lane * 40 + 4 * w) = (unsigned long long)pk2a(kq[0], kq[1]) | ((unsigned long long)pk2a(kq[2], kq[3]) << 32); }
        LDS_BARRIER();
        { const int mat = w >> 1, mt = w & 1; f32x4 acc[1][2]; zero_acc<1, 2>(acc);
            lds_mma<1, 2, 2>(acc, (mat < 2 ? At : Rt) + 16 * mt * 72, 72, (mat & 1) ? Kn : Bn, 72, lane);
            const int t = 16 * mt + (lane & 15);
#pragma unroll
            for (int n = 0; n < 2; ++n) { f32x4 o;
#pragma unroll
                for (int e = 0; e < 4; ++e) { const int j = 16 * n + 4 * (lane >> 4) + e; const bool keep = mat < 2 ? j < t : j <= t; o[e] = keep ? acc[0][n][e] : 0.f; }
                if (mat == 0) { *(LAS f32x4*)(Mabf + t * 36 + 16 * n + 4 * (lane >> 4)) = o;
                    if (mt == 1 && n == 0) *(LAS unsigned long long*)(iA1 + (lane & 15) * 40 + 4 * (lane >> 4)) = (unsigned long long)pk2(o[0], o[1]) | ((unsigned long long)pk2(o[2], o[3]) << 32);
                } else { LAS bf16_t* dst = mat == 1 ? Makb : (mat == 2 ? (LAS bf16_t*)(rec + R_MRB) : Mrkb);
                    *(LAS unsigned long long*)(dst + t * 40 + 16 * n + 4 * (lane >> 4)) = (unsigned long long)pk2(o[0], o[1]) | ((unsigned long long)pk2(o[2], o[3]) << 32); } } }
        if (w < 2) {
            asm volatile("s_waitcnt lgkmcnt(0)" ::: "memory");
            const int cidx = lane & 15, o16 = 16 * w; float T[16];
            int vz = 0; asm volatile("" : "+v"(vz)); const LAS float* mb = Mabf + vz + o16 * 36 + o16;
#pragma unroll
            for (int t = 0; t < 16; ++t) { float row = cidx == t ? 1.0f : 0.f;
                float mrow[16];
#pragma unroll
                for (int q = 0; q < 4; ++q) if (4 * q < t) { const f32x4 mv = *(const LAS f32x4*)(mb + t * 36 + 4 * q); mrow[4 * q] = mv[0]; mrow[4 * q + 1] = mv[1]; mrow[4 * q + 2] = mv[2]; mrow[4 * q + 3] = mv[3]; }
#pragma unroll
                for (int j = 0; j < t; ++j) row += mrow[j] * T[j];
                T[t] = row; }
            if (lane < 16) {
                LAS bf16_t* tl = (LAS bf16_t*)(rec + R_TL);
#pragma unroll
                for (int t = 0; t < 16; t += 2) { const unsigned tp = pk2a(T[t], T[t + 1]); const bf16_t lo = (bf16_t)(tp & 0xffffu), hi = (bf16_t)(tp >> 16);
                    tl[(o16 + t) * 40 + o16 + cidx] = lo; tl[(o16 + t + 1) * 40 + o16 + cidx] = hi;
                    if (w == 0) { iB1[cidx * 40 + t] = lo; iB1[cidx * 40 + t + 1] = hi; }
                    else { iA2[t * 40 + cidx] = lo; iA2[(t + 1) * 40 + cidx] = hi; } }
            }
        } else {
            for (int tt = 16 + (w - 2); tt < 32; tt += 6) { f32x4 acc[1][1]; zero_acc<1, 1>(acc);
                const int m = (tt - 16) >> 2, n = (tt - 16) & 3;
                lds_mma<1, 1, 1>(acc, Vt + 16 * m * 40, 40, Ktt + 16 * n * 40, 40, lane);
                const f32x4 v = acc[0][0];
                *(LAS unsigned long long*)((LAS bf16_t*)(rec + R_HV) + (16 * m + (lane & 15)) * 64 + 16 * n + 4 * (lane >> 4)) = (unsigned long long)pk2(v[0], v[1]) | ((unsigned long long)pk2(v[2], v[3]) << 32); } }
        LDS_BARRIER();
        if (w == 0) {
            f32x4 acc[1][1]; zero_acc<1, 1>(acc);
            lds_mma<1, 1, 1>(acc, iA1, 40, iB1, 40, lane);
#pragma unroll
            for (int e = 0; e < 4; ++e) iWt[(4 * (lane >> 4) + e) * 40 + (lane & 15)] = (bf16_t)f2bf(acc[0][0][e]);
            asm volatile("s_waitcnt lgkmcnt(0)" ::: "memory");
            zero_acc<1, 1>(acc);
            lds_mma<1, 1, 1>(acc, iA2, 40, iWt, 40, lane);
            const f32x4 v = acc[0][0];
            *(LAS unsigned long long*)((LAS bf16_t*)(rec + R_TL) + (16 + (lane & 15)) * 40 + 4 * (lane >> 4)) = (unsigned long long)pk2(v[0], v[1]) | ((unsigned long long)pk2(v[2], v[3]) << 32);
        } else {
            for (int tt = w - 1; tt < 16; tt += 7) { f32x4 acc[1][1]; zero_acc<1, 1>(acc);
                const int m = (tt & 7) >> 1, n = tt & 1; const bool isg = tt < 8;
                lds_mma<1, 1, 1>(acc, Vt + 16 * m * 40, 40, (isg ? Makb : Mrkb) + 16 * n * 40, 40, lane);
                const f32x4 v = acc[0][0];
                *(LAS unsigned long long*)((LAS bf16_t*)(rec + (isg ? R_G : R_YV)) + (16 * m + (lane & 15)) * 32 + 16 * n + 4 * (lane >> 4)) = (unsigned long long)pk2(v[0], v[1]) | ((unsigned long long)pk2(v[2], v[3]) << 32); } }
        LDS_BARRIER();
        { GAS u32x4* dst = (GAS u32x4*)(recg + ((size_t)(b * 8 + hd) * 72 + c) * REC_BYTES);
            for (int p = tid; p < REC_BYTES / 16; p += 512) dst[p] = *(const LAS u32x4*)(rec + (size_t)p * 16); }
    }
    __syncthreads();
}

__device__ __forceinline__ void rwkv_seq(const PV& P, int l, int unit, LAS unsigned char* lds) {
    const int tid = otid(), lane = tid & 63, w = __builtin_amdgcn_readfirstlane(tid >> 6), fr = lane & 15, fq = lane >> 4;
    const int dir = unit & 1, h = (unit >> 1) & 3, b = unit >> 3;
    LAS unsigned char* recb = lds;
    LAS bf16_t* S0b = (LAS bf16_t*)(lds + 2 * REC_BYTES);
    LAS bf16_t* Xb = S0b + 4608;
    LAS bf16_t* SAb = Xb + 2560;
    LAS float* Ys = (LAS float*)(SAb + 2560);
    GAS bf16_t* yout = (GAS bf16_t*)(P.ws + WS_Y) + (size_t)(0 * 2 + dir) * YSZ;
    const GAS u32x4* recg = (const GAS u32x4*)(P.ws + WS_REC + (size_t)unit * 72 * REC_BYTES);
    for (int idx = tid; idx < 4608 / 2; idx += 512) ((LAS unsigned*)S0b)[idx] = 0u;
    f32x4 Sacc[1][2]; zero_acc<1, 2>(Sacc);
    const int ms = w >> 1, nbs = (w & 1) * 2;
    const int m1 = w & 3;
    u32x4 pre[5];
    static_assert(REC_BYTES / 16 == 2256, "record = 4 full 512-thread passes + 208 pieces");
    const GAS u32x4* rp = recg + tid;
    auto issue = [&](int c) { const GAS u32x4* q = rp + (size_t)c * 2256;
        pre[0] = q[0]; pre[1] = q[512]; pre[2] = q[1024]; pre[3] = q[1536]; if (tid < 208) pre[4] = q[2048]; };
    pre[4] = (u32x4){0u, 0u, 0u, 0u};
    issue(0);
    for (int c = 0; c < 72; ++c) {
        LAS unsigned char* rec = recb + (c & 1) * REC_BYTES;
        { LAS u32x4* rl = (LAS u32x4*)rec + tid; rl[0] = pre[0]; rl[512] = pre[1]; rl[1024] = pre[2]; rl[1536] = pre[3]; if (tid < 208) rl[2048] = pre[4]; }
        LDS_BARRIER();
        if (c + 1 < 72) issue(c + 1);
        if (c > 0) {
            const int cp = c - 1; const bool isctx = cp < 8; const int cc = isctx ? cp : cp - 8, seqlen = isctx ? CTX : SEQ;
            const int tlo = dir ? seqlen - 32 - 32 * cc : 32 * cc; const size_t rb = isctx ? (size_t)TL + b * CTX : (size_t)b * SEQ;
            const int i = tid >> 4, rg = tid & 15, t = dir ? tlo + 31 - i : tlo + i;
            const f32x4 v = *(const LAS f32x4*)(Ys + i * 64 + 4 * rg);
            *(GAS unsigned long long*)(yout + (rb + t) * 256 + h * 64 + 4 * rg) = (unsigned long long)pk2(v[0], v[1]) | ((unsigned long long)pk2(v[2], v[3]) << 32); }
        f32x4 aPQ[1][2]; zero_acc<1, 2>(aPQ);
        lds_mma<1, 2, 2>(aPQ, S0b + 16 * m1 * 72, 72, (const LAS bf16_t*)(rec + (w < 4 ? R_AT : R_RT)), 72, lane);
        if (w < 4) {
#pragma unroll
            for (int n = 0; n < 2; ++n) { const u32x2 gw = *(const LAS u32x2*)(rec + R_G + ((16 * m1 + fr) * 32 + 16 * n + 4 * fq) * 2);
                const float x0 = aPQ[0][n][0] + bflo(gw.x), x1 = aPQ[0][n][1] + bfhi(gw.x), x2 = aPQ[0][n][2] + bflo(gw.y), x3 = aPQ[0][n][3] + bfhi(gw.y);
                *(LAS unsigned long long*)(Xb + (16 * m1 + fr) * 40 + 16 * n + 4 * fq) = (unsigned long long)pk2(x0, x1) | ((unsigned long long)pk2(x2, x3) << 32); }
            asm volatile("s_waitcnt lgkmcnt(0)" ::: "memory");
            f32x4 aSA[1][2]; zero_acc<1, 2>(aSA);
            lds_mma<1, 2, 1>(aSA, Xb + 16 * m1 * 40, 40, (const LAS bf16_t*)(rec + R_TL), 40, lane);
#pragma unroll
            for (int n = 0; n < 2; ++n) { const f32x4 v = aSA[0][n];
                *(LAS unsigned long long*)(SAb + (16 * m1 + fr) * 40 + 16 * n + 4 * fq) = (unsigned long long)pk2(v[0], v[1]) | ((unsigned long long)pk2(v[2], v[3]) << 32); } }
        LDS_BARRIER();
        if (w >= 4) { lds_mma<1, 2, 1>(aPQ, SAb + 16 * m1 * 40, 40, (const LAS bf16_t*)(rec + R_MRB), 40, lane);
#pragma unroll
            for (int n = 0; n < 2; ++n) { const u32x2 yw = *(const LAS u32x2*)(rec + R_YV + ((16 * m1 + fr) * 32 + 16 * n + 4 * fq) * 2);
                const int t0 = 16 * n + 4 * fq, row = 16 * m1 + fr;
                Ys[(t0 + 0) * 64 + row] = aPQ[0][n][0] + bflo(yw.x); Ys[(t0 + 1) * 64 + row] = aPQ[0][n][1] + bfhi(yw.x);
                Ys[(t0 + 2) * 64 + row] = aPQ[0][n][2] + bflo(yw.y); Ys[(t0 + 3) * 64 + row] = aPQ[0][n][3] + bfhi(yw.y); } }
        { f32x4 aS[1][2]; zero_acc<1, 2>(aS);
            lds_mma<1, 2, 1>(aS, SAb + 16 * ms * 40, 40, (const LAS bf16_t*)(rec + R_BT) + 16 * nbs * 40, 40, lane);
#pragma unroll
            for (int n = 0; n < 2; ++n) { const int k0 = 16 * (nbs + n) + 4 * fq, row = 16 * ms + fr;
                const u32x2 hw = *(const LAS u32x2*)(rec + R_HV + (row * 64 + k0) * 2); const f32x4 gm = *(const LAS f32x4*)(rec + R_GAM + k0 * 4);
                f32x4 sn; sn[0] = gm[0] * (Sacc[0][n][0] + aS[0][n][0] + bflo(hw.x)); sn[1] = gm[1] * (Sacc[0][n][1] + aS[0][n][1] + bfhi(hw.x));
                sn[2] = gm[2] * (Sacc[0][n][2] + aS[0][n][2] + bflo(hw.y)); sn[3] = gm[3] * (Sacc[0][n][3] + aS[0][n][3] + bfhi(hw.y));
                Sacc[0][n] = sn;
                *(LAS unsigned long long*)(S0b + row * 72 + k0) = (unsigned long long)pk2(sn[0], sn[1]) | ((unsigned long long)pk2(sn[2], sn[3]) << 32); } }
    }
    LDS_BARRIER();
    { const int cp = 71; const int seqlen = SEQ, cc = cp - 8; const int tlo = dir ? seqlen - 32 - 32 * cc : 32 * cc; const size_t rb = (size_t)b * SEQ;
        const int i = tid >> 4, rg = tid & 15, t = dir ? tlo + 31 - i : tlo + i;
        const f32x4 v = *(const LAS f32x4*)(Ys + i * 64 + 4 * rg);
        *(GAS unsigned long long*)(yout + (rb + t) * 256 + h * 64 + 4 * rg) = (unsigned long long)pk2(v[0], v[1]) | ((unsigned long long)pk2(v[2], v[3]) << 32); }
    __syncthreads();
}

__device__ __forceinline__ void ret_unit(const PV& P, int l, int unit, LAS unsigned char* lds) {
    const int tid = otid(), lane = tid & 63, w = __builtin_amdgcn_readfirstlane(tid >> 6);
    const int dir = unit & 1, h = (unit >> 1) & 3, b = unit >> 3;
    LAS bf16_t* Qs = (LAS bf16_t*)lds; LAS bf16_t* Ks = Qs + 4608; LAS bf16_t* Kt = Ks + 4608; LAS bf16_t* Vt = Kt + 4608; LAS bf16_t* Att = Vt + 4608; LAS bf16_t* St = Att + 4608;
    const GAS bf16_t* z = (const GAS bf16_t*)(P.ws + WS_Z);
    GAS bf16_t* yout = (GAS bf16_t*)(P.ws + WS_Y) + (size_t)(1 * 2 + dir) * YSZ;
    const float lg = __logf(1.0f - exp2f(-((dir ? 5.5f : 5.0f) + (float)h)));
    for (int idx = tid; idx < 4608; idx += 512) St[idx] = 0;
    f32x4 Sacc[1][2]; zero_acc<1, 2>(Sacc);
    const int m = w >> 1, nb = (w & 1) * 2, fr = lane & 15, fq = lane >> 4;
    const float cdec = __expf(lg * 64.0f);
    u32x4 pre[3];
    auto tok = [&](int c, int i, size_t& rb, int& pos) -> int {
        const bool isctx = c < 4; const int cc = isctx ? c : c - 4, seqlen = isctx ? CTX : SEQ;
        const int tlo = dir ? seqlen - 64 - 64 * cc : 64 * cc; rb = isctx ? (size_t)TL + b * CTX : (size_t)b * SEQ;
        const int t = dir ? tlo + 63 - i : tlo + i; pos = (isctx ? 0 : CTX) + t; return t;
    };
    auto issue_loads = [&](int c) { const int i = tid >> 3, vc = tid & 7; size_t rb; int pos; const int t = tok(c, i, rb, pos);
#pragma unroll
        for (int k = 0; k < 3; ++k) pre[k] = *(const GAS u32x4*)(z + (rb + t) * ZW + CB_ + k * 256 + h * 64 + vc * 8); };
    issue_loads(0);
    for (int c = 0; c < 36; ++c) {
        LDS_BARRIER();
        { const int i = tid >> 3, vc = tid & 7;
            *(LAS u32x4*)(Qs + i * 72 + vc * 8) = pre[0]; *(LAS u32x4*)(Ks + i * 72 + vc * 8) = pre[1];
            const unsigned vw[4] = {pre[2].x, pre[2].y, pre[2].z, pre[2].w};
#pragma unroll
            for (int e = 0; e < 4; ++e) { Vt[(vc * 8 + 2 * e) * 72 + i] = (bf16_t)(vw[e] & 0xffffu); Vt[(vc * 8 + 2 * e + 1) * 72 + i] = (bf16_t)(vw[e] >> 16); } }
        LDS_BARRIER();
        if (c + 1 < 36) issue_loads(c + 1);
#pragma unroll
        for (int k = 0; k < 4; ++k) { const int idx = tid + 512 * k, i = idx >> 5, d = idx & 31; size_t rb; int pos; tok(c, i, rb, pos);
            float rev = (float)pos * (exp2f(-(float)d * (13.287712379549449f / 32.0f)) * 0.15915494309189535f); rev -= floorf(rev);
            const float sn = __builtin_amdgcn_sinf(rev), cs = __builtin_amdgcn_cosf(rev);
            const float q1 = bf2f(Qs[i * 72 + d]), q2 = bf2f(Qs[i * 72 + d + 32]), k1 = bf2f(Ks[i * 72 + d]), k2 = bf2f(Ks[i * 72 + d + 32]);
            Qs[i * 72 + d] = (bf16_t)f2bf((q1 * cs - q2 * sn) * 0.125f); Qs[i * 72 + d + 32] = (bf16_t)f2bf((q1 * sn + q2 * cs) * 0.125f);
            const float o1 = k1 * cs - k2 * sn, o2 = k1 * sn + k2 * cs, wd = __expf(lg * (float)(63 - i));
            Ks[i * 72 + d] = (bf16_t)f2bf(o1); Ks[i * 72 + d + 32] = (bf16_t)f2bf(o2);
            Kt[d * 72 + i] = (bf16_t)f2bf(o1 * wd); Kt[(d + 32) * 72 + i] = (bf16_t)f2bf(o2 * wd); }
        LDS_BARRIER();
        f32x4 aS[1][2], aO2[1][2]; zero_acc<1, 2>(aS); zero_acc<1, 2>(aO2);
        lds_mma<1, 2, 2>(aS, Qs + 16 * m * 72, 72, Ks + 16 * nb * 72, 72, lane);
        lds_mma<1, 2, 2>(aO2, Qs + 16 * m * 72, 72, St + 16 * nb * 72, 72, lane);
        const int i = 16 * m + fr;
#pragma unroll
        for (int n = 0; n < 2; ++n) { float o[4];
#pragma unroll
            for (int e = 0; e < 4; ++e) { const int j = 16 * (nb + n) + 4 * fq + e, diff = i - j; const bool keep = dir ? diff > 0 : diff >= 0;
                o[e] = keep ? aS[0][n][e] * __expf(lg * (float)diff) : 0.f; }
            *(LAS unsigned long long*)(Att + i * 72 + 16 * (nb + n) + 4 * fq) = (unsigned long long)pk2(o[0], o[1]) | ((unsigned long long)pk2(o[2], o[3]) << 32); }
        LDS_BARRIER();
        f32x4 aO1[1][2], aT[1][2]; zero_acc<1, 2>(aO1); zero_acc<1, 2>(aT);
        lds_mma<1, 2, 2>(aO1, Att + 16 * m * 72, 72, Vt + 16 * nb * 72, 72, lane);
        lds_mma<1, 2, 2>(aT, Vt + 16 * m * 72, 72, Kt + 16 * nb * 72, 72, lane);
        { size_t rb; int pos; const int t = tok(c, i, rb, pos); const float rd = __expf(lg * (float)(i + 1));
#pragma unroll
            for (int n = 0; n < 2; ++n) { const f32x4 o = aO1[0][n] + rd * aO2[0][n];
                *(GAS unsigned long long*)(yout + (rb + t) * 256 + h * 64 + 16 * (nb + n) + 4 * fq) = (unsigned long long)pk2(o[0], o[1]) | ((unsigned long long)pk2(o[2], o[3]) << 32); } }
#pragma unroll
        for (int n = 0; n < 2; ++n) { Sacc[0][n] = cdec * Sacc[0][n] + aT[0][n]; const f32x4 s = Sacc[0][n];
            *(LAS unsigned long long*)(St + i * 72 + 16 * (nb + n) + 4 * fq) = (unsigned long long)pk2(s[0], s[1]) | ((unsigned long long)pk2(s[2], s[3]) << 32); }
    }
    __syncthreads();
}

__device__ __forceinline__ void lru_items(const PV& P, int l, LAS unsigned char* lds) {
    const int tid0 = otid();
    LAS bf16_t* waT = (LAS bf16_t*)lds; LAS bf16_t* wxT = waT + 4608; LAS bf16_t* xcb = wxT + 4608;
    LAS float* xraw = (LAS float*)(lds + 27648);
    LAS float* xcf = xraw + 67 * 64;
    LAS float* a_s = xcf + 4352; LAS float* b_s = a_s + 4352;
    LAS float* segA = b_s + 4352; LAS float* segH = segA + 512; LAS float* par = segH + 512;
    const GAS bf16_t* z = (const GAS bf16_t*)(P.ws + WS_Z);
    int cur_key = -1;
    u32x4 pre[2];
    auto geo = [&](int u, int& key, int& b, int& c, int& tlo, int& seqlen, size_t& rb) { key = u & 7; const int rest = u >> 3; b = rest / 36; c = rest % 36; const int dir = key >> 2;
        const bool isctx = c < 4; const int cc = isctx ? c : c - 4; seqlen = isctx ? CTX : SEQ; tlo = dir ? seqlen - 64 - 64 * cc : 64 * cc; rb = isctx ? (size_t)TL + b * CTX : (size_t)b * SEQ; };
    auto issue = [&](int u, int tid) { int key, b, c, tlo, seqlen; size_t rb; geo(u, key, b, c, tlo, seqlen, rb);
#pragma unroll
        for (int k = 0; k < 2; ++k) { const int v = tid + 512 * k; pre[k] = (u32x4){0u, 0u, 0u, 0u};
            if (v < 536) { const int rr = v >> 3, vc = v & 7, t = tlo - 2 + rr; if (t >= 0 && t < seqlen) pre[k] = *(const GAS u32x4*)(z + (rb + t) * ZW + CC_ + (key & 3) * 64 + vc * 8); } } };
    if ((int)blockIdx.x < 2304) issue(blockIdx.x, tid0);
    for (int u = blockIdx.x; u < 2304; u += gridDim.x) {
        const int tid = otid(), lane = tid & 63, w = __builtin_amdgcn_readfirstlane(tid >> 6);
        int key, b, c, tlo, seqlen; size_t rb; geo(u, key, b, c, tlo, seqlen, rb); const int dir = key >> 2, blk = key & 3;
        GAS bf16_t* hout = (GAS bf16_t*)(P.ws + WS_Y) + (size_t)(2 * 2 + dir) * YSZ; GAS bf16_t* aout = (GAS bf16_t*)(P.ws + WS_ACU) + (size_t)dir * YSZ;
        LDS_BARRIER();
        if (key != cur_key) { cur_key = key;
            for (int idx = tid; idx < 4096; idx += 512) { const int i = idx >> 6, j = idx & 63; const size_t o = ((size_t)((l * 2 + dir) * 4 + blk) * 64 + i) * 64 + j;
                waT[j * 72 + i] = (bf16_t)f2bf(PIN(I_WA)[o]); wxT[j * 72 + i] = (bf16_t)f2bf(PIN(I_WX)[o]); }
            { const int k = tid >> 6, cc = tid & 63, ch = blk * 64 + cc; float v;
                if (k < 4) v = PIN(I_CVW)[(l * 4 + k) * 256 + ch]; else if (k == 4) v = PIN(I_CVB)[l * 256 + ch];
                else if (k == 5) v = PIN(I_BA)[(l * 2 + dir) * 256 + ch]; else if (k == 6) v = PIN(I_BX)[(l * 2 + dir) * 256 + ch];
                else v = softplusf_(-PIN(I_LAM)[(l * 2 + dir) * 256 + ch]);
                par[tid] = v; } }
#pragma unroll
        for (int k = 0; k < 2; ++k) { const int v = tid + 512 * k; if (v < 536) { const unsigned ww[4] = {pre[k].x, pre[k].y, pre[k].z, pre[k].w};
#pragma unroll
                for (int e = 0; e < 4; ++e) { xraw[v * 8 + 2 * e] = bflo(ww[e]); xraw[v * 8 + 2 * e + 1] = bfhi(ww[e]); } } }
        LDS_BARRIER();
        if (u + (int)gridDim.x < 2304) issue(u + gridDim.x, tid);
        { const int ch = tid & 63, tg = w;
            const float cw0 = par[ch], cw1 = par[64 + ch], cw2 = par[128 + ch], cw3 = par[192 + ch], cbb = par[256 + ch];
            float xr[11];
#pragma unroll
            for (int e = 0; e < 11; ++e) xr[e] = xraw[(tg * 8 + e) * 64 + ch];
#pragma unroll
            for (int e = 0; e < 8; e += 2) { const int tt = tg * 8 + e;
                const float xa = cbb + cw0 * xr[e] + cw1 * xr[e + 1] + cw2 * xr[e + 2] + cw3 * xr[e + 3], xb2 = cbb + cw0 * xr[e + 1] + cw1 * xr[e + 2] + cw2 * xr[e + 3] + cw3 * xr[e + 4];
                const int i = dir ? 63 - tt : tt, i2 = dir ? i - 1 : i + 1; const unsigned pk = pk2a(xa, xb2);
                xcf[i * 68 + ch] = xa; xcf[i2 * 68 + ch] = xb2; xcb[i * 72 + ch] = (bf16_t)(pk & 0xffffu); xcb[i2 * 72 + ch] = (bf16_t)(pk >> 16); } }
        LDS_BARRIER();
        { const int m = w >> 1, nb = (w & 1) * 2, fr = lane & 15, fq = lane >> 4;
            f32x4 aR[1][2], aI[1][2]; zero_acc<1, 2>(aR); zero_acc<1, 2>(aI);
            lds_mma<1, 2, 2>(aR, xcb + 16 * m * 72, 72, waT + 16 * nb * 72, 72, lane);
            lds_mma<1, 2, 2>(aI, xcb + 16 * m * 72, 72, wxT + 16 * nb * 72, 72, lane);
            const int i = 16 * m + fr;
#pragma unroll
            for (int n = 0; n < 2; ++n) { f32x4 av, bv;
#pragma unroll
                for (int e = 0; e < 4; ++e) { const int ch = 16 * (nb + n) + 4 * fq + e;
                    const float r = sigmoidf_(aR[0][n][e] + par[320 + ch]), ig = sigmoidf_(aI[0][n][e] + par[384 + ch]);
                    const float la = -8.0f * r * par[448 + ch]; av[e] = __expf(la);
                    const float y2 = 2.0f * la;
                    const float om = y2 > -0.125f ? -y2 * (1.0f + y2 * (0.5f + y2 * (0.16666667f + y2 * (0.041666668f + y2 * 0.0083333338f)))) : 1.0f - __expf(y2);
                    bv[e] = __builtin_amdgcn_sqrtf(fmaxf(om, 0.f)) * ig * xcf[i * 68 + ch]; }
                *(LAS f32x4*)(a_s + i * 68 + 16 * (nb + n) + 4 * fq) = av; *(LAS f32x4*)(b_s + i * 68 + 16 * (nb + n) + 4 * fq) = bv; } }
        LDS_BARRIER();
        const int ch = tid & 63, seg = tid >> 6;
        float av[8], bv[8];
        { float A = 1.f, H = 0.f;
#pragma unroll
            for (int e = 0; e < 8; ++e) { const int i = seg * 8 + e; av[e] = a_s[i * 68 + ch]; bv[e] = b_s[i * 68 + ch]; }
#pragma unroll
            for (int e = 0; e < 8; ++e) { H = av[e] * H + bv[e]; A *= av[e]; av[e] = A; bv[e] = H; }
            segA[seg * 64 + ch] = A; segH[seg * 64 + ch] = H; }
        LDS_BARRIER();
        float hin = 0.f, ap = 1.f;
#pragma unroll
        for (int s2 = 0; s2 < 7; ++s2) if (s2 < seg) { const float sa = segA[s2 * 64 + ch]; hin = sa * hin + segH[s2 * 64 + ch]; ap *= sa; }
        GAS bf16_t* hp = hout + (rb + (dir ? tlo + 63 - seg * 8 : tlo + seg * 8)) * 256 + blk * 64 + ch; GAS bf16_t* ap2 = aout + (hp - hout); const int tstep = dir ? -256 : 256;
#pragma unroll
        for (int e = 0; e < 8; ++e) { const int i = seg * 8 + e;
            const float hl = bv[e] + av[e] * hin, ac = av[e] * ap; const unsigned pk = pk2a(hl, ac);
            hp[e * tstep] = (bf16_t)(pk & 0xffffu); ap2[e * tstep] = (bf16_t)(pk >> 16);
            if (i == 63) { GAS float* ag = (GAS float*)(P.ws + WS_AGG) + ((size_t)((b * 2 + dir) * 36 + c) * 2) * 256 + blk * 64 + ch; ag[0] = ac; ag[256] = hl; } }
    }
    __syncthreads();
}
__device__ __forceinline__ void lru_carry_unit(const PV& P, int unit) {
    const int tid = otid();
    if (tid < 256) { const float* ag = (const float*)(P.ws + WS_AGG) + (size_t)unit * 36 * 512 + tid; float* ci = (float*)(P.ws + WS_CIN) + (size_t)unit * 36 * 256 + tid;
        float A[36], H[36];
#pragma unroll
        for (int c = 0; c < 36; ++c) { A[c] = ag[c * 512]; H[c] = ag[c * 512 + 256]; }
        float carry = 0.f;
#pragma unroll
        for (int c = 0; c < 36; ++c) { ci[c * 256] = carry; carry = A[c] * carry + H[c]; } }
}

__device__ __forceinline__ void s5_unit(const PV& P, int l, int unit, LAS unsigned char* lds) {
    const int tid = otid(), lane = tid & 63, w = __builtin_amdgcn_readfirstlane(tid >> 6);
    const int gp = unit & 7, dir = (unit >> 3) & 1, b = unit >> 4;
    LAS float* bu0 = (LAS float*)lds;
    LAS bf16_t* Hs0 = (LAS bf16_t*)(lds + 66560);
    LAS bf16_t* Us0 = (LAS bf16_t*)(lds + 100352);
    LAS bf16_t* Bbu = (LAS bf16_t*)(lds + 105472);
    LAS bf16_t* By = (LAS bf16_t*)(lds + 125952);
    const GAS bf16_t* z = (const GAS bf16_t*)(P.ws + WS_Z);
    GAS bf16_t* yout = (GAS bf16_t*)(P.ws + WS_Y) + (size_t)(3 * 2 + dir) * YSZ;
    for (int idx = tid; idx < 256 * 40 / 2; idx += 512) ((LAS unsigned*)Bbu)[idx] = 0u;
    __syncthreads();
    float lr = 0.f, li = 0.f, hr = 0.f, hi = 0.f;
    if (tid < 128) { const int gl = tid >> 6, p = tid & 63, g = 2 * gp + gl; const size_t pidx = ((size_t)(l * 2 + dir) * 16 + g) * 64 + p;
        const float are = PIN(I_SARE)[pidx], aim = PIN(I_SAIM)[pidx], dt = __expf(PIN(I_SLDT)[(l * 2 + dir) * 16 + g]);
        const float mag = __expf(are * dt); float rev = aim * dt * 0.15915494309189535f; rev -= floorf(rev);
        lr = mag * __builtin_amdgcn_cosf(rev); li = mag * __builtin_amdgcn_sinf(rev);
        const float nre = lr - 1.0f, nim = li, den = 1.0f / (are * are + aim * aim);
        const float cre = (nre * are + nim * aim) * den, cim = (nim * are - nre * aim) * den;
#pragma unroll
        for (int c = 0; c < 16; ++c) { const float bre = PIN(I_SBRE)[pidx * 16 + c], bim = PIN(I_SBIM)[pidx * 16 + c];
            Bbu[(gl * 128 + 2 * p) * 40 + gl * 16 + c] = (bf16_t)f2bf(cre * bre - cim * bim); Bbu[(gl * 128 + 2 * p + 1) * 40 + gl * 16 + c] = (bf16_t)f2bf(cre * bim + cim * bre); } }
    for (int idx = tid; idx < 4096; idx += 512) { const int gl = idx >> 11, c = (idx >> 7) & 15, kk = idx & 127, part = kk >> 6, p = kk & 63, g = 2 * gp + gl;
        const size_t src = (((size_t)(l * 2 + dir) * 16 + g) * 16 + c) * 64 + p;
        By[(gl * 16 + c) * 136 + 2 * p + part] = (bf16_t)f2bf(part ? -PIN(I_SCIM)[src] : PIN(I_SCRE)[src]); }
    auto rowof = [&](int c, int i) -> size_t {
        if (c < 8) { const int s = 32 * c + i, t = dir ? 255 - s : s; return (size_t)TL + b * CTX + t; }
        const int sl = 32 * (c - 8) + i, slr = dir ? 2047 - sl : sl, col = slr >> 5, rg = slr & 31; return (size_t)b * SEQ + rg * 64 + col; };
    const int t6 = tid - 384;
    u32x4 pre = (u32x4){0u, 0u, 0u, 0u};
    if (w >= 6) { pre = *(const GAS u32x4*)(z + rowof(0, t6 >> 2) * ZW + CD_ + gp * 32 + (t6 & 3) * 8); *(LAS u32x4*)(Us0 + (t6 >> 2) * 40 + (t6 & 3) * 8) = pre;
        pre = *(const GAS u32x4*)(z + rowof(1, t6 >> 2) * ZW + CD_ + gp * 32 + (t6 & 3) * 8); }
    __syncthreads();
#pragma unroll 1
    for (int k = 0; k < 74; ++k) {
        if (w < 2) {
            const float hr_s = hr, hi_s = hi;
            for (int r3 = 0; r3 < ((PROBE_DUP & 524288) ? 2 : 1); ++r3)
            if (k >= 1 && k <= 72) { const LAS float* bu = bu0 + ((k - 1) & 1) * 8320; LAS bf16_t* Hs = Hs0 + ((k - 1) & 1) * 8448; hr = hr_s; hi = hi_s;
                const int cr = (tid >> 6) * 128 + 2 * (tid & 63);
#pragma unroll 1
                for (int i0 = 0; i0 < 32; i0 += 8) { f32x2 bb[8];
#pragma unroll
                    for (int e = 0; e < 8; ++e) bb[e] = *(const LAS f32x2*)(bu + (i0 + e) * 260 + cr);
                    unsigned orr[8];
#pragma unroll
                    for (int e = 0; e < 8; ++e) { const float nr = lr * hr - li * hi + bb[e][0], ni = lr * hi + li * hr + bb[e][1]; hr = nr; hi = ni; orr[e] = pk2a(nr, ni); }
#pragma unroll
                    for (int e = 0; e < 8; ++e) *(LAS unsigned*)(Hs + (i0 + e) * 264 + cr) = orr[e]; } }
        } else if (w < 6) {
            for (int r3 = 0; r3 < ((PROBE_DUP & 131072) ? 2 : 1); ++r3)
            if (k <= 71) { LAS float* bu = bu0 + (k & 1) * 8320; const LAS bf16_t* Us = Us0 + (k & 1) * 1280; const int wq = w - 2;
                f32x4 acc[2][4]; zero_acc<2, 4>(acc);
                lds_mma<2, 4, 1>(acc, Us, 40, Bbu + 64 * wq * 40, 40, lane);
#pragma unroll
                for (int mm = 0; mm < 2; ++mm)
#pragma unroll
                    for (int n = 0; n < 4; ++n) *(LAS f32x4*)(bu + (16 * mm + (lane & 15)) * 260 + 64 * wq + 16 * n + 4 * (lane >> 4)) = acc[mm][n]; }
        } else {
            for (int r3 = 0; r3 < ((PROBE_DUP & 262144) ? 2 : 1); ++r3)
            if (k >= 2) { const LAS bf16_t* Hs = Hs0 + (k & 1) * 8448; const int gl = w - 6, cy = k - 2;
                f32x4 acc[2][1]; zero_acc<2, 1>(acc);
                lds_mma<2, 1, 4>(acc, Hs + gl * 128, 264, By + gl * 16 * 136, 136, lane);
#pragma unroll
                for (int mm = 0; mm < 2; ++mm) { const int i = 16 * mm + (lane & 15); const f32x4 v = acc[mm][0];
                    *(GAS unsigned long long*)(yout + rowof(cy, i) * 256 + gp * 32 + gl * 16 + 4 * (lane >> 4)) = (unsigned long long)pk2(v[0], v[1]) | ((unsigned long long)pk2(v[2], v[3]) << 32); } }
            if (k + 1 <= 71) { *(LAS u32x4*)(Us0 + ((k + 1) & 1) * 1280 + (t6 >> 2) * 40 + (t6 & 3) * 8) = pre;
                if (k + 2 <= 71) pre = *(const GAS u32x4*)(z + rowof(k + 2, t6 >> 2) * ZW + CD_ + gp * 32 + (t6 & 3) * 8); }
        }
        LDS_BARRIER();
    }
    __syncthreads();
}

__device__ __forceinline__ float sum16(float v) { v = sum8(v); return v + dppf<0x140>(v); }
struct CmbRow { u32x2 zr[3], zk[3], zv[3], zg[3], gB, gC, uD, y[8], ac[2]; f32x4 ci[2]; };
__device__ __forceinline__ void p3_combine(const PV& P, int l, int nrows, LAS unsigned char* lds) {
    const int tid = otid(), lane = tid & 63, w = __builtin_amdgcn_readfirstlane(tid >> 6), c4 = 4 * lane, hh = lane >> 4;
    LAS float* gup = (LAS float*)lds;
    LAS float* smu = gup + 16384;
    LAS float* spar = smu + 1664;
    LAS float* sgs = spar + 1280 + w * 64;
    for (int idx = tid; idx < 16384; idx += 512) gup[idx] = PIN(I_GUP)[(size_t)l * 16384 + idx];
    for (int idx = tid; idx < 1664; idx += 512) { const int which = idx / 832, col = idx % 832; smu[idx] = PIN(I_MU)[(size_t)(l * 2 + which) * 960 + col]; }
    for (int idx = tid; idx < 1280; idx += 512) { const int k = idx >> 8, c = idx & 255;
        spar[idx] = k == 0 ? PIN(I_LNG)[l * 256 + c] : k == 1 ? PIN(I_LNB)[l * 256 + c] : k == 2 ? PIN(I_RK)[l * 256 + c] : k == 3 ? PIN(I_GNG)[l * 256 + c] : PIN(I_SD)[l * 256 + c]; }
    __syncthreads();
    const GAS bf16_t* z = (const GAS bf16_t*)(P.ws + WS_Z); const GAS bf16_t* Y = (const GAS bf16_t*)(P.ws + WS_Y);
    GAS bf16_t* mix = (GAS bf16_t*)(P.ws + WS_ACT); GAS bf16_t* s5g = (GAS bf16_t*)(P.ws + WS_S5G);
    const int gw = blockIdx.x * 8 + w, NGW = gridDim.x * 8;
    auto ld = [&](int row, CmbRow& L) {
        const bool isctx = row >= TL; const int t = isctx ? ((row - TL) & 255) : (row & 2047), seqlen = isctx ? CTX : SEQ;
        const GAS bf16_t* zr = z + (size_t)row * ZW;
#pragma unroll
        for (int d = 0; d < 3; ++d) { const bool ok = d == 1 || (d == 0 ? t > 0 : t < seqlen - 1); const GAS bf16_t* zz = zr + (d - 1) * ZW; const u32x2 zero = (u32x2){0u, 0u};
            L.zr[d] = ok ? *(const GAS u32x2*)(zz + c4) : zero; L.zk[d] = ok ? *(const GAS u32x2*)(zz + 256 + c4) : zero; L.zv[d] = ok ? *(const GAS u32x2*)(zz + 512 + c4) : zero;
            L.zg[d] = (ok && lane < 16) ? *(const GAS u32x2*)(zz + 768 + c4) : zero; }
        L.gB = *(const GAS u32x2*)(zr + CB_ + 768 + c4); L.gC = *(const GAS u32x2*)(zr + CC_ + 256 + c4); L.uD = *(const GAS u32x2*)(zr + CD_ + c4);
#pragma unroll
        for (int k = 0; k < 8; ++k) L.y[k] = *(const GAS u32x2*)(Y + (size_t)k * YSZ + (size_t)row * 256 + c4);
        const int bb = isctx ? (row - TL) >> 8 : row >> 11;
#pragma unroll
        for (int d = 0; d < 2; ++d) { const int ts = d ? seqlen - 1 - t : t, ck = (isctx ? 0 : 4) + (ts >> 6);
            L.ac[d] = *(const GAS u32x2*)((const GAS bf16_t*)(P.ws + WS_ACU) + (size_t)d * YSZ + (size_t)row * 256 + c4);
            L.ci[d] = *(const GAS f32x4*)((const GAS float*)(P.ws + WS_CIN) + ((size_t)(bb * 2 + d) * 36 + ck) * 256 + c4); }
    };
    auto up4 = [](const u32x2 v, float (&o)[4]) { o[0] = bflo(v.x); o[1] = bfhi(v.x); o[2] = bflo(v.y); o[3] = bfhi(v.y); };
    auto st4 = [](GAS bf16_t* p, const float (&o)[4]) { *(GAS unsigned long long*)p = (unsigned long long)pk2(o[0], o[1]) | ((unsigned long long)pk2(o[2], o[3]) << 32); };
    auto shift4 = [&](const u32x2 (&zz)[3], int col, float (&o)[4]) { float a[4], m[4], n[4]; up4(zz[1], a); up4(zz[0], m); up4(zz[2], n);
        const f32x4 u0 = *(const LAS f32x4*)(smu + col), u1 = *(const LAS f32x4*)(smu + 832 + col);
#pragma unroll
        for (int e = 0; e < 4; ++e) o[e] = a[e] + u0[e] * (m[e] - a[e]) + u1[e] * (n[e] - a[e]); };
    auto cmp = [&](int row, const CmbRow& L) {
        if (lane < 16) { float gl[4]; shift4(L.zg, 768 + c4, gl);
            *(LAS f32x4*)(sgs + c4) = (f32x4){sigmoidf_(gl[0]), sigmoidf_(gl[1]), sigmoidf_(gl[2]), sigmoidf_(gl[3])}; }
        asm volatile("s_waitcnt lgkmcnt(0)" ::: "memory");
        f32x4 g = (f32x4){0.f, 0.f, 0.f, 0.f};
#pragma unroll 8
        for (int i = 0; i < 64; ++i) g += sgs[i] * *(const LAS f32x4*)(gup + i * 256 + c4);
        float r[4], k[4], v[4]; shift4(L.zr, c4, r); shift4(L.zk, 256 + c4, k); shift4(L.zv, 512 + c4, v);
        const f32x4 lng = *(const LAS f32x4*)(spar + c4), lnb = *(const LAS f32x4*)(spar + 256 + c4), rk = *(const LAS f32x4*)(spar + 512 + c4), gng = *(const LAS f32x4*)(spar + 768 + c4), sd = *(const LAS f32x4*)(spar + 1024 + c4);
        float ya[4], yb[4], t0[4], t1[4];
        up4(L.y[0], t0); up4(L.y[1], t1);
#pragma unroll
        for (int e = 0; e < 4; ++e) ya[e] = t0[e] + t1[e];
        { const float mean = sum16((ya[0] + ya[1]) + (ya[2] + ya[3])) * (1.0f / 64.0f); float q = 0.f, bsum = 0.f;
#pragma unroll
            for (int e = 0; e < 4; ++e) { ya[e] -= mean; q += ya[e] * ya[e]; bsum += r[e] * k[e] * rk[e]; }
            const float rs = __builtin_amdgcn_rsqf(sum16(q) * (1.0f / 64.0f) + 64e-5f); bsum = sum16(bsum); float o[4];
#pragma unroll
            for (int e = 0; e < 4; ++e) o[e] = (ya[e] * rs * lng[e] + lnb[e] + bsum * v[e]) * g[e];
            st4(mix + (size_t)row * 1024 + c4, o); }
        up4(L.y[2], t0); up4(L.y[3], t1);
#pragma unroll
        for (int e = 0; e < 4; ++e) yb[e] = t0[e] + t1[e];
        { const float mean = sum16((yb[0] + yb[1]) + (yb[2] + yb[3])) * (1.0f / 64.0f); float q = 0.f;
#pragma unroll
            for (int e = 0; e < 4; ++e) { yb[e] -= mean; q += yb[e] * yb[e]; }
            const float rs = __builtin_amdgcn_rsqf(sum16(q) * (1.0f / 64.0f) + 1e-5f); float gt[4], o[4]; up4(L.gB, gt);
#pragma unroll
            for (int e = 0; e < 4; ++e) o[e] = siluf_(gt[e]) * (yb[e] * rs * gng[e]);
            st4(mix + (size_t)row * 1024 + 256 + c4, o); }
        { float gt[4], o[4], a0[4], a1[4]; up4(L.gC, gt); up4(L.y[4], t0); up4(L.y[5], t1); up4(L.ac[0], a0); up4(L.ac[1], a1);
#pragma unroll
            for (int e = 0; e < 4; ++e) o[e] = geluf_(gt[e]) * ((t0[e] + a0[e] * L.ci[0][e]) + (t1[e] + a1[e] * L.ci[1][e]));
            st4(mix + (size_t)row * 1024 + 512 + c4, o); }
        { float uu[4], o[4]; up4(L.uD, uu); up4(L.y[6], t0); up4(L.y[7], t1);
#pragma unroll
            for (int e = 0; e < 4; ++e) o[e] = geluf_(sd[e] * uu[e] + t0[e] + t1[e]);
            st4(s5g + (size_t)row * 256 + c4, o); }
    };
    (void)hh;
    for (int row = gw; row < nrows; row += 2 * NGW) {
        CmbRow LA, LB; const int rowB = row + NGW; const bool hasB = rowB < nrows;
        ld(row, LA); if (hasB) ld(rowB, LB);
        cmp(row, LA); if (hasB) cmp(rowB, LB);
    }
}

__device__ __forceinline__ void p6_h2(const PV& P, int l, int nrows) {
    const int tid = otid(), lane = tid & 63, gw = blockIdx.x * 8 + __builtin_amdgcn_readfirstlane(tid >> 6), NGW = gridDim.x * 8;
    const float* mod = (const float*)(P.ws + WS_MOD) + (size_t)l * 9 * 6144; const float* X1 = (const float*)(P.ws + WS_X1);
    bf16_t* act = (bf16_t*)(P.ws + WS_ACT);
    for (int row = gw; row < nrows; row += NGW) { const int mr = row < TL ? (row >> 11) : 8;
        float x[16], y[16]; load_row16(X1 + (size_t)row * 1024, lane, x);
        norm_mod16(x, PIN(I_N2G) + l * 1024, mod + (size_t)mr * 6144 + 3 * 1024, mod + (size_t)mr * 6144 + 4 * 1024, lane, y);
        store_row16_bf16(act + (size_t)row * 1024, lane, y); }
}

__device__ __forceinline__ unsigned skey(float f) { const unsigned u = __builtin_bit_cast(unsigned, f); return u ^ ((unsigned)((int)u >> 31) | 0x80000000u); }
__device__ __forceinline__ float unskey(unsigned s) { const unsigned u = (s & 0x80000000u) ? (s ^ 0x80000000u) : ~s; return __builtin_bit_cast(float, u); }

__device__ __forceinline__ void ce_(unsigned& a, unsigned& b) { const unsigned hi = max(a, b), lo = min(a, b); a = hi; b = lo; }
__device__ __forceinline__ void sort16_(unsigned (&v)[16]) {
#pragma unroll
    for (int k = 2; k <= 16; k <<= 1)
#pragma unroll
        for (int j = k >> 1; j > 0; j >>= 1)
#pragma unroll
            for (int i = 0; i < 16; ++i) { const int p = i ^ j; if (p > i) { if ((i & k) == 0) ce_(v[i], v[p]); else ce_(v[p], v[i]); } }
}
__device__ __forceinline__ void merge16_(unsigned (&a)[16], const unsigned (&b)[16]) {
#pragma unroll
    for (int i = 0; i < 16; ++i) a[i] = max(a[i], b[15 - i]);
#pragma unroll
    for (int j = 8; j > 0; j >>= 1)
#pragma unroll
        for (int i = 0; i < 16; ++i) { const int p = i ^ j; if (p > i) ce_(a[i], a[p]); }
}
__device__ __forceinline__ void p8a_topk(const PV& P, int nrows, LAS unsigned char* lds) {
    const int tid = otid();
    LAS unsigned* tb = (LAS unsigned*)lds;
    const GAS float* sc = (const GAS float*)(P.ws + WS_SC); GAS u32x2* list = (GAS u32x2*)(P.ws + WS_LIST);
    const int items = nrows * 16, nth = gridDim.x * 512;
    for (int item = blockIdx.x * 512 + tid; item < items; item += nth) {
        const int row = item >> 4, hp = item & 15, hh = hp >> 1, p = hp & 1;
        const GAS f32x4* sp = (const GAS f32x4*)(sc + (size_t)row * 2048 + hp * 128);
        unsigned top[16];
        f32x4 nx[4];
#pragma unroll
        for (int q = 0; q < 4; ++q) nx[q] = sp[q];
#pragma unroll 1
        for (int bk = 0; bk < 8; ++bk) { unsigned cur[16];
#pragma unroll
            for (int q = 0; q < 4; ++q) { const f32x4 v = nx[q];
#pragma unroll
                for (int k = 0; k < 4; ++k) cur[q * 4 + k] = (skey(v[k]) & 0xFFFFFF80u) | (unsigned)(bk * 16 + q * 4 + k); }
            { const int nb = bk < 7 ? bk + 1 : 7;
#pragma unroll
                for (int q = 0; q < 4; ++q) nx[q] = sp[nb * 4 + q]; }
            sort16_(cur);
            if (bk == 0) {
#pragma unroll
                for (int s = 0; s < 16; ++s) top[s] = cur[s];
            } else merge16_(top, cur); }
        float v1[16], v2[16]; unsigned i1[16], i2[16];
#pragma unroll
        for (int s = 0; s < 16; ++s) { const float mv = unskey(top[s] & 0xFFFFFF80u); const unsigned mi = top[s] & 127u;
            const float ov = dppf<0xB1>(mv); const unsigned oi = dppu<0xB1>(mi);
            v1[s] = p ? ov : mv; i1[s] = p ? oi : mi; v2[s] = p ? mv : ov; i2[s] = p ? mi : oi; }
        unsigned k2[16];
        { unsigned cand[64]; int n = 0;
#pragma unroll
            for (int a = 0; a < 16; ++a)
#pragma unroll
                for (int bb = 0; bb < 16; ++bb) if ((a + 1) * (bb + 1) <= 16) { cand[n] = (skey(v1[a] + v2[bb]) & 0xFFFFFF00u) | (unsigned)(a * 16 + bb); ++n; }
#pragma unroll
            for (int q = 50; q < 64; ++q) cand[q] = 0u;
#pragma unroll
            for (int bk = 0; bk < 4; ++bk) { unsigned cur[16];
#pragma unroll
                for (int s = 0; s < 16; ++s) cur[s] = cand[bk * 16 + s];
                sort16_(cur);
                if (bk == 0) {
#pragma unroll
                    for (int s = 0; s < 16; ++s) k2[s] = cur[s];
                } else merge16_(k2, cur); } }
#pragma unroll
        for (int s = 0; s < 16; ++s) { tb[s * 512 + tid] = i1[s]; tb[(16 + s) * 512 + tid] = i2[s]; }
        const float mx = unskey(k2[0] & 0xFFFFFF00u); float ev[16], sum = 0.f; unsigned pl[16];
#pragma unroll
        for (int s = 0; s < 16; ++s) { ev[s] = __expf(unskey(k2[s] & 0xFFFFFF00u) - mx); sum += ev[s];
            const unsigned a = (k2[s] >> 4) & 15u, bb = k2[s] & 15u; pl[s] = (tb[a * 512 + tid] << 7) | tb[(16 + bb) * 512 + tid]; }
        const float inv = __builtin_amdgcn_rcpf(sum);
        if (p == 0) { GAS u32x2* lp = list + (size_t)row * 128 + hh * 16;
#pragma unroll
            for (int s = 0; s < 16; ++s) lp[s] = (u32x2){pl[s], __builtin_bit_cast(unsigned, ev[s] * inv)}; }
    }
}

template <class PT> __device__ __forceinline__ void load_row16c(PT p, int lane, float (&x)[16]) {
#pragma unroll
    for (int k = 0; k < 4; ++k) { const f32x4 a = *(const GAS f32x4*)(p + 16 * lane + 4 * k);
#pragma unroll
        for (int e = 0; e < 4; ++e) x[4 * k + e] = a[e]; }
}
template <class PT> __device__ __forceinline__ void store_row16c_f32(PT p, int lane, const float (&x)[16]) {
#pragma unroll
    for (int k = 0; k < 4; ++k) *(GAS f32x4*)(p + 16 * lane + 4 * k) = (f32x4){x[4 * k], x[4 * k + 1], x[4 * k + 2], x[4 * k + 3]};
}
template <class PT> __device__ __forceinline__ void store_row16c_bf16(PT p, int lane, const float (&y)[16]) {
    u32x4 a, b; a.x = pk2(y[0], y[1]); a.y = pk2(y[2], y[3]); a.z = pk2(y[4], y[5]); a.w = pk2(y[6], y[7]);
    b.x = pk2(y[8], y[9]); b.y = pk2(y[10], y[11]); b.z = pk2(y[12], y[13]); b.w = pk2(y[14], y[15]);
    *(GAS u32x4*)(p + 16 * lane) = a; *(GAS u32x4*)(p + 16 * lane + 8) = b;
}
template <class G1, class G2> __device__ __forceinline__ void norm_mod16c(const float (&x)[16], G1 g, G2 shift, G2 scale, int lane, float (&y)[16]) {
    float ss = 0.f;
#pragma unroll
    for (int e = 0; e < 16; ++e) ss += x[e] * x[e];
    ss = wave_sum(ss);
    const float r = __builtin_amdgcn_rsqf(ss * (1.0f / 1024.0f) + 1e-6f);
    float gg[16]; load_row16c(g, lane, gg);
    if (shift) { float sh[16], sc[16]; load_row16c(shift, lane, sh); load_row16c(scale, lane, sc);
#pragma unroll
        for (int e = 0; e < 16; ++e) y[e] = x[e] * r * gg[e] * (1.0f + sc[e]) + sh[e];
    } else {
#pragma unroll
        for (int e = 0; e < 16; ++e) y[e] = x[e] * r * gg[e];
    }
}
__device__ __forceinline__ void p8u_dots(const PV& P, int l, int nrows) {
    const int tid = otid(), lane = tid & 63, w = __builtin_amdgcn_readfirstlane(tid >> 6), eg = lane >> 3, cs = lane & 7;
    const bool sliced = (gridDim.x & 7) == 0;
    const int x0 = sliced ? (blockIdx.x & 7) : 0, xstep = sliced ? 8 : 1;
    const int gwx = sliced ? (blockIdx.x >> 3) * 8 + w : blockIdx.x * 8 + w, nW = sliced ? (gridDim.x >> 3) * 8 : gridDim.x * 8;
    const GAS unsigned* listw = (const GAS unsigned*)(P.ws + WS_LIST); const GAS bf16_t* h2 = (const GAS bf16_t*)(P.ws + WS_ACT);
    GAS bf16_t* pd = (GAS bf16_t*)(P.ws + WS_SC);
    for (int x = x0; x < 8; x += xstep) {
        const GAS unsigned char* U8 = (const GAS unsigned char*)P.ws + WS_U8 + (size_t)l * NEXP * 1024 + (size_t)x * NEXP * 128 + 16 * cs;
        unsigned idn[16]; u32x4 uu[16]; u32x4 hc0, hc1, hn0, hn1;
        int row = gwx;
        if (row < nrows) {
#pragma unroll
            for (int g = 0; g < 16; ++g) idn[g] = listw[((size_t)row * 128 + 8 * g + eg) * 2];
            hc0 = *(const GAS u32x4*)(h2 + (size_t)row * 1024 + 128 * x + 16 * cs); hc1 = *(const GAS u32x4*)(h2 + (size_t)row * 1024 + 128 * x + 16 * cs + 8);
#pragma unroll
            for (int g = 0; g < 16; ++g) uu[g] = *(const GAS u32x4*)(U8 + (size_t)idn[g] * 128);
            const int rn = row + nW < nrows ? row + nW : row;
#pragma unroll
            for (int g = 0; g < 16; ++g) idn[g] = listw[((size_t)rn * 128 + 8 * g + eg) * 2];
            hn0 = *(const GAS u32x4*)(h2 + (size_t)rn * 1024 + 128 * x + 16 * cs); hn1 = *(const GAS u32x4*)(h2 + (size_t)rn * 1024 + 128 * x + 16 * cs + 8);
        }
        for (; row < nrows; row += nW) {
            f32x2 hx[8];
            hx[0] = (f32x2){bflo(hc0.x), bfhi(hc0.x)}; hx[1] = (f32x2){bflo(hc0.y), bfhi(hc0.y)}; hx[2] = (f32x2){bflo(hc0.z), bfhi(hc0.z)}; hx[3] = (f32x2){bflo(hc0.w), bfhi(hc0.w)};
            hx[4] = (f32x2){bflo(hc1.x), bfhi(hc1.x)}; hx[5] = (f32x2){bflo(hc1.y), bfhi(hc1.y)}; hx[6] = (f32x2){bflo(hc1.z), bfhi(hc1.z)}; hx[7] = (f32x2){bflo(hc1.w), bfhi(hc1.w)};
#pragma unroll
            for (int k = 0; k < 8; ++k) asm volatile("" : "+v"(hx[k]));
            GAS bf16_t* pdr = pd + ((size_t)x * nrows + row) * 128 + 8 * cs + eg;
#pragma unroll
            for (int half = 0; half < 2; ++half) { float d[8];
#pragma unroll
                for (int gg = 0; gg < 8; ++gg) { const int g = 8 * half + gg; f32x2 a2 = (f32x2){0.f, 0.f};
#pragma unroll
                    for (int q = 0; q < 4; ++q) { const f32x2 lo = __builtin_amdgcn_cvt_pk_f32_fp8((int)uu[g][q], false), hi = __builtin_amdgcn_cvt_pk_f32_fp8((int)uu[g][q], true);
                        a2 += lo * hx[2 * q]; a2 += hi * hx[2 * q + 1]; }
                    uu[g] = *(const GAS u32x4*)(U8 + (size_t)idn[g] * 128);
                    d[gg] = a2[0] + a2[1]; }
                const bool c4 = (cs & 4) != 0, c2 = (cs & 2) != 0, c1 = (cs & 1) != 0;
                float e4[4], e2[2];
#pragma unroll
                for (int j = 0; j < 4; ++j) { const float snd = c4 ? d[j] : d[j + 4], kp = c4 ? d[j + 4] : d[j]; e4[j] = kp + dppf<0x141>(snd); }
#pragma unroll
                for (int j = 0; j < 2; ++j) { const float snd = c2 ? e4[j] : e4[j + 2], kp = c2 ? e4[j + 2] : e4[j]; e2[j] = kp + dppf<0x4E>(snd); }
                { const float snd = c1 ? e2[0] : e2[1], kp = c1 ? e2[1] : e2[0]; pdr[64 * half] = (bf16_t)f2bf(kp + dppf<0xB1>(snd)); } }
            hc0 = hn0; hc1 = hn1;
            const int r2 = row + 2 * nW < nrows ? row + 2 * nW : row;
#pragma unroll
            for (int g = 0; g < 16; ++g) idn[g] = listw[((size_t)r2 * 128 + 8 * g + eg) * 2];
            hn0 = *(const GAS u32x4*)(h2 + (size_t)r2 * 1024 + 128 * x + 16 * cs); hn1 = *(const GAS u32x4*)(h2 + (size_t)r2 * 1024 + 128 * x + 16 * cs + 8);
        }
    }
}
__device__ __forceinline__ void p8c_coef(const PV& P, int nrows) {
    const int tid = otid();
    GAS u32x4* list4 = (GAS u32x4*)(P.ws + WS_LIST); const GAS u32x2* pd4 = (const GAS u32x2*)(P.ws + WS_SC);
    const int n4 = nrows * 32, nth = gridDim.x * 512;
    for (int i = blockIdx.x * 512 + tid; i < n4; i += nth) { f32x4 sacc = (f32x4){0.f, 0.f, 0.f, 0.f};
        u32x4 e0 = list4[(size_t)2 * i], e1 = list4[(size_t)2 * i + 1];
#pragma unroll
        for (int xx = 0; xx < 8; ++xx) { const u32x2 pw = pd4[(size_t)xx * n4 + i]; sacc += (f32x4){bflo(pw.x), bfhi(pw.x), bflo(pw.y), bfhi(pw.y)}; }
        const unsigned g0 = e0.y, g1 = e0.w, g2 = e1.y, g3 = e1.w;
        e0.y = __float_as_uint(__uint_as_float(g0) * geluf_(sacc[0] * (1.0f / 32.0f)) * 0.5f);
        e0.w = __float_as_uint(__uint_as_float(g1) * geluf_(sacc[1] * (1.0f / 32.0f)) * 0.5f);
        e1.y = __float_as_uint(__uint_as_float(g2) * geluf_(sacc[2] * (1.0f / 32.0f)) * 0.5f);
        e1.w = __float_as_uint(__uint_as_float(g3) * geluf_(sacc[3] * (1.0f / 32.0f)) * 0.5f);
        list4[(size_t)2 * i] = e0; list4[(size_t)2 * i + 1] = e1; }
}
__device__ __forceinline__ void p8v_accum(const PV& P, int l, int nrows, LAS unsigned char* lds) {
    const int tid = otid(), lane = tid & 63, w = __builtin_amdgcn_readfirstlane(tid >> 6), eg = lane >> 3, cs = lane & 7;
    const bool sliced = (gridDim.x & 7) == 0;
    const int x0 = sliced ? (blockIdx.x & 7) : 0, xstep = sliced ? 8 : 1;
    const int gwx = sliced ? (blockIdx.x >> 3) * 8 + w : blockIdx.x * 8 + w, nW = sliced ? (gridDim.x >> 3) * 8 : gridDim.x * 8;
    const GAS unsigned* listw = (const GAS unsigned*)(P.ws + WS_LIST);
    const GAS float* modl = (const GAS float*)(P.ws + WS_MOD) + (size_t)l * 9 * 6144; const GAS float* X1 = (const GAS float*)(P.ws + WS_X1);
    LAS float* cl = (LAS float*)(lds + w * 1024);
    LAS unsigned* il = (LAS unsigned*)(cl + 128);
    const bool b5 = (lane & 32) != 0, b4 = (lane & 16) != 0, b3 = (lane & 8) != 0;
    for (int x = x0; x < 8; x += xstep) {
        const GAS unsigned char* V8 = (const GAS unsigned char*)P.ws + WS_V8 + (size_t)l * NEXP * 1024 + (size_t)x * NEXP * 128 + 16 * cs;
        unsigned n_i0, n_i1, n_c0, n_c1;
        u32x4 vv[16]; float cfc[16];
#define V_LOAD1(r) do { const GAS unsigned* lw = listw + ((size_t)(r) * 128 + lane) * 2; n_i0 = lw[0]; n_c0 = lw[1]; n_i1 = lw[128]; n_c1 = lw[129]; } while (0)
#define V_TOLDS() do { cl[lane] = __builtin_bit_cast(float, n_c0); cl[64 + lane] = __builtin_bit_cast(float, n_c1); il[lane] = n_i0; il[64 + lane] = n_i1; asm volatile("s_waitcnt lgkmcnt(0)" ::: "memory"); } while (0)
        int row = gwx;
        if (row < nrows) {
            V_LOAD1(row); V_TOLDS();
#pragma unroll
            for (int g = 0; g < 16; ++g) { const unsigned id = il[8 * g + eg]; cfc[g] = cl[8 * g + eg]; vv[g] = *(const GAS u32x4*)(V8 + (size_t)id * 128); }
            const int rn = row + nW < nrows ? row + nW : row;
            V_LOAD1(rn); asm volatile("s_waitcnt lgkmcnt(0)" ::: "memory"); V_TOLDS();
            const int r2 = row + 2 * nW < nrows ? row + 2 * nW : row;
            V_LOAD1(r2);
        }
        for (; row < nrows; row += nW) { const int mr = row < TL ? (row >> 11) : 8;
            f32x2 acc[8];
#pragma unroll
            for (int j = 0; j < 8; ++j) acc[j] = (f32x2){0.f, 0.f};
#pragma unroll
            for (int g = 0; g < 16; ++g) { const f32x2 c2 = (f32x2){cfc[g], cfc[g]};
#pragma unroll
                for (int q = 0; q < 4; ++q) { const f32x2 lo = __builtin_amdgcn_cvt_pk_f32_fp8((int)vv[g][q], false), hi = __builtin_amdgcn_cvt_pk_f32_fp8((int)vv[g][q], true);
                    acc[2 * q] += c2 * lo; acc[2 * q + 1] += c2 * hi; }
                const unsigned id = il[8 * g + eg]; cfc[g] = cl[8 * g + eg]; vv[g] = *(const GAS u32x4*)(V8 + (size_t)id * 128); }
            f32x2 a4[4], a2v[2], a1;
#pragma unroll
            for (int j = 0; j < 4; ++j) { const f32x2 snd = b5 ? acc[j] : acc[j + 4], kp = b5 ? acc[j + 4] : acc[j]; a4[j] = kp + (f32x2){__shfl_xor(snd[0], 32), __shfl_xor(snd[1], 32)}; }
#pragma unroll
            for (int j = 0; j < 2; ++j) { const f32x2 snd = b4 ? a4[j] : a4[j + 2], kp = b4 ? a4[j + 2] : a4[j]; a2v[j] = kp + (f32x2){__shfl_xor(snd[0], 16), __shfl_xor(snd[1], 16)}; }
            { const f32x2 snd = b3 ? a2v[0] : a2v[1], kp = b3 ? a2v[1] : a2v[0]; a1 = kp + (f32x2){__shfl_xor(snd[0], 8), __shfl_xor(snd[1], 8)}; }
            const int col = 128 * x + 16 * cs + 2 * eg;
            const f32x2 xm = *(const GAS f32x2*)(X1 + (size_t)row * 1024 + col), g5 = *(const GAS f32x2*)(modl + (size_t)mr * 6144 + 5 * 1024 + col);
            GAS float* xo = row < TL ? (GAS float*)P.out + (size_t)row * 1024 : (GAS float*)(P.ws + WS_X0C) + (size_t)(row - TL) * 1024;
            *(GAS f32x2*)(xo + col) = xm + g5 * a1;
            V_TOLDS();
            const int r3 = row + 3 * nW < nrows ? row + 3 * nW : row;
            V_LOAD1(r3);
        }
#undef V_LOAD1
#undef V_TOLDS
    }
}
__device__ __forceinline__ void p8w_norm(const PV& P, int l, int nrows) {
    const int tid = otid(), lane = tid & 63, gw = blockIdx.x * 8 + __builtin_amdgcn_readfirstlane(tid >> 6), NGW = gridDim.x * 8;
    for (int row = gw; row < nrows; row += NGW) { const int mr = row < TL ? (row >> 11) : 8;
        float* xo = row < TL ? P.out + (size_t)row * 1024 : (float*)(P.ws + WS_X0C) + (size_t)(row - TL) * 1024;
        float xn[16], y[16]; load_row16c(xo, lane, xn);
        if (l == 0) { const float* mod1 = (const float*)(P.ws + WS_MOD) + (size_t)9 * 6144 + (size_t)mr * 6144;
            norm_mod16c(xn, PIN(I_N1G) + 1024, mod1, mod1 + 1024, lane, y);
            store_row16c_bf16((bf16_t*)(P.ws + WS_ACT) + (size_t)row * 1024, lane, y);
        } else { norm_mod16c(xn, PIN(I_FNG), (const float*)nullptr, (const float*)nullptr, lane, y); store_row16c_f32(xo, lane, y); }
    }
}

typedef __attribute__((address_space(1))) unsigned gu32;
#define XB_TMO      128
#define XB_XCNT(j)  (256  + 64 * (j))
#define XB_XSUB(j)  (1280 + 64 * (j))
#define XB_XGEN(j)  (2304 + 64 * (j))
#define XB_TOP      3328
#define XB_TOPGEN   3392
#define XCD_BAR_WORDS 3456
#define XB_SPIN_CAP (1u << 18)

__device__ __forceinline__ unsigned xb_ld(unsigned* p)              { return __hip_atomic_load(p, __ATOMIC_RELAXED, __HIP_MEMORY_SCOPE_AGENT); }
__device__ __forceinline__ unsigned xb_add(unsigned* p, unsigned v) { return __hip_atomic_fetch_add(p, v, __ATOMIC_RELAXED, __HIP_MEMORY_SCOPE_AGENT); }
__device__ __forceinline__ unsigned xb_xcc_id() { return (unsigned)__builtin_amdgcn_s_getreg((3 << 11) | 20) & 0xFu; }
#define XB_SPIN(cond, bar) do { unsigned _sp = 0; while (cond) { __builtin_amdgcn_s_sleep(1); \
    if ((++_sp & 255u) == 0u) { if (xb_ld(&(bar)[XB_TMO])) break; if (_sp > XB_SPIN_CAP) { atomicAdd(&(bar)[XB_TMO], 1u); break; } } } } while (0)

struct XcdBarrier {
    unsigned* bar; unsigned x;
    volatile LAS unsigned* st;
};

__device__ __forceinline__ XcdBarrier xcd_barrier_post(unsigned* bar, volatile LAS unsigned* st) {
    XcdBarrier b; b.bar = bar; b.x = xb_xcc_id(); b.st = st;
    if (threadIdx.x == 0) (void)xb_add(&bar[XB_XCNT(b.x)], 1u);
    return b;
}
__device__ __forceinline__ void xcd_barrier_complete(unsigned* bar, unsigned x, unsigned& nloc, unsigned& nx) {
    const unsigned G = gridDim.x * gridDim.y * gridDim.z;
    unsigned sum, cnt, mine, sp = 0u;
    for (;;) {
        sum = 0u; cnt = 0u; mine = 0u;
#pragma unroll
        for (unsigned j = 0; j < 16; ++j) { const unsigned c = xb_ld(&bar[XB_XCNT(j)]); sum += c; cnt += (c > 0u) ? 1u : 0u; mine = (j == x) ? c : mine; }
        if (sum == G) break;
        __builtin_amdgcn_s_sleep(1);
        if ((++sp & 255u) == 0u) { if (xb_ld(&bar[XB_TMO])) break; if (sp > XB_SPIN_CAP) { atomicAdd(&bar[XB_TMO], 1u); break; } }
    }
    nloc = mine > 0u ? mine : 1u; nx = cnt > 0u ? cnt : 1u;
}

__device__ __forceinline__ void xcd_barrier(const XcdBarrier& b) {
    asm volatile("s_waitcnt vmcnt(0)" ::: "memory");
    __syncthreads();
    if (threadIdx.x == 0) {
        unsigned* bar = b.bar;
        __builtin_amdgcn_s_waitcnt(0);
        unsigned nloc = b.st[0], nx = b.st[1];
        if (nloc == 0u) { xcd_barrier_complete(bar, b.x, nloc, nx); b.st[0] = nloc; b.st[1] = nx; }
        const unsigned old = xb_add(&bar[XB_XSUB(b.x)], 1u);
        const unsigned gen = old / nloc;
        if (old + 1u == (gen + 1u) * nloc) {
            __builtin_amdgcn_fence(__ATOMIC_RELEASE, "agent");
            asm volatile("s_waitcnt vmcnt(0)" ::: "memory");
            const unsigned og = xb_add(&bar[XB_TOP], 1u);
            const unsigned tg = og / nx;
            if (og + 1u == (tg + 1u) * nx) xb_add(&bar[XB_TOPGEN], 1u);
            else XB_SPIN(xb_ld(&bar[XB_TOPGEN]) == tg, bar);
            __builtin_amdgcn_fence(__ATOMIC_ACQUIRE, "agent");
            xb_add(&bar[XB_XGEN(b.x)], 1u);
            asm volatile("s_waitcnt vmcnt(0)" ::: "memory");
        } else {
            XB_SPIN(xb_ld(&bar[XB_XGEN(b.x)]) == gen, bar);
            __builtin_amdgcn_fence(__ATOMIC_ACQUIRE, "agent");
            asm volatile("s_waitcnt vmcnt(0)" ::: "memory");
        }
    }
    __syncthreads();
}

#define GSYNC() do { xcd_barrier(xbar); if (PROBE_DUP & 32) xcd_barrier(xbar); } while (0)
template <int l>
__device__ __forceinline__ void run_layer(const PV& P, const XcdBarrier& xbar) {
    const int nrows = l == 0 ? TT : TL;
    for (int rep = 0; rep < ((PROBE_DUP & 8) ? 2 : 1); ++rep) { const PV Q = opq(P);
        pg8::Gemm g{(const bf16_t*)(Q.ws + WS_ACT), (const bf16_t*)(Q.ws + WS_WIN) + (size_t)l * ZW * 1024, TT, ZW, 1024};
        pg8::StaticOrder S; S.init(TT, ZW, gridDim.x, blockIdx.x);
        pg8::EpiZ E{(bf16_t*)(Q.ws + WS_Z), ZW};
        pg8::gemm_phase<pg8::EpiZ, pg8::StaticOrder, true, true>(Q.lds, g, S, E);
        if ((int)gridDim.x == 256) { if ((int)blockIdx.x >= 24) p0_tables(Q, l, blockIdx.x - 24, 232); }
        else p0_tables(Q, l, blockIdx.x, gridDim.x); }
    GSYNC();
    for (int rep = 0; rep < ((PROBE_DUP & 128) ? 2 : 1); ++rep) { const PV Q = opq(P); rwkv_pre(Q, l, Q.lds); }
    for (int rep = 0; rep < ((PROBE_DUP & 65536) ? 2 : 1); ++rep) { const PV Q = opq(P); lru_items(Q, l, Q.lds); }
    GSYNC();
    for (int rep = 0; rep < ((PROBE_DUP & 2) ? 2 : 1); ++rep) {
        for (;;) {
            const PV Q = opq(P);
            __syncthreads();
            if (otid() == 0) *(LAS int*)(Q.lds + LDS_BYTES - 16) = (int)atomicAdd((unsigned*)(Q.ws + WS_CTL) + 64 * (1 + l + 2 * rep), 1u);
            __syncthreads();
            const int u = *(LAS int*)(Q.lds + LDS_BYTES - 16);
            if (u >= 272) break;
            if (u < 128) { for (int r2 = 0; r2 < ((PROBE_DUP & 16384) ? 2 : 1); ++r2) s5_unit(Q, l, u, Q.lds); }
            else if (u < 192) { for (int r2 = 0; r2 < ((PROBE_DUP & 4096) ? 2 : 1); ++r2) rwkv_seq(Q, l, u - 128, Q.lds); }
            else if (u < 256) { for (int r2 = 0; r2 < ((PROBE_DUP & 8192) ? 2 : 1); ++r2) ret_unit(Q, l, u - 192, Q.lds); }
            else lru_carry_unit(Q, u - 256);
        }
        if (PROBE_DUP & 2) GSYNC();
    }
    if (!(PROBE_DUP & 2)) GSYNC();
    for (int rep = 0; rep < ((PROBE_DUP & 16) ? 2 : 1); ++rep) { const PV Q = opq(P); p3_combine(Q, l, nrows, Q.lds); __syncthreads(); }
    GSYNC();
    for (int rep = 0; rep < ((PROBE_DUP & 8) ? 2 : 1); ++rep) { const PV Q = opq(P);
        pg8::Gemm g{(const bf16_t*)(Q.ws + WS_S5G), (const bf16_t*)(Q.ws + WS_GLU) + (size_t)l * 512 * 256, nrows, 512, 256};
        pg8::StaticOrder S; S.init(nrows, 512, gridDim.x, blockIdx.x);
        pg8::EpiGlu E{(bf16_t*)(Q.ws + WS_ACT), inp_(Q.tab, I_GLUB) + l * 512};
        pg8::gemm_phase<pg8::EpiGlu, pg8::StaticOrder, true, true>(Q.lds, g, S, E); }
    GSYNC();
    for (int rep = 0; rep < ((PROBE_DUP & 8) ? 2 : 1); ++rep) { const PV Q = opq(P);
        pg8::Gemm g{(const bf16_t*)(Q.ws + WS_ACT), (const bf16_t*)(Q.ws + WS_WOUT) + (size_t)l * 1024 * 1024, nrows, 1024, 1024};
        pg8::StaticOrder S; S.init(nrows, 1024, gridDim.x, blockIdx.x);
        pg8::EpiRes E{l == 0 ? inp_(Q.tab, I_X) : (const float*)Q.out, l == 0 ? inp_(Q.tab, I_CTX) : (const float*)(Q.ws + WS_X0C),
                      (const float*)(Q.ws + WS_MOD) + (size_t)l * 9 * 6144 + 2048, (float*)(Q.ws + WS_X1)};
        pg8::gemm_phase<pg8::EpiRes, pg8::StaticOrder, true, true>(Q.lds, g, S, E);
        if (l == 0 && (int)gridDim.x == 256) { if ((int)blockIdx.x >= 32) p0_weff(Q, 0, blockIdx.x - 32, 224, Q.lds); }
        else if (l == 0) p0_weff(Q, 0, blockIdx.x, gridDim.x, Q.lds); }
    GSYNC();
    for (int rep = 0; rep < ((PROBE_DUP & 16) ? 2 : 1); ++rep) { const PV Q = opq(P); p6_h2(Q, l, nrows); }
    GSYNC();
    for (int rep = 0; rep < ((PROBE_DUP & 8) ? 2 : 1); ++rep) { const PV Q = opq(P);
        pg8::Gemm g{(const bf16_t*)(Q.ws + WS_ACT), (const bf16_t*)(Q.ws + WS_WEFF) + (size_t)l * 2048 * 1024, nrows, 2048, 1024};
        pg8::StaticOrder S; S.init(nrows, 2048, gridDim.x, blockIdx.x);
        pg8::EpiF32 E{(float*)(Q.ws + WS_SC), 2048};
        pg8::gemm_phase<pg8::EpiF32, pg8::StaticOrder, true, true>(Q.lds, g, S, E);
        if (l == 0 && (int)gridDim.x == 256) { if ((int)blockIdx.x >= 64) { p0_transposes(Q, 1, blockIdx.x - 64, 192, Q.lds); __syncthreads(); p0_weff(Q, 1, blockIdx.x - 64, 192, Q.lds); } }
        else if (l == 0) { p0_transposes(Q, 1, blockIdx.x, gridDim.x, Q.lds); __syncthreads(); p0_weff(Q, 1, blockIdx.x, gridDim.x, Q.lds); } }
    GSYNC();
    for (int rep = 0; rep < ((PROBE_DUP & 4) ? 2 : 1); ++rep) { const PV Q = opq(P); p8a_topk(Q, nrows, Q.lds); }
    GSYNC();
    for (int rep = 0; rep < ((PROBE_DUP & 1) ? 2 : 1); ++rep) { const PV Q = opq(P); p8u_dots(Q, l, nrows); }
    GSYNC();
    { const PV Q = opq(P); p8c_coef(Q, nrows); }
    GSYNC();
    for (int rep = 0; rep < ((PROBE_DUP & 2048) ? 2 : 1); ++rep) { const PV Q = opq(P); p8v_accum(Q, l, nrows, Q.lds); }
    GSYNC();
    { const PV Q = opq(P); p8w_norm(Q, l, nrows); }
    if (l == 0) GSYNC();
}

__global__ void __launch_bounds__(512, 2) fwd_mega(Params KP) {
    extern __shared__ __attribute__((aligned(16))) unsigned char lds_raw[];
    LAS unsigned char* lds = (LAS unsigned char*)lds_raw;
    cg::grid_group grid = cg::this_grid();
    const int tid = otid();
    PV P; P.tab = (const LAS unsigned*)(lds + LDS_BYTES - 1024); P.ws = KP.ws; P.out = KP.out; P.lds = lds;
    if (tid < 88) { const unsigned* ka = (const unsigned*)__builtin_amdgcn_kernarg_segment_ptr(); ((LAS unsigned*)(lds + LDS_BYTES - 1024))[tid] = ka[tid]; }
    if (tid < 4) ((LAS unsigned*)(lds + LDS_BYTES - 64))[tid] = 0u;
    __syncthreads();
    const XcdBarrier xbar = xcd_barrier_post((unsigned*)(KP.ws + WS_CTL) + 4096, (volatile LAS unsigned*)(lds + LDS_BYTES - 64));

    for (int rep = 0; rep < ((PROBE_DUP & 64) ? 2 : 1); ++rep) { const PV Q = opq(P); p0_prologue(Q, Q.lds); __syncthreads(); }
    if (KP.ws == nullptr) grid.sync();
    GSYNC();
    { const PV Q = opq(P); p0b_ain(Q); }
    GSYNC();

    run_layer<0>(P, xbar);
    run_layer<1>(P, xbar);
}

extern "C" void kernel_launch(void* const* d_in, const int* in_sizes, int n_in, void* d_out, int out_size, void* d_ws, size_t ws_size, hipStream_t stream) {
    static int grid = 0;
    if (grid == 0) {
        if (n_in != 44 || out_size != TL * DM || ws_size < WS_END) { fprintf(stderr, "kernel_launch: unexpected shapes (n_in %d, out %d, ws %zu; need ws >= %zu)\n", n_in, out_size, ws_size, (size_t)WS_END); grid = -1; return; }
        int dev = 0, cus = 0, per_cu = 0;
        hipGetDevice(&dev); hipDeviceGetAttribute(&cus, hipDeviceAttributeMultiprocessorCount, dev);
        hipFuncSetAttribute((const void*)fwd_mega, hipFuncAttributeMaxDynamicSharedMemorySize, LDS_BYTES);
        hipOccupancyMaxActiveBlocksPerMultiprocessor(&per_cu, (const void*)fwd_mega, 512, LDS_BYTES);
        if (per_cu < 1) { fprintf(stderr, "kernel_launch: occupancy query says %d blocks/CU\n", per_cu); per_cu = 1; }
        grid = cus;
        (void)hipGetLastError();
    }
    if (grid < 0) return;
    hipMemsetAsync((char*)d_ws + WS_CTL, 0, 65536, stream);
    Params p{};
    for (int i = 0; i < 44; ++i) p.in[i] = (const float*)d_in[i];
    p.out = (float*)d_out; p.ws = (unsigned char*)d_ws;
    void* args[] = {&p};
    hipError_t e = hipLaunchCooperativeKernel((const void*)fwd_mega, dim3(grid), dim3(512), args, LDS_BYTES, stream);
    if (e != hipSuccess) fprintf(stderr, "cooperative launch failed: %s (grid %d)\n", hipGetErrorString(e), grid);
}
```

```cpp
#include <hip/hip_runtime.h>
#include <hip/hip_cooperative_groups.h>
#include <hip/hip_fp16.h>
#include <cstdio>
#include <cstdint>
namespace cg = cooperative_groups;

#define LAS __attribute__((address_space(3)))
#define GAS __attribute__((address_space(1)))
typedef unsigned short bf16_t;
typedef short bf16x8 __attribute__((ext_vector_type(8)));
typedef float f32x4 __attribute__((ext_vector_type(4)));
typedef float f32x2 __attribute__((ext_vector_type(2)));
typedef unsigned u32x4 __attribute__((ext_vector_type(4)));
typedef unsigned u32x2 __attribute__((ext_vector_type(2)));
typedef _Float16 h16x2 __attribute__((ext_vector_type(2)));

constexpr int DM = 1024, NB = 8, SEQ = 2048, CTX = 256;
constexpr int TL = NB * SEQ;
constexpr int TC = NB * CTX;
constexpr int TT = TL + TC;
constexpr int ZW = 2816;
constexpr int INC = 2752;
constexpr int CB_ = 960, CC_ = 1984, CD_ = 2496;
constexpr int NEXP = 16384;

constexpr size_t MiB = 1u << 20;
constexpr size_t WS_CTL = 0;
constexpr size_t WS_MOD = 1 * MiB;
constexpr size_t WS_WIN = 2 * MiB;
constexpr size_t WS_WOUT = 14 * MiB;
constexpr size_t WS_WEFF = 18 * MiB;
constexpr size_t WS_GLU = 26 * MiB;
constexpr size_t WS_U8 = 28 * MiB;
constexpr size_t WS_V8 = 60 * MiB;
constexpr size_t WS_H2Q = 92 * MiB;
constexpr size_t WS_H2S = 110 * MiB;
constexpr size_t WS_US = 111 * MiB;
constexpr size_t WS_COEF = 112 * MiB;
constexpr size_t WS_REC = 156 * MiB;
constexpr size_t WS_ACT = 156 * MiB;
constexpr size_t WS_S5G = 192 * MiB;
constexpr size_t WS_X1 = 202 * MiB;
constexpr size_t WS_X0B = 122 * MiB;
constexpr size_t WS_X0C = 274 * MiB;
constexpr size_t WS_Z = 316 * MiB;
constexpr size_t WS_Y = 415 * MiB;
constexpr size_t WS_SC = 316 * MiB;
constexpr size_t WS_LIST = 462 * MiB;
constexpr size_t WS_ACU = 487 * MiB;
constexpr size_t WS_AGG = 505 * MiB;
constexpr size_t WS_CIN = 507 * MiB;
constexpr size_t WS_END = 508 * MiB;
constexpr size_t YSZ = (size_t)TT * 256;
static_assert(WS_SC + (size_t)TT * 2048 * 4 <= WS_LIST && WS_LIST + (size_t)TT * 128 * 8 <= WS_END, "ws map");
static_assert(WS_Y + 8 * YSZ * 2 <= WS_END && WS_Z + (size_t)TT * ZW * 2 <= WS_Y, "ws map");
static_assert(WS_REC + (size_t)64 * 72 * 36096 <= WS_Z, "ws map");

constexpr int LDS_BYTES = 147456;

struct Params { const float* in[44]; float* out; unsigned char* ws; };
struct PV { const LAS unsigned* tab; unsigned char* ws; float* out; LAS unsigned char* lds; };
__device__ __forceinline__ const float* inp_(const LAS unsigned* tab, int i) {
    const unsigned lo = (unsigned)__builtin_amdgcn_readfirstlane((int)tab[2 * i]), hi = (unsigned)__builtin_amdgcn_readfirstlane((int)tab[2 * i + 1]);
    return (const float*)(((unsigned long long)hi << 32) | (unsigned long long)lo);
}
#define PIN(i) inp_(P.tab, (i))
__device__ __forceinline__ PV opq(const PV& P) { PV q = P; unsigned o = 0; asm volatile("" : "+s"(q.ws), "+s"(q.out), "+s"(o)); q.lds = P.lds + o; q.tab = (const LAS unsigned*)(q.lds + LDS_BYTES - 1024); return q; }
enum { I_X = 0, I_C, I_CTX, I_CCTX, I_N1G, I_N2G, I_ADAW, I_ADAB, I_WIN, I_WOUT, I_MU, I_W0, I_WUP, I_A0, I_AUP, I_GUP, I_KK, I_KA, I_RK, I_LNG, I_LNB,
       I_GNG, I_CVW, I_CVB, I_WA, I_BA, I_WX, I_BX, I_LAM, I_SARE, I_SAIM, I_SLDT, I_SBRE, I_SBIM, I_SCRE, I_SCIM, I_SD, I_GLUW, I_GLUB, I_WQ, I_KEYS, I_PU, I_PV, I_FNG };

#define LDS_BARRIER() do { asm volatile("s_waitcnt lgkmcnt(0)" ::: "memory"); __builtin_amdgcn_s_barrier(); asm volatile("" ::: "memory"); } while (0)
__device__ __forceinline__ int otid() { int t = threadIdx.x; asm volatile("" : "+v"(t)); return t; }
typedef __bf16 hwbf16x2 __attribute__((ext_vector_type(2)));
typedef float cvf32x2 __attribute__((ext_vector_type(2)));
__device__ __forceinline__ unsigned pk2(float lo, float hi) { const cvf32x2 v = {lo, hi}; return __builtin_bit_cast(unsigned, __builtin_convertvector(v, hwbf16x2)); }
__device__ __forceinline__ unsigned f2bf(float f) { return (unsigned)__builtin_bit_cast(unsigned short, (__bf16)f); }
__device__ __forceinline__ unsigned pk2a(float lo, float hi) { unsigned r; asm("v_cvt_pk_bf16_f32 %0, %1, %2" : "=v"(r) : "v"(lo), "v"(hi)); return r; }
__device__ __forceinline__ float bf2f(unsigned b) { return __builtin_bit_cast(float, b << 16); }
__device__ __forceinline__ float bflo(unsigned w) { return __builtin_bit_cast(float, w << 16); }
__device__ __forceinline__ float bfhi(unsigned w) { return __builtin_bit_cast(float, w & 0xffff0000u); }

template <int CTRL> __device__ __forceinline__ float dppf(float v) {
    return __builtin_bit_cast(float, __builtin_amdgcn_update_dpp(0, __builtin_bit_cast(int, v), CTRL, 0xF, 0xF, true));
}
template <int CTRL> __device__ __forceinline__ unsigned dppu(unsigned v) {
    return (unsigned)__builtin_amdgcn_update_dpp(0, (int)v, CTRL, 0xF, 0xF, true);
}
__device__ __forceinline__ float sum8(float v) {
    v += dppf<0xB1>(v);
    v += dppf<0x4E>(v);
    v += dppf<0x141>(v);
    return v;
}
__device__ __forceinline__ float wave_sum(float v) {
    v = sum8(v); v += dppf<0x140>(v);
    const float s0 = __builtin_bit_cast(float, __builtin_amdgcn_readlane(__builtin_bit_cast(int, v), 0)), s1 = __builtin_bit_cast(float, __builtin_amdgcn_readlane(__builtin_bit_cast(int, v), 16));
    const float s2 = __builtin_bit_cast(float, __builtin_amdgcn_readlane(__builtin_bit_cast(int, v), 32)), s3 = __builtin_bit_cast(float, __builtin_amdgcn_readlane(__builtin_bit_cast(int, v), 48));
    return (s0 + s1) + (s2 + s3);
}
__device__ __forceinline__ float swapsum32(float a, float b) { const auto r = __builtin_amdgcn_permlane32_swap(__float_as_uint(a), __float_as_uint(b), false, false); const unsigned x = r[0], y = r[1]; return __uint_as_float(x) + __uint_as_float(y); }
__device__ __forceinline__ float swapsum16(float a, float b) { const auto r = __builtin_amdgcn_permlane16_swap(__float_as_uint(a), __float_as_uint(b), false, false); const unsigned x = r[0], y = r[1]; return __uint_as_float(x) + __uint_as_float(y); }
__device__ __forceinline__ float wave_max(float v) {
    v = fmaxf(v, dppf<0xB1>(v)); v = fmaxf(v, dppf<0x4E>(v)); v = fmaxf(v, dppf<0x141>(v)); v = fmaxf(v, dppf<0x140>(v));
    const float s0 = __builtin_bit_cast(float, __builtin_amdgcn_readlane(__builtin_bit_cast(int, v), 0)), s1 = __builtin_bit_cast(float, __builtin_amdgcn_readlane(__builtin_bit_cast(int, v), 16));
    const float s2 = __builtin_bit_cast(float, __builtin_amdgcn_readlane(__builtin_bit_cast(int, v), 32)), s3 = __builtin_bit_cast(float, __builtin_amdgcn_readlane(__builtin_bit_cast(int, v), 48));
    return fmaxf(fmaxf(s0, s1), fmaxf(s2, s3));
}
__device__ __forceinline__ unsigned pack_i8x4(float a, float b, float c, float d) {
    const int q0 = (int)__builtin_rintf(a), q1 = (int)__builtin_rintf(b), q2 = (int)__builtin_rintf(c), q3 = (int)__builtin_rintf(d);
    return ((unsigned)q0 & 255u) | (((unsigned)q1 & 255u) << 8) | (((unsigned)q2 & 255u) << 16) | ((unsigned)q3 << 24);
}
__device__ __forceinline__ float sigmoidf_(float x) { return __builtin_amdgcn_rcpf(1.0f + __expf(-x)); }
__device__ __forceinline__ float tanhf_(float x) { return 1.0f - 2.0f * __builtin_amdgcn_rcpf(1.0f + __expf(2.0f * x)); }
__device__ __forceinline__ float softplusf_(float x) { return fmaxf(x, 0.0f) + __logf(1.0f + __expf(-fabsf(x))); }
__device__ __forceinline__ float geluf_(float x) { return 0.5f * x * (1.0f + tanhf_(0.7978845608f * (x + 0.044715f * x * x * x))); }
__device__ __forceinline__ float siluf_(float x) { return x * sigmoidf_(x); }

template <int MT, int NT, int KS>
__device__ __forceinline__ void lds_mma(f32x4 (&acc)[MT][NT], const LAS bf16_t* A, int lda, const LAS bf16_t* Bt, int ldb, int lane) {
    const int r = lane & 15, q = lane >> 4;
#pragma unroll
    for (int ks = 0; ks < KS; ++ks) {
        bf16x8 a[MT], b[NT];
#pragma unroll
        for (int m = 0; m < MT; ++m) a[m] = *(const LAS bf16x8*)(A + (m * 16 + r) * lda + ks * 32 + q * 8);
#pragma unroll
        for (int n = 0; n < NT; ++n) b[n] = *(const LAS bf16x8*)(Bt + (n * 16 + r) * ldb + ks * 32 + q * 8);
#pragma unroll
        for (int m = 0; m < MT; ++m)
#pragma unroll
            for (int n = 0; n < NT; ++n) acc[m][n] = __builtin_amdgcn_mfma_f32_16x16x32_bf16(b[n], a[m], acc[m][n], 0, 0, 0);
    }
}
template <int MT, int NT> __device__ __forceinline__ void zero_acc(f32x4 (&acc)[MT][NT]) {
#pragma unroll
    for (int m = 0; m < MT; ++m)
#pragma unroll
        for (int n = 0; n < NT; ++n) acc[m][n] = (f32x4){0.f, 0.f, 0.f, 0.f};
}

namespace pg8 {
#define PG8_LAS __attribute__((address_space(3)))
typedef unsigned short bf16_t;
typedef short bf16x8 __attribute__((ext_vector_type(8)));
typedef float f32x4 __attribute__((ext_vector_type(4)));
typedef unsigned u32x4 __attribute__((ext_vector_type(4)));
constexpr int BM = 256, BK = 64, HALF = 128, HTB = HALF * BK * 2  , STAGE_BYTES = 8 * HTB, NXCD = 8, WGM = 8;

__host__ __device__ __forceinline__ int lds_byte(int r, int c) { const int st = (r >> 4) * 2 + (c >> 5), rr = r & 15, cc = c & 31, ob = rr * 64 + cc * 2; return st * 1024 + (ob ^ (((ob >> 9) & 1) << 5)); }
__host__ __device__ __forceinline__ void stage_rc(int b, int& R, int& C) { const int st = b / 1024, sb = b % 1024, swz = sb ^ (((sb >> 9) & 1) << 5); R = (st >> 1) * 16 + swz / 64; C = (st & 1) * 32 + (swz % 64) / 2; }
__host__ __device__ __forceinline__ int perm32(int rho) { const int n = rho >> 4, i = rho & 15; return 8 * (i >> 2) + 4 * n + (i & 3); }

struct Unit { int pm, pn; };
struct Gemm { const bf16_t* A; const bf16_t* Bt; int M, N, K; };

struct StaticOrder {
    int nM, nN, nwg, G, c;
    __host__ __device__ void init(int M, int N, int G_, int c_) { nM = M / BM; nN = N / BM; nwg = nM * nN; G = G_; c = c_; }
    __host__ __device__ bool next(int i, Unit& u) const {
        const long L = (long)i * G + c; if (L >= nwg) return false;
        int wgid = (int)L; { const int q = nwg / NXCD, r = nwg % NXCD, xcd = wgid % NXCD, off = wgid / NXCD; wgid = (xcd < r ? xcd * (q + 1) : r * (q + 1) + (xcd - r) * q) + off; }
        const int nig = WGM * nN, gid = wgid / nig, fm = gid * WGM, gsz = (nM - fm) < WGM ? (nM - fm) : WGM;
        u.pm = fm + ((wgid % nig) % gsz); u.pn = (wgid % nig) / gsz; return true;
    }
    __device__ __forceinline__ void a_ready(const Unit&) const {}
    __device__ __forceinline__ void done(const Unit&) const {}
};


__device__ __forceinline__ unsigned cvt_pk_bf16(float lo, float hi) { unsigned r; asm volatile("v_cvt_pk_bf16_f32 %0, %1, %2" : "=v"(r) : "v"(lo), "v"(hi)); return r; }

struct EpiZ {
    static constexpr bool PERM = true, AFTER_DRAIN = false;
    bf16_t* O; int ldc;
    __device__ __forceinline__ void operator()(const f32x4 (&acc)[2][2][4][2], const Unit& u, int wr, int wc, int fr, int fq) const {
        const int row0 = u.pm * BM + wr * 64 + fr, col0 = u.pn * BM + wc * 32 + 8 * fq;
#pragma unroll
        for (int ai = 0; ai < 2; ++ai)
#pragma unroll
            for (int m = 0; m < 4; ++m) { bf16_t* rowp = O + (size_t)(row0 + ai * HALF + m * 16) * ldc + col0;
#pragma unroll
                for (int bj = 0; bj < 2; ++bj) { const f32x4 v0 = acc[ai][bj][m][0], v1 = acc[ai][bj][m][1];
                    u32x4 w; w.x = cvt_pk_bf16(v0[0], v0[1]); w.y = cvt_pk_bf16(v0[2], v0[3]); w.z = cvt_pk_bf16(v1[0], v1[1]); w.w = cvt_pk_bf16(v1[2], v1[3]);
                    *(u32x4*)(rowp + bj * HALF) = w; } }
    }
};
struct EpiGlu {
    static constexpr bool PERM = false, AFTER_DRAIN = false;
    bf16_t* O; const float* gb;
    __device__ __forceinline__ void operator()(const f32x4 (&acc)[2][2][4][2], const Unit& u, int wr, int wc, int fr, int fq) const {
#pragma unroll
        for (int ai = 0; ai < 2; ++ai)
#pragma unroll
            for (int m = 0; m < 4; ++m) { const int row = u.pm * BM + ai * HALF + wr * 64 + m * 16 + fr;
#pragma unroll
                for (int n = 0; n < 2; ++n) { const int ch = u.pn * 128 + wc * 32 + n * 16 + 4 * fq;
                    const float* gp = gb; asm volatile("" : "+s"(gp));
                    const f32x4 bv = *(const f32x4*)(gp + ch), bg = *(const f32x4*)(gp + 256 + ch);
                    const f32x4 v = acc[ai][0][m][n] + bv, g = acc[ai][1][m][n] + bg; float o[4];
#pragma unroll
                    for (int e = 0; e < 4; ++e) o[e] = v[e] * __builtin_amdgcn_rcpf(1.0f + __expf(-g[e]));
                    unsigned lo = cvt_pk_bf16(o[0], o[1]), hi = cvt_pk_bf16(o[2], o[3]);
                    *(unsigned long long*)(O + (size_t)row * 1024 + 768 + ch) = (unsigned long long)lo | ((unsigned long long)hi << 32); } }
    }
};
struct EpiRes {
    static constexpr bool PERM = false, AFTER_DRAIN = false;
    const float* baseL; const float* baseC; const float* gate; float* out; bool b16;
    __device__ __forceinline__ void operator()(const f32x4 (&acc)[2][2][4][2], const Unit& u, int wr, int wc, int fr, int fq) const {
        const int rowt = u.pm * BM; const int mr = rowt < 16384 ? (rowt >> 11) : 8;
        const float* grow = gate + (size_t)mr * 6144;
#pragma unroll
        for (int bj = 0; bj < 2; ++bj)
#pragma unroll
            for (int n = 0; n < 2; ++n) { const int col = u.pn * BM + bj * HALF + wc * 32 + n * 16 + 4 * fq; const f32x4 gv = *(const f32x4*)(grow + col);
#pragma unroll
                for (int ai = 0; ai < 2; ++ai)
#pragma unroll
                    for (int m = 0; m < 4; ++m) { const int row = rowt + ai * HALF + wr * 64 + m * 16 + fr;
                        f32x4 bs;
                        if (b16) { const bf16_t* bp = row < 16384 ? (const bf16_t*)baseL + (size_t)row * 1024 + col : (const bf16_t*)baseC + (size_t)(row - 16384) * 1024 + col;
                            const u32x2 bw = *(const u32x2*)bp; bs = (f32x4){bflo(bw.x), bfhi(bw.x), bflo(bw.y), bfhi(bw.y)}; }
                        else { const float* bp = row < 16384 ? baseL + (size_t)row * 1024 + col : baseC + (size_t)(row - 16384) * 1024 + col; bs = *(const f32x4*)bp; } const f32x4 xv = bs + gv * acc[ai][bj][m][n];
                        *(unsigned long long*)((bf16_t*)out + (size_t)row * 1024 + col) = (unsigned long long)cvt_pk_bf16(xv[0], xv[1]) | ((unsigned long long)cvt_pk_bf16(xv[2], xv[3]) << 32); } }
    }
};
struct EpiF16 {
    static constexpr bool PERM = false, AFTER_DRAIN = false;
    bf16_t* O; int ldc;
    __device__ __forceinline__ void operator()(const f32x4 (&acc)[2][2][4][2], const Unit& u, int wr, int wc, int fr, int fq) const {
#pragma unroll
        for (int ai = 0; ai < 2; ++ai)
#pragma unroll
            for (int m = 0; m < 4; ++m) { const int row = u.pm * BM + ai * HALF + wr * 64 + m * 16 + fr;
#pragma unroll
                for (int bj = 0; bj < 2; ++bj)
#pragma unroll
                    for (int n = 0; n < 2; ++n) { const int col = u.pn * BM + bj * HALF + wc * 32 + n * 16 + 4 * fq; const f32x4 v = acc[ai][bj][m][n];
                        const _Float16 h0 = (_Float16)v[0], h1 = (_Float16)v[1], h2 = (_Float16)v[2], h3 = (_Float16)v[3];
                        const unsigned lo = (unsigned)__builtin_bit_cast(unsigned short, h0) | ((unsigned)__builtin_bit_cast(unsigned short, h1) << 16);
                        const unsigned hi = (unsigned)__builtin_bit_cast(unsigned short, h2) | ((unsigned)__builtin_bit_cast(unsigned short, h3) << 16);
                        *(unsigned long long*)(O + (size_t)row * ldc + col) = (unsigned long long)lo | ((unsigned long long)hi << 32); } }
    }
};
struct EpiF32 {
    static constexpr bool PERM = false, AFTER_DRAIN = false;
    float* O; int ldc;
    __device__ __forceinline__ void operator()(const f32x4 (&acc)[2][2][4][2], const Unit& u, int wr, int wc, int fr, int fq) const {
#pragma unroll
        for (int ai = 0; ai < 2; ++ai)
#pragma unroll
            for (int m = 0; m < 4; ++m) { const int row = u.pm * BM + ai * HALF + wr * 64 + m * 16 + fr;
#pragma unroll
                for (int bj = 0; bj < 2; ++bj)
#pragma unroll
                    for (int n = 0; n < 2; ++n) { const int col = u.pn * BM + bj * HALF + wc * 32 + n * 16 + 4 * fq;
                        *(f32x4*)(O + (size_t)row * ldc + col) = acc[ai][bj][m][n]; } }
    }
};

template <class Epi, class Sched, bool ALIGN_EPI = false, bool SP2 = false>
__device__ __forceinline__ void gemm_phase(PG8_LAS unsigned char* lds, const Gemm g, const Sched& S, const Epi& E) {
    int tid_ = threadIdx.x; asm volatile("" : "+v"(tid_));
    const int tid = tid_, wid = __builtin_amdgcn_readfirstlane(tid >> 6), lane = tid & 63, wr = wid >> 2, wc = wid & 3, fr = lane & 15, fq = lane >> 4;
    const int K = g.K, nt = K / BK;
    unsigned voffA[2], voffB[2];
#pragma unroll
    for (int i = 0; i < 2; ++i) { int R, C; stage_rc(tid * 16 + i * 8192, R, C); const int Rb = Epi::PERM ? ((R & ~31) + perm32(R & 31)) : R;
        voffA[i] = (unsigned)(R * K + C) * 2u; voffB[i] = (unsigned)(Rb * K + C) * 2u; }
    const size_t kstep = (size_t)(BK * 2);
    const size_t hstep = (size_t)HALF * K * 2;
    const size_t tstep = 2 * hstep;
    const unsigned ldsw = (unsigned)wid * 1024u;
    const int aoff = lds_byte(wr * 64 + fr, fq * 8), boff = lds_byte(wc * 32 + fr, fq * 8);
#define PG8_SA(b, h) (((b) * 2 + (h)) * HTB)
#define PG8_SB(b, h) ((4 + (b) * 2 + (h)) * HTB)
#define PG8_STAGE(bufoff, gbase, voff) do { _Pragma("unroll") for (int _i = 0; _i < 2; ++_i) \
        __builtin_amdgcn_global_load_lds((const unsigned*)((const char*)(gbase) + (voff)[_i]), (PG8_LAS unsigned*)(lds + (bufoff) + ldsw + _i * 8192), 16, 0, 0); } while (0)
#define PG8_LDA(dst, b, h) do { _Pragma("unroll") for (int m = 0; m < 4; ++m) _Pragma("unroll") for (int k = 0; k < 2; ++k) dst[m][k] = *(const PG8_LAS bf16x8*)(lds + PG8_SA(b, h) + aoff + m * 2048 + k * 1024); } while (0)
#define PG8_LDB(dst, b, h) do { _Pragma("unroll") for (int n = 0; n < 2; ++n) _Pragma("unroll") for (int k = 0; k < 2; ++k) dst[n][k] = *(const PG8_LAS bf16x8*)(lds + PG8_SB(b, h) + boff + n * 2048 + k * 1024); } while (0)
#define PG8_MMA(ai, bj, At, Bt) do { __builtin_amdgcn_s_setprio(1); _Pragma("unroll") for (int m = 0; m < 4; ++m) _Pragma("unroll") for (int n = 0; n < 2; ++n) _Pragma("unroll") for (int k = 0; k < 2; ++k) \
        acc[ai][bj][m][n] = __builtin_amdgcn_mfma_f32_16x16x32_bf16(Bt[n][k], At[m][k], acc[ai][bj][m][n], 0, 0, 0); __builtin_amdgcn_s_setprio(0); } while (0)
#define PG8_WAIT_V(n) asm volatile("s_waitcnt vmcnt(" #n ")" ::: "memory")
#define PG8_WAIT_L(n) asm volatile("s_waitcnt lgkmcnt(" #n ")" ::: "memory")
#define PG8_BAR __builtin_amdgcn_s_barrier()
#define PG8_SCHED __builtin_amdgcn_sched_barrier(0)
    Unit cur, nxt; int ui = 0;
    if (!S.next(0, cur)) return;
    f32x4 acc[2][2][4][2];
#pragma unroll
    for (int a = 0; a < 2; ++a)
#pragma unroll
        for (int b = 0; b < 2; ++b)
#pragma unroll
            for (int m = 0; m < 4; ++m)
#pragma unroll
                for (int n = 0; n < 2; ++n) acc[a][b][m][n] = (f32x4){0.f, 0.f, 0.f, 0.f};
    bf16x8 At[4][2], B0[2][2], B1[2][2];
    const char* cA = (const char*)g.A + (size_t)cur.pm * tstep; const char* cB = (const char*)g.Bt + (size_t)cur.pn * tstep;
    S.a_ready(cur);
    if constexpr (SP2) {
        PG8_STAGE(PG8_SB(0, 0), cB, voffB); PG8_STAGE(PG8_SB(0, 1), cB + hstep, voffB); PG8_STAGE(PG8_SA(0, 0), cA, voffA); PG8_STAGE(PG8_SA(0, 1), cA + hstep, voffA);
        if (wr == 1) PG8_BAR;
        PG8_WAIT_V(2); PG8_BAR;
        PG8_STAGE(PG8_SB(1, 0), cB + kstep, voffB); PG8_STAGE(PG8_SA(1, 0), cA + kstep, voffA); PG8_STAGE(PG8_SB(1, 1), cB + hstep + kstep, voffB);
        PG8_WAIT_V(6); PG8_BAR;
    } else {
        PG8_STAGE(PG8_SB(0, 0), cB, voffB); PG8_STAGE(PG8_SA(0, 0), cA, voffA); PG8_STAGE(PG8_SB(0, 1), cB + hstep, voffB); PG8_STAGE(PG8_SA(0, 1), cA + hstep, voffA);
        if (wr == 1) PG8_BAR;
        PG8_WAIT_V(4); PG8_BAR;
        PG8_STAGE(PG8_SB(1, 0), cB + kstep, voffB); PG8_STAGE(PG8_SA(1, 0), cA + kstep, voffA); PG8_STAGE(PG8_SB(1, 1), cB + hstep + kstep, voffB);
        PG8_WAIT_V(6); PG8_BAR;
    }
    for (;;) {
        const bool has_next = S.next(ui + 1, nxt);
        const char* nA = has_next ? (const char*)g.A + (size_t)nxt.pm * tstep : cA; const char* nB = has_next ? (const char*)g.Bt + (size_t)nxt.pn * tstep : cB;
        for (int t = 0; t < nt; t += 2) {
            const bool last = (t == nt - 2);
            const char* a1 = cA + (size_t)(t + 1) * kstep;
            const char* a2 = last ? nA : cA + (size_t)(t + 2) * kstep; const char* b2 = last ? nB : cB + (size_t)(t + 2) * kstep;
            const char* a3 = a2 + kstep; const char* b3 = b2 + kstep;
            if (last && has_next) S.a_ready(nxt);
            if constexpr (SP2) {
            PG8_LDB(B0, 0, 0); PG8_LDB(B1, 0, 1); PG8_SCHED; PG8_LDA(At, 0, 0); PG8_STAGE(PG8_SA(1, 1), a1 + hstep, voffA);
            PG8_WAIT_V(8); PG8_WAIT_L(0); PG8_BAR; PG8_MMA(0, 0, At, B0); PG8_MMA(0, 1, At, B1); PG8_BAR; PG8_SCHED;
            PG8_LDA(At, 0, 1); PG8_STAGE(PG8_SB(0, 0), b2, voffB); PG8_STAGE(PG8_SB(0, 1), b2 + hstep, voffB); PG8_STAGE(PG8_SA(0, 0), a2, voffA);
            PG8_WAIT_V(8); PG8_WAIT_L(0); PG8_BAR; PG8_MMA(1, 0, At, B0); PG8_MMA(1, 1, At, B1); PG8_BAR; PG8_SCHED;
            PG8_LDB(B0, 1, 0); PG8_LDB(B1, 1, 1); PG8_SCHED; PG8_LDA(At, 1, 0); PG8_STAGE(PG8_SA(0, 1), a2 + hstep, voffA);
            PG8_WAIT_V(8); PG8_WAIT_L(0); PG8_BAR; PG8_MMA(0, 0, At, B0); PG8_MMA(0, 1, At, B1); PG8_BAR; PG8_SCHED;
            PG8_LDA(At, 1, 1); PG8_STAGE(PG8_SB(1, 0), b3, voffB); PG8_STAGE(PG8_SB(1, 1), b3 + hstep, voffB); PG8_STAGE(PG8_SA(1, 0), a3, voffA);
            PG8_WAIT_V(8); PG8_WAIT_L(0); PG8_BAR; PG8_MMA(1, 0, At, B0); PG8_MMA(1, 1, At, B1); PG8_BAR; PG8_SCHED;
            } else {
            PG8_LDB(B0, 0, 0); PG8_SCHED; PG8_LDA(At, 0, 0); PG8_STAGE(PG8_SA(1, 1), a1 + hstep, voffA);
            PG8_WAIT_L(8); PG8_BAR; PG8_WAIT_L(0); PG8_MMA(0, 0, At, B0); PG8_BAR; PG8_SCHED;
            PG8_LDB(B1, 0, 1); PG8_STAGE(PG8_SB(0, 0), b2, voffB);
            PG8_BAR; PG8_WAIT_L(0); PG8_MMA(0, 1, At, B1); PG8_BAR;
            PG8_LDA(At, 0, 1); PG8_STAGE(PG8_SA(0, 0), a2, voffA);
            PG8_BAR; PG8_WAIT_L(0); PG8_MMA(1, 0, At, B0); PG8_BAR; PG8_SCHED;
            PG8_STAGE(PG8_SB(0, 1), b2 + hstep, voffB);
            PG8_WAIT_V(6); PG8_BAR; PG8_MMA(1, 1, At, B1); PG8_BAR;
            PG8_LDB(B0, 1, 0); PG8_SCHED; PG8_LDA(At, 1, 0); PG8_STAGE(PG8_SA(0, 1), a2 + hstep, voffA);
            PG8_WAIT_L(8); PG8_BAR; PG8_WAIT_L(0); PG8_MMA(0, 0, At, B0); PG8_BAR; PG8_SCHED;
            PG8_LDB(B1, 1, 1); PG8_STAGE(PG8_SB(1, 0), b3, voffB);
            PG8_BAR; PG8_WAIT_L(0); PG8_MMA(0, 1, At, B1); PG8_BAR;
            PG8_LDA(At, 1, 1); PG8_STAGE(PG8_SA(1, 0), a3, voffA);
            PG8_BAR; PG8_WAIT_L(0); PG8_MMA(1, 0, At, B0); PG8_BAR; PG8_SCHED;
            PG8_STAGE(PG8_SB(1, 1), b3 + hstep, voffB);
            PG8_WAIT_V(6); PG8_BAR; PG8_MMA(1, 1, At, B1); PG8_BAR;
            }
        }
        if constexpr (ALIGN_EPI) { if (wr == 0) PG8_BAR; }
        if constexpr (!Epi::AFTER_DRAIN) { E(acc, cur, wr, wc, fr, fq); S.done(cur); }
        if (!has_next) break;
#pragma unroll
        for (int a = 0; a < 2; ++a)
#pragma unroll
            for (int b = 0; b < 2; ++b)
#pragma unroll
                for (int m = 0; m < 4; ++m)
#pragma unroll
                    for (int n = 0; n < 2; ++n) acc[a][b][m][n] = (f32x4){0.f, 0.f, 0.f, 0.f};
        cur = nxt; cA = nA; cB = nB; ++ui;
        if constexpr (ALIGN_EPI) { if (wr == 1) PG8_BAR; }
    }
    PG8_WAIT_V(0);
    if constexpr (!ALIGN_EPI) { if (wr == 0) PG8_BAR; }
    PG8_BAR;
    if constexpr (Epi::AFTER_DRAIN) { E.fused(acc, cur, wr, wc, fr, fq, lds, wid, lane); S.done(cur); }
#undef PG8_SA
#undef PG8_SB
#undef PG8_STAGE
#undef PG8_LDA
#undef PG8_LDB
#undef PG8_MMA
#undef PG8_WAIT_V
#undef PG8_WAIT_L
#undef PG8_BAR
#undef PG8_SCHED
}
}
#ifndef PROBE_DUP
#define PROBE_DUP 0
#endif

template <class PT> __device__ __forceinline__ void load_row16(PT p, int lane, float (&x)[16]) {
    const f32x4 a = *(const GAS f32x4*)(p + 8 * lane), b = *(const GAS f32x4*)(p + 8 * lane + 4), c = *(const GAS f32x4*)(p + 512 + 8 * lane), d = *(const GAS f32x4*)(p + 512 + 8 * lane + 4);
#pragma unroll
    for (int e = 0; e < 4; ++e) { x[e] = a[e]; x[4 + e] = b[e]; x[8 + e] = c[e]; x[12 + e] = d[e]; }
}
__device__ __forceinline__ void store_row16_f32(float* p, int lane, const float (&x)[16]) {
    *(f32x4*)(p + 8 * lane) = (f32x4){x[0], x[1], x[2], x[3]}; *(f32x4*)(p + 8 * lane + 4) = (f32x4){x[4], x[5], x[6], x[7]};
    *(f32x4*)(p + 512 + 8 * lane) = (f32x4){x[8], x[9], x[10], x[11]}; *(f32x4*)(p + 512 + 8 * lane + 4) = (f32x4){x[12], x[13], x[14], x[15]};
}
template <class PT> __device__ __forceinline__ void store_row16_bf16(PT p, int lane, const float (&y)[16]) {
    u32x4 a, b; a.x = pk2(y[0], y[1]); a.y = pk2(y[2], y[3]); a.z = pk2(y[4], y[5]); a.w = pk2(y[6], y[7]);
    b.x = pk2(y[8], y[9]); b.y = pk2(y[10], y[11]); b.z = pk2(y[12], y[13]); b.w = pk2(y[14], y[15]);
    *(GAS u32x4*)(p + 8 * lane) = a; *(GAS u32x4*)(p + 512 + 8 * lane) = b;
}
template <class G1, class G2> __device__ __forceinline__ void norm_mod16(const float (&x)[16], G1 g, G2 shift, G2 scale, int lane, float (&y)[16]) {
    float ss = 0.f;
#pragma unroll
    for (int e = 0; e < 16; ++e) ss += x[e] * x[e];
    ss = wave_sum(ss);
    const float r = __builtin_amdgcn_rsqf(ss * (1.0f / 1024.0f) + 1e-6f);
    float gg[16]; load_row16(g, lane, gg);
    if (shift) { float sh[16], sc[16]; load_row16(shift, lane, sh); load_row16(scale, lane, sc);
#pragma unroll
        for (int e = 0; e < 16; ++e) y[e] = x[e] * r * gg[e] * (1.0f + sc[e]) + sh[e];
    } else {
#pragma unroll
        for (int e = 0; e < 16; ++e) y[e] = x[e] * r * gg[e];
    }
}

template <int MODE>
__device__ __forceinline__ void transpose_item(const float* W, int K, int N, bf16_t* WT, LAS float* scr, int item, int lane) {
    const int nblk = N / 32, kb = item / nblk, nb = item % nblk, k0 = 64 * kb, n0 = 32 * nb;
#pragma unroll 8
    for (int i = 0; i < 32; ++i) { const int kk = 2 * i + (lane >> 5); scr[kk * 33 + (lane & 31)] = W[(size_t)(k0 + kk) * N + n0 + (lane & 31)]; }
    asm volatile("s_waitcnt lgkmcnt(0)" ::: "memory");
    const int c = lane & 7;
#pragma unroll
    for (int j = 0; j < 4; ++j) { const int n = (lane >> 3) + 8 * j; const LAS float* s = scr + (8 * c) * 33 + n;
        u32x4 o; o.x = pk2(s[0 * 33], s[1 * 33]); o.y = pk2(s[2 * 33], s[3 * 33]); o.z = pk2(s[4 * 33], s[5 * 33]); o.w = pk2(s[6 * 33], s[7 * 33]);
        int row = n0 + n;
        if (MODE == 1) { const int ch = row & 255, gatepart = row >> 8; row = (ch >> 7) * 256 + gatepart * 128 + (ch & 127); }
        *(u32x4*)(WT + (size_t)row * K + k0 + 8 * c) = o; }
    asm volatile("s_waitcnt lgkmcnt(0)" ::: "memory");
}

__device__ __forceinline__ void p0_transposes(const PV& P, int l, int part, int nparts, LAS unsigned char* lds) {
    const int tid = otid(), lane = tid & 63, w = __builtin_amdgcn_readfirstlane(tid >> 6);
    unsigned char* ws = P.ws;
    LAS float* scr = (LAS float*)(lds + w * 8448);
    const int gw = part * 8 + w, NGW = nparts * 8;
    constexpr int I_IN = 16 * (INC / 32), I_OUT = 16 * 32, I_GL = 4 * 16, PER_L = I_IN + I_OUT + I_GL;
    for (int it = gw; it < PER_L; it += NGW) { int r = it;
        if (r < I_IN) { transpose_item<0>(PIN(I_WIN) + (size_t)l * 1024 * INC, 1024, INC, (bf16_t*)(ws + WS_WIN) + (size_t)l * ZW * 1024, scr, r, lane); continue; } r -= I_IN;
        if (r < I_OUT) { transpose_item<0>(PIN(I_WOUT) + (size_t)l * 1024 * 1024, 1024, 1024, (bf16_t*)(ws + WS_WOUT) + (size_t)l * 1024 * 1024, scr, r, lane); continue; } r -= I_OUT;
        transpose_item<1>(PIN(I_GLUW) + (size_t)l * 256 * 512, 256, 512, (bf16_t*)(ws + WS_GLU) + (size_t)l * 512 * 256, scr, r, lane); }
    for (int i = part * 512 + tid; i < 8192; i += nparts * 512) *(GAS u32x4*)((bf16_t*)(ws + WS_WIN) + ((size_t)l * ZW + INC) * 1024 + (size_t)i * 8) = (u32x4){0u, 0u, 0u, 0u};
}
__device__ __forceinline__ void p0_tables(const PV& P, int l, int part, int nparts) {
    const int tid = otid();
    const size_t n16 = (size_t)NEXP * 1024 / 16, stride = (size_t)nparts * 512;
    const GAS f32x4* su = (const GAS f32x4*)(PIN(I_PU) + (size_t)l * NEXP * 1024); const GAS f32x4* sv = (const GAS f32x4*)(PIN(I_PV) + (size_t)l * NEXP * 1024);
    GAS u32x4* du = (GAS u32x4*)(P.ws + WS_U8 + (size_t)l * NEXP * 1024); GAS u32x4* dv = (GAS u32x4*)(P.ws + WS_V8 + (size_t)l * NEXP * 1024);
    GAS float* us = (GAS float*)(P.ws + WS_US) + (size_t)l * NEXP;
#pragma unroll 2
    for (size_t i = (size_t)part * 512 + tid; i < n16; i += stride) {
        u32x4 o, q; f32x4 a[4]; float m = 0.f;
#pragma unroll
        for (int k = 0; k < 4; ++k) { a[k] = su[4 * i + k]; m = fmaxf(fmaxf(m, fmaxf(fabsf(a[k][0]), fabsf(a[k][1]))), fmaxf(fabsf(a[k][2]), fabsf(a[k][3]))); }
        m = wave_max(m);
        const float inv = m > 0.f ? 127.0f * __builtin_amdgcn_rcpf(m) : 0.f;
#pragma unroll
        for (int k = 0; k < 4; ++k) { const f32x4 c = sv[4 * i + k] * 2.0f;
            int wc = __builtin_amdgcn_cvt_pk_fp8_f32(c[0], c[1], 0, false); wc = __builtin_amdgcn_cvt_pk_fp8_f32(c[2], c[3], wc, true);
            o[k] = pack_i8x4(a[k][0] * inv, a[k][1] * inv, a[k][2] * inv, a[k][3] * inv); q[k] = (unsigned)wc; }
        const size_t e = i >> 6, j16 = i & 63, di = (((j16 >> 3) * NEXP + e) << 3) + (j16 & 7);
        __builtin_nontemporal_store(o, du + di); __builtin_nontemporal_store(q, dv + di);
        if (j16 == 0) us[e] = m * (1.0f / 127.0f);
    }
}
__device__ __forceinline__ void p0_weff(const PV& P, int l, int part, int nparts, LAS unsigned char* lds) {
    const int tid = otid(), lane = tid & 63, w = __builtin_amdgcn_readfirstlane(tid >> 6);
    for (int u = part; u < 128; u += nparts) {
        const int hp = (u >> 3) & 15, dmb = u & 7;
        LAS bf16_t* As = (LAS bf16_t*)lds; LAS bf16_t* Bs = As + 128 * 136;
        const float* kp = PIN(I_KEYS) + (size_t)(l * 16 + hp) * 128 * 128;
        const float* qp = PIN(I_WQ) + ((size_t)l * 1024 + dmb * 128) * 2048 + hp * 128;
        __syncthreads();
        for (int idx = tid; idx < 16384; idx += 512) { const int n = idx >> 7, d = idx & 127;
            As[n * 136 + d] = (bf16_t)f2bf(kp[idx]); Bs[n * 136 + d] = (bf16_t)f2bf(qp[(size_t)n * 2048 + d]); }
        __syncthreads();
        f32x4 acc[1][8]; zero_acc<1, 8>(acc);
        lds_mma<1, 8, 4>(acc, As + 16 * w * 136, 136, Bs, 136, lane);
        bf16_t* op = (bf16_t*)(P.ws + WS_WEFF) + ((size_t)l * 2048 + hp * 128 + 16 * w + (lane & 15)) * 1024 + dmb * 128 + 4 * (lane >> 4);
#pragma unroll
        for (int n = 0; n < 8; ++n) { const f32x4 v = acc[0][n]; *(unsigned long long*)(op + 16 * n) = (unsigned long long)pk2(v[0], v[1]) | ((unsigned long long)pk2(v[2], v[3]) << 32); }
    }
    __syncthreads();
}
__device__ __forceinline__ void p0_prologue(const PV& P, LAS unsigned char* lds) {
    const int tid = otid(), lane = tid & 63, w = __builtin_amdgcn_readfirstlane(tid >> 6);
    const int G = gridDim.x, bx = blockIdx.x;
    unsigned char* ws = P.ws;
    for (int u = bx; u < 192; u += G) {
        const int l = u / 96, cb = u % 96, rs = lane >> 4, cg = lane & 15;
        LAS float* sc = (LAS float*)lds;
        LAS float* red = sc + 9216;
        __syncthreads();
        for (int idx = tid; idx < 9216; idx += 512) { const int r = idx >> 10, k = idx & 1023; const float v = r < 8 ? PIN(I_C)[r * 1024 + k] : PIN(I_CCTX)[k]; sc[idx] = siluf_(v); }
        __syncthreads();
        f32x4 acc[9];
#pragma unroll
        for (int r = 0; r < 9; ++r) acc[r] = (f32x4){0.f, 0.f, 0.f, 0.f};
        const float* wp = PIN(I_ADAW) + ((size_t)l * 1024 + 128 * w + rs) * 6144 + cb * 64 + 4 * cg;
#pragma unroll 8
        for (int j = 0; j < 32; ++j) { const f32x4 wv = *(const GAS f32x4*)(wp + (size_t)(4 * j) * 6144);
#pragma unroll
            for (int r = 0; r < 9; ++r) acc[r] += sc[r * 1024 + 128 * w + 4 * j + rs] * wv; }
#pragma unroll
        for (int r = 0; r < 9; ++r) *(LAS f32x4*)(red + ((w * 4 + rs) * 9 + r) * 64 + 4 * cg) = acc[r];
        __syncthreads();
        for (int idx = tid; idx < 9 * 64; idx += 512) { const int r = idx >> 6, cc = idx & 63; float sacc = 0.f;
#pragma unroll
            for (int ww = 0; ww < 32; ++ww) sacc += red[(ww * 9 + r) * 64 + cc];
            ((float*)(ws + WS_MOD))[(size_t)(l * 9 + r) * 6144 + cb * 64 + cc] = sacc + PIN(I_ADAB)[l * 6144 + cb * 64 + cc]; }
    }
    __syncthreads();
    (void)lane; (void)w; (void)ws;
}

__device__ __forceinline__ void p0b_ain(const PV& P) {
    const int tid = otid(), lane = tid & 63, gw = blockIdx.x * 8 + __builtin_amdgcn_readfirstlane(tid >> 6), NGW = gridDim.x * 8;
    const float* mod = (const float*)(P.ws + WS_MOD);
    bf16_t* act = (bf16_t*)(P.ws + WS_ACT);
    for (int row = gw; row < TT; row += NGW) {
        const float* xp = row < TL ? PIN(I_X) + (size_t)row * 1024 : PIN(I_CTX) + (size_t)(row - TL) * 1024;
        const int mr = row < TL ? (row >> 11) : 8;
        float x[16], y[16]; load_row16(xp, lane, x);
        norm_mod16(x, PIN(I_N1G), mod + (size_t)mr * 6144, mod + (size_t)mr * 6144 + 1024, lane, y);
        store_row16_bf16(act + (size_t)row * 1024, lane, y);
    }
}

__device__ __forceinline__ int rwkv_col(int gc, int h, int dir) {
    const int seg = gc >> 6;
    if (seg == 0) return h * 64 + gc;
    if (seg == 1) return 256 + h * 64 + (gc - 64);
    if (seg == 2) return 512 + h * 64 + (gc - 128);
    const int o = gc - 192; return o < 32 ? 832 + dir * 32 + o : 896 + dir * 32 + (o - 32);
}

constexpr int R_AT = 0, R_RT = 4608, R_BT = 9216, R_TL = 14336, R_MRB = 16896, R_G = 19456, R_YV = 23552, R_HV = 27648, R_GAM = 35840, REC_BYTES = 36096;

__device__ __forceinline__ void rwkv_pre(const PV& P, int l, LAS unsigned char* lds) {
    const int tid = otid(), lane = tid & 63, w = __builtin_amdgcn_readfirstlane(tid >> 6);
    LAS bf16_t* WUt = (LAS bf16_t*)lds;
    LAS bf16_t* AUt = WUt + 2560;
    LAS float* s_mu = (LAS float*)(AUt + 2560);
    LAS float* s_par = s_mu + 512;
    LAS bf16_t* raw = (LAS bf16_t*)(s_par + 256);
    LAS float* f_r = (LAS float*)(raw + 34 * 256);
    LAS float* f_k = f_r + 2048;
    LAS float* f_v = f_k + 2048;
    LAS bf16_t* WLb = (LAS bf16_t*)(f_v + 2048);
    LAS bf16_t* ALb = WLb + 1280;
    LAS float* lor = (LAS float*)raw;
    LAS bf16_t* Bn = ALb + 1280;
    LAS bf16_t* Kn = Bn + 2304;
    LAS bf16_t* Ktt = Kn + 2304;
    LAS bf16_t* Vt = Ktt + 2560;
    LAS float* Mabf = (LAS float*)(Vt + 2560);
    LAS bf16_t* Makb = (LAS bf16_t*)(Mabf + 1152);
    LAS bf16_t* Mrkb = Makb + 1280;
    LAS float* Ltot = (LAS float*)(Mrkb + 1280);
    LAS bf16_t* iA1 = (LAS bf16_t*)(Ltot + 512);
    LAS bf16_t* iB1 = iA1 + 640;
    LAS bf16_t* iA2 = iB1 + 640;
    LAS bf16_t* iWt = iA2 + 640;
    LAS unsigned char* rec = (LAS unsigned char*)(iWt + 640);
    LAS bf16_t* At = (LAS bf16_t*)(rec + R_AT); LAS bf16_t* Rt = (LAS bf16_t*)(rec + R_RT); LAS bf16_t* Btt = (LAS bf16_t*)(rec + R_BT);
    const GAS bf16_t* z = (const GAS bf16_t*)(P.ws + WS_Z);
    GAS unsigned char* recg = (GAS unsigned char*)(P.ws + WS_REC);
    for (int idx = tid; idx < 4 * 640 / 2; idx += 512) ((LAS unsigned*)iA1)[idx] = 0u;
    for (int idx = tid; idx < 2 * 1280 / 2; idx += 512) ((LAS unsigned*)WLb)[idx] = 0u;
    for (int idx = tid; idx < 2 * 2560 / 2; idx += 512) ((LAS unsigned*)WUt)[idx] = 0u;
    for (int idx = tid; idx < 1280 / 2; idx += 512) ((LAS unsigned*)(rec + R_TL))[idx] = 0u;
    int cur_hd = -1;
    u32x4 pre[3];
    auto geo = [&](int u, int& hd, int& b, int& c, int& tlo, int& seqlen, size_t& rb) { hd = u & 7; const int rest = u >> 3; b = rest / 72; c = rest % 72; const int dir = hd & 1;
        const bool isctx = c < 8; const int cc = isctx ? c : c - 8; seqlen = isctx ? CTX : SEQ; tlo = dir ? seqlen - 32 - 32 * cc : 32 * cc; rb = isctx ? (size_t)TL + b * CTX : (size_t)b * SEQ; };
    int pcol = 0, pcol_hd = -1;
    auto issue = [&](int u, int tid) { int hd, b, c, tlo, seqlen; size_t rb; geo(u, hd, b, c, tlo, seqlen, rb);
        if (hd != pcol_hd) { pcol_hd = hd; pcol = rwkv_col((tid & 31) * 8, hd >> 1, hd & 1); }
#pragma unroll
        for (int k = 0; k < 3; ++k) { const int v = tid + 512 * k; pre[k] = (u32x4){0u, 0u, 0u, 0u};
            if (v < 1088) { const int t = tlo - 1 + (v >> 5); if (t >= 0 && t < seqlen) pre[k] = *(const GAS u32x4*)(z + (rb + t) * ZW + pcol); } } };
    if ((int)blockIdx.x < 4608) issue(blockIdx.x, tid);
    for (int u = blockIdx.x; u < 4608; u += gridDim.x) {
        const int tid = otid(), lane = tid & 63, w = __builtin_amdgcn_readfirstlane(tid >> 6);
        int hd, b, c, tlo, seqlen; size_t rb; geo(u, hd, b, c, tlo, seqlen, rb); const int h = hd >> 1, dir = hd & 1;
        if (hd != cur_hd) { LDS_BARRIER(); cur_hd = hd;
            for (int idx = tid; idx < 2048; idx += 512) { const int m = idx >> 6, j = idx & 63; const size_t o = ((size_t)(l * 2 + dir) * 32 + m) * 256 + h * 64 + j;
                WUt[j * 40 + m] = (bf16_t)f2bf(PIN(I_WUP)[o]); AUt[j * 40 + m] = (bf16_t)f2bf(PIN(I_AUP)[o]); }
            { const int which = tid >> 8, gc = tid & 255; s_mu[tid] = PIN(I_MU)[(size_t)(l * 2 + which) * 960 + rwkv_col(gc, h, dir)]; }
            if (tid < 256) { const int k = tid >> 6, j = tid & 63; float v;
                if (k == 0) v = PIN(I_W0)[(l * 2 + dir) * 256 + h * 64 + j]; else if (k == 1) v = PIN(I_A0)[(l * 2 + dir) * 256 + h * 64 + j];
                else if (k == 2) v = PIN(I_KK)[l * 256 + h * 64 + j]; else v = PIN(I_KA)[l * 256 + h * 64 + j];
                s_par[tid] = v; } }
#pragma unroll
        for (int k = 0; k < 3; ++k) { const int v = tid + 512 * k; if (v < 1088) *(LAS u32x4*)(raw + (size_t)v * 8) = pre[k]; }
        LDS_BARRIER();
        if (u + (int)gridDim.x < 4608) issue(u + gridDim.x, tid);
        { const int gc = tid & 255, th = tid >> 8; const float mu0 = s_mu[gc], mu1 = s_mu[256 + gc];
            const int r0 = th * 16 + 1;
            float zm = bf2f(raw[(r0 - 1) * 256 + gc]), z0 = bf2f(raw[r0 * 256 + gc]);
            if (gc < 192) { LAS float* dst = gc < 64 ? f_r + gc : (gc < 128 ? f_k + (gc - 64) : f_v + (gc - 128));
#pragma unroll 4
                for (int ii = 0; ii < 16; ++ii) { const int rr = r0 + ii, i = dir ? 32 - rr : rr - 1;
                    const float zp = bf2f(raw[(rr + 1) * 256 + gc]);
                    dst[i * 64] = z0 + mu0 * (zm - z0) + mu1 * (zp - z0);
                    zm = z0; z0 = zp; }
            } else { const bool isw = gc < 224; LAS bf16_t* dstb = isw ? WLb + (gc - 192) : ALb + (gc - 224);
#pragma unroll 4
                for (int ii = 0; ii < 16; ++ii) { const int rr = r0 + ii, i = dir ? 32 - rr : rr - 1;
                    const float zp = bf2f(raw[(rr + 1) * 256 + gc]);
                    const float val = z0 + mu0 * (zm - z0) + mu1 * (zp - z0);
                    dstb[i * 40] = (bf16_t)f2bf(isw ? tanhf_(val) : val);
                    zm = z0; z0 = zp; } } }
        LDS_BARRIER();
        { const int which = w >> 2, mt = (w >> 1) & 1, np = (w & 1) * 2; f32x4 acc[1][2]; zero_acc<1, 2>(acc);
            lds_mma<1, 2, 1>(acc, (which ? ALb : WLb) + 16 * mt * 40, 40, (which ? AUt : WUt) + 16 * np * 40, 40, lane);
#pragma unroll
            for (int n = 0; n < 2; ++n) *(LAS f32x4*)(lor + which * 2176 + (16 * mt + (lane & 15)) * 68 + 16 * (np + n) + 4 * (lane >> 4)) = acc[0][n]; }
        { const int row = tid & 63, ig = tid >> 6;
#pragma unroll
            for (int e = 0; e < 4; ++e) Vt[row * 40 + 4 * ig + e] = (bf16_t)f2bf(f_v[(4 * ig + e) * 64 + row]); }
        LDS_BARRIER();
        float Lloc[4], lwv[4], agv[4], kkv[4], kdv[4]; float Lrun = 0.f;
#pragma unroll
        for (int ii = 0; ii < 4; ++ii) { const int i = 4 * w + ii, j = lane;
            const float wv = s_par[j] + lor[i * 68 + j], av = s_par[64 + j] + lor[2176 + i * 68 + j];
            const float wlog = -softplusf_(-wv) - 0.5f, lw = -__expf(wlog);
            Lrun += lw; Lloc[ii] = Lrun; lwv[ii] = lw; agv[ii] = sigmoidf_(av);
            const float kx = f_k[i * 64 + j], kkj = kx * s_par[128 + j];
            const float ss = wave_sum(kkj * kkj); kkv[ii] = kkj * __builtin_amdgcn_rsqf(fmaxf(ss, 1e-24f));
            kdv[ii] = kx * (1.0f + (agv[ii] - 1.0f) * s_par[192 + j]); }
        Ltot[w * 64 + lane] = Lrun;
        LDS_BARRIER();
        { float off = 0.f;
#pragma unroll
            for (int ww = 0; ww < 7; ++ww) if (ww < w) off += Ltot[ww * 64 + lane];
            float bq[4], kq[4];
#pragma unroll
            for (int ii = 0; ii < 4; ++ii) { const int i = 4 * w + ii, j = lane; const float L = off + Lloc[ii], eP = __expf(L - lwv[ii]), eL = __expf(L), eN = __expf(-L);
                bq[ii] = kkv[ii] * agv[ii] * eN; kq[ii] = kdv[ii] * eN;
                const unsigned ar = pk2a(-kkv[ii] * eP, f_r[i * 64 + j] * eL), bk = pk2a(bq[ii], kq[ii]);
                At[i * 72 + j] = (bf16_t)(ar & 0xffffu); Rt[i * 72 + j] = (bf16_t)(ar >> 16);
                Bn[i * 72 + j] = (bf16_t)(bk & 0xffffu); Kn[i * 72 + j] = (bf16_t)(bk >> 16);
                if (i == 31) ((LAS float*)(rec + R_GAM))[j] = eL; }
            *(LAS unsigned long long*)(Btt + lane * 40 + 4 * w) = (unsigned long long)pk2a(bq[0], bq[1]) | ((unsigned long long)pk2a(bq[2], bq[3]) << 32);
            *(LAS unsigned long long*)(Ktt + lane * 40 + 4 * w) = (unsigned long long)pk2a(kq[0], kq[1]) | ((unsigned long long)pk2a(kq[2], kq[3]) << 32); }
        LDS_BARRIER();
        { const int mat = w >> 1, mt = w & 1; f32x4 acc[1][2]; zero_acc<1, 2>(acc);
            lds_mma<1, 2, 2>(acc, (mat < 2 ? At : Rt) + 16 * mt * 72, 72, (mat & 1) ? Kn : Bn, 72, lane);
            const int t = 16 * mt + (lane & 15);
#pragma unroll
            for (int n = 0; n < 2; ++n) { f32x4 o;
#pragma unroll
                for (int e = 0; e < 4; ++e) { const int j = 16 * n + 4 * (lane >> 4) + e; const bool keep = mat < 2 ? j < t : j <= t; o[e] = keep ? acc[0][n][e] : 0.f; }
                if (mat == 0) { *(LAS f32x4*)(Mabf + t * 36 + 16 * n + 4 * (lane >> 4)) = o;
                    if (mt == 1 && n == 0) *(LAS unsigned long long*)(iA1 + (lane & 15) * 40 + 4 * (lane >> 4)) = (unsigned long long)pk2(o[0], o[1]) | ((unsigned long long)pk2(o[2], o[3]) << 32);
                } else { LAS bf16_t* dst = mat == 1 ? Makb : (mat == 2 ? (LAS bf16_t*)(rec + R_MRB) : Mrkb);
                    *(LAS unsigned long long*)(dst + t * 40 + 16 * n + 4 * (lane >> 4)) = (unsigned long long)pk2(o[0], o[1]) | ((unsigned long long)pk2(o[2], o[3]) << 32); } } }
        if (w < 2) {
            asm volatile("s_waitcnt lgkmcnt(0)" ::: "memory");
            const int cidx = lane & 15, o16 = 16 * w; float T[16];
            int vz = 0; asm volatile("" : "+v"(vz)); const LAS float* mb = Mabf + vz + o16 * 36 + o16;
#pragma unroll
            for (int t = 0; t < 16; ++t) { float row = cidx == t ? 1.0f : 0.f;
                float mrow[16];
#pragma unroll
                for (int q = 0; q < 4; ++q) if (4 * q < t) { const f32x4 mv = *(const LAS f32x4*)(mb + t * 36 + 4 * q); mrow[4 * q] = mv[0]; mrow[4 * q + 1] = mv[1]; mrow[4 * q + 2] = mv[2]; mrow[4 * q + 3] = mv[3]; }
#pragma unroll
                for (int j = 0; j < t; ++j) row += mrow[j] * T[j];
                T[t] = row; }
            if (lane < 16) {
                LAS bf16_t* tl = (LAS bf16_t*)(rec + R_TL);
#pragma unroll
                for (int t = 0; t < 16; t += 2) { const unsigned tp = pk2a(T[t], T[t + 1]); const bf16_t lo = (bf16_t)(tp & 0xffffu), hi = (bf16_t)(tp >> 16);
                    tl[(o16 + t) * 40 + o16 + cidx] = lo; tl[(o16 + t + 1) * 40 + o16 + cidx] = hi;
                    if (w == 0) { iB1[cidx * 40 + t] = lo; iB1[cidx * 40 + t + 1] = hi; }
                    else { iA2[t * 40 + cidx] = lo; iA2[(t + 1) * 40 + cidx] = hi; } }
            }
        } else {
            for (int tt = 16 + (w - 2); tt < 32; tt += 6) { f32x4 acc[1][1]; zero_acc<1, 1>(acc);
                const int m = (tt - 16) >> 2, n = (tt - 16) & 3;
                lds_mma<1, 1, 1>(acc, Vt + 16 * m * 40, 40, Ktt + 16 * n * 40, 40, lane);
                const f32x4 v = acc[0][0];
                *(LAS unsigned long long*)((LAS bf16_t*)(rec + R_HV) + (16 * m + (lane & 15)) * 64 + 16 * n + 4 * (lane >> 4)) = (unsigned long long)pk2(v[0], v[1]) | ((unsigned long long)pk2(v[2], v[3]) << 32); } }
        LDS_BARRIER();
        if (w == 0) {
            f32x4 acc[1][1]; zero_acc<1, 1>(acc);
            lds_mma<1, 1, 1>(acc, iA1, 40, iB1, 40, lane);
#pragma unroll
            for (int e = 0; e < 4; ++e) iWt[(4 * (lane >> 4) + e) * 40 + (lane & 15)] = (bf16_t)f2bf(acc[0][0][e]);
            asm volatile("s_waitcnt lgkmcnt(0)" ::: "memory");
            zero_acc<1, 1>(acc);
            lds_mma<1, 1, 1>(acc, iA2, 40, iWt, 40, lane);
            const f32x4 v = acc[0][0];
            *(LAS unsigned long long*)((LAS bf16_t*)(rec + R_TL) + (16 + (lane & 15)) * 40 + 4 * (lane >> 4)) = (unsigned long long)pk2(v[0], v[1]) | ((unsigned long long)pk2(v[2], v[3]) << 32);
        } else {
            for (int tt = w - 1; tt < 16; tt += 7) { f32x4 acc[1][1]; zero_acc<1, 1>(acc);
                const int m = (tt & 7) >> 1, n = tt & 1; const bool isg = tt < 8;
                lds_mma<1, 1, 1>(acc, Vt + 16 * m * 40, 40, (isg ? Makb : Mrkb) + 16 * n * 40, 40, lane);
                const f32x4 v = acc[0][0];
                *(LAS unsigned long long*)((LAS bf16_t*)(rec + (isg ? R_G : R_YV)) + (16 * m + (lane & 15)) * 32 + 16 * n + 4 * (lane >> 4)) = (unsigned long long)pk2(v[0], v[1]) | ((unsigned long long)pk2(v[2], v[3]) << 32); } }
        LDS_BARRIER();
        { GAS u32x4* dst = (GAS u32x4*)(recg + ((size_t)(b * 8 + hd) * 72 + c) * REC_BYTES);
            for (int p = tid; p < REC_BYTES / 16; p += 512) __builtin_nontemporal_store(*(const LAS u32x4*)(rec + (size_t)p * 16), dst + p); }
    }
    __syncthreads();
}

__device__ __forceinline__ void rwkv_seq(const PV& P, int l, int unit, LAS unsigned char* lds) {
    const int tid = otid(), lane = tid & 63, w = __builtin_amdgcn_readfirstlane(tid >> 6), fr = lane & 15, fq = lane >> 4;
    const int dir = unit & 1, h = (unit >> 1) & 3, b = unit >> 3;
    LAS unsigned char* recb = lds;
    LAS bf16_t* S0b = (LAS bf16_t*)(lds + 3 * REC_BYTES);
    LAS bf16_t* Xb = S0b + 4608;
    LAS bf16_t* SAb = Xb + 2560;
    LAS float* Ys = (LAS float*)(SAb + 2560);
    GAS bf16_t* yout = (GAS bf16_t*)(P.ws + WS_Y) + (size_t)(0 * 2 + dir) * YSZ;
    const GAS u32x4* recg = (const GAS u32x4*)(P.ws + WS_REC + (size_t)unit * 72 * REC_BYTES);
    for (int idx = tid; idx < 4608 / 2; idx += 512) ((LAS unsigned*)S0b)[idx] = 0u;
    f32x4 Sacc[1][2]; zero_acc<1, 2>(Sacc);
    const int ms = w >> 1, nbs = (w & 1) * 2;
    const int m1 = w & 3;
    static_assert(REC_BYTES / 16 == 2256, "record = 4 full 512-thread passes + 208 pieces");
    const GAS u32x4* rp = recg + tid;
    auto dma16 = [&](const GAS u32x4* g, LAS unsigned char* l) { asm volatile("s_mov_b32 m0, %0\n\ts_nop 0\n\tglobal_load_lds_dwordx4 %1, off" :: "s"((unsigned)(unsigned long)l), "v"(g) : "memory", "m0"); };
    auto issue = [&](int c, int buf) { const GAS u32x4* q = rp + (size_t)c * 2256; LAS unsigned char* dst = recb + buf * REC_BYTES + w * 1024;
#pragma unroll
        for (int k = 0; k < 4; ++k) dma16(q + 512 * k, dst + 8192 * k);
        if (tid < 208) dma16(q + 2048, dst + 32768); };
    issue(0, 0); issue(1, 1);
    int cb = 0;
    for (int c = 0; c < 72; ++c) {
        LAS unsigned char* rec = recb + cb * REC_BYTES;
        if (c == 71) asm volatile("s_waitcnt vmcnt(0)" ::: "memory");
        else if (w < 4) asm volatile("s_waitcnt vmcnt(5)" ::: "memory");
        else asm volatile("s_waitcnt vmcnt(4)" ::: "memory");
        LDS_BARRIER();
        const int nb = cb == 0 ? 2 : cb - 1;
        cb = cb == 2 ? 0 : cb + 1;
        if (c > 0) {
            const int cp = c - 1; const bool isctx = cp < 8; const int cc = isctx ? cp : cp - 8, seqlen = isctx ? CTX : SEQ;
            const int tlo = dir ? seqlen - 32 - 32 * cc : 32 * cc; const size_t rb = isctx ? (size_t)TL + b * CTX : (size_t)b * SEQ;
            const int i = tid >> 4, rg = tid & 15, t = dir ? tlo + 31 - i : tlo + i;
            const f32x4 v = *(const LAS f32x4*)(Ys + i * 64 + 4 * rg);
            *(GAS unsigned long long*)(yout + (rb + t) * 256 + h * 64 + 4 * rg) = (unsigned long long)pk2(v[0], v[1]) | ((unsigned long long)pk2(v[2], v[3]) << 32); }
        if (c + 2 < 72) issue(c + 2, nb);
        f32x4 aPQ[1][2]; zero_acc<1, 2>(aPQ);
        lds_mma<1, 2, 2>(aPQ, S0b + 16 * m1 * 72, 72, (const LAS bf16_t*)(rec + (w < 4 ? R_AT : R_RT)), 72, lane);
        if (w < 4) {
#pragma unroll
            for (int n = 0; n < 2; ++n) { const u32x2 gw = *(const LAS u32x2*)(rec + R_G + ((16 * m1 + fr) * 32 + 16 * n + 4 * fq) * 2);
                const float x0 = aPQ[0][n][0] + bflo(gw.x), x1 = aPQ[0][n][1] + bfhi(gw.x), x2 = aPQ[0][n][2] + bflo(gw.y), x3 = aPQ[0][n][3] + bfhi(gw.y);
                *(LAS unsigned long long*)(Xb + (16 * m1 + fr) * 40 + 16 * n + 4 * fq) = (unsigned long long)pk2(x0, x1) | ((unsigned long long)pk2(x2, x3) << 32); }
            asm volatile("s_waitcnt lgkmcnt(0)" ::: "memory");
            f32x4 aSA[1][2]; zero_acc<1, 2>(aSA);
            lds_mma<1, 2, 1>(aSA, Xb + 16 * m1 * 40, 40, (const LAS bf16_t*)(rec + R_TL), 40, lane);
#pragma unroll
            for (int n = 0; n < 2; ++n) { const f32x4 v = aSA[0][n];
                *(LAS unsigned long long*)(SAb + (16 * m1 + fr) * 40 + 16 * n + 4 * fq) = (unsigned long long)pk2(v[0], v[1]) | ((unsigned long long)pk2(v[2], v[3]) << 32); } }
        LDS_BARRIER();
        if (w >= 4) { lds_mma<1, 2, 1>(aPQ, SAb + 16 * m1 * 40, 40, (const LAS bf16_t*)(rec + R_MRB), 40, lane);
#pragma unroll
            for (int n = 0; n < 2; ++n) { const u32x2 yw = *(const LAS u32x2*)(rec + R_YV + ((16 * m1 + fr) * 32 + 16 * n + 4 * fq) * 2);
                const int t0 = 16 * n + 4 * fq, row = 16 * m1 + fr;
                Ys[(t0 + 0) * 64 + row] = aPQ[0][n][0] + bflo(yw.x); Ys[(t0 + 1) * 64 + row] = aPQ[0][n][1] + bfhi(yw.x);
                Ys[(t0 + 2) * 64 + row] = aPQ[0][n][2] + bflo(yw.y); Ys[(t0 + 3) * 64 + row] = aPQ[0][n][3] + bfhi(yw.y); } }
        { f32x4 aS[1][2]; zero_acc<1, 2>(aS);
            lds_mma<1, 2, 1>(aS, SAb + 16 * ms * 40, 40, (const LAS bf16_t*)(rec + R_BT) + 16 * nbs * 40, 40, lane);
#pragma unroll
            for (int n = 0; n < 2; ++n) { const int k0 = 16 * (nbs + n) + 4 * fq, row = 16 * ms + fr;
                const u32x2 hw = *(const LAS u32x2*)(rec + R_HV + (row * 64 + k0) * 2); const f32x4 gm = *(const LAS f32x4*)(rec + R_GAM + k0 * 4);
                f32x4 sn; sn[0] = gm[0] * (Sacc[0][n][0] + aS[0][n][0] + bflo(hw.x)); sn[1] = gm[1] * (Sacc[0][n][1] + aS[0][n][1] + bfhi(hw.x));
                sn[2] = gm[2] * (Sacc[0][n][2] + aS[0][n][2] + bflo(hw.y)); sn[3] = gm[3] * (Sacc[0][n][3] + aS[0][n][3] + bfhi(hw.y));
                Sacc[0][n] = sn;
                *(LAS unsigned long long*)(S0b + row * 72 + k0) = (unsigned long long)pk2(sn[0], sn[1]) | ((unsigned long long)pk2(sn[2], sn[3]) << 32); } }
    }
    LDS_BARRIER();
    { const int cp = 71; const int seqlen = SEQ, cc = cp - 8; const int tlo = dir ? seqlen - 32 - 32 * cc : 32 * cc; const size_t rb = (size_t)b * SEQ;
        const int i = tid >> 4, rg = tid & 15, t = dir ? tlo + 31 - i : tlo + i;
        const f32x4 v = *(const LAS f32x4*)(Ys + i * 64 + 4 * rg);
        *(GAS unsigned long long*)(yout + (rb + t) * 256 + h * 64 + 4 * rg) = (unsigned long long)pk2(v[0], v[1]) | ((unsigned long long)pk2(v[2], v[3]) << 32); }
    __syncthreads();
}

__device__ __forceinline__ void ret_unit(const PV& P, int l, int unit, LAS unsigned char* lds) {
    const int tid = otid(), lane = tid & 63, w = __builtin_amdgcn_readfirstlane(tid >> 6);
    const int dir = unit & 1, h = (unit >> 1) & 3, b = unit >> 3;
    LAS bf16_t* Qs = (LAS bf16_t*)lds; LAS bf16_t* Ks = Qs + 4608; LAS bf16_t* Kt = Ks + 4608; LAS bf16_t* Vt = Kt + 4608; LAS bf16_t* Att = Vt + 4608; LAS bf16_t* St = Att + 4608;
    const GAS bf16_t* z = (const GAS bf16_t*)(P.ws + WS_Z);
    GAS bf16_t* yout = (GAS bf16_t*)(P.ws + WS_Y) + (size_t)(1 * 2 + dir) * YSZ;
    const float lg = __logf(1.0f - exp2f(-((dir ? 5.5f : 5.0f) + (float)h)));
    for (int idx = tid; idx < 4608; idx += 512) St[idx] = 0;
    f32x4 Sacc[1][2]; zero_acc<1, 2>(Sacc);
    const int m = w >> 1, nb = (w & 1) * 2, fr = lane & 15, fq = lane >> 4;
    const float cdec = __expf(lg * 64.0f);
    u32x4 pre[3];
    auto tok = [&](int c, int i, size_t& rb, int& pos) -> int {
        const bool isctx = c < 4; const int cc = isctx ? c : c - 4, seqlen = isctx ? CTX : SEQ;
        const int tlo = dir ? seqlen - 64 - 64 * cc : 64 * cc; rb = isctx ? (size_t)TL + b * CTX : (size_t)b * SEQ;
        const int t = dir ? tlo + 63 - i : tlo + i; pos = (isctx ? 0 : CTX) + t; return t;
    };
    auto issue_loads = [&](int c) { const int i = tid >> 3, vc = tid & 7; size_t rb; int pos; const int t = tok(c, i, rb, pos);
#pragma unroll
        for (int k = 0; k < 3; ++k) pre[k] = *(const GAS u32x4*)(z + (rb + t) * ZW + CB_ + k * 256 + h * 64 + vc * 8); };
    issue_loads(0);
    for (int c = 0; c < 36; ++c) {
        LDS_BARRIER();
        { const int i = tid >> 3, vc = tid & 7;
            *(LAS u32x4*)(Qs + i * 72 + vc * 8) = pre[0]; *(LAS u32x4*)(Ks + i * 72 + vc * 8) = pre[1];
            const unsigned vw[4] = {pre[2].x, pre[2].y, pre[2].z, pre[2].w};
#pragma unroll
            for (int e = 0; e < 4; ++e) { Vt[(vc * 8 + 2 * e) * 72 + i] = (bf16_t)(vw[e] & 0xffffu); Vt[(vc * 8 + 2 * e + 1) * 72 + i] = (bf16_t)(vw[e] >> 16); } }
        LDS_BARRIER();
        if (c + 1 < 36) issue_loads(c + 1);
#pragma unroll
        for (int k = 0; k < 4; ++k) { const int idx = tid + 512 * k, i = idx >> 5, d = idx & 31; size_t rb; int pos; tok(c, i, rb, pos);
            float rev = (float)pos * (exp2f(-(float)d * (13.287712379549449f / 32.0f)) * 0.15915494309189535f); rev -= floorf(rev);
            const float sn = __builtin_amdgcn_sinf(rev), cs = __builtin_amdgcn_cosf(rev);
            const float q1 = bf2f(Qs[i * 72 + d]), q2 = bf2f(Qs[i * 72 + d + 32]), k1 = bf2f(Ks[i * 72 + d]), k2 = bf2f(Ks[i * 72 + d + 32]);
            Qs[i * 72 + d] = (bf16_t)f2bf((q1 * cs - q2 * sn) * 0.125f); Qs[i * 72 + d + 32] = (bf16_t)f2bf((q1 * sn + q2 * cs) * 0.125f);
            const float o1 = k1 * cs - k2 * sn, o2 = k1 * sn + k2 * cs, wd = __expf(lg * (float)(63 - i));
            Ks[i * 72 + d] = (bf16_t)f2bf(o1); Ks[i * 72 + d + 32] = (bf16_t)f2bf(o2);
            Kt[d * 72 + i] = (bf16_t)f2bf(o1 * wd); Kt[(d + 32) * 72 + i] = (bf16_t)f2bf(o2 * wd); }
        LDS_BARRIER();
        f32x4 aS[1][2], aO2[1][2]; zero_acc<1, 2>(aS); zero_acc<1, 2>(aO2);
        lds_mma<1, 2, 2>(aS, Qs + 16 * m * 72, 72, Ks + 16 * nb * 72, 72, lane);
        lds_mma<1, 2, 2>(aO2, Qs + 16 * m * 72, 72, St + 16 * nb * 72, 72, lane);
        const int i = 16 * m + fr;
#pragma unroll
        for (int n = 0; n < 2; ++n) { float o[4];
#pragma unroll
            for (int e = 0; e < 4; ++e) { const int j = 16 * (nb + n) + 4 * fq + e, diff = i - j; const bool keep = dir ? diff > 0 : diff >= 0;
                o[e] = keep ? aS[0][n][e] * __expf(lg * (float)diff) : 0.f; }
            *(LAS unsigned long long*)(Att + i * 72 + 16 * (nb + n) + 4 * fq) = (unsigned long long)pk2(o[0], o[1]) | ((unsigned long long)pk2(o[2], o[3]) << 32); }
        LDS_BARRIER();
        f32x4 aO1[1][2], aT[1][2]; zero_acc<1, 2>(aO1); zero_acc<1, 2>(aT);
        lds_mma<1, 2, 2>(aO1, Att + 16 * m * 72, 72, Vt + 16 * nb * 72, 72, lane);
        lds_mma<1, 2, 2>(aT, Vt + 16 * m * 72, 72, Kt + 16 * nb * 72, 72, lane);
        { size_t rb; int pos; const int t = tok(c, i, rb, pos); const float rd = __expf(lg * (float)(i + 1));
#pragma unroll
            for (int n = 0; n < 2; ++n) { const f32x4 o = aO1[0][n] + rd * aO2[0][n];
                *(GAS unsigned long long*)(yout + (rb + t) * 256 + h * 64 + 16 * (nb + n) + 4 * fq) = (unsigned long long)pk2(o[0], o[1]) | ((unsigned long long)pk2(o[2], o[3]) << 32); } }
#pragma unroll
        for (int n = 0; n < 2; ++n) { Sacc[0][n] = cdec * Sacc[0][n] + aT[0][n]; const f32x4 s = Sacc[0][n];
            *(LAS unsigned long long*)(St + i * 72 + 16 * (nb + n) + 4 * fq) = (unsigned long long)pk2(s[0], s[1]) | ((unsigned long long)pk2(s[2], s[3]) << 32); }
    }
    __syncthreads();
}

__device__ __forceinline__ void lru_items(const PV& P, int l, LAS unsigned char* lds) {
    const int tid0 = otid();
    LAS bf16_t* waT = (LAS bf16_t*)lds; LAS bf16_t* wxT = waT + 4608; LAS bf16_t* xcb = wxT + 4608;
    LAS float* xraw = (LAS float*)(lds + 27648);
    LAS float* xcf = xraw + 67 * 64;
    LAS float* a_s = xcf + 4352; LAS float* b_s = a_s + 4352;
    LAS float* segA = b_s + 4352; LAS float* segH = segA + 512; LAS float* par = segH + 512;
    const GAS bf16_t* z = (const GAS bf16_t*)(P.ws + WS_Z);
    int cur_key = -1;
    u32x4 pre[2];
    auto geo = [&](int u, int& key, int& b, int& c, int& tlo, int& seqlen, size_t& rb) { key = u & 7; const int rest = u >> 3; b = rest / 36; c = rest % 36; const int dir = key >> 2;
        const bool isctx = c < 4; const int cc = isctx ? c : c - 4; seqlen = isctx ? CTX : SEQ; tlo = dir ? seqlen - 64 - 64 * cc : 64 * cc; rb = isctx ? (size_t)TL + b * CTX : (size_t)b * SEQ; };
    auto issue = [&](int u, int tid) { int key, b, c, tlo, seqlen; size_t rb; geo(u, key, b, c, tlo, seqlen, rb);
#pragma unroll
        for (int k = 0; k < 2; ++k) { const int v = tid + 512 * k; pre[k] = (u32x4){0u, 0u, 0u, 0u};
            if (v < 536) { const int rr = v >> 3, vc = v & 7, t = tlo - 2 + rr; if (t >= 0 && t < seqlen) pre[k] = *(const GAS u32x4*)(z + (rb + t) * ZW + CC_ + (key & 3) * 64 + vc * 8); } } };
    if ((int)blockIdx.x < 2304) issue(blockIdx.x, tid0);
    for (int u = blockIdx.x; u < 2304; u += gridDim.x) {
        const int tid = otid(), lane = tid & 63, w = __builtin_amdgcn_readfirstlane(tid >> 6);
        int key, b, c, tlo, seqlen; size_t rb; geo(u, key, b, c, tlo, seqlen, rb); const int dir = key >> 2, blk = key & 3;
        GAS bf16_t* hout = (GAS bf16_t*)(P.ws + WS_Y) + (size_t)(2 * 2 + dir) * YSZ; GAS bf16_t* aout = (GAS bf16_t*)(P.ws + WS_ACU) + (size_t)dir * YSZ;
        LDS_BARRIER();
        if (key != cur_key) { cur_key = key;
            for (int idx = tid; idx < 4096; idx += 512) { const int i = idx >> 6, j = idx & 63; const size_t o = ((size_t)((l * 2 + dir) * 4 + blk) * 64 + i) * 64 + j;
                waT[j * 72 + i] = (bf16_t)f2bf(PIN(I_WA)[o]); wxT[j * 72 + i] = (bf16_t)f2bf(PIN(I_WX)[o]); }
            { const int k = tid >> 6, cc = tid & 63, ch = blk * 64 + cc; float v;
                if (k < 4) v = PIN(I_CVW)[(l * 4 + k) * 256 + ch]; else if (k == 4) v = PIN(I_CVB)[l * 256 + ch];
                else if (k == 5) v = PIN(I_BA)[(l * 2 + dir) * 256 + ch]; else if (k == 6) v = PIN(I_BX)[(l * 2 + dir) * 256 + ch];
                else v = softplusf_(-PIN(I_LAM)[(l * 2 + dir) * 256 + ch]);
                par[tid] = v; } }
#pragma unroll
        for (int k = 0; k < 2; ++k) { const int v = tid + 512 * k; if (v < 536) { const unsigned ww[4] = {pre[k].x, pre[k].y, pre[k].z, pre[k].w};
#pragma unroll
                for (int e = 0; e < 4; ++e) { xraw[v * 8 + 2 * e] = bflo(ww[e]); xraw[v * 8 + 2 * e + 1] = bfhi(ww[e]); } } }
        LDS_BARRIER();
        if (u + (int)gridDim.x < 2304) issue(u + gridDim.x, tid);
        { const int ch = tid & 63, tg = w;
            const float cw0 = par[ch], cw1 = par[64 + ch], cw2 = par[128 + ch], cw3 = par[192 + ch], cbb = par[256 + ch];
            float xr[11];
#pragma unroll
            for (int e = 0; e < 11; ++e) xr[e] = xraw[(tg * 8 + e) * 64 + ch];
#pragma unroll
            for (int e = 0; e < 8; e += 2) { const int tt = tg * 8 + e;
                const float xa = cbb + cw0 * xr[e] + cw1 * xr[e + 1] + cw2 * xr[e + 2] + cw3 * xr[e + 3], xb2 = cbb + cw0 * xr[e + 1] + cw1 * xr[e + 2] + cw2 * xr[e + 3] + cw3 * xr[e + 4];
                const int i = dir ? 63 - tt : tt, i2 = dir ? i - 1 : i + 1; const unsigned pk = pk2a(xa, xb2);
                xcf[i * 68 + ch] = xa; xcf[i2 * 68 + ch] = xb2; xcb[i * 72 + ch] = (bf16_t)(pk & 0xffffu); xcb[i2 * 72 + ch] = (bf16_t)(pk >> 16); } }
        LDS_BARRIER();
        { const int m = w >> 1, nb = (w & 1) * 2, fr = lane & 15, fq = lane >> 4;
            f32x4 aR[1][2], aI[1][2]; zero_acc<1, 2>(aR); zero_acc<1, 2>(aI);
            lds_mma<1, 2, 2>(aR, xcb + 16 * m * 72, 72, waT + 16 * nb * 72, 72, lane);
            lds_mma<1, 2, 2>(aI, xcb + 16 * m * 72, 72, wxT + 16 * nb * 72, 72, lane);
            const int i = 16 * m + fr;
#pragma unroll
            for (int n = 0; n < 2; ++n) { f32x4 av, bv;
#pragma unroll
                for (int e = 0; e < 4; ++e) { const int ch = 16 * (nb + n) + 4 * fq + e;
                    const float r = sigmoidf_(aR[0][n][e] + par[320 + ch]), ig = sigmoidf_(aI[0][n][e] + par[384 + ch]);
                    const float la = -8.0f * r * par[448 + ch]; av[e] = __expf(la);
                    const float y2 = 2.0f * la;
                    const float om = y2 > -0.125f ? -y2 * (1.0f + y2 * (0.5f + y2 * (0.16666667f + y2 * (0.041666668f + y2 * 0.0083333338f)))) : 1.0f - __expf(y2);
                    bv[e] = __builtin_amdgcn_sqrtf(fmaxf(om, 0.f)) * ig * xcf[i * 68 + ch]; }
                *(LAS f32x4*)(a_s + i * 68 + 16 * (nb + n) + 4 * fq) = av; *(LAS f32x4*)(b_s + i * 68 + 16 * (nb + n) + 4 * fq) = bv; } }
        LDS_BARRIER();
        const int ch = tid & 63, seg = tid >> 6;
        float av[8], bv[8];
        { float A = 1.f, H = 0.f;
#pragma unroll
            for (int e = 0; e < 8; ++e) { const int i = seg * 8 + e; av[e] = a_s[i * 68 + ch]; bv[e] = b_s[i * 68 + ch]; }
#pragma unroll
            for (int e = 0; e < 8; ++e) { H = av[e] * H + bv[e]; A *= av[e]; av[e] = A; bv[e] = H; }
            segA[seg * 64 + ch] = A; segH[seg * 64 + ch] = H; }
        LDS_BARRIER();
        float hin = 0.f, ap = 1.f;
#pragma unroll
        for (int s2 = 0; s2 < 7; ++s2) if (s2 < seg) { const float sa = segA[s2 * 64 + ch]; hin = sa * hin + segH[s2 * 64 + ch]; ap *= sa; }
        GAS bf16_t* hp = hout + (rb + (dir ? tlo + 63 - seg * 8 : tlo + seg * 8)) * 256 + blk * 64 + ch; GAS bf16_t* ap2 = aout + (hp - hout); const int tstep = dir ? -256 : 256;
#pragma unroll
        for (int e = 0; e < 8; ++e) { const int i = seg * 8 + e;
            const float hl = bv[e] + av[e] * hin, ac = av[e] * ap; const unsigned pk = pk2a(hl, ac);
            hp[e * tstep] = (bf16_t)(pk & 0xffffu); ap2[e * tstep] = (bf16_t)(pk >> 16);
            if (i == 63) { GAS float* ag = (GAS float*)(P.ws + WS_AGG) + ((size_t)((b * 2 + dir) * 36 + c) * 2) * 256 + blk * 64 + ch; ag[0] = ac; ag[256] = hl; } }
    }
    __syncthreads();
}
__device__ __forceinline__ void lru_carry_unit(const PV& P, int unit) {
    const int tid = otid();
    if (tid < 256) { const float* ag = (const float*)(P.ws + WS_AGG) + (size_t)unit * 36 * 512 + tid; float* ci = (float*)(P.ws + WS_CIN) + (size_t)unit * 36 * 256 + tid;
        float A[36], H[36];
#pragma unroll
        for (int c = 0; c < 36; ++c) { A[c] = ag[c * 512]; H[c] = ag[c * 512 + 256]; }
        float carry = 0.f;
#pragma unroll
        for (int c = 0; c < 36; ++c) { ci[c * 256] = carry; carry = A[c] * carry + H[c]; } }
}

__device__ __forceinline__ void s5_unit(const PV& P, int l, int unit, LAS unsigned char* lds) {
    const int tid = otid(), lane = tid & 63, w = __builtin_amdgcn_readfirstlane(tid >> 6);
    const int gp = unit & 7, dir = (unit >> 3) & 1, b = unit >> 4;
    LAS float* bu0 = (LAS float*)lds;
    LAS bf16_t* Hs0 = (LAS bf16_t*)(lds + 66560);
    LAS bf16_t* Us0 = (LAS bf16_t*)(lds + 100352);
    LAS bf16_t* Bbu = (LAS bf16_t*)(lds + 105472);
    LAS bf16_t* By = (LAS bf16_t*)(lds + 125952);
    const GAS bf16_t* z = (const GAS bf16_t*)(P.ws + WS_Z);
    GAS bf16_t* yout = (GAS bf16_t*)(P.ws + WS_Y) + (size_t)(3 * 2 + dir) * YSZ;
    for (int idx = tid; idx < 256 * 40 / 2; idx += 512) ((LAS unsigned*)Bbu)[idx] = 0u;
    __syncthreads();
    float lr = 0.f, li = 0.f, hr = 0.f, hi = 0.f;
    if (tid < 128) { const int gl = tid >> 6, p = tid & 63, g = 2 * gp + gl; const size_t pidx = ((size_t)(l * 2 + dir) * 16 + g) * 64 + p;
        const float are = PIN(I_SARE)[pidx], aim = PIN(I_SAIM)[pidx], dt = __expf(PIN(I_SLDT)[(l * 2 + dir) * 16 + g]);
        const float mag = __expf(are * dt); float rev = aim * dt * 0.15915494309189535f; rev -= floorf(rev);
        lr = mag * __builtin_amdgcn_cosf(rev); li = mag * __builtin_amdgcn_sinf(rev);
        const float nre = lr - 1.0f, nim = li, den = 1.0f / (are * are + aim * aim);
        const float cre = (nre * are + nim * aim) * den, cim = (nim * are - nre * aim) * den;
#pragma unroll
        for (int c = 0; c < 16; ++c) { const float bre = PIN(I_SBRE)[pidx * 16 + c], bim = PIN(I_SBIM)[pidx * 16 + c];
            Bbu[(gl * 128 + 2 * p) * 40 + gl * 16 + c] = (bf16_t)f2bf(cre * bre - cim * bim); Bbu[(gl * 128 + 2 * p + 1) * 40 + gl * 16 + c] = (bf16_t)f2bf(cre * bim + cim * bre); } }
    for (int idx = tid; idx < 4096; idx += 512) { const int gl = idx >> 11, c = (idx >> 7) & 15, kk = idx & 127, part = kk >> 6, p = kk & 63, g = 2 * gp + gl;
        const size_t src = (((size_t)(l * 2 + dir) * 16 + g) * 16 + c) * 64 + p;
        By[(gl * 16 + c) * 136 + 2 * p + part] = (bf16_t)f2bf(part ? -PIN(I_SCIM)[src] : PIN(I_SCRE)[src]); }
    auto rowof = [&](int c, int i) -> size_t {
        if (c < 8) { const int s = 32 * c + i, t = dir ? 255 - s : s; return (size_t)TL + b * CTX + t; }
        const int sl = 32 * (c - 8) + i, slr = dir ? 2047 - sl : sl, col = slr >> 5, rg = slr & 31; return (size_t)b * SEQ + rg * 64 + col; };
    const int t6 = tid - 384;
    u32x4 pre = (u32x4){0u, 0u, 0u, 0u};
    if (w >= 6) { pre = *(const GAS u32x4*)(z + rowof(0, t6 >> 2) * ZW + CD_ + gp * 32 + (t6 & 3) * 8); *(LAS u32x4*)(Us0 + (t6 >> 2) * 40 + (t6 & 3) * 8) = pre;
        pre = *(const GAS u32x4*)(z + rowof(1, t6 >> 2) * ZW + CD_ + gp * 32 + (t6 & 3) * 8); }
    __syncthreads();
#pragma unroll 1
    for (int k = 0; k < 74; ++k) {
        if (w < 2) {
            const float hr_s = hr, hi_s = hi;
            for (int r3 = 0; r3 < ((PROBE_DUP & 524288) ? 2 : 1); ++r3)
            if (k >= 1 && k <= 72) { const LAS float* bu = bu0 + ((k - 1) & 1) * 8320; LAS bf16_t* Hs = Hs0 + ((k - 1) & 1) * 8448; hr = hr_s; hi = hi_s;
                const int cr = (tid >> 6) * 128 + 2 * (tid & 63); const float nli = -li;
#pragma unroll 1
                for (int i0 = 0; i0 < 32; i0 += 8) { f32x2 bb[8];
#pragma unroll
                    for (int e = 0; e < 8; ++e) bb[e] = *(const LAS f32x2*)(bu + (i0 + e) * 260 + cr);
                    unsigned orr[8];
#pragma unroll
                    for (int e = 0; e < 8; ++e) {
                        float t0, t1, nr, ni; const float br = bb[e][0], bi = bb[e][1];
                        asm("v_fma_f32 %0, %1, %2, %3" : "=v"(t0) : "v"(nli), "v"(hi), "v"(br));
                        asm("v_fma_f32 %0, %1, %2, %3" : "=v"(t1) : "v"(li), "v"(hr), "v"(bi));
                        asm("v_fma_f32 %0, %1, %2, %3" : "=v"(nr) : "v"(lr), "v"(hr), "v"(t0));
                        asm("v_fma_f32 %0, %1, %2, %3" : "=v"(ni) : "v"(lr), "v"(hi), "v"(t1));
                        hr = nr; hi = ni; orr[e] = pk2a(nr, ni); }
#pragma unroll
                    for (int e = 0; e < 8; ++e) *(LAS unsigned*)(Hs + (i0 + e) * 264 + cr) = orr[e]; } }
        } else if (w < 6) {
            for (int r3 = 0; r3 < ((PROBE_DUP & 131072) ? 2 : 1); ++r3)
            if (k <= 71) { LAS float* bu = bu0 + (k & 1) * 8320; const LAS bf16_t* Us = Us0 + (k & 1) * 1280; const int wq = w - 2;
                f32x4 acc[2][4]; zero_acc<2, 4>(acc);
                lds_mma<2, 4, 1>(acc, Us, 40, Bbu + 64 * wq * 40, 40, lane);
#pragma unroll
                for (int mm = 0; mm < 2; ++mm)
#pragma unroll
                    for (int n = 0; n < 4; ++n) *(LAS f32x4*)(bu + (16 * mm + (lane & 15)) * 260 + 64 * wq + 16 * n + 4 * (lane >> 4)) = acc[mm][n]; }
        } else {
            for (int r3 = 0; r3 < ((PROBE_DUP & 262144) ? 2 : 1); ++r3)
            if (k >= 2) { const LAS bf16_t* Hs = Hs0 + (k & 1) * 8448; const int gl = w - 6, cy = k - 2;
                f32x4 acc[2][1]; zero_acc<2, 1>(acc);
                lds_mma<2, 1, 4>(acc, Hs + gl * 128, 264, By + gl * 16 * 136, 136, lane);
#pragma unroll
                for (int mm = 0; mm < 2; ++mm) { const int i = 16 * mm + (lane & 15); const f32x4 v = acc[mm][0];
                    *(GAS unsigned long long*)(yout + rowof(cy, i) * 256 + gp * 32 + gl * 16 + 4 * (lane >> 4)) = (unsigned long long)pk2(v[0], v[1]) | ((unsigned long long)pk2(v[2], v[3]) << 32); } }
            if (k + 1 <= 71) { *(LAS u32x4*)(Us0 + ((k + 1) & 1) * 1280 + (t6 >> 2) * 40 + (t6 & 3) * 8) = pre;
                if (k + 2 <= 71) pre = *(const GAS u32x4*)(z + rowof(k + 2, t6 >> 2) * ZW + CD_ + gp * 32 + (t6 & 3) * 8); }
        }
        LDS_BARRIER();
    }
    __syncthreads();
}

__device__ __forceinline__ float sum16(float v) { v = sum8(v); return v + dppf<0x140>(v); }
struct CmbRow { u32x2 zr[3], zk[3], zv[3], gB, gC, uD, y[8], ac[2]; f32x4 ci[2]; };
template <int PART> __device__ __forceinline__ void p3_combine(const PV& P, int l, int nrows, LAS unsigned char* lds) {
    const int tid = otid(), lane = tid & 63, w = __builtin_amdgcn_readfirstlane(tid >> 6), c4 = 4 * lane, hh = lane >> 4;
    LAS bf16_t* gupT = (LAS bf16_t*)lds;
    LAS float* smu = (LAS float*)(lds + 36864);
    LAS float* spar = smu + 1664;
    LAS bf16_t* sgw = (LAS bf16_t*)(lds + 48640) + w * (16 * 72);
    LAS bf16_t* Gw = (LAS bf16_t*)(lds + 67072) + w * (16 * 264);
    if (PART == 0) {
    for (int idx = tid; idx < 16384; idx += 512) { const int k = idx >> 8, n = idx & 255; gupT[n * 72 + k] = (bf16_t)f2bf(PIN(I_GUP)[(size_t)l * 16384 + idx]); }
    for (int idx = tid; idx < 1664; idx += 512) { const int which = idx / 832, col = idx % 832; smu[idx] = PIN(I_MU)[(size_t)(l * 2 + which) * 960 + col]; }
    for (int idx = tid; idx < 1280; idx += 512) { const int k = idx >> 8, c = idx & 255;
        spar[idx] = k == 0 ? PIN(I_LNG)[l * 256 + c] : k == 1 ? PIN(I_LNB)[l * 256 + c] : k == 2 ? PIN(I_RK)[l * 256 + c] : k == 3 ? PIN(I_GNG)[l * 256 + c] : PIN(I_SD)[l * 256 + c]; }
    __syncthreads();
    return; }
    const GAS bf16_t* z = (const GAS bf16_t*)(P.ws + WS_Z); const GAS bf16_t* Y = (const GAS bf16_t*)(P.ws + WS_Y);
    GAS bf16_t* mix = (GAS bf16_t*)(P.ws + WS_ACT); GAS bf16_t* s5g = (GAS bf16_t*)(P.ws + WS_S5G);
    const int gw = blockIdx.x * 8 + w, NGW = gridDim.x * 8;
    auto ld = [&](int row, CmbRow& L) {
        const bool isctx = row >= TL; const int t = isctx ? ((row - TL) & 255) : (row & 2047), seqlen = isctx ? CTX : SEQ;
        const GAS bf16_t* zr = z + (size_t)row * ZW;
#pragma unroll
        for (int d = 0; d < 3; ++d) { const bool ok = d == 1 || (d == 0 ? t > 0 : t < seqlen - 1); const GAS bf16_t* zz = zr + (d - 1) * ZW; const u32x2 zero = (u32x2){0u, 0u};
            L.zr[d] = ok ? *(const GAS u32x2*)(zz + c4) : zero; L.zk[d] = ok ? *(const GAS u32x2*)(zz + 256 + c4) : zero; L.zv[d] = ok ? *(const GAS u32x2*)(zz + 512 + c4) : zero;
            }
        L.gB = *(const GAS u32x2*)(zr + CB_ + 768 + c4); L.gC = *(const GAS u32x2*)(zr + CC_ + 256 + c4); L.uD = *(const GAS u32x2*)(zr + CD_ + c4);
#pragma unroll
        for (int k = 0; k < 8; ++k) L.y[k] = *(const GAS u32x2*)(Y + (size_t)k * YSZ + (size_t)row * 256 + c4);
        const int bb = isctx ? (row - TL) >> 8 : row >> 11;
#pragma unroll
        for (int d = 0; d < 2; ++d) { const int ts = d ? seqlen - 1 - t : t, ck = (isctx ? 0 : 4) + (ts >> 6);
            L.ac[d] = *(const GAS u32x2*)((const GAS bf16_t*)(P.ws + WS_ACU) + (size_t)d * YSZ + (size_t)row * 256 + c4);
            L.ci[d] = *(const GAS f32x4*)((const GAS float*)(P.ws + WS_CIN) + ((size_t)(bb * 2 + d) * 36 + ck) * 256 + c4); }
    };
    auto up4 = [](const u32x2 v, float (&o)[4]) { o[0] = bflo(v.x); o[1] = bfhi(v.x); o[2] = bflo(v.y); o[3] = bfhi(v.y); };
    auto st4 = [](GAS bf16_t* p, const float (&o)[4]) { *(GAS unsigned long long*)p = (unsigned long long)pk2(o[0], o[1]) | ((unsigned long long)pk2(o[2], o[3]) << 32); };
    auto shift4 = [&](const u32x2 (&zz)[3], int col, float (&o)[4]) { float a[4], m[4], n[4]; up4(zz[1], a); up4(zz[0], m); up4(zz[2], n);
        const f32x4 u0 = *(const LAS f32x4*)(smu + col), u1 = *(const LAS f32x4*)(smu + 832 + col);
#pragma unroll
        for (int e = 0; e < 4; ++e) o[e] = a[e] + u0[e] * (m[e] - a[e]) + u1[e] * (n[e] - a[e]); };
    auto cmp = [&](int row, int slot, const CmbRow& L) {
        float g[4]; up4(*(const LAS u32x2*)(Gw + slot * 264 + c4), g);
        float r[4], k[4], v[4]; shift4(L.zr, c4, r); shift4(L.zk, 256 + c4, k); shift4(L.zv, 512 + c4, v);
        const f32x4 lng = *(const LAS f32x4*)(spar + c4), lnb = *(const LAS f32x4*)(spar + 256 + c4), rk = *(const LAS f32x4*)(spar + 512 + c4), gng = *(const LAS f32x4*)(spar + 768 + c4), sd = *(const LAS f32x4*)(spar + 1024 + c4);
        float ya[4], yb[4], t0[4], t1[4];
        up4(L.y[0], t0); up4(L.y[1], t1);
#pragma unroll
        for (int e = 0; e < 4; ++e) ya[e] = t0[e] + t1[e];
        { const float mean = sum16((ya[0] + ya[1]) + (ya[2] + ya[3])) * (1.0f / 64.0f); float q = 0.f, bsum = 0.f;
#pragma unroll
            for (int e = 0; e < 4; ++e) { ya[e] -= mean; q += ya[e] * ya[e]; bsum += r[e] * k[e] * rk[e]; }
            const float rs = __builtin_amdgcn_rsqf(sum16(q) * (1.0f / 64.0f) + 64e-5f); bsum = sum16(bsum); float o[4];
#pragma unroll
            for (int e = 0; e < 4; ++e) o[e] = (ya[e] * rs * lng[e] + lnb[e] + bsum * v[e]) * g[e];
            st4(mix + (size_t)row * 1024 + c4, o); }
        up4(L.y[2], t0); up4(L.y[3], t1);
#pragma unroll
        for (int e = 0; e < 4; ++e) yb[e] = t0[e] + t1[e];
        { const float mean = sum16((yb[0] + yb[1]) + (yb[2] + yb[3])) * (1.0f / 64.0f); float q = 0.f;
#pragma unroll
            for (int e = 0; e < 4; ++e) { yb[e] -= mean; q += yb[e] * yb[e]; }
            const float rs = __builtin_amdgcn_rsqf(sum16(q) * (1.0f / 64.0f) + 1e-5f); float gt[4], o[4]; up4(L.gB, gt);
#pragma unroll
            for (int e = 0; e < 4; ++e) o[e] = siluf_(gt[e]) * (yb[e] * rs * gng[e]);
            st4(mix + (size_t)row * 1024 + 256 + c4, o); }
        { float gt[4], o[4], a0[4], a1[4]; up4(L.gC, gt); up4(L.y[4], t0); up4(L.y[5], t1); up4(L.ac[0], a0); up4(L.ac[1], a1);
#pragma unroll
            for (int e = 0; e < 4; ++e) o[e] = geluf_(gt[e]) * ((t0[e] + a0[e] * L.ci[0][e]) + (t1[e] + a1[e] * L.ci[1][e]));
            st4(mix + (size_t)row * 1024 + 512 + c4, o); }
        { float uu[4], o[4]; up4(L.uD, uu); up4(L.y[6], t0); up4(L.y[7], t1);
#pragma unroll
            for (int e = 0; e < 4; ++e) o[e] = geluf_(sd[e] * uu[e] + t0[e] + t1[e]);
            st4(s5g + (size_t)row * 256 + c4, o); }
    };
    (void)hh;
    for (int r0 = gw; r0 < nrows; r0 += 16 * NGW) {
#pragma unroll
        for (int pass = 0; pass < 4; ++pass) { const int slot = pass * 4 + (lane >> 4), cg = lane & 15, row = r0 + slot * NGW;
            if (row < nrows) { const bool isctx = row >= TL; const int t = isctx ? ((row - TL) & 255) : (row & 2047), seqlen = isctx ? CTX : SEQ;
                const GAS bf16_t* zz = z + (size_t)row * ZW + 768 + 4 * cg; const u32x2 zero = (u32x2){0u, 0u}; u32x2 zg[3];
                zg[0] = t > 0 ? *(const GAS u32x2*)(zz - ZW) : zero; zg[1] = *(const GAS u32x2*)zz; zg[2] = t < seqlen - 1 ? *(const GAS u32x2*)(zz + ZW) : zero;
                float gl[4]; shift4(zg, 768 + 4 * cg, gl);
                *(LAS unsigned long long*)(sgw + slot * 72 + 4 * cg) = (unsigned long long)pk2(sigmoidf_(gl[0]), sigmoidf_(gl[1])) | ((unsigned long long)pk2(sigmoidf_(gl[2]), sigmoidf_(gl[3])) << 32); } }
        asm volatile("s_waitcnt lgkmcnt(0)" ::: "memory");
        { f32x4 acc[1][16]; zero_acc<1, 16>(acc);
            lds_mma<1, 16, 2>(acc, sgw, 72, gupT, 72, lane);
#pragma unroll
            for (int n = 0; n < 16; ++n) { const f32x4 v = acc[0][n];
                *(LAS unsigned long long*)(Gw + (lane & 15) * 264 + 16 * n + 4 * (lane >> 4)) = (unsigned long long)pk2(v[0], v[1]) | ((unsigned long long)pk2(v[2], v[3]) << 32); } }
        asm volatile("s_waitcnt lgkmcnt(0)" ::: "memory");
        { CmbRow LA, LB; int row = r0, slot = 0;
            if (row < nrows) ld(row, LA);
            if (row + NGW < nrows) ld(row + NGW, LB);
            for (; slot < 16 && row < nrows; row += 2 * NGW, slot += 2) {
                cmp(row, slot, LA);
                if (slot + 2 < 16 && row + 2 * NGW < nrows) ld(row + 2 * NGW, LA);
                if (row + NGW < nrows) { cmp(row + NGW, slot + 1, LB); if (slot + 3 < 16 && row + 3 * NGW < nrows) ld(row + 3 * NGW, LB); }
            } }
    }
}

__device__ __forceinline__ void p6_h2(const PV& P, int l, int nrows) {
    const int tid = otid(), lane = tid & 63, gw = blockIdx.x * 8 + __builtin_amdgcn_readfirstlane(tid >> 6), NGW = gridDim.x * 8;
    const float* mod = (const float*)(P.ws + WS_MOD) + (size_t)l * 9 * 6144; const GAS bf16_t* X1 = (const GAS bf16_t*)(P.ws + WS_X1);
    bf16_t* act = (bf16_t*)(P.ws + WS_ACT);
    for (int row = gw; row < nrows; row += NGW) { const int mr = row < TL ? (row >> 11) : 8;
        float x[16], y[16];
        { const u32x4 xa = *(const GAS u32x4*)(X1 + (size_t)row * 1024 + 8 * lane), xb = *(const GAS u32x4*)(X1 + (size_t)row * 1024 + 512 + 8 * lane);
#pragma unroll
            for (int e = 0; e < 4; ++e) { x[2 * e] = bflo(xa[e]); x[2 * e + 1] = bfhi(xa[e]); x[8 + 2 * e] = bflo(xb[e]); x[8 + 2 * e + 1] = bfhi(xb[e]); } }
        norm_mod16(x, PIN(I_N2G) + l * 1024, mod + (size_t)mr * 6144 + 3 * 1024, mod + (size_t)mr * 6144 + 4 * 1024, lane, y);
        store_row16_bf16(act + (size_t)row * 1024, lane, y);
        float m = 0.f;
#pragma unroll
        for (int e = 0; e < 16; ++e) m = fmaxf(m, fabsf(y[e]));
        m = wave_max(m);
        const float inv = m > 0.f ? 127.0f * __builtin_amdgcn_rcpf(m) : 0.f;
        GAS unsigned char* hq = (GAS unsigned char*)(P.ws + WS_H2Q) + (size_t)row * 1024 + 8 * lane;
        *(GAS u32x2*)hq = (u32x2){pack_i8x4(y[0] * inv, y[1] * inv, y[2] * inv, y[3] * inv), pack_i8x4(y[4] * inv, y[5] * inv, y[6] * inv, y[7] * inv)};
        *(GAS u32x2*)(hq + 512) = (u32x2){pack_i8x4(y[8] * inv, y[9] * inv, y[10] * inv, y[11] * inv), pack_i8x4(y[12] * inv, y[13] * inv, y[14] * inv, y[15] * inv)};
        if (lane == 0) ((GAS float*)(P.ws + WS_H2S))[row] = m * (1.0f / 127.0f); }
}

typedef short s16x2_t __attribute__((ext_vector_type(2)));
__device__ __forceinline__ unsigned skey(float f) { const unsigned u = __builtin_bit_cast(unsigned, f); return u ^ ((unsigned)((int)u >> 31) | 0x80000000u); }
__device__ __forceinline__ float unskey(unsigned s) { const unsigned u = (s & 0x80000000u) ? (s ^ 0x80000000u) : ~s; return __builtin_bit_cast(float, u); }

__device__ __forceinline__ void ce_(unsigned& a, unsigned& b) { const unsigned hi = max(a, b), lo = min(a, b); a = hi; b = lo; }
__device__ __forceinline__ void sort16_(unsigned (&v)[16]) {
#pragma unroll
    for (int p = 1; p < 16; p <<= 1)
#pragma unroll
        for (int k = p; k >= 1; k >>= 1)
#pragma unroll
            for (int j = k % p; j + k < 16; j += 2 * k)
#pragma unroll
                for (int i = 0; i < k; ++i) if (i + j + k < 16 && (i + j) / (2 * p) == (i + j + k) / (2 * p)) ce_(v[i + j], v[i + j + k]);
}
__device__ __forceinline__ void merge16_(unsigned (&a)[16], const unsigned (&b)[16]) {
#pragma unroll
    for (int i = 0; i < 16; ++i) a[i] = max(a[i], b[15 - i]);
#pragma unroll
    for (int j = 8; j > 0; j >>= 1)
#pragma unroll
        for (int i = 0; i < 16; ++i) { const int p = i ^ j; if (p > i) ce_(a[i], a[p]); }
}
__device__ __forceinline__ void p8a_topk(const PV& P, int nrows, LAS unsigned char* lds) {
    const int tid = otid();
    LAS unsigned* tb = (LAS unsigned*)lds;
    const GAS unsigned short* sc = (const GAS unsigned short*)(P.ws + WS_SC); GAS unsigned short* ids = (GAS unsigned short*)(P.ws + WS_LIST); GAS unsigned short* gates = (GAS unsigned short*)(P.ws + WS_LIST + 8 * MiB);
    const int items = nrows * 16, nth = gridDim.x * 512;
    const int full = items / nth, rem = items - full * nth; const int chunk = (((rem + (int)gridDim.x - 1) / (int)gridDim.x) + 63) & ~63;
    for (int rnd = 0; rnd <= full; ++rnd) {
        int item = rnd * nth + blockIdx.x * 512 + tid;
        if (rnd == full) { item = full * nth + blockIdx.x * chunk + tid; if (tid >= chunk || item >= items) break; }
        const int row = item >> 4, hp = item & 15, hh = hp >> 1, p = hp & 1;
        const GAS u32x4* sp = (const GAS u32x4*)(sc + (size_t)row * 2048 + hp * 128);
        unsigned top[16];
        u32x4 nx[2];
#pragma unroll
        for (int q = 0; q < 2; ++q) nx[q] = sp[q];
#pragma unroll 1
        for (int bk = 0; bk < 8; ++bk) { unsigned cur[16];
#pragma unroll
            for (int q = 0; q < 2; ++q) { const u32x4 v = nx[q];
#pragma unroll
                for (int k = 0; k < 4; ++k) { const unsigned wv = v[k];
                    const s16x2_t sm = __builtin_bit_cast(s16x2_t, wv) >> (short)15;
                    const unsigned k2 = wv ^ (__builtin_bit_cast(unsigned, sm) | 0x80008000u);
                    cur[q * 8 + 2 * k] = (k2 << 16) | (unsigned)(bk * 16 + q * 8 + 2 * k);
                    cur[q * 8 + 2 * k + 1] = (k2 & 0xFFFF0000u) | (unsigned)(bk * 16 + q * 8 + 2 * k + 1); } }
            { const int nb = bk < 7 ? bk + 1 : 7;
#pragma unroll
                for (int q = 0; q < 2; ++q) nx[q] = sp[nb * 2 + q]; }
            sort16_(cur);
            if (bk == 0) {
#pragma unroll
                for (int s = 0; s < 16; ++s) top[s] = cur[s];
            } else merge16_(top, cur); }
        float v1[16], v2[16]; unsigned i1[16], i2[16];
#pragma unroll
        for (int s = 0; s < 16; ++s) { const unsigned ks = top[s] & 0xFFFF0000u, ku = (ks & 0x80000000u) ? (ks ^ 0x80000000u) : (~ks & 0xFFFF0000u);
            const float mv = (float)__builtin_bit_cast(_Float16, (unsigned short)(ku >> 16)); const unsigned mi = top[s] & 127u;
            const float ov = dppf<0xB1>(mv); const unsigned oi = dppu<0xB1>(mi);
            v1[s] = p ? ov : mv; i1[s] = p ? oi : mi; v2[s] = p ? mv : ov; i2[s] = p ? mi : oi; }
        unsigned k2[16];
        float d1[16], d2[16];
#pragma unroll
        for (int s = 0; s < 16; ++s) { d1[s] = v1[s] - v1[15]; d2[s] = v2[s] - v2[15]; }
        { unsigned cand[64]; int n = 0;
#pragma unroll
            for (int a = 0; a < 16; ++a)
#pragma unroll
                for (int bb = 0; bb < 16; ++bb) if ((a + 1) * (bb + 1) <= 16) { cand[n] = (__float_as_uint(d1[a] + d2[bb]) & 0xFFFFFF00u) | (unsigned)(a * 16 + bb); ++n; }
#pragma unroll
            for (int q = 50; q < 64; ++q) cand[q] = 0u;
#pragma unroll
            for (int bk = 0; bk < 4; ++bk) { unsigned cur[16];
#pragma unroll
                for (int s = 0; s < 16; ++s) cur[s] = cand[bk * 16 + s];
                sort16_(cur);
                if (bk == 0) {
#pragma unroll
                    for (int s = 0; s < 16; ++s) k2[s] = cur[s];
                } else merge16_(k2, cur); } }
#pragma unroll
        for (int s = 0; s < 16; ++s) { tb[s * 512 + tid] = i1[s]; tb[(16 + s) * 512 + tid] = i2[s]; }
        const float mx = __uint_as_float(k2[0] & 0xFFFFFF00u); float ev[16], sum = 0.f; unsigned pl[16];
#pragma unroll
        for (int s = 0; s < 16; ++s) { ev[s] = __expf(__uint_as_float(k2[s] & 0xFFFFFF00u) - mx); sum += ev[s];
            const unsigned a = (k2[s] >> 4) & 15u, bb = k2[s] & 15u; pl[s] = (tb[a * 512 + tid] << 7) | tb[(16 + bb) * 512 + tid]; }
        const float inv = __builtin_amdgcn_rcpf(sum);
        if (p == 0) { GAS unsigned short* ip = ids + (size_t)row * 128 + hh * 16; GAS unsigned short* gp = gates + (size_t)row * 128 + hh * 16;
            *(GAS u32x4*)ip = (u32x4){pl[0] | (pl[1] << 16), pl[2] | (pl[3] << 16), pl[4] | (pl[5] << 16), pl[6] | (pl[7] << 16)};
            *(GAS u32x4*)(ip + 8) = (u32x4){pl[8] | (pl[9] << 16), pl[10] | (pl[11] << 16), pl[12] | (pl[13] << 16), pl[14] | (pl[15] << 16)};
            unsigned gh[8];
#pragma unroll
            for (int q = 0; q < 8; ++q) { const _Float16 ga = (_Float16)(ev[2 * q] * inv), gb = (_Float16)(ev[2 * q + 1] * inv);
                gh[q] = (unsigned)__builtin_bit_cast(unsigned short, ga) | ((unsigned)__builtin_bit_cast(unsigned short, gb) << 16); }
            *(GAS u32x4*)gp = (u32x4){gh[0], gh[1], gh[2], gh[3]}; *(GAS u32x4*)(gp + 8) = (u32x4){gh[4], gh[5], gh[6], gh[7]}; }
    }
}

template <class PT> __device__ __forceinline__ void load_row16c(PT p, int lane, float (&x)[16]) {
#pragma unroll
    for (int k = 0; k < 4; ++k) { const f32x4 a = *(const GAS f32x4*)(p + 16 * lane + 4 * k);
#pragma unroll
        for (int e = 0; e < 4; ++e) x[4 * k + e] = a[e]; }
}
template <class PT> __device__ __forceinline__ void store_row16c_f32(PT p, int lane, const float (&x)[16]) {
#pragma unroll
    for (int k = 0; k < 4; ++k) *(GAS f32x4*)(p + 16 * lane + 4 * k) = (f32x4){x[4 * k], x[4 * k + 1], x[4 * k + 2], x[4 * k + 3]};
}
template <class PT> __device__ __forceinline__ void store_row16c_bf16(PT p, int lane, const float (&y)[16]) {
    u32x4 a, b; a.x = pk2(y[0], y[1]); a.y = pk2(y[2], y[3]); a.z = pk2(y[4], y[5]); a.w = pk2(y[6], y[7]);
    b.x = pk2(y[8], y[9]); b.y = pk2(y[10], y[11]); b.z = pk2(y[12], y[13]); b.w = pk2(y[14], y[15]);
    *(GAS u32x4*)(p + 16 * lane) = a; *(GAS u32x4*)(p + 16 * lane + 8) = b;
}
template <class G1, class G2> __device__ __forceinline__ void norm_mod16c(const float (&x)[16], G1 g, G2 shift, G2 scale, int lane, float (&y)[16]) {
    float ss = 0.f;
#pragma unroll
    for (int e = 0; e < 16; ++e) ss += x[e] * x[e];
    ss = wave_sum(ss);
    const float r = __builtin_amdgcn_rsqf(ss * (1.0f / 1024.0f) + 1e-6f);
    float gg[16]; load_row16c(g, lane, gg);
    if (shift) { float sh[16], sc[16]; load_row16c(shift, lane, sh); load_row16c(scale, lane, sc);
#pragma unroll
        for (int e = 0; e < 16; ++e) y[e] = x[e] * r * gg[e] * (1.0f + sc[e]) + sh[e];
    } else {
#pragma unroll
        for (int e = 0; e < 16; ++e) y[e] = x[e] * r * gg[e];
    }
}
__device__ __forceinline__ void p8u_dots(const PV& P, int l, int nrows) {
    const int tid = otid(), lane = tid & 63, w = __builtin_amdgcn_readfirstlane(tid >> 6), eg = lane >> 3, cs = lane & 7;
    const bool sliced = (gridDim.x & 7) == 0;
    const int x0 = sliced ? (blockIdx.x & 7) : 0, xstep = sliced ? 8 : 1;
    const int gwx = sliced ? (blockIdx.x >> 3) * 8 + w : blockIdx.x * 8 + w, nW = sliced ? (gridDim.x >> 3) * 8 : gridDim.x * 8;
    const GAS unsigned short* ids = (const GAS unsigned short*)(P.ws + WS_LIST); const GAS unsigned char* h2q = (const GAS unsigned char*)(P.ws + WS_H2Q);
    const GAS float* h2s = (const GAS float*)(P.ws + WS_H2S);
    GAS bf16_t* pd = (GAS bf16_t*)(P.ws + WS_SC);
    for (int x = x0; x < 8; x += xstep) {
        const GAS unsigned char* U8 = (const GAS unsigned char*)P.ws + WS_U8 + (size_t)l * NEXP * 1024 + (size_t)x * NEXP * 128;
        const unsigned cso = 16u * (unsigned)cs;
        LAS unsigned* il = (LAS unsigned*)(P.lds + w * 512);
        unsigned n_i0, n_i1; u32x4 uu[16]; u32x4 hc, hn; float sc, sn;
#define U_LOADI(r) do { const GAS unsigned short* lw = ids + (size_t)(r) * 128 + lane; n_i0 = lw[0]; n_i1 = lw[64]; } while (0)
#define U_STI() do { il[lane] = n_i0; il[64 + lane] = n_i1; asm volatile("s_waitcnt lgkmcnt(0)" ::: "memory"); } while (0)
        int row = gwx;
        if (row < nrows) {
            U_LOADI(row); U_STI();
            hc = *(const GAS u32x4*)(h2q + (size_t)row * 1024 + 128 * x + 16 * cs); sc = h2s[row];
#pragma unroll
            for (int g = 0; g < 16; ++g) { const unsigned id = il[8 * g + eg]; uu[g] = *(const GAS u32x4*)(U8 + (id * 128u + cso)); }
            const int rn = row + nW < nrows ? row + nW : row;
            U_LOADI(rn); asm volatile("s_waitcnt lgkmcnt(0)" ::: "memory"); U_STI();
            hn = *(const GAS u32x4*)(h2q + (size_t)rn * 1024 + 128 * x + 16 * cs); sn = h2s[rn];
            const int r2 = row + 2 * nW < nrows ? row + 2 * nW : row;
            U_LOADI(r2);
        }
        for (; row < nrows; row += nW) {
            GAS bf16_t* pdr = pd + ((size_t)x * nrows + row) * 128 + 8 * cs + eg;
#pragma unroll
            for (int half = 0; half < 2; ++half) { unsigned d[8];
#pragma unroll
                for (int gg = 0; gg < 8; ++gg) { const int g = 8 * half + gg;
                    int a = __builtin_amdgcn_sdot4((int)uu[g][0], (int)hc[0], 0, false); a = __builtin_amdgcn_sdot4((int)uu[g][1], (int)hc[1], a, false);
                    a = __builtin_amdgcn_sdot4((int)uu[g][2], (int)hc[2], a, false); a = __builtin_amdgcn_sdot4((int)uu[g][3], (int)hc[3], a, false);
                    const unsigned id = il[8 * g + eg]; uu[g] = *(const GAS u32x4*)(U8 + (id * 128u + cso));
                    d[gg] = (unsigned)a; }
                const bool c4 = (cs & 4) != 0, c2 = (cs & 2) != 0, c1 = (cs & 1) != 0;
                unsigned e4[4], e2[2];
#pragma unroll
                for (int j = 0; j < 4; ++j) { const unsigned snd = c4 ? d[j] : d[j + 4], kp = c4 ? d[j + 4] : d[j]; e4[j] = kp + dppu<0x141>(snd); }
#pragma unroll
                for (int j = 0; j < 2; ++j) { const unsigned snd = c2 ? e4[j] : e4[j + 2], kp = c2 ? e4[j + 2] : e4[j]; e2[j] = kp + dppu<0x4E>(snd); }
                { const unsigned snd = c1 ? e2[0] : e2[1], kp = c1 ? e2[1] : e2[0]; pdr[64 * half] = (bf16_t)f2bf((float)(int)(kp + dppu<0xB1>(snd)) * sc); } }
            hc = hn; sc = sn;
            U_STI();
            const int r2 = row + 2 * nW < nrows ? row + 2 * nW : row, r3 = row + 3 * nW < nrows ? row + 3 * nW : row;
            hn = *(const GAS u32x4*)(h2q + (size_t)r2 * 1024 + 128 * x + 16 * cs); sn = h2s[r2];
            U_LOADI(r3);
        }
#undef U_LOADI
#undef U_STI
    }
}
__device__ __forceinline__ void p8c_coef(const PV& P, int l, int nrows) {
    const int tid = otid();
    const GAS u32x2* ids4 = (const GAS u32x2*)(P.ws + WS_LIST); const GAS u32x2* gate4 = (const GAS u32x2*)(P.ws + WS_LIST + 8 * MiB); GAS u32x2* coef4 = (GAS u32x2*)(P.ws + WS_COEF); const GAS u32x2* pd4 = (const GAS u32x2*)(P.ws + WS_SC);
    const GAS float* us = (const GAS float*)(P.ws + WS_US) + (size_t)l * NEXP;
    const int n4 = nrows * 32, nth = gridDim.x * 512;
    constexpr int NB = 3;
    for (int i0 = blockIdx.x * 512 + tid; i0 < n4; i0 += NB * nth) {
        u32x2 iw[NB]; u32x2 gv[NB]; u32x2 pw[NB][8]; float us4[NB][4];
#pragma unroll
        for (int k = 0; k < NB; ++k) { const int i = i0 + k * nth < n4 ? i0 + k * nth : i0;
            iw[k] = ids4[i]; gv[k] = gate4[i];
#pragma unroll
            for (int xx = 0; xx < 8; ++xx) pw[k][xx] = pd4[(size_t)xx * n4 + i]; }
#pragma unroll
        for (int k = 0; k < NB; ++k) { const unsigned wa = iw[k].x, wb = iw[k].y; const unsigned i0_ = wa & 0xffffu, i1_ = wa >> 16, i2_ = wb & 0xffffu, i3_ = wb >> 16;
            us4[k][0] = us[i0_]; us4[k][1] = us[i1_]; us4[k][2] = us[i2_]; us4[k][3] = us[i3_]; }
#pragma unroll
        for (int k = 0; k < NB; ++k) { f32x4 sacc = (f32x4){0.f, 0.f, 0.f, 0.f};
#pragma unroll
            for (int xx = 0; xx < 8; ++xx) sacc += (f32x4){bflo(pw[k][xx].x), bfhi(pw[k][xx].x), bflo(pw[k][xx].y), bfhi(pw[k][xx].y)};
            const unsigned gwa = gv[k].x, gwb = gv[k].y;
            const float g0 = (float)__builtin_bit_cast(_Float16, (unsigned short)(gwa & 0xffffu)), g1 = (float)__builtin_bit_cast(_Float16, (unsigned short)(gwa >> 16));
            const float g2 = (float)__builtin_bit_cast(_Float16, (unsigned short)(gwb & 0xffffu)), g3 = (float)__builtin_bit_cast(_Float16, (unsigned short)(gwb >> 16));
            const _Float16 c0 = (_Float16)(g0 * geluf_(sacc[0] * us4[k][0]) * 0.5f), c1 = (_Float16)(g1 * geluf_(sacc[1] * us4[k][1]) * 0.5f);
            const _Float16 c2 = (_Float16)(g2 * geluf_(sacc[2] * us4[k][2]) * 0.5f), c3 = (_Float16)(g3 * geluf_(sacc[3] * us4[k][3]) * 0.5f);
            const unsigned lo = (unsigned)__builtin_bit_cast(unsigned short, c0) | ((unsigned)__builtin_bit_cast(unsigned short, c1) << 16);
            const unsigned hi = (unsigned)__builtin_bit_cast(unsigned short, c2) | ((unsigned)__builtin_bit_cast(unsigned short, c3) << 16);
            if (i0 + k * nth < n4) coef4[i0 + k * nth] = (u32x2){lo, hi}; }
    }
}
__device__ __forceinline__ void p8v_accum(const PV& P, int l, int nrows, LAS unsigned char* lds) {
    const int tid = otid(), lane = tid & 63, w = __builtin_amdgcn_readfirstlane(tid >> 6), eg = lane >> 3, cs = lane & 7;
    const bool sliced = (gridDim.x & 7) == 0;
    const int x0 = sliced ? (blockIdx.x & 7) : 0, xstep = sliced ? 8 : 1;
    const int gwx = sliced ? (blockIdx.x >> 3) * 8 + w : blockIdx.x * 8 + w, nW = sliced ? (gridDim.x >> 3) * 8 : gridDim.x * 8;
    const GAS unsigned short* ids = (const GAS unsigned short*)(P.ws + WS_LIST); const GAS unsigned short* coefh = (const GAS unsigned short*)(P.ws + WS_COEF);
    const GAS float* modl = (const GAS float*)(P.ws + WS_MOD) + (size_t)l * 9 * 6144; const GAS bf16_t* X1 = (const GAS bf16_t*)(P.ws + WS_X1);
    const bool b3 = (lane & 8) != 0;
    struct VSt { unsigned n_i0, n_i1, n_c0, n_c1; u32x4 vv[16]; float cfc[16]; };
    for (int x = x0; x < 8; x += xstep) {
        const GAS unsigned char* V8 = (const GAS unsigned char*)P.ws + WS_V8 + (size_t)l * NEXP * 1024 + (size_t)x * NEXP * 128;
        const unsigned cso = 16u * (unsigned)cs;
        if (gwx >= nrows) continue;
        auto load1 = [&](VSt& s, int r) { const GAS unsigned short* lw = ids + (size_t)r * 128 + lane; const GAS unsigned short* cw = coefh + (size_t)r * 128 + lane; s.n_i0 = lw[0]; s.n_c0 = cw[0]; s.n_i1 = lw[64]; s.n_c1 = cw[64]; };
        auto tolds = [&](VSt& s, LAS float* cl, LAS unsigned* il) { cl[lane] = (float)__builtin_bit_cast(_Float16, (unsigned short)s.n_c0); cl[64 + lane] = (float)__builtin_bit_cast(_Float16, (unsigned short)s.n_c1); il[lane] = s.n_i0; il[64 + lane] = s.n_i1;
            asm volatile("s_waitcnt lgkmcnt(0)" ::: "memory"); };
        auto clampr = [&](int r) { return r < nrows ? r : gwx; };
        auto prime = [&](VSt& s, LAS float* cl, LAS unsigned* il, int row, int stp) {
            load1(s, clampr(row)); tolds(s, cl, il);
#pragma unroll
            for (int g = 0; g < 16; ++g) { const unsigned id = il[8 * g + eg]; s.cfc[g] = cl[8 * g + eg]; s.vv[g] = *(const GAS u32x4*)(V8 + (id * 128u + cso)); }
            load1(s, clampr(row + stp)); asm volatile("s_waitcnt lgkmcnt(0)" ::: "memory"); tolds(s, cl, il);
            load1(s, clampr(row + 2 * stp)); };
        auto body = [&](VSt& s, LAS float* cl, LAS unsigned* il, int row, int stp) {
            const bool valid = row < nrows; const int rr = valid ? row : gwx; const int mr = rr < TL ? (rr >> 11) : 8;
            f32x2 acc[8];
#pragma unroll
            for (int j = 0; j < 8; ++j) acc[j] = (f32x2){0.f, 0.f};
#pragma unroll
            for (int g = 0; g < 16; ++g) { const f32x2 c2 = (f32x2){s.cfc[g], s.cfc[g]};
#pragma unroll
                for (int q = 0; q < 4; ++q) { const f32x2 lo = __builtin_amdgcn_cvt_pk_f32_fp8((int)s.vv[g][q], false), hi = __builtin_amdgcn_cvt_pk_f32_fp8((int)s.vv[g][q], true);
                    acc[2 * q] += c2 * lo; acc[2 * q + 1] += c2 * hi; }
                const unsigned id = il[8 * g + eg]; s.cfc[g] = cl[8 * g + eg]; s.vv[g] = *(const GAS u32x4*)(V8 + (id * 128u + cso)); }
            f32x2 a4[4], a2v[2], a1;
#pragma unroll
            for (int j = 0; j < 4; ++j) a4[j] = (f32x2){swapsum32(acc[j][0], acc[j + 4][0]), swapsum32(acc[j][1], acc[j + 4][1])};
#pragma unroll
            for (int j = 0; j < 2; ++j) a2v[j] = (f32x2){swapsum16(a4[j][0], a4[j + 2][0]), swapsum16(a4[j][1], a4[j + 2][1])};
            { const f32x2 snd = b3 ? a2v[0] : a2v[1], kp = b3 ? a2v[1] : a2v[0]; a1 = kp + (f32x2){dppf<0x128>(snd[0]), dppf<0x128>(snd[1])}; }
            const int col = 128 * x + 16 * cs + 2 * eg;
            const unsigned xw = *(const GAS unsigned*)(X1 + (size_t)rr * 1024 + col); const f32x2 xm = (f32x2){bflo(xw), bfhi(xw)}, g5 = *(const GAS f32x2*)(modl + (size_t)mr * 6144 + 5 * 1024 + col);
            const f32x2 xv = xm + g5 * a1;
            { GAS bf16_t* xb = rr < TL ? (GAS bf16_t*)(P.ws + WS_X0B) + (size_t)rr * 1024 : (GAS bf16_t*)(P.ws + WS_X0C) + (size_t)(rr - TL) * 1024;
                if (valid) *(GAS unsigned*)(xb + col) = pk2(xv[0], xv[1]); }
            tolds(s, cl, il);
            load1(s, clampr(row + 3 * stp)); };
        LAS float* cl0 = (LAS float*)(lds + w * 2048); LAS unsigned* il0 = (LAS unsigned*)(cl0 + 128);
        LAS float* cl1 = cl0 + 256; LAS unsigned* il1 = (LAS unsigned*)(cl1 + 128);
        VSt A, B;
        prime(A, cl0, il0, gwx, 2 * nW); prime(B, cl1, il1, gwx + nW, 2 * nW);
        for (int row = gwx; row < nrows; row += 2 * nW) { body(A, cl0, il0, row, 2 * nW); body(B, cl1, il1, row + nW, 2 * nW); }
    }
}
__device__ __forceinline__ void p8w_norm(const PV& P, int l, int nrows) {
    const int tid = otid(), lane = tid & 63, gw = blockIdx.x * 8 + __builtin_amdgcn_readfirstlane(tid >> 6), NGW = gridDim.x * 8;
    for (int row = gw; row < nrows; row += NGW) { const int mr = row < TL ? (row >> 11) : 8;
        float* xo = P.out + (size_t)row * 1024;
        float xn[16], y[16];
        { const GAS bf16_t* xb = row < TL ? (const GAS bf16_t*)(P.ws + WS_X0B) + (size_t)row * 1024 : (const GAS bf16_t*)(P.ws + WS_X0C) + (size_t)(row - TL) * 1024;
            const u32x4 xa = *(const GAS u32x4*)(xb + 16 * lane), xc = *(const GAS u32x4*)(xb + 16 * lane + 8);
#pragma unroll
            for (int e = 0; e < 4; ++e) { xn[2 * e] = bflo(xa[e]); xn[2 * e + 1] = bfhi(xa[e]); xn[8 + 2 * e] = bflo(xc[e]); xn[8 + 2 * e + 1] = bfhi(xc[e]); } }
        if (l == 0) { const float* mod1 = (const float*)(P.ws + WS_MOD) + (size_t)9 * 6144 + (size_t)mr * 6144;
            norm_mod16c(xn, PIN(I_N1G) + 1024, mod1, mod1 + 1024, lane, y);
            store_row16c_bf16((bf16_t*)(P.ws + WS_ACT) + (size_t)row * 1024, lane, y);
        } else { norm_mod16c(xn, PIN(I_FNG), (const float*)nullptr, (const float*)nullptr, lane, y); store_row16c_f32(xo, lane, y); }
    }
}

typedef __attribute__((address_space(1))) unsigned gu32;
#define XB_TMO      128
#define XB_XCNT(j)  (256  + 64 * (j))
#define XB_XSUB(j)  (1280 + 64 * (j))
#define XB_XGEN(j)  (2304 + 64 * (j))
#define XB_TOP      3328
#define XB_TOPGEN   3392
#define XCD_BAR_WORDS 3456
#define XB_SPIN_CAP (1u << 18)

__device__ __forceinline__ unsigned xb_ld(unsigned* p)              { return __hip_atomic_load(p, __ATOMIC_RELAXED, __HIP_MEMORY_SCOPE_AGENT); }
__device__ __forceinline__ unsigned xb_add(unsigned* p, unsigned v) { return __hip_atomic_fetch_add(p, v, __ATOMIC_RELAXED, __HIP_MEMORY_SCOPE_AGENT); }
__device__ __forceinline__ unsigned xb_xcc_id() { return (unsigned)__builtin_amdgcn_s_getreg((3 << 11) | 20) & 0xFu; }
#define XB_SPIN(cond, bar) do { unsigned _sp = 0; while (cond) { __builtin_amdgcn_s_sleep(1); \
    if ((++_sp & 255u) == 0u) { if (xb_ld(&(bar)[XB_TMO])) break; if (_sp > XB_SPIN_CAP) { atomicAdd(&(bar)[XB_TMO], 1u); break; } } } } while (0)

struct XcdBarrier {
    unsigned* bar; unsigned x;
    volatile LAS unsigned* st;
};

__device__ __forceinline__ XcdBarrier xcd_barrier_post(unsigned* bar, volatile LAS unsigned* st) {
    XcdBarrier b; b.bar = bar; b.x = xb_xcc_id(); b.st = st;
    if (threadIdx.x == 0) (void)xb_add(&bar[XB_XCNT(b.x)], 1u);
    return b;
}
__device__ __forceinline__ void xcd_barrier_complete(unsigned* bar, unsigned x, unsigned& nloc, unsigned& nx) {
    const unsigned G = gridDim.x * gridDim.y * gridDim.z;
    unsigned sum, cnt, mine, sp = 0u;
    for (;;) {
        sum = 0u; cnt = 0u; mine = 0u;
#pragma unroll
        for (unsigned j = 0; j < 16; ++j) { const unsigned c = xb_ld(&bar[XB_XCNT(j)]); sum += c; cnt += (c > 0u) ? 1u : 0u; mine = (j == x) ? c : mine; }
        if (sum == G) break;
        __builtin_amdgcn_s_sleep(1);
        if ((++sp & 255u) == 0u) { if (xb_ld(&bar[XB_TMO])) break; if (sp > XB_SPIN_CAP) { atomicAdd(&bar[XB_TMO], 1u); break; } }
    }
    nloc = mine > 0u ? mine : 1u; nx = cnt > 0u ? cnt : 1u;
}

__device__ __forceinline__ void xcd_barrier(const XcdBarrier& b) {
    asm volatile("s_waitcnt vmcnt(0)" ::: "memory");
    __syncthreads();
    if (threadIdx.x == 0) {
        unsigned* bar = b.bar;
        __builtin_amdgcn_s_waitcnt(0);
        unsigned nloc = b.st[0], nx = b.st[1];
        if (nloc == 0u) { xcd_barrier_complete(bar, b.x, nloc, nx); b.st[0] = nloc; b.st[1] = nx; }
        const unsigned old = xb_add(&bar[XB_XSUB(b.x)], 1u);
        const unsigned gen = old / nloc;
        if (old + 1u == (gen + 1u) * nloc) {
            __builtin_amdgcn_fence(__ATOMIC_RELEASE, "agent");
            asm volatile("s_waitcnt vmcnt(0)" ::: "memory");
            const unsigned og = xb_add(&bar[XB_TOP], 1u);
            const unsigned tg = og / nx;
            if (og + 1u == (tg + 1u) * nx) xb_add(&bar[XB_TOPGEN], 1u);
            else XB_SPIN(xb_ld(&bar[XB_TOPGEN]) == tg, bar);
            __builtin_amdgcn_fence(__ATOMIC_ACQUIRE, "agent");
            xb_add(&bar[XB_XGEN(b.x)], 1u);
            asm volatile("s_waitcnt vmcnt(0)" ::: "memory");
        } else {
            XB_SPIN(xb_ld(&bar[XB_XGEN(b.x)]) == gen, bar);
            __builtin_amdgcn_fence(__ATOMIC_ACQUIRE, "agent");
            asm volatile("s_waitcnt vmcnt(0)" ::: "memory");
        }
    }
    __syncthreads();
}

__device__ __forceinline__ void xcd_barrier_arrive(const XcdBarrier& b, volatile LAS unsigned* tk) {
    asm volatile("s_waitcnt vmcnt(0)" ::: "memory");
    __syncthreads();
    if (threadIdx.x == 0) {
        unsigned* bar = b.bar;
        __builtin_amdgcn_s_waitcnt(0);
        unsigned nloc = b.st[0], nx = b.st[1];
        if (nloc == 0u) { xcd_barrier_complete(bar, b.x, nloc, nx); b.st[0] = nloc; b.st[1] = nx; }
        const unsigned old = xb_add(&bar[XB_XSUB(b.x)], 1u);
        const unsigned gen = old / nloc;
        if (old + 1u == (gen + 1u) * nloc) {
            __builtin_amdgcn_fence(__ATOMIC_RELEASE, "agent");
            asm volatile("s_waitcnt vmcnt(0)" ::: "memory");
            const unsigned og = xb_add(&bar[XB_TOP], 1u);
            const unsigned tg = og / nx;
            if (og + 1u == (tg + 1u) * nx) xb_add(&bar[XB_TOPGEN], 1u);
            else XB_SPIN(xb_ld(&bar[XB_TOPGEN]) == tg, bar);
            __builtin_amdgcn_fence(__ATOMIC_ACQUIRE, "agent");
            xb_add(&bar[XB_XGEN(b.x)], 1u);
            asm volatile("s_waitcnt vmcnt(0)" ::: "memory");
            tk[1] = 0u;
        } else { tk[0] = gen; tk[1] = 1u; }
    }
    __syncthreads();
}
__device__ __forceinline__ void xcd_barrier_wait(const XcdBarrier& b, volatile LAS unsigned* tk) {
    __syncthreads();
    if (threadIdx.x == 0 && tk[1] != 0u) {
        unsigned* bar = b.bar; const unsigned gen = tk[0];
        XB_SPIN(xb_ld(&bar[XB_XGEN(b.x)]) == gen, bar);
        __builtin_amdgcn_fence(__ATOMIC_ACQUIRE, "agent");
        asm volatile("s_waitcnt vmcnt(0)" ::: "memory");
        tk[1] = 0u;
    }
    __syncthreads();
}

#define GSYNC() do { xcd_barrier(xbar); if (PROBE_DUP & 32) xcd_barrier(xbar); } while (0)
template <int l>
__device__ __forceinline__ void run_layer(const PV& P, const XcdBarrier& xbar) {
    const int nrows = l == 0 ? TT : TL;
    for (int rep = 0; rep < ((PROBE_DUP & 8) ? 2 : 1); ++rep) { const PV Q = opq(P);
        pg8::Gemm g{(const bf16_t*)(Q.ws + WS_ACT), (const bf16_t*)(Q.ws + WS_WIN) + (size_t)l * ZW * 1024, TT, ZW, 1024};
        pg8::StaticOrder S; S.init(TT, ZW, gridDim.x, blockIdx.x);
        pg8::EpiZ E{(bf16_t*)(Q.ws + WS_Z), ZW};
        pg8::gemm_phase<pg8::EpiZ, pg8::StaticOrder, true, true>(Q.lds, g, S, E);
        if ((int)gridDim.x == 256) { if ((int)blockIdx.x >= 24) for (int r2 = 0; r2 < ((PROBE_DUP & (1 << 20)) ? 2 : 1); ++r2) p0_tables(Q, l, blockIdx.x - 24, 232); }
        else p0_tables(Q, l, blockIdx.x, gridDim.x); }
    GSYNC();
    for (int rep = 0; rep < ((PROBE_DUP & 128) ? 2 : 1); ++rep) { const PV Q = opq(P); rwkv_pre(Q, l, Q.lds); }
    for (int rep = 0; rep < ((PROBE_DUP & 65536) ? 2 : 1); ++rep) { const PV Q = opq(P); lru_items(Q, l, Q.lds); }
    volatile LAS unsigned* tk = (volatile LAS unsigned*)(P.lds + LDS_BYTES - 32);
    xcd_barrier_arrive(xbar, tk);
    for (;;) {
        const PV Q = opq(P);
        __syncthreads();
        if (otid() == 0) *(LAS int*)(Q.lds + LDS_BYTES - 16) = (int)atomicAdd((unsigned*)(Q.ws + WS_CTL) + 64 * (1 + l), 1u);
        __syncthreads();
        const int u = *(LAS int*)(Q.lds + LDS_BYTES - 16);
        if (u >= 272) break;
        if (u < 128) { for (int r2 = 0; r2 < ((PROBE_DUP & 16384) ? 2 : 1); ++r2) s5_unit(Q, l, u, Q.lds); }
        else if (u < 192) { for (int r2 = 0; r2 < ((PROBE_DUP & 8192) ? 2 : 1); ++r2) ret_unit(Q, l, u - 128, Q.lds); }
        else { xcd_barrier_wait(xbar, tk);
            if (u < 256) { for (int r2 = 0; r2 < ((PROBE_DUP & 4096) ? 2 : 1); ++r2) rwkv_seq(Q, l, u - 192, Q.lds); }
            else lru_carry_unit(Q, u - 256); }
    }
    xcd_barrier_wait(xbar, tk);
    xcd_barrier_arrive(xbar, tk);
    { const PV Q = opq(P); p3_combine<0>(Q, l, nrows, Q.lds); }
    xcd_barrier_wait(xbar, tk);
    for (int rep = 0; rep < ((PROBE_DUP & 16) ? 2 : 1); ++rep) { const PV Q = opq(P); if (rep) p3_combine<0>(Q, l, nrows, Q.lds); p3_combine<1>(Q, l, nrows, Q.lds); __syncthreads(); }
    GSYNC();
    for (int rep = 0; rep < ((PROBE_DUP & 8) ? 2 : 1); ++rep) { const PV Q = opq(P);
        pg8::Gemm g{(const bf16_t*)(Q.ws + WS_S5G), (const bf16_t*)(Q.ws + WS_GLU) + (size_t)l * 512 * 256, nrows, 512, 256};
        pg8::StaticOrder S; S.init(nrows, 512, gridDim.x, blockIdx.x);
        pg8::EpiGlu E{(bf16_t*)(Q.ws + WS_ACT), inp_(Q.tab, I_GLUB) + l * 512};
        pg8::gemm_phase<pg8::EpiGlu, pg8::StaticOrder, true, true>(Q.lds, g, S, E); }
    GSYNC();
    for (int rep = 0; rep < ((PROBE_DUP & 8) ? 2 : 1); ++rep) { const PV Q = opq(P);
        pg8::Gemm g{(const bf16_t*)(Q.ws + WS_ACT), (const bf16_t*)(Q.ws + WS_WOUT) + (size_t)l * 1024 * 1024, nrows, 1024, 1024};
        pg8::StaticOrder S; S.init(nrows, 1024, gridDim.x, blockIdx.x);
        pg8::EpiRes E{l == 0 ? inp_(Q.tab, I_X) : (const float*)(Q.ws + WS_X0B), l == 0 ? inp_(Q.tab, I_CTX) : (const float*)(Q.ws + WS_X0C),
                      (const float*)(Q.ws + WS_MOD) + (size_t)l * 9 * 6144 + 2048, (float*)(Q.ws + WS_X1), l != 0};
        pg8::gemm_phase<pg8::EpiRes, pg8::StaticOrder, true, true>(Q.lds, g, S, E);
        if (l == 0 && (int)gridDim.x == 256) { if ((int)blockIdx.x >= 32) p0_weff(Q, 0, blockIdx.x - 32, 224, Q.lds); }
        else if (l == 0) p0_weff(Q, 0, blockIdx.x, gridDim.x, Q.lds); }
    GSYNC();
    for (int rep = 0; rep < ((PROBE_DUP & 16) ? 2 : 1); ++rep) { const PV Q = opq(P); p6_h2(Q, l, nrows); }
    GSYNC();
    for (int rep = 0; rep < ((PROBE_DUP & 8) ? 2 : 1); ++rep) { const PV Q = opq(P);
        pg8::Gemm g{(const bf16_t*)(Q.ws + WS_ACT), (const bf16_t*)(Q.ws + WS_WEFF) + (size_t)l * 2048 * 1024, nrows, 2048, 1024};
        pg8::StaticOrder S; S.init(nrows, 2048, gridDim.x, blockIdx.x);
        pg8::EpiF16 E{(bf16_t*)(Q.ws + WS_SC), 2048};
        pg8::gemm_phase<pg8::EpiF16, pg8::StaticOrder, true, true>(Q.lds, g, S, E);
        if (l == 0 && (int)gridDim.x == 256) { if ((int)blockIdx.x >= 64) { p0_transposes(Q, 1, blockIdx.x - 64, 192, Q.lds); __syncthreads(); p0_weff(Q, 1, blockIdx.x - 64, 192, Q.lds); } }
        else if (l == 0) { p0_transposes(Q, 1, blockIdx.x, gridDim.x, Q.lds); __syncthreads(); p0_weff(Q, 1, blockIdx.x, gridDim.x, Q.lds); } }
    GSYNC();
    for (int rep = 0; rep < ((PROBE_DUP & 4) ? 2 : 1); ++rep) { const PV Q = opq(P); p8a_topk(Q, nrows, Q.lds); }
    GSYNC();
    for (int rep = 0; rep < ((PROBE_DUP & 1) ? 2 : (PROBE_DUP & (1 << 21)) ? 3 : 1); ++rep) { const PV Q = opq(P); p8u_dots(Q, l, nrows); }
    GSYNC();
    for (int rep = 0; rep < ((PROBE_DUP & (1 << 22)) ? 2 : 1); ++rep) { const PV Q = opq(P); p8c_coef(Q, l, nrows); }
    GSYNC();
    for (int rep = 0; rep < ((PROBE_DUP & 2048) ? 2 : 1); ++rep) { const PV Q = opq(P); p8v_accum(Q, l, nrows, Q.lds); }
    GSYNC();
    { const PV Q = opq(P); p8w_norm(Q, l, nrows); }
    if (l == 0) GSYNC();
}

__global__ void __launch_bounds__(512, 2) fwd_mega(Params KP) {
    extern __shared__ __attribute__((aligned(16))) unsigned char lds_raw[];
    LAS unsigned char* lds = (LAS unsigned char*)lds_raw;
    cg::grid_group grid = cg::this_grid();
    const int tid = otid();
    PV P; P.tab = (const LAS unsigned*)(lds + LDS_BYTES - 1024); P.ws = KP.ws; P.out = KP.out; P.lds = lds;
    if (tid < 88) { const unsigned* ka = (const unsigned*)__builtin_amdgcn_kernarg_segment_ptr(); ((LAS unsigned*)(lds + LDS_BYTES - 1024))[tid] = ka[tid]; }
    if (tid < 12) ((LAS unsigned*)(lds + LDS_BYTES - 64))[tid] = 0u;
    __syncthreads();
    const XcdBarrier xbar = xcd_barrier_post((unsigned*)(KP.ws + WS_CTL) + 4096, (volatile LAS unsigned*)(lds + LDS_BYTES - 64));

    for (int rep = 0; rep < ((PROBE_DUP & 64) ? 2 : 1); ++rep) { const PV Q = opq(P); p0_prologue(Q, Q.lds); __syncthreads(); }
    if (KP.ws == nullptr) grid.sync();
    { volatile LAS unsigned* tk = (volatile LAS unsigned*)(lds + LDS_BYTES - 32);
        xcd_barrier_arrive(xbar, tk);
        for (int rep = 0; rep < ((PROBE_DUP & 64) ? 2 : 1); ++rep) { const PV Q = opq(P); p0_transposes(Q, 0, blockIdx.x, gridDim.x, Q.lds); __syncthreads(); }
        xcd_barrier_wait(xbar, tk); }
    { const PV Q = opq(P); p0b_ain(Q); }
    GSYNC();

    run_layer<0>(P, xbar);
    run_layer<1>(P, xbar);
}

extern "C" void kernel_launch(void* const* d_in, const int* in_sizes, int n_in, void* d_out, int out_size, void* d_ws, size_t ws_size, hipStream_t stream) {
    static int grid = 0;
    if (grid == 0) {
        if (n_in != 44 || out_size != TL * DM || ws_size < WS_END) { fprintf(stderr, "kernel_launch: unexpected shapes (n_in %d, out %d, ws %zu; need ws >= %zu)\n", n_in, out_size, ws_size, (size_t)WS_END); grid = -1; return; }
        int dev = 0, cus = 0, per_cu = 0;
        hipGetDevice(&dev); hipDeviceGetAttribute(&cus, hipDeviceAttributeMultiprocessorCount, dev);
        hipFuncSetAttribute((const void*)fwd_mega, hipFuncAttributeMaxDynamicSharedMemorySize, LDS_BYTES);
        hipOccupancyMaxActiveBlocksPerMultiprocessor(&per_cu, (const void*)fwd_mega, 512, LDS_BYTES);
        if (per_cu < 1) { fprintf(stderr, "kernel_launch: occupancy query says %d blocks/CU\n", per_cu); per_cu = 1; }
        grid = cus;
        (void)hipGetLastError();
    }
    if (grid < 0) return;
    hipMemsetAsync((char*)d_ws + WS_CTL, 0, 65536, stream);
    Params p{};
    for (int i = 0; i < 44; ++i) p.in[i] = (const float*)d_in[i];
    p.out = (float*)d_out; p.ws = (unsigned char*)d_ws;
    void* args[] = {&p};
    hipError_t e = hipLaunchCooperativeKernel((const void*)fwd_mega, dim3(grid), dim3(512), args, LDS_BYTES, stream);
    if (e != hipSuccess) fprintf(stderr, "cooperative launch failed: %s (grid %d)\n", hipGetErrorString(e), grid);
}
```
